# Optimizing an MI355X kernel written in HIP

```python
import math
import jax, jax.numpy as jnp
from jax import lax
import numpy as np

D_MODEL = 2048
BATCH = 4
SEQ = 4096
DEPTH = 1
DEC_BATCH = 8
DEC_SEQ = 64
PAST_LEN = 1024

CHUNK = 64
A_HEADS = 8
A_DK = 128
A_DV = 128
A_QK = A_HEADS * A_DK
A_WIDTH = A_HEADS * A_DV
B_HEADS = 8
B_DH = 64
B_DV = 2 * B_DH
B_QK = B_HEADS * 2 * B_DH
B_WIDTH = B_HEADS * B_DV
MIX_WIDTH = A_WIDTH + B_WIDTH
IN_SPLITS = [A_QK, 2 * A_QK, 2 * A_QK + A_WIDTH, 2 * A_QK + 2 * A_WIDTH,
             2 * A_QK + 2 * A_WIDTH + B_QK, 2 * A_QK + 2 * A_WIDTH + 2 * B_QK]
IN_COLS = 2 * A_QK + 2 * A_WIDTH + 2 * B_QK + B_WIDTH
Q_BLOCK = 128
PEER_HEADS = 8
N_KEYS = 128
N_EXPERTS = N_KEYS * N_KEYS
PEER_TOPK = 16
PEER_DQ = 256
PEER_DHALF = PEER_DQ // 2
TOKEN_BLOCK = 128
LN_EPS = 1e-5
RMS_EPS = 1e-5
DEEPNORM_ALPHA = (2.0 * DEPTH) ** 0.25
DEEPNORM_BETA = (8.0 * DEPTH) ** -0.25

kernel_name = "hymba_hgrn2_diffattn_peer_stream"


def layer_norm(x, g, b):
    xf = x.astype(jnp.float32)
    mu = jnp.mean(xf, axis=-1, keepdims=True)
    var = jnp.mean(jnp.square(xf - mu), axis=-1, keepdims=True)
    return ((xf - mu) * lax.rsqrt(var + LN_EPS)).astype(x.dtype) * g + b


def rms_norm(x, g):
    xf = x.astype(jnp.float32)
    return (xf * lax.rsqrt(jnp.mean(xf * xf, axis=-1, keepdims=True) + RMS_EPS)) * g


def hgrn2_recurrence(q, k, log_f, v, s0):
    bsz, length, h, _ = q.shape
    dv = v.shape[-1]
    c = min(CHUNK, length)
    n = length // c

    def chunks(t):
        return jnp.moveaxis(t.astype(jnp.float32).reshape(bsz, n, c, h, t.shape[-1]), 1, 0)

    causal = jnp.tril(jnp.ones((c, c), dtype=bool))[None, :, :, None, None]

    def step(s, inp):
        qc, kc, lfc, vc = inp
        b = jnp.cumsum(lfc, axis=1)
        decay = jnp.exp(jnp.where(causal, b[:, :, None] - b[:, None, :], -jnp.inf))
        scores = jnp.einsum('bthk,bshk,btshk->bhts', qc, kc, decay)
        o = (jnp.einsum('bhts,bshv->bthv', scores, vc)
             + jnp.einsum('bthk,bhkv->bthv', qc * jnp.exp(b), s))
        b_end = b[:, -1]
        s_new = (jnp.exp(b_end)[..., None] * s
                 + jnp.einsum('bshk,bshv->bhkv', kc * jnp.exp(b_end[:, None] - b), vc))
        return s_new, o

    s_fin, o = lax.scan(step, s0.astype(jnp.float32),
                        (chunks(q), chunks(k), chunks(log_f), chunks(v)))
    return jnp.moveaxis(o, 0, 1).reshape(bsz, length, h, dv), s_fin


def diff_attend(q, k, v, qpos, kpos, lam):
    slopes = 2.0 ** (-8.0 * jnp.arange(1, B_HEADS + 1, dtype=jnp.float32) / B_HEADS)
    s = jnp.einsum('bthmd,bshmd->bhmts', q, k).astype(jnp.float32) * (B_DH ** -0.5)
    dist = jnp.abs(qpos[:, None] - kpos[None, :]).astype(jnp.float32)
    visible = (kpos[None, :] // CHUNK) <= (qpos[:, None] // CHUNK)
    bias = jnp.where(visible[None], -slopes[:, None, None] * dist[None], -jnp.inf)
    p = jax.nn.softmax(s + bias[None, :, None], axis=-1)
    w = p[:, :, 0] - lam * p[:, :, 1]
    return jnp.einsum('bhts,bshv->bthv', w.astype(v.dtype), v)


def diff_attention_prompt(q, k, v, lam):
    bsz, length = q.shape[0], q.shape[1]
    nq = length // Q_BLOCK
    qb = jnp.moveaxis(q.reshape(bsz, nq, Q_BLOCK, B_HEADS, 2, B_DH), 1, 0)
    kpos = jnp.arange(length)

    def block(args):
        qi, i = args
        qpos = i * Q_BLOCK + jnp.arange(Q_BLOCK)
        return diff_attend(qi, k, v, qpos, kpos, lam)

    out = lax.map(block, (qb, jnp.arange(nq)))
    return jnp.moveaxis(out, 0, 1).reshape(bsz, length, B_HEADS, B_DV)


def peer(x, wq, sub_keys, u, v):
    bsz, length, d = x.shape
    n = bsz * length
    pad = (-n) % TOKEN_BLOCK
    xb = jnp.pad(x.reshape(n, d), ((0, pad), (0, 0))).reshape(-1, TOKEN_BLOCK, d)

    def block(xt):
        q = (xt @ wq).reshape(TOKEN_BLOCK, PEER_HEADS, 2, PEER_DHALF)
        s = jnp.einsum('thcd,hckd->thck', q, sub_keys).astype(jnp.float32)
        sv, si = lax.top_k(s, PEER_TOPK)
        cand = (sv[:, :, 0, :, None] + sv[:, :, 1, None, :]).reshape(TOKEN_BLOCK, PEER_HEADS, -1)
        cid = (si[:, :, 0, :, None] * N_KEYS + si[:, :, 1, None, :]).reshape(TOKEN_BLOCK, PEER_HEADS, -1)
        cv, ci = lax.top_k(cand, PEER_TOPK)
        eidx = jnp.take_along_axis(cid, ci, axis=-1)
        g = jax.nn.softmax(cv, axis=-1)
        act = jax.nn.gelu(jnp.einsum('thkd,td->thk', u[eidx], xt).astype(jnp.float32), approximate=False)
        return jnp.einsum('thk,thkd->td', (g * act).astype(xt.dtype), v[eidx])

    y = lax.map(block, xb).reshape(-1, d)[:n]
    return y.reshape(bsz, length, d)


def trunk_layer(x, past_k, past_v, s0, lb, lam, lam_init, w_in, a_norm_g, b_norm_g, w_out,
                ln1_g, ln1_b, peer_wq, peer_sub_keys, peer_u, peer_v, ln2_g, ln2_b):
    bsz, length, _ = x.shape
    qa, fa, ia, ga, qb, kb, vb = jnp.split(jnp.einsum('bld,dc->blc', x, w_in), IN_SPLITS, axis=-1)

    f = lb + (1.0 - lb) * jax.nn.sigmoid(fa.astype(jnp.float32))
    a_heads = lambda t, dd: t.reshape(bsz, length, A_HEADS, dd)
    if s0 is None:
        s0 = jnp.zeros((bsz, A_HEADS, A_DK, A_DV), jnp.float32)
    o_a, s_new = hgrn2_recurrence(a_heads(qa, A_DK), a_heads(1.0 - f, A_DK),
                                  a_heads(jnp.log(f), A_DK), a_heads(ia, A_DV), s0)
    o_a = rms_norm(o_a, a_norm_g) * jax.nn.sigmoid(a_heads(ga, A_DV).astype(jnp.float32))

    q = qb.reshape(bsz, length, B_HEADS, 2, B_DH)
    k_new = kb.reshape(bsz, length, B_HEADS, 2 * B_DH)
    v_new = vb.reshape(bsz, length, B_HEADS, B_DV)
    if past_k is None:
        o_b = diff_attention_prompt(q, k_new.reshape(bsz, length, B_HEADS, 2, B_DH), v_new, lam)
    else:
        past = past_k.shape[1]
        k_all = jnp.concatenate([past_k.astype(k_new.dtype), k_new], axis=1)
        v_all = jnp.concatenate([past_v.astype(v_new.dtype), v_new], axis=1)
        qpos = past + jnp.arange(length)
        kpos = jnp.arange(past + length)
        o_b = diff_attend(q, k_all.reshape(bsz, past + length, B_HEADS, 2, B_DH), v_all, qpos, kpos, lam)
    o_b = rms_norm(o_b, b_norm_g) * (1.0 - lam_init)

    merged = jnp.concatenate([o_a.reshape(bsz, length, A_WIDTH),
                              o_b.reshape(bsz, length, B_WIDTH)], axis=-1).astype(x.dtype)
    x = layer_norm(DEEPNORM_ALPHA * x + merged @ w_out, ln1_g, ln1_b)
    x = layer_norm(DEEPNORM_ALPHA * x + peer(x, peer_wq, peer_sub_keys, peer_u, peer_v), ln2_g, ln2_b)
    return x, k_new, v_new, s_new


def setup_inputs(seed: int = 0) -> dict:
    key = jax.random.key(seed)
    ks = jax.random.split(key, 24)
    f32 = jnp.float32
    nrm = lambda k, shape, s: jax.random.normal(k, shape, f32) * s
    beta = DEEPNORM_BETA
    col_scale = jnp.concatenate([jnp.ones((2 * A_QK,), f32), jnp.full((A_WIDTH,), beta, f32),
                                 jnp.ones((A_WIDTH + 2 * B_QK,), f32), jnp.full((B_WIDTH,), beta, f32)])
    return {
        "x_prompt": nrm(ks[0], (BATCH, SEQ, D_MODEL), 1.0),
        "x_sample": nrm(ks[1], (DEC_BATCH, DEC_SEQ, D_MODEL), 1.0),
        "cache_k": nrm(ks[2], (DEPTH, DEC_BATCH, PAST_LEN, B_HEADS, 2 * B_DH), 1.0),
        "cache_v": nrm(ks[3], (DEPTH, DEC_BATCH, PAST_LEN, B_HEADS, B_DV), 0.5),
        "state_hgrn": nrm(ks[4], (DEPTH, DEC_BATCH, A_HEADS, A_DK, A_DV), 0.5),
        "w_in": nrm(ks[5], (DEPTH, D_MODEL, IN_COLS), D_MODEL ** -0.5) * col_scale,
        "hgrn_lb": nrm(ks[6], (DEPTH + 1, A_QK), 0.1),
        "hgrn_norm_g": 1.0 + nrm(ks[7], (DEPTH, A_DV), 0.02),
        "diff_lq1": nrm(ks[8], (DEPTH, B_DH), 0.1),
        "diff_lk1": nrm(ks[9], (DEPTH, B_DH), 0.1),
        "diff_lq2": nrm(ks[10], (DEPTH, B_DH), 0.1),
        "diff_lk2": nrm(ks[11], (DEPTH, B_DH), 0.1),
        "diff_norm_g": 1.0 + nrm(ks[12], (DEPTH, B_DV), 0.02),
        "w_out": nrm(ks[13], (DEPTH, MIX_WIDTH, D_MODEL), beta * MIX_WIDTH ** -0.5),
        "ln1_g": 1.0 + nrm(ks[14], (DEPTH, D_MODEL), 0.02),
        "ln1_b": nrm(ks[15], (DEPTH, D_MODEL), 0.02),
        "peer_wq": nrm(ks[16], (DEPTH, D_MODEL, PEER_HEADS * PEER_DQ), D_MODEL ** -0.5),
        "peer_sub_keys": nrm(ks[17], (DEPTH, PEER_HEADS, 2, N_KEYS, PEER_DHALF), PEER_DHALF ** -0.5),
        "peer_u": nrm(ks[18], (DEPTH, N_EXPERTS, D_MODEL), D_MODEL ** -0.5),
        "peer_v": nrm(ks[19], (DEPTH, N_EXPERTS, D_MODEL), beta * PEER_HEADS ** -0.5),
        "ln2_g": 1.0 + nrm(ks[20], (DEPTH, D_MODEL), 0.02),
        "ln2_b": nrm(ks[21], (DEPTH, D_MODEL), 0.02),
    }


def reference(x_prompt, x_sample, cache_k, cache_v, state_hgrn, w_in, hgrn_lb, hgrn_norm_g,
              diff_lq1, diff_lk1, diff_lq2, diff_lk2, diff_norm_g, w_out, ln1_g, ln1_b,
              peer_wq, peer_sub_keys, peer_u, peer_v, ln2_g, ln2_b):
    lower_bounds = jnp.cumsum(jax.nn.softmax(hgrn_lb.astype(jnp.float32), axis=0), axis=0)
    y_p, y_s = x_prompt, x_sample
    kp_l, vp_l, sp_l, ks_l, vs_l, ss_l = [], [], [], [], [], []
    for l in range(DEPTH):
        lam_init = 0.8 - 0.6 * math.exp(-0.3 * l)
        lam = (jnp.exp(jnp.sum(diff_lq1[l].astype(jnp.float32) * diff_lk1[l].astype(jnp.float32)))
               - jnp.exp(jnp.sum(diff_lq2[l].astype(jnp.float32) * diff_lk2[l].astype(jnp.float32)))
               + lam_init)
        shared = (lower_bounds[l], lam, lam_init, w_in[l], hgrn_norm_g[l], diff_norm_g[l], w_out[l],
                  ln1_g[l], ln1_b[l], peer_wq[l], peer_sub_keys[l], peer_u[l], peer_v[l], ln2_g[l], ln2_b[l])
        y_p, kp, vp, sp = trunk_layer(y_p, None, None, None, *shared)
        y_s, kn, vn, sn = trunk_layer(y_s, cache_k[l], cache_v[l], state_hgrn[l], *shared)
        kp_l.append(kp); vp_l.append(vp); sp_l.append(sp)
        ks_l.append(kn); vs_l.append(vn); ss_l.append(sn)
    return (y_p, y_s, jnp.stack(kp_l), jnp.stack(vp_l), jnp.stack(sp_l),
            jnp.stack(ks_l), jnp.stack(vs_l), jnp.stack(ss_l))
```

```cpp
#include <hip/hip_runtime.h>
#include <hip/hip_cooperative_groups.h>
#include <stdint.h>
#include <cstdio>
namespace cg = cooperative_groups;

typedef unsigned short bf16_t;
typedef short bf16x8 __attribute__((ext_vector_type(8)));
typedef float f32x4 __attribute__((ext_vector_type(4)));
typedef unsigned u32x4 __attribute__((ext_vector_type(4)));
typedef unsigned u32x2 __attribute__((ext_vector_type(2)));

#define NTOK 16896
#define NPTOK 16384
#define LDS_BYTES 65536

#define OUT_Y   0
#define OUT_KP  34603008
#define OUT_VP  51380224
#define OUT_SP  68157440
#define OUT_KS  68681728
#define OUT_VS  69206016
#define OUT_SS  69730304

constexpr size_t SZ_XB     = (size_t)NTOK * 2048 * 2;
constexpr size_t SZ_T1K2   = (size_t)NTOK * 1024 * 2;
constexpr size_t SZ_W2     = (size_t)2048 * 2048 * 2;
constexpr size_t SZ_KS     = (size_t)64 * 1088 * 128 * 2;
constexpr size_t SZ_KP     = (size_t)32 * 4096 * 128 * 2;
constexpr size_t OFF_CTR   = 0;
constexpr size_t OFF_LB    = 4096;
constexpr size_t OFF_XB    = 8192;
constexpr size_t OFF_WINT  = OFF_XB + SZ_XB;
constexpr size_t OFF_WOUTT = OFF_WINT + (size_t)7168 * 2048 * 2;
constexpr size_t OFF_WQT   = OFF_WOUTT + SZ_W2;
constexpr size_t OFF_SKB   = OFF_WQT + SZ_W2;
constexpr size_t OFF_KS    = OFF_SKB + 524288;
constexpr size_t OFF_VTS   = OFF_KS + SZ_KS;
constexpr size_t OFF_R4    = OFF_VTS + SZ_KS;
constexpr size_t OFF_QA    = OFF_R4;
constexpr size_t OFF_LOGF  = OFF_QA + SZ_T1K2;
constexpr size_t OFF_IAT   = OFF_LOGF + 2 * SZ_T1K2;
constexpr size_t OFF_GA    = OFF_IAT + SZ_T1K2;
constexpr size_t OFF_QB    = OFF_GA + SZ_T1K2;
constexpr size_t OFF_KP    = OFF_QB + SZ_T1K2;
constexpr size_t OFF_VTP   = OFF_KP + SZ_KP;
constexpr size_t OFF_R4END = OFF_VTP + SZ_KP;
constexpr size_t OFF_X1F   = OFF_R4;
constexpr size_t OFF_UB    = OFF_XB;
constexpr size_t OFF_VB    = OFF_UB + (size_t)16384 * 2048;
constexpr size_t OFF_SCL   = OFF_VB + (size_t)16384 * 2048;
constexpr size_t OFF_MERGED= OFF_R4END;
constexpr size_t OFF_QP    = OFF_MERGED;
constexpr size_t OFF_X1B   = OFF_X1F + (size_t)NTOK * 2048 * 4;
constexpr size_t OFF_EIDX  = OFF_WINT;
constexpr size_t OFF_GATE  = OFF_EIDX + (size_t)NTOK * 128 * 4;
constexpr size_t OFF_DBUF  = OFF_WINT + (size_t)20 * 1024 * 1024;
constexpr size_t OFF_LS    = OFF_XB;
constexpr size_t WS_NEED_PAR = OFF_MERGED + SZ_XB;
static_assert((size_t)32 * 64 * 16 * 256 * 8 <= SZ_XB, "LS fits XB");
static_assert(OFF_SCL + 32768 * 4 <= OFF_WINT, "overlay"); static_assert(OFF_X1B + SZ_XB <= OFF_R4END, "overlay");

struct Params {
  const float* x_prompt; const float* x_sample; const float* cache_k; const float* cache_v; const float* state;
  const float* w_in; const float* hgrn_lb; const float* hgrn_g; const float* lq1; const float* lk1;
  const float* lq2; const float* lk2; const float* diff_g; const float* w_out; const float* ln1_g; const float* ln1_b;
  const float* wq; const float* subk; const float* pu; const float* pv; const float* ln2_g; const float* ln2_b;
  float* out; char* ws;
};

typedef __bf16 bf16x2_t __attribute__((ext_vector_type(2)));
typedef float f32x2_t __attribute__((ext_vector_type(2)));
__device__ __forceinline__ unsigned pk_bf16(float lo, float hi) {
  f32x2_t f = {lo, hi};
  bf16x2_t b = __builtin_convertvector(f, bf16x2_t);
  return __builtin_bit_cast(unsigned, b);
}
__device__ __forceinline__ float bf2f(unsigned short x) { return __uint_as_float(((unsigned)x) << 16); }
__device__ __forceinline__ float bflo(unsigned x) { return __uint_as_float(x << 16); }
__device__ __forceinline__ float bfhi(unsigned x) { return __uint_as_float(x & 0xffff0000u); }
__device__ __forceinline__ f32x4 mfma16(bf16x8 a, bf16x8 b, f32x4 c) {
  return __builtin_amdgcn_mfma_f32_16x16x32_bf16(a, b, c, 0, 0, 0);
}
__device__ __forceinline__ bf16x8 mk8(unsigned a, unsigned b, unsigned c, unsigned d) {
  u32x4 v = {a, b, c, d}; return __builtin_bit_cast(bf16x8, v);
}
__device__ __forceinline__ bf16x8 mk8(u32x2 a, u32x2 b) {
  u32x4 v = {a.x, a.y, b.x, b.y}; return __builtin_bit_cast(bf16x8, v);
}
__device__ __forceinline__ float wave_sum(float v) {
#pragma unroll
  for (int o = 32; o >= 1; o >>= 1) v += __shfl_xor(v, o);
  return v;
}

__device__ void transpose_conv(const float* __restrict__ W, bf16_t* __restrict__ WT, int K, int N, char* lds) {
  float* tile = (float*)lds;
  int tid_o = threadIdx.x; asm volatile("" : "+v"(tid_o)); const int tid = tid_o;
  const int nkt = K / 64, nnt = N / 64;
  for (int t = blockIdx.x; t < nkt * nnt; t += gridDim.x) {
    const int kt = t / nnt, nt = t % nnt;
    const int c = tid & 63, r0 = tid >> 6;
#pragma unroll 4
    for (int i = 0; i < 16; ++i) {
      int r = i * 4 + r0;
      tile[r * 65 + c] = W[(size_t)(kt * 64 + r) * N + nt * 64 + c];
    }
    __syncthreads();
#pragma unroll 4
    for (int i = 0; i < 16; ++i) {
      int n = i * 4 + r0;
      float v = tile[c * 65 + n];
      WT[(size_t)(nt * 64 + n) * K + kt * 64 + c] = (bf16_t)(pk_bf16(v, 0.f) & 0xffff);
    }
    __syncthreads();
  }
}

__device__ __forceinline__ void conv8(const float* __restrict__ src, bf16_t* __restrict__ dst) {
  f32x4 a = *(const f32x4*)src, b = *(const f32x4*)(src + 4);
  u32x4 o = {pk_bf16(a.x, a.y), pk_bf16(a.z, a.w), pk_bf16(b.x, b.y), pk_bf16(b.z, b.w)};
  *(u32x4*)dst = o;
}

__device__ void phase0(const Params& p, char* lds) {
  int tid_o = threadIdx.x; asm volatile("" : "+v"(tid_o)); const int tid = tid_o, bid = blockIdx.x;
  const size_t gtid = (size_t)bid * 256 + tid, gsz = (size_t)gridDim.x * 256;
  if (bid == 0) {
    if (tid < 64) {
      float a = p.lq1[tid] * p.lk1[tid], b = p.lq2[tid] * p.lk2[tid];
      a = wave_sum(a); b = wave_sum(b);
      if (tid == 0) ((float*)(p.ws + OFF_CTR))[16] = expf(a) - expf(b) + 0.2f;
    }
    float* LB = (float*)(p.ws + OFF_LB);
    for (int k = tid; k < 1024; k += 256) {
      float a0 = p.hgrn_lb[k], a1 = p.hgrn_lb[1024 + k];
      LB[k] = 1.0f / (1.0f + expf(a1 - a0));
    }
  }
  {
    bf16_t* XB = (bf16_t*)(p.ws + OFF_XB);
    const size_t nch = (size_t)NTOK * 2048 / 8;
    for (size_t c = gtid; c < nch; c += gsz) {
      size_t e = c * 8;
      const float* src = (e < (size_t)NPTOK * 2048) ? (p.x_prompt + e) : (p.x_sample + (e - (size_t)NPTOK * 2048));
      conv8(src, XB + e);
    }
  }
  {
    bf16_t* KS = (bf16_t*)(p.ws + OFF_KS);
    for (size_t c = gtid; c < (size_t)1048576; c += gsz) {
      int d8 = c & 15, h = (c >> 4) & 7, s = (c >> 7) & 1023, b = (int)(c >> 17);
      conv8(p.cache_k + c * 8, KS + ((size_t)((b * 8 + h) * 1088 + s) * 128 + d8 * 8));
    }
  }
  {
    bf16_t* VTS = (bf16_t*)(p.ws + OFF_VTS);
    for (size_t i = gtid; i < (size_t)2097152; i += gsz) {
      int vc = i & 127, s4 = (i >> 7) & 255, h = (i >> 15) & 7, b = (int)(i >> 18);
      const float* src = p.cache_v + ((size_t)(b * 1024 + s4 * 4) * 8 + h) * 128 + vc;
      float v0 = src[0], v1 = src[1024], v2 = src[2048], v3 = src[3072];
      u32x2 o = {pk_bf16(v0, v1), pk_bf16(v2, v3)};
      *(u32x2*)(VTS + ((size_t)((b * 8 + h) * 128 + vc) * 1088 + s4 * 4)) = o;
    }
  }
  {
    bf16_t* SKB = (bf16_t*)(p.ws + OFF_SKB);
    for (size_t c = gtid; c < (size_t)32768; c += gsz) conv8(p.subk + c * 8, SKB + c * 8);
  }
  transpose_conv(p.w_in, (bf16_t*)(p.ws + OFF_WINT), 2048, 7168, lds);
  transpose_conv(p.w_out, (bf16_t*)(p.ws + OFF_WOUTT), 2048, 2048, lds);
  transpose_conv(p.wq, (bf16_t*)(p.ws + OFF_WQT), 2048, 2048, lds);
}

template <bool SWAP>
__device__ __forceinline__ void gemm_compute_tile(const char* cur, int aoff, int boff, int sw, int fq, f32x4 (&acc)[4][4]) {
#pragma unroll
  for (int ks = 0; ks < 2; ++ks) {
    bf16x8 af[4], bfr[4];
    const int ch = ((ks * 4 + fq) ^ sw) << 4;
#pragma unroll
    for (int m = 0; m < 4; ++m) af[m] = *(const bf16x8*)(cur + aoff + m * 2048 + ch);
#pragma unroll
    for (int n = 0; n < 4; ++n) bfr[n] = *(const bf16x8*)(cur + boff + n * 2048 + ch);
#pragma unroll
    for (int m = 0; m < 4; ++m)
#pragma unroll
      for (int n = 0; n < 4; ++n)
        acc[m][n] = SWAP ? mfma16(bfr[n], af[m], acc[m][n]) : mfma16(af[m], bfr[n], acc[m][n]);
  }
}

template <bool SWAP>
__device__ __forceinline__ void gemm_mainloop(const bf16_t* A, const bf16_t* B,
                                              int row0, int col0, int K, char* lds, f32x4 (&acc)[4][4]) {
  int tid_o = threadIdx.x; asm volatile("" : "+v"(tid_o)); const int tid = tid_o, lane = tid & 63, wave = tid >> 6;
  const int wm = wave >> 1, wn = wave & 1, fr = lane & 15, fq = lane >> 4;
  const int lrow = tid >> 3, lc = tid & 7;
  const int cl = lc ^ (lrow & 7);
  const bf16_t* ga = A + (size_t)(row0 + lrow) * K + cl * 8;
  const bf16_t* gb = B + (size_t)(col0 + lrow) * K + cl * 8;
  const int loff = tid * 16;
#define G_STAGE(BUF, KT) { _Pragma("unroll") for (int i = 0; i < 4; ++i) { \
      __builtin_amdgcn_global_load_lds((const unsigned*)(ga + (size_t)i * 32 * K + (KT) * 64), (unsigned*)((BUF) + loff + i * 4096), 16, 0, 0); \
      __builtin_amdgcn_global_load_lds((const unsigned*)(gb + (size_t)i * 32 * K + (KT) * 64), (unsigned*)((BUF) + 16384 + loff + i * 4096), 16, 0, 0); } }
  const int nkt = K >> 6;
  G_STAGE(lds, 0);
  __syncthreads();
  const int aoff = (wm * 64 + fr) * 128, boff = 16384 + (wn * 64 + fr) * 128;
  const int sw = fr & 7;
  for (int kt = 0; kt < nkt; ++kt) {
    char* cur = lds + (kt & 1) * 32768;
    char* nxt = lds + ((kt + 1) & 1) * 32768;
    if (kt + 1 < nkt) G_STAGE(nxt, kt + 1);
    gemm_compute_tile<SWAP>(cur, aoff, boff, sw, fq, acc);
    __syncthreads();
  }
#undef G_STAGE
}

template <bool SWAP>
__device__ __forceinline__ void gemm_mainloop_big(const bf16_t* A, const bf16_t* B,
                                                  int row0, int col0, int K, char* lds, f32x4 (&acc)[8][4]) {
  int tid_o = threadIdx.x; asm volatile("" : "+v"(tid_o)); const int tid = tid_o, lane = tid & 63, wave = tid >> 6;
  const int wm = wave >> 1, wn = wave & 1, fr = lane & 15, fq = lane >> 4;
  const int lrow = tid >> 3, lc = tid & 7;
  const int cl = lc ^ (lrow & 7);
  const bf16_t* ga = A + (size_t)(row0 + lrow) * K + cl * 8;
  const bf16_t* gb = B + (size_t)(col0 + lrow) * K + cl * 8;
  const int loff = tid * 16;
  const int nkt = K >> 6;
  const int aoff = (wm * 128 + fr) * 128, boff = 32768 + (wn * 64 + fr) * 128;
  const int sw = fr & 7;
  for (int kt = 0; kt < nkt; ++kt) {
#pragma unroll
    for (int i = 0; i < 8; ++i)
      __builtin_amdgcn_global_load_lds((const unsigned*)(ga + (size_t)i * 32 * K + kt * 64), (unsigned*)(lds + loff + i * 4096), 16, 0, 0);
#pragma unroll
    for (int i = 0; i < 4; ++i)
      __builtin_amdgcn_global_load_lds((const unsigned*)(gb + (size_t)i * 32 * K + kt * 64), (unsigned*)(lds + 32768 + loff + i * 4096), 16, 0, 0);
    __syncthreads();
#pragma unroll
    for (int ks = 0; ks < 2; ++ks) {
      bf16x8 af[8], bfr[4];
      const int ch = ((ks * 4 + fq) ^ sw) << 4;
#pragma unroll
      for (int m = 0; m < 8; ++m) af[m] = *(const bf16x8*)(lds + aoff + m * 2048 + ch);
#pragma unroll
      for (int n = 0; n < 4; ++n) bfr[n] = *(const bf16x8*)(lds + boff + n * 2048 + ch);
#pragma unroll
      for (int m = 0; m < 8; ++m)
#pragma unroll
        for (int n = 0; n < 4; ++n)
          acc[m][n] = SWAP ? mfma16(bfr[n], af[m], acc[m][n]) : mfma16(af[m], bfr[n], acc[m][n]);
    }
    __syncthreads();
  }
}

template <bool SWAP>
__device__ void gemm1_tile(const Params& p, int mt, int nt, char* lds) {
  f32x4 acc[8][4];
#pragma unroll
  for (int m = 0; m < 8; ++m)
#pragma unroll
    for (int n = 0; n < 4; ++n) acc[m][n] = (f32x4){0.f, 0.f, 0.f, 0.f};
  gemm_mainloop_big<SWAP>((const bf16_t*)(p.ws + OFF_XB), (const bf16_t*)(p.ws + OFF_WINT), mt * 256, nt * 128, 2048, lds, acc);
  int tidv = threadIdx.x; asm volatile("" : "+v"(tidv));
  const int tid = tidv, lane = tid & 63, wave = tid >> 6;
  const int wm = wave >> 1, wn = wave & 1, fr = lane & 15, fq = lane >> 4;
  const int seg = nt >> 3, h = nt & 7;
  const bool samp = (mt * 256 >= NPTOK);
  if (SWAP) {
    const float* LB = (const float*)(p.ws + OFF_LB);
#pragma unroll
    for (int m = 0; m < 8; ++m) {
      const int tok = mt * 256 + wm * 128 + m * 16 + fr;
#pragma unroll
      for (int n = 0; n < 4; ++n) {
        const int cl = wn * 64 + n * 16 + fq * 4;
        const int kidx = h * 128 + cl;
        f32x4 v = acc[m][n];
        if (seg == 0) {
          u32x2 o = {pk_bf16(v.x, v.y), pk_bf16(v.z, v.w)};
          *(u32x2*)((bf16_t*)(p.ws + OFF_QA) + (size_t)tok * 1024 + kidx) = o;
        } else if (seg == 1) {
          f32x4 lb = *(const f32x4*)(LB + kidx);
          f32x4 o;
          o.x = lb.x + (1.f - lb.x) / (1.f + __expf(-v.x));
          o.y = lb.y + (1.f - lb.y) / (1.f + __expf(-v.y));
          o.z = lb.z + (1.f - lb.z) / (1.f + __expf(-v.z));
          o.w = lb.w + (1.f - lb.w) / (1.f + __expf(-v.w));
          *(f32x4*)((float*)(p.ws + OFF_LOGF) + (size_t)tok * 1024 + kidx) = o;
        } else if (seg == 3) {
          float s0 = 1.f / (1.f + __expf(-v.x)), s1 = 1.f / (1.f + __expf(-v.y));
          float s2 = 1.f / (1.f + __expf(-v.z)), s3 = 1.f / (1.f + __expf(-v.w));
          u32x2 o = {pk_bf16(s0, s1), pk_bf16(s2, s3)};
          *(u32x2*)((bf16_t*)(p.ws + OFF_GA) + (size_t)tok * 1024 + kidx) = o;
        } else if (seg == 4) {
          const float sc = 0.18033688011112042f;
          u32x2 o = {pk_bf16(v.x * sc, v.y * sc), pk_bf16(v.z * sc, v.w * sc)};
          *(u32x2*)((bf16_t*)(p.ws + OFF_QB) + (size_t)tok * 1024 + kidx) = o;
        } else {
          u32x2 o = {pk_bf16(v.x, v.y), pk_bf16(v.z, v.w)};
          if (!samp) {
            *(f32x4*)(p.out + OUT_KP + (size_t)tok * 1024 + kidx) = v;
            const int b = tok >> 12, t = tok & 4095;
            *(u32x2*)((bf16_t*)(p.ws + OFF_KP) + ((size_t)((b * 8 + h) * 4096 + t) * 128 + cl)) = o;
          } else {
            const int ts = tok - NPTOK;
            *(f32x4*)(p.out + OUT_KS + (size_t)ts * 1024 + kidx) = v;
            const int b = ts >> 6, t = ts & 63;
            *(u32x2*)((bf16_t*)(p.ws + OFF_KS) + ((size_t)((b * 8 + h) * 1088 + 1024 + t) * 128 + cl)) = o;
          }
        }
      }
    }
  } else {
#pragma unroll
    for (int m = 0; m < 8; ++m) {
      const int tok0 = mt * 256 + wm * 128 + m * 16 + fq * 4;
#pragma unroll
      for (int n = 0; n < 4; ++n) {
        const int cl = wn * 64 + n * 16 + fr;
        f32x4 v = acc[m][n];
        u32x2 o = {pk_bf16(v.x, v.y), pk_bf16(v.z, v.w)};
        if (seg == 2) {
          bf16_t* IAT = (bf16_t*)(p.ws + OFF_IAT);
          if (!samp) {
            const int b = tok0 >> 12, t = tok0 & 4095;
            *(u32x2*)(IAT + ((size_t)((b * 8 + h) * 128 + cl) * 4096 + t)) = o;
          } else {
            const int ts = tok0 - NPTOK, b = ts >> 6, t = ts & 63;
            *(u32x2*)(IAT + (size_t)32 * 128 * 4096 + ((size_t)((b * 8 + h) * 128 + cl) * 64 + t)) = o;
          }
        } else {
          if (!samp) {
            float* ov = p.out + OUT_VP + (size_t)tok0 * 1024 + h * 128 + cl;
            ov[0] = v.x; ov[1024] = v.y; ov[2048] = v.z; ov[3072] = v.w;
            const int b = tok0 >> 12, t = tok0 & 4095;
            *(u32x2*)((bf16_t*)(p.ws + OFF_VTP) + ((size_t)((b * 8 + h) * 128 + cl) * 4096 + t)) = o;
          } else {
            const int ts = tok0 - NPTOK, b = ts >> 6, t = ts & 63;
            float* ov = p.out + OUT_VS + (size_t)ts * 1024 + h * 128 + cl;
            ov[0] = v.x; ov[1024] = v.y; ov[2048] = v.z; ov[3072] = v.w;
            *(u32x2*)((bf16_t*)(p.ws + OFF_VTS) + ((size_t)((b * 8 + h) * 128 + cl) * 1088 + 1024 + t)) = o;
          }
        }
      }
    }
  }
}

__device__ void phase1(const Params& p, char* lds) {
  const int xcd = blockIdx.x & 7, lb = blockIdx.x >> 3, nbx = gridDim.x >> 3;
  const int nM = NTOK / 256, nNx = 7;
  for (int li = lb; li < nM * nNx; li += nbx) {
    const int mt = li / nNx, nt = (li % nNx) * 8 + xcd;
    const int seg = nt >> 3;
    if (seg == 2 || seg == 6) gemm1_tile<false>(p, mt, nt, lds);
    else gemm1_tile<true>(p, mt, nt, lds);
  }
}

template <int MODE>
__device__ void gemm23(const Params& p, char* lds) {
  const int xcd = blockIdx.x & 7, lb = blockIdx.x >> 3, nbx = gridDim.x >> 3;
  const int nM = NTOK / 128, nNx = 2;
  const bf16_t* A = (const bf16_t*)(p.ws + (MODE == 0 ? OFF_MERGED : OFF_X1B));
  const bf16_t* B = (const bf16_t*)(p.ws + (MODE == 0 ? OFF_WOUTT : OFF_WQT));
  int tid_o = threadIdx.x; asm volatile("" : "+v"(tid_o)); const int tid = tid_o, lane = tid & 63, wave = tid >> 6;
  const int wm = wave >> 1, wn = wave & 1, fr = lane & 15, fq = lane >> 4;
  for (int li = lb; li < nM * nNx; li += nbx) {
    const int mt = li / nNx, nt = (li % nNx) * 8 + xcd;
    f32x4 acc[4][4];
#pragma unroll
    for (int m = 0; m < 4; ++m)
#pragma unroll
      for (int n = 0; n < 4; ++n) acc[m][n] = (f32x4){0.f, 0.f, 0.f, 0.f};
    gemm_mainloop<true>(A, B, mt * 128, nt * 128, 2048, lds, acc);
#pragma unroll
    for (int m = 0; m < 4; ++m) {
      const int tok = mt * 128 + wm * 64 + m * 16 + fr;
#pragma unroll
      for (int n = 0; n < 4; ++n) {
        const int col = nt * 128 + wn * 64 + n * 16 + fq * 4;
        f32x4 v = acc[m][n];
        if (MODE == 0) {
          const float* xin = (tok < NPTOK) ? (p.x_prompt + (size_t)tok * 2048) : (p.x_sample + (size_t)(tok - NPTOK) * 2048);
          f32x4 xv = *(const f32x4*)(xin + col);
          const float al = 1.189207115002721f;
          u32x2 o = {pk_bf16(al * xv.x + v.x, al * xv.y + v.y), pk_bf16(al * xv.z + v.z, al * xv.w + v.w)};
          *(u32x2*)((bf16_t*)(p.ws + OFF_X1B) + (size_t)tok * 2048 + col) = o;
        } else {
          u32x2 o = {pk_bf16(v.x, v.y), pk_bf16(v.z, v.w)};
          *(u32x2*)((bf16_t*)(p.ws + OFF_QP) + (size_t)tok * 2048 + col) = o;
        }
      }
    }
  }
}

__device__ void hgrn_item(const Params& p, int kind, int b, int h, char* lds, int mode, int c0) {
  int tid_o = threadIdx.x; asm volatile("" : "+v"(tid_o)); const int tid = tid_o, lane = tid & 63, w = tid >> 6, fr = lane & 15, fq = lane >> 4;
  const int tokbase = kind == 0 ? b * 4096 : NPTOK + b * 64;
  const int c_begin = mode == 0 ? 0 : c0, nch = mode == 0 ? (kind == 0 ? 64 : 1) : c0 + 1;
  u32x2* LSb = (u32x2*)(p.ws + OFF_LS) + ((size_t)((b * 8 + h) * 64 + c0) * 16) * 256 + tid;
  const bf16_t* IATb = (const bf16_t*)(p.ws + OFF_IAT) +
      (kind == 0 ? (size_t)((b * 8 + h) * 128) * 4096 : (size_t)32 * 128 * 4096 + (size_t)((b * 8 + h) * 128) * 64);
  const int iat_stride = kind == 0 ? 4096 : 64;
  const float* LOGF = (const float*)(p.ws + OFF_LOGF);
  const bf16_t* QA = (const bf16_t*)(p.ws + OFF_QA);
  const bf16_t* GA = (const bf16_t*)(p.ws + OFF_GA);
  bf16_t* MERGED = (bf16_t*)(p.ws + OFF_MERGED);

  f32x4 S[8][2];
  if (mode == 2) {
#pragma unroll
    for (int kt = 0; kt < 8; ++kt)
#pragma unroll
      for (int vv = 0; vv < 2; ++vv) {
        u32x2 t = LSb[(kt * 2 + vv) * 256];
        S[kt][vv] = (f32x4){bflo(t.x), bfhi(t.x), bflo(t.y), bfhi(t.y)};
      }
  } else if (kind == 0) {
#pragma unroll
    for (int kt = 0; kt < 8; ++kt)
#pragma unroll
      for (int vv = 0; vv < 2; ++vv) S[kt][vv] = (f32x4){0.f, 0.f, 0.f, 0.f};
  } else {
    const float* st = p.state + (size_t)((b * 8 + h) * 128) * 128 + (4 * fq) * 128 + 32 * w + fr;
#pragma unroll
    for (int kt = 0; kt < 8; ++kt)
#pragma unroll
      for (int vv = 0; vv < 2; ++vv)
#pragma unroll
        for (int j = 0; j < 4; ++j) S[kt][vv][j] = st[(16 * kt + j) * 128 + 16 * vv];
  }
  f32x4 gn[2];
#pragma unroll
  for (int vv = 0; vv < 2; ++vv) gn[vv] = *(const f32x4*)(p.hgrn_g + 32 * w + 16 * vv + 4 * fq);

  const int ekp = tid & 63, eq = tid >> 6;

  u32x4 gR[8];
  unsigned qn[16];
#pragma unroll
  for (int i = 0; i < 8; ++i) {
    int id = tid + 256 * i, row = id >> 5, cc = id & 31;
    gR[i] = *(const u32x4*)(LOGF + (size_t)(tokbase + c_begin * 64 + row) * 1024 + h * 128 + cc * 4);
  }
#pragma unroll
  for (int i = 0; i < 16; ++i) qn[i] = *(const unsigned*)(QA + (size_t)(tokbase + c_begin * 64 + 16 * eq + i) * 1024 + h * 128 + 2 * ekp);
  for (int c = c_begin; c < nch; ++c) {
    int zz = 0; asm volatile("" : "+v"(zz));
    int tidv = threadIdx.x; asm volatile("" : "+v"(tidv));
    const int tid = tidv, lane = tid & 63, w = tid >> 6, fr = lane & 15, fq = lane >> 4, ekp = tid & 63, eq = tid >> 6;
    char* L = lds + zz;
    float* Dl = (float*)(L + 57344);
    float* part = (float*)(L + 57856);
    const int tok0 = tokbase + c * 64 + zz;
#pragma unroll
    for (int i = 0; i < 8; ++i) {
      int id = tid + 256 * i, row = id >> 5, cc = id & 31;
      *(u32x4*)(L + row * 512 + cc * 16) = gR[i];
    }
    unsigned qv[16];
#pragma unroll
    for (int i = 0; i < 16; ++i) qv[i] = qn[i];
    if (c + 1 < nch) {
#pragma unroll
      for (int i = 0; i < 8; ++i) {
        int id = tid + 256 * i, row = id >> 5, cc = id & 31;
        gR[i] = *(const u32x4*)(LOGF + (size_t)(tok0 + 64 + row) * 1024 + h * 128 + cc * 4);
      }
    }
    bf16x8 vfr[2][2];
#pragma unroll
    for (int ss = 0; ss < 2; ++ss)
#pragma unroll
      for (int vv = 0; vv < 2; ++vv)
        vfr[ss][vv] = *(const bf16x8*)(IATb + (size_t)(32 * w + 16 * vv + fr) * iat_stride + c * 64 + zz + 32 * ss + 8 * fq);
    __syncthreads();
    typedef float f32x2 __attribute__((ext_vector_type(2)));
    f32x2 gv[16];
    const float* Gl = (const float*)L;
    float* qtot = (float*)(L + 58880);
    float tot0 = 1.f, tot1 = 1.f;
#pragma unroll
    for (int i = 0; i < 16; ++i) { gv[i] = *(const f32x2*)(Gl + (16 * eq + i) * 128 + 2 * ekp); tot0 *= gv[i].x; tot1 *= gv[i].y; }
    qtot[eq * 128 + 2 * ekp] = tot0; qtot[eq * 128 + 2 * ekp + 1] = tot1;
    __syncthreads();
    {
      float run0 = 1.f, run1 = 1.f;
      for (int qq = 0; qq < eq; ++qq) { run0 *= qtot[qq * 128 + 2 * ekp]; run1 *= qtot[qq * 128 + 2 * ekp + 1]; }
      const int k0 = 2 * ekp;
#pragma unroll
      for (int i4 = 0; i4 < 4; ++i4) {
        float ka[4], kb[4];
#pragma unroll
        for (int ii = 0; ii < 4; ++ii) {
          const int i = i4 * 4 + ii, t = 16 * eq + i;
          const float f0 = gv[i].x, f1 = gv[i].y;
          run0 *= f0; run1 *= f1;
          const float q0 = bflo(qv[i]) * run0, q1 = bfhi(qv[i]) * run1;
          const float kk0 = (1.f - f0) * __builtin_amdgcn_rcpf(run0), kk1 = (1.f - f1) * __builtin_amdgcn_rcpf(run1);
          ka[ii] = kk0; kb[ii] = kk1;
          const int o = (t * 128 + ((((k0 >> 3) ^ (t & 15)) << 3) | (k0 & 7))) * 2;
          if (mode != 1) {
            *(unsigned*)(L + o) = pk_bf16(q0, q1);
            *(unsigned*)(L + 16384 + o) = pk_bf16(kk0, kk1);
          }
        }
        const int t0 = 16 * eq + i4 * 4;
        u32x2 oa = {pk_bf16(ka[0], ka[1]), pk_bf16(ka[2], ka[3])};
        u32x2 ob = {pk_bf16(kb[0], kb[1]), pk_bf16(kb[2], kb[3])};
        if (mode != 2) {
          *(u32x2*)(L + 32768 + k0 * 128 + ((((t0 >> 3) ^ (k0 & 7)) << 4) | ((t0 & 7) << 1))) = oa;
          *(u32x2*)(L + 32768 + (k0 + 1) * 128 + ((((t0 >> 3) ^ ((k0 + 1) & 7)) << 4) | ((t0 & 7) << 1))) = ob;
        }
      }
      if (eq == 3) { Dl[k0] = run0; Dl[k0 + 1] = run1; }
    }
    if (c + 1 < nch) {
#pragma unroll
      for (int i = 0; i < 16; ++i) qn[i] = *(const unsigned*)(QA + (size_t)(tok0 + 64 + 16 * eq + i) * 1024 + h * 128 + 2 * ekp);
    }
    __syncthreads();
    if (mode != 1) {
      bf16x8 qf[4];
#pragma unroll
      for (int ks = 0; ks < 4; ++ks) {
        const int t = 16 * w + fr;
        qf[ks] = *(const bf16x8*)(L + t * 256 + (((4 * ks + fq) ^ (t & 15)) << 4));
      }
#pragma unroll
      for (int st = 0; st < 4; ++st) {
        f32x4 a = {0.f, 0.f, 0.f, 0.f};
#pragma unroll
        for (int ks = 0; ks < 4; ++ks) {
          const int s = 16 * st + fr;
          bf16x8 kf = *(const bf16x8*)(L + 16384 + s * 256 + (((4 * ks + fq) ^ (s & 15)) << 4));
          a = mfma16(kf, qf[ks], a);
        }
        const int t = 16 * w + fr, s0 = 16 * st + 4 * fq;
        float p0 = (s0 + 0 <= t) ? a.x : 0.f, p1 = (s0 + 1 <= t) ? a.y : 0.f;
        float p2 = (s0 + 2 <= t) ? a.z : 0.f, p3 = (s0 + 3 <= t) ? a.w : 0.f;
        u32x2 o2 = {pk_bf16(p0, p1), pk_bf16(p2, p3)};
        *(u32x2*)(L + 49152 + t * 128 + ((((s0 >> 3) ^ (t & 7)) << 4) | ((s0 & 7) << 1))) = o2;
      }
    }
    f32x4 O[2][4];
#pragma unroll
    for (int vv = 0; vv < 2; ++vv)
#pragma unroll
      for (int tt = 0; tt < 4; ++tt) O[vv][tt] = (f32x4){0.f, 0.f, 0.f, 0.f};
    if (mode != 1) {
#pragma unroll
    for (int ks = 0; ks < 4; ++ks) {
      bf16x8 sf[2];
#pragma unroll
      for (int vv = 0; vv < 2; ++vv)
        sf[vv] = mk8(pk_bf16(S[2 * ks][vv].x, S[2 * ks][vv].y), pk_bf16(S[2 * ks][vv].z, S[2 * ks][vv].w),
                     pk_bf16(S[2 * ks + 1][vv].x, S[2 * ks + 1][vv].y), pk_bf16(S[2 * ks + 1][vv].z, S[2 * ks + 1][vv].w));
#pragma unroll
      for (int tt = 0; tt < 4; ++tt) {
        const int t = 16 * tt + fr;
        const int c0 = 4 * ks + (fq >> 1), c1 = 4 * ks + 2 + (fq >> 1);
        u32x2 q0 = *(const u32x2*)(L + t * 256 + ((c0 ^ (t & 15)) << 4) + ((fq & 1) << 3));
        u32x2 q1 = *(const u32x2*)(L + t * 256 + ((c1 ^ (t & 15)) << 4) + ((fq & 1) << 3));
        bf16x8 qp = mk8(q0, q1);
#pragma unroll
        for (int vv = 0; vv < 2; ++vv) O[vv][tt] = mfma16(sf[vv], qp, O[vv][tt]);
      }
    }
    }
    __syncthreads();
#pragma unroll
    for (int ss = 0; ss < 2; ++ss) {
      bf16x8 vf[2];
#pragma unroll
      for (int vv = 0; vv < 2; ++vv) vf[vv] = vfr[ss][vv];
      if (mode != 1) {
#pragma unroll
      for (int tt = 0; tt < 4; ++tt) {
        const int t = 16 * tt + fr;
        bf16x8 pf = *(const bf16x8*)(L + 49152 + t * 128 + (((4 * ss + fq) ^ (t & 7)) << 4));
#pragma unroll
        for (int vv = 0; vv < 2; ++vv) O[vv][tt] = mfma16(vf[vv], pf, O[vv][tt]);
      }
      }
      if (mode != 2) {
#pragma unroll
      for (int kt = 0; kt < 8; ++kt) {
        const int r = 16 * kt + fr;
        bf16x8 kf = *(const bf16x8*)(L + 32768 + r * 128 + (((4 * ss + fq) ^ (r & 7)) << 4));
#pragma unroll
        for (int vv = 0; vv < 2; ++vv) S[kt][vv] = mfma16(kf, vf[vv], S[kt][vv]);
      }
      }
    }
    if (mode != 2) {
#pragma unroll
    for (int kt = 0; kt < 8; ++kt) {
      f32x4 d = *(const f32x4*)(Dl + 16 * kt + 4 * fq);
#pragma unroll
      for (int vv = 0; vv < 2; ++vv) { S[kt][vv].x *= d.x; S[kt][vv].y *= d.y; S[kt][vv].z *= d.z; S[kt][vv].w *= d.w; }
    }
    }
    if (mode == 1 && tid < 128) ((float*)(p.ws + OFF_DBUF))[(size_t)((b * 8 + h) * 64 + c) * 128 + tid] = Dl[tid];
    if (mode != 1) {
#pragma unroll
    for (int tt = 0; tt < 4; ++tt) {
      float ss = 0.f;
#pragma unroll
      for (int vv = 0; vv < 2; ++vv) ss += O[vv][tt].x * O[vv][tt].x + O[vv][tt].y * O[vv][tt].y + O[vv][tt].z * O[vv][tt].z + O[vv][tt].w * O[vv][tt].w;
      ss += __shfl_xor(ss, 16);
      ss += __shfl_xor(ss, 32);
      if (fq == 0) part[w * 64 + 16 * tt + fr] = ss;
    }
    __syncthreads();
#pragma unroll
    for (int tt = 0; tt < 4; ++tt) {
      const int t = 16 * tt + fr;
      const float tot = part[t] + part[64 + t] + part[128 + t] + part[192 + t];
      const float r = rsqrtf(tot * (1.f / 128.f) + 1e-5f);
      const size_t tok = (size_t)(tok0 + t);
#pragma unroll
      for (int vv = 0; vv < 2; ++vv) {
        const int v0 = h * 128 + 32 * w + 16 * vv + 4 * fq;
        u32x2 gt = *(const u32x2*)(GA + tok * 1024 + v0);
        float o0 = O[vv][tt].x * r * gn[vv].x * bflo(gt.x);
        float o1 = O[vv][tt].y * r * gn[vv].y * bfhi(gt.x);
        float o2 = O[vv][tt].z * r * gn[vv].z * bflo(gt.y);
        float o3 = O[vv][tt].w * r * gn[vv].w * bfhi(gt.y);
        u32x2 ov = {pk_bf16(o0, o1), pk_bf16(o2, o3)};
        *(u32x2*)(MERGED + tok * 2048 + v0) = ov;
      }
    }
    }
    __syncthreads();
  }
  if (mode == 1) {
#pragma unroll
    for (int kt = 0; kt < 8; ++kt)
#pragma unroll
      for (int vv = 0; vv < 2; ++vv) {
        u32x2 t = {pk_bf16(S[kt][vv].x, S[kt][vv].y), pk_bf16(S[kt][vv].z, S[kt][vv].w)};
        LSb[(kt * 2 + vv) * 256] = t;
      }
    return;
  }
  if (mode == 2) return;
  int zq = 0; asm volatile("" : "+v"(zq));
  float* so = p.out + (kind == 0 ? OUT_SP : OUT_SS) + (size_t)((b * 8 + h) * 128) * 128 + (4 * fq) * 128 + 32 * w + fr + zq;
#pragma unroll
  for (int kt = 0; kt < 8; ++kt)
#pragma unroll
    for (int vv = 0; vv < 2; ++vv)
#pragma unroll
      for (int j = 0; j < 4; ++j) so[(16 * kt + j) * 128 + 16 * vv] = S[kt][vv][j];
}


__device__ void hgrn_scan_item(const Params& p, int chain, int kt) {
  int tid_o = threadIdx.x; asm volatile("" : "+v"(tid_o)); const int tid = tid_o, lane = tid & 63, w = tid >> 6, fr = lane & 15, fq = lane >> 4;
  u32x2* LS = (u32x2*)(p.ws + OFF_LS) + ((size_t)(chain * 64) * 16 + kt * 2) * 256 + tid;
  const float* DB = (const float*)(p.ws + OFF_DBUF) + (size_t)(chain * 64) * 128 + 16 * kt + 4 * fq;
  f32x4 S0 = {0.f, 0.f, 0.f, 0.f}, S1 = {0.f, 0.f, 0.f, 0.f};
#pragma unroll 1
  for (int c8 = 0; c8 < 64; c8 += 8) {
    u32x2 l0[8], l1[8];
    f32x4 d[8];
#pragma unroll
    for (int i = 0; i < 8; ++i) {
      l0[i] = LS[(size_t)(c8 + i) * 16 * 256];
      l1[i] = LS[(size_t)(c8 + i) * 16 * 256 + 256];
      d[i] = *(const f32x4*)(DB + (c8 + i) * 128);
    }
#pragma unroll
    for (int i = 0; i < 8; ++i) {
      u32x2 o0 = {pk_bf16(S0.x, S0.y), pk_bf16(S0.z, S0.w)}, o1 = {pk_bf16(S1.x, S1.y), pk_bf16(S1.z, S1.w)};
      LS[(size_t)(c8 + i) * 16 * 256] = o0; LS[(size_t)(c8 + i) * 16 * 256 + 256] = o1;
      S0.x = d[i].x * S0.x + bflo(l0[i].x); S0.y = d[i].y * S0.y + bfhi(l0[i].x); S0.z = d[i].z * S0.z + bflo(l0[i].y); S0.w = d[i].w * S0.w + bfhi(l0[i].y);
      S1.x = d[i].x * S1.x + bflo(l1[i].x); S1.y = d[i].y * S1.y + bfhi(l1[i].x); S1.z = d[i].z * S1.z + bflo(l1[i].y); S1.w = d[i].w * S1.w + bfhi(l1[i].y);
    }
  }
  float* so = p.out + OUT_SP + (size_t)(chain * 128) * 128 + (size_t)(16 * kt + 4 * fq) * 128 + 32 * w + fr;
  so[0] = S0.x; so[128] = S0.y; so[256] = S0.z; so[384] = S0.w;
  so[16] = S1.x; so[128 + 16] = S1.y; so[256 + 16] = S1.z; so[384 + 16] = S1.w;
}

__device__ void attn_item(const Params& p, int kind, int bh, int qt, char* lds) {
  int tid_o = threadIdx.x; asm volatile("" : "+v"(tid_o)); const int tid = tid_o, lane = tid & 63, w = tid >> 6, fr = lane & 15, fq = lane >> 4;
  const int b = bh >> 3, h = bh & 7;
  const int nkt = kind == 0 ? qt + 1 : 17;
  const int tok0 = kind == 0 ? b * 4096 + qt * 64 : NPTOK + b * 64;
  const int qpos0 = kind == 0 ? qt * 64 : 1024;
  const bf16_t* Kb = kind == 0 ? (const bf16_t*)(p.ws + OFF_KP) + (size_t)bh * 4096 * 128
                               : (const bf16_t*)(p.ws + OFF_KS) + (size_t)bh * 1088 * 128;
  const bf16_t* Vb = kind == 0 ? (const bf16_t*)(p.ws + OFF_VTP) + (size_t)bh * 128 * 4096
                               : (const bf16_t*)(p.ws + OFF_VTS) + (size_t)bh * 128 * 1088;
  const int vstride = kind == 0 ? 4096 : 1088;
  const float slope2 = exp2f(-(float)(h + 1)) * 1.4426950408889634f;

  const int tok = tok0 + 16 * w + fr;
  bf16x8 qf[4];
  {
    const bf16_t* qp = (const bf16_t*)(p.ws + OFF_QB) + (size_t)tok * 1024 + h * 128;
#pragma unroll
    for (int ks = 0; ks < 4; ++ks) qf[ks] = *(const bf16x8*)(qp + 32 * ks + 8 * fq);
  }
  const float qposf = (float)(qpos0 + 16 * w + fr);
  f32x4 O0[8], O1[8];
#pragma unroll
  for (int i = 0; i < 8; ++i) { O0[i] = (f32x4){0.f, 0.f, 0.f, 0.f}; O1[i] = (f32x4){0.f, 0.f, 0.f, 0.f}; }
  float mx[2] = {-1e30f, -1e30f}, ls[2] = {0.f, 0.f};

  u32x4 rk[4], rv[4];
  {
    const int kkey = tid >> 4, kc = tid & 15, vrow = tid >> 3, vc = tid & 7;
    const int kt = nkt - 1;
#pragma unroll
    for (int i = 0; i < 4; ++i) {
      rk[i] = *(const u32x4*)(Kb + (size_t)(kt * 64 + kkey + 16 * i) * 128 + kc * 8);
      rv[i] = *(const u32x4*)(Vb + (size_t)(vrow + 32 * i) * vstride + kt * 64 + vc * 8);
    }
#pragma unroll
    for (int i = 0; i < 4; ++i) {
      const int key = kkey + 16 * i;
      *(u32x4*)(lds + key * 256 + ((kc ^ (key & 15)) << 4)) = rk[i];
      const int r = vrow + 32 * i;
      *(u32x4*)(lds + 16384 + r * 128 + ((vc ^ ((r >> 1) & 7)) << 4)) = rv[i];
    }
    if (nkt > 1) {
#pragma unroll
      for (int i = 0; i < 4; ++i) {
        rk[i] = *(const u32x4*)(Kb + (size_t)((kt - 1) * 64 + kkey + 16 * i) * 128 + kc * 8);
        rv[i] = *(const u32x4*)(Vb + (size_t)(vrow + 32 * i) * vstride + (kt - 1) * 64 + vc * 8);
      }
    }
    __syncthreads();
  }
  for (int it = 0; it < nkt; ++it) {
    int zz = 0; asm volatile("" : "+v"(zz));
    int tidv = threadIdx.x; asm volatile("" : "+v"(tidv));
    const int tid = tidv, lane = tid & 63, w = tid >> 6, fr = lane & 15, fq = lane >> 4;
    const int kkey = tid >> 4, kc = tid & 15, vrow = tid >> 3, vc = tid & 7;
    const int kt = nkt - 1 - it;
    char* L = lds + zz + (it & 1) * 32768;
    char* Ln = lds + zz + ((it + 1) & 1) * 32768;
    if (it + 1 < nkt) {
#pragma unroll
      for (int i = 0; i < 4; ++i) {
        const int key = kkey + 16 * i;
        *(u32x4*)(Ln + key * 256 + ((kc ^ (key & 15)) << 4)) = rk[i];
        const int r = vrow + 32 * i;
        *(u32x4*)(Ln + 16384 + r * 128 + ((vc ^ ((r >> 1) & 7)) << 4)) = rv[i];
      }
    }
    if (it + 2 < nkt) {
#pragma unroll
      for (int i = 0; i < 4; ++i) {
        rk[i] = *(const u32x4*)(Kb + (size_t)((kt - 2) * 64 + zz + kkey + 16 * i) * 128 + kc * 8);
        rv[i] = *(const u32x4*)(Vb + (size_t)(vrow + 32 * i) * vstride + (kt - 2) * 64 + zz + vc * 8);
      }
    }
    const float kposf = (float)(kt * 64 + 4 * fq) - qposf;
    bf16x8 pf[2][2];
    bool live[2];
#pragma unroll
    for (int m = 0; m < 2; ++m) {
      f32x4 s[4];
#pragma unroll
      for (int k16 = 0; k16 < 4; ++k16) {
        s[k16] = (f32x4){0.f, 0.f, 0.f, 0.f};
        const int key = 16 * k16 + fr;
#pragma unroll
        for (int ks2 = 0; ks2 < 2; ++ks2) {
          bf16x8 kf = *(const bf16x8*)(L + key * 256 + (((8 * m + 4 * ks2 + fq) ^ (key & 15)) << 4));
          s[k16] = mfma16(kf, qf[2 * m + ks2], s[k16]);
        }
      }
      float tmax = -1e30f;
#pragma unroll
      for (int k16 = 0; k16 < 4; ++k16)
#pragma unroll
        for (int j = 0; j < 4; ++j) {
          const float d = kposf + (float)(16 * k16 + j);
          const float v = s[k16][j] - slope2 * fabsf(d);
          s[k16][j] = v;
          tmax = fmaxf(tmax, v);
        }
      tmax = fmaxf(tmax, __shfl_xor(tmax, 16));
      tmax = fmaxf(tmax, __shfl_xor(tmax, 32));
      live[m] = !__all(tmax - mx[m] < -40.f);
      if (live[m]) {
        const float mnew = fmaxf(mx[m], tmax);
        const float alpha = __builtin_amdgcn_exp2f(mx[m] - mnew);
        mx[m] = mnew;
        float psum = 0.f;
#pragma unroll
        for (int k16 = 0; k16 < 4; ++k16)
#pragma unroll
          for (int j = 0; j < 4; ++j) { const float e = __builtin_amdgcn_exp2f(s[k16][j] - mnew); s[k16][j] = e; psum += e; }
        ls[m] = ls[m] * alpha + psum;
        if (m == 0) {
#pragma unroll
          for (int i = 0; i < 8; ++i) { O0[i].x *= alpha; O0[i].y *= alpha; O0[i].z *= alpha; O0[i].w *= alpha; }
        } else {
#pragma unroll
          for (int i = 0; i < 8; ++i) { O1[i].x *= alpha; O1[i].y *= alpha; O1[i].z *= alpha; O1[i].w *= alpha; }
        }
#pragma unroll
        for (int ks = 0; ks < 2; ++ks)
          pf[m][ks] = mk8(pk_bf16(s[2 * ks].x, s[2 * ks].y), pk_bf16(s[2 * ks].z, s[2 * ks].w),
                          pk_bf16(s[2 * ks + 1].x, s[2 * ks + 1].y), pk_bf16(s[2 * ks + 1].z, s[2 * ks + 1].w));
      } else {
#pragma unroll
        for (int ks = 0; ks < 2; ++ks) pf[m][ks] = mk8(0u, 0u, 0u, 0u);
      }
    }
    if (live[0] || live[1]) {
#pragma unroll
      for (int vt = 0; vt < 8; ++vt) {
        const int r = 16 * vt + fr;
        const int rs = (r >> 1) & 7;
#pragma unroll
        for (int ks = 0; ks < 2; ++ks) {
          const int u0 = 8 * ks + fq, u1 = 8 * ks + 4 + fq;
          u32x2 a0 = *(const u32x2*)(L + 16384 + r * 128 + (((u0 >> 1) ^ rs) << 4) + ((u0 & 1) << 3));
          u32x2 a1 = *(const u32x2*)(L + 16384 + r * 128 + (((u1 >> 1) ^ rs) << 4) + ((u1 & 1) << 3));
          bf16x8 vf = mk8(a0, a1);
          O0[vt] = mfma16(vf, pf[0][ks], O0[vt]);
          O1[vt] = mfma16(vf, pf[1][ks], O1[vt]);
        }
      }
    }
    __syncthreads();
  }
  float l0 = ls[0], l1 = ls[1];
  l0 += __shfl_xor(l0, 16); l0 += __shfl_xor(l0, 32);
  l1 += __shfl_xor(l1, 16); l1 += __shfl_xor(l1, 32);
  const float lam = ((const float*)(p.ws + OFF_CTR))[16];
  const float i0 = 1.f / l0, i1 = lam / l1;
  float ssq = 0.f;
#pragma unroll
  for (int vt = 0; vt < 8; ++vt) {
#pragma unroll
    for (int j = 0; j < 4; ++j) {
      const float o = O0[vt][j] * i0 - O1[vt][j] * i1;
      O0[vt][j] = o;
      ssq += o * o;
    }
  }
  ssq += __shfl_xor(ssq, 16);
  ssq += __shfl_xor(ssq, 32);
  const float r = rsqrtf(ssq * (1.f / 128.f) + 1e-5f) * 0.8f;
  bf16_t* mo = (bf16_t*)(p.ws + OFF_MERGED) + (size_t)tok * 2048 + 1024 + h * 128;
#pragma unroll
  for (int vt = 0; vt < 8; ++vt) {
    f32x4 g = *(const f32x4*)(p.diff_g + 16 * vt + 4 * fq);
    u32x2 ov = {pk_bf16(O0[vt].x * r * g.x, O0[vt].y * r * g.y), pk_bf16(O0[vt].z * r * g.z, O0[vt].w * r * g.w)};
    *(u32x2*)(mo + 16 * vt + 4 * fq) = ov;
  }
}


__device__ void quant_item(const Params& p, int item) {
  int tid_o = threadIdx.x; asm volatile("" : "+v"(tid_o)); const int tid = tid_o, lane = tid & 63, w = tid >> 6;
  unsigned char* U8 = (unsigned char*)(p.ws + OFF_UB);
  float* SCL = (float*)(p.ws + OFF_SCL);
  for (int rr = 0; rr < 16; ++rr) {
    const int row = item * 64 + rr * 4 + w;
    const float* srow = row < 16384 ? p.pu + (size_t)row * 2048 : p.pv + (size_t)(row - 16384) * 2048;
    f32x4 v[8];
    float am = 0.f;
#pragma unroll
    for (int i = 0; i < 8; ++i) {
      v[i] = *(const f32x4*)(srow + 256 * i + lane * 4);
      am = fmaxf(fmaxf(am, fmaxf(fabsf(v[i].x), fabsf(v[i].y))), fmaxf(fabsf(v[i].z), fabsf(v[i].w)));
    }
#pragma unroll
    for (int o = 32; o >= 1; o >>= 1) am = fmaxf(am, __shfl_xor(am, o));
    const float sc = am > 0.f ? 224.f / am : 1.f;
    unsigned char* drow = U8 + (size_t)row * 2048;
#pragma unroll
    for (int i = 0; i < 8; ++i) {
      int pk = __builtin_amdgcn_cvt_pk_fp8_f32(v[i].x * sc, v[i].y * sc, 0, false);
      pk = __builtin_amdgcn_cvt_pk_fp8_f32(v[i].z * sc, v[i].w * sc, pk, true);
      *(int*)(drow + 256 * i + lane * 4) = pk;
    }
    if (lane == 0) SCL[row] = am > 0.f ? am * (1.f / 224.f) : 1.f;
  }
}

__device__ void phase2(const Params& p, char* lds, int rep, int par) {
  unsigned* ctr = (unsigned*)(p.ws + OFF_CTR) + rep;
  int* sitem = (int*)lds;
  const int nA = par ? 2048 : 0;
  for (;;) {
    __syncthreads();
    if (threadIdx.x == 0) *sitem = (int)atomicAdd(ctr, 1u);
    __syncthreads();
    int item = *sitem;
    __syncthreads();
    if (item >= nA + 2208) break;
    if (item < 2 * nA) {
      if (!(item & 1)) { const int ia = item >> 1; hgrn_item(p, 0, (ia & 31) >> 3, ia & 7, lds, 1, ia >> 5); continue; }
      item >>= 1;
    } else item -= nA;
    if (item < 96) {
      const int kind = item < 32 ? 0 : 1, ii = item < 32 ? item : item - 32;
      if (kind == 0 && par) continue;
      hgrn_item(p, kind, ii >> 3, ii & 7, lds, 0, 0);
    } else {
      const int kind = item < 160 ? 1 : 0, j = item - 160;
      attn_item(p, kind, kind ? item - 96 : (j & 31), kind ? 0 : 63 - (j >> 5), lds);
    }
  }
}

__device__ void phase2b(const Params& p) {
  for (int item = blockIdx.x; item < 256; item += gridDim.x) hgrn_scan_item(p, item >> 3, item & 7);
}

__device__ void phase2c(const Params& p, char* lds) {
  for (int item = blockIdx.x; item < 2048; item += gridDim.x) {
    __syncthreads();
    hgrn_item(p, 0, (item & 31) >> 3, item & 7, lds, 2, item >> 5);
  }
}

__device__ void phase4(const Params& p) {
  int tid_o = threadIdx.x; asm volatile("" : "+v"(tid_o)); const int tid = tid_o, lane = tid & 63, w = tid >> 6;
  bf16_t* X1B = (bf16_t*)(p.ws + OFF_X1B);
  for (int row = blockIdx.x * 4 + w; row < NTOK; row += gridDim.x * 4) {
    bf16_t* xr = X1B + (size_t)row * 2048;
    float v[4][8];
    float s = 0.f;
#pragma unroll
    for (int i = 0; i < 4; ++i) {
      u32x4 t = *(const u32x4*)(xr + 512 * i + lane * 8);
      v[i][0] = bflo(t.x); v[i][1] = bfhi(t.x); v[i][2] = bflo(t.y); v[i][3] = bfhi(t.y);
      v[i][4] = bflo(t.z); v[i][5] = bfhi(t.z); v[i][6] = bflo(t.w); v[i][7] = bfhi(t.w);
#pragma unroll
      for (int e = 0; e < 8; ++e) s += v[i][e];
    }
    s = wave_sum(s);
    const float mean = s * (1.f / 2048.f);
    float q = 0.f;
#pragma unroll
    for (int i = 0; i < 4; ++i)
#pragma unroll
      for (int e = 0; e < 8; ++e) { const float d = v[i][e] - mean; q += d * d; }
    q = wave_sum(q);
    const float rs = rsqrtf(q * (1.f / 2048.f) + 1e-5f);
#pragma unroll
    for (int i = 0; i < 4; ++i) {
      const int col = 512 * i + lane * 8;
      f32x4 g0 = *(const f32x4*)(p.ln1_g + col), g1 = *(const f32x4*)(p.ln1_g + col + 4);
      f32x4 b0 = *(const f32x4*)(p.ln1_b + col), b1 = *(const f32x4*)(p.ln1_b + col + 4);
      u32x4 o;
      o.x = pk_bf16((v[i][0] - mean) * rs * g0.x + b0.x, (v[i][1] - mean) * rs * g0.y + b0.y);
      o.y = pk_bf16((v[i][2] - mean) * rs * g0.z + b0.z, (v[i][3] - mean) * rs * g0.w + b0.w);
      o.z = pk_bf16((v[i][4] - mean) * rs * g1.x + b1.x, (v[i][5] - mean) * rs * g1.y + b1.y);
      o.w = pk_bf16((v[i][6] - mean) * rs * g1.z + b1.z, (v[i][7] - mean) * rs * g1.w + b1.w);
      *(u32x4*)(xr + col) = o;
    }
  }
}

__device__ __forceinline__ unsigned f2key(float f) {
  unsigned b = __float_as_uint(f);
  return (b & 0x80000000u) ? ~b : (b | 0x80000000u);
}
__device__ __forceinline__ float key2f(unsigned k) {
  unsigned b = (k & 0x80000000u) ? (k & 0x7fffffffu) : ~k;
  return __uint_as_float(b);
}

__device__ __forceinline__ unsigned row_allmax(unsigned x) {
  x = max(x, (unsigned)__builtin_amdgcn_update_dpp(0, (int)x, 0x121, 0xF, 0xF, false));
  x = max(x, (unsigned)__builtin_amdgcn_update_dpp(0, (int)x, 0x122, 0xF, 0xF, false));
  x = max(x, (unsigned)__builtin_amdgcn_update_dpp(0, (int)x, 0x124, 0xF, 0xF, false));
  x = max(x, (unsigned)__builtin_amdgcn_update_dpp(0, (int)x, 0x128, 0xF, 0xF, false));
  return x;
}
__device__ __forceinline__ float row_allsum(float x) {
  x += __int_as_float(__builtin_amdgcn_update_dpp(0, __float_as_int(x), 0x121, 0xF, 0xF, false));
  x += __int_as_float(__builtin_amdgcn_update_dpp(0, __float_as_int(x), 0x122, 0xF, 0xF, false));
  x += __int_as_float(__builtin_amdgcn_update_dpp(0, __float_as_int(x), 0x124, 0xF, 0xF, false));
  x += __int_as_float(__builtin_amdgcn_update_dpp(0, __float_as_int(x), 0x128, 0xF, 0xF, false));
  return x;
}
#define CE_DESC(a, b) { const unsigned _hi = max(a, b), _lo = min(a, b); a = _hi; b = _lo; }

__device__ void phase6(const Params& p, char* lds) {
  int tid_o = threadIdx.x; asm volatile("" : "+v"(tid_o)); const int tid = tid_o, lane = tid & 63, w = tid >> 6, fr = lane & 15, fq = lane >> 4;
  const bf16_t* QP = (const bf16_t*)(p.ws + OFF_QP);
  const bf16_t* SKB = (const bf16_t*)(p.ws + OFF_SKB);
  int* EIDX = (int*)(p.ws + OFF_EIDX);
  float* GATE = (float*)(p.ws + OFF_GATE);
  const bool qfirst = ((blockIdx.x >> 3) & 1) != 0;
  if (qfirst) for (int qi = blockIdx.x; qi < 512; qi += gridDim.x) quant_item(p, qi);
  unsigned char* tbl = (unsigned char*)lds;
  __syncthreads();
  if (tid < 64) tbl[tid] = 0xFF;
  __syncthreads();
  {
    const int i = tid >> 4, j = tid & 15;
    if ((i + 1) * (j + 1) <= 16) {
      int rank = j;
      for (int ii = 0; ii < i; ++ii) rank += 16 / (ii + 1);
      tbl[rank] = (unsigned char)((i << 4) | j);
    }
  }
  __syncthreads();
  int pi[4], pj[4]; bool pvalid[4];
#pragma unroll
  for (int s = 0; s < 4; ++s) {
    const int pidx = fr + 16 * s;
    const unsigned code = tbl[pidx];
    pvalid[s] = (pidx < 50);
    pi[s] = pvalid[s] ? (int)(code >> 4) : 0;
    pj[s] = pvalid[s] ? (int)(code & 15) : 0;
  }
  const int rowbase = lane & 48;
  __syncthreads();
  {
    const int hh = blockIdx.x & 7;
#pragma unroll 1
    for (int c = 0; c < 2; ++c)
#pragma unroll 4
      for (int i = 0; i < 8; ++i) {
        const int id = tid + 256 * i, key = id >> 4, ch = id & 15;
        u32x4 v = *(const u32x4*)(SKB + (size_t)((hh * 2 + c) * 128 + key) * 128 + ch * 8);
        *(u32x4*)(lds + c * 32768 + key * 256 + ((ch ^ (key & 15)) << 4)) = v;
      }
  }
  __syncthreads();
  for (int item = blockIdx.x; item < 264 * 8; item += gridDim.x) {
    int zz = 0; asm volatile("" : "+v"(zz));
    const char* L = lds + zz;
    const int tile = item >> 3, h = item & 7;
    const int tok0 = tile * 64;
    unsigned Lst[2][4];
#pragma unroll
    for (int c = 0; c < 2; ++c) {
      unsigned K[8][4];
      {
        bf16x8 af[4];
        const bf16_t* qp = QP + (size_t)(tok0 + 16 * w + fr) * 2048 + h * 256 + c * 128;
#pragma unroll
        for (int ks = 0; ks < 4; ++ks) af[ks] = *(const bf16x8*)(qp + 32 * ks + 8 * fq);
#pragma unroll
        for (int kt = 0; kt < 8; ++kt) {
          f32x4 a = {0.f, 0.f, 0.f, 0.f};
#pragma unroll
          for (int ks = 0; ks < 4; ++ks) {
            const int key = 16 * kt + fr;
            bf16x8 bfr = *(const bf16x8*)(L + c * 32768 + key * 256 + (((4 * ks + fq) ^ (key & 15)) << 4));
            a = mfma16(af[ks], bfr, a);
          }
          const unsigned code = (unsigned)(127 - (16 * kt + fr));
#pragma unroll
          for (int j = 0; j < 4; ++j) K[kt][j] = (f2key(a[j]) & ~127u) | code;
        }
      }
#pragma unroll
      for (int j = 0; j < 4; ++j) {
        CE_DESC(K[0][j], K[1][j]); CE_DESC(K[2][j], K[3][j]); CE_DESC(K[4][j], K[5][j]); CE_DESC(K[6][j], K[7][j]);
        CE_DESC(K[0][j], K[2][j]); CE_DESC(K[1][j], K[3][j]); CE_DESC(K[4][j], K[6][j]); CE_DESC(K[5][j], K[7][j]);
        CE_DESC(K[1][j], K[2][j]); CE_DESC(K[5][j], K[6][j]); CE_DESC(K[0][j], K[4][j]); CE_DESC(K[3][j], K[7][j]);
        CE_DESC(K[1][j], K[5][j]); CE_DESC(K[2][j], K[6][j]);
        CE_DESC(K[1][j], K[4][j]); CE_DESC(K[3][j], K[6][j]);
        CE_DESC(K[2][j], K[4][j]); CE_DESC(K[3][j], K[5][j]);
        CE_DESC(K[3][j], K[4][j]);
      }
      unsigned best[4] = {0u, 0u, 0u, 0u};
#pragma unroll 1
      for (int it = 0; it < 16; ++it) {
#pragma unroll
        for (int j = 0; j < 4; ++j) {
          const unsigned rm = row_allmax(K[0][j]);
          const bool win = (K[0][j] == rm);
#pragma unroll
          for (int k = 0; k < 7; ++k) K[k][j] = win ? K[k + 1][j] : K[k][j];
          K[7][j] = win ? 0u : K[7][j];
          best[j] = (fr == it) ? rm : best[j];
        }
      }
#pragma unroll
      for (int j = 0; j < 4; ++j) Lst[c][j] = best[j];
    }
#pragma unroll
    for (int j = 0; j < 4; ++j) {
      unsigned C[4];
#pragma unroll
      for (int s = 0; s < 4; ++s) {
        const unsigned k0 = (unsigned)__shfl((int)Lst[0][j], rowbase + pi[s]);
        const unsigned k1 = (unsigned)__shfl((int)Lst[1][j], rowbase + pj[s]);
        const float sum = key2f(k0 & ~127u) + key2f(k1 & ~127u);
        C[s] = pvalid[s] ? ((f2key(sum) & ~255u) | (unsigned)(255 - (pi[s] * 16 + pj[s]))) : 0u;
      }
      CE_DESC(C[0], C[1]); CE_DESC(C[2], C[3]); CE_DESC(C[0], C[2]); CE_DESC(C[1], C[3]); CE_DESC(C[1], C[2]);
      unsigned sel = 0u;
#pragma unroll 1
      for (int it = 0; it < 16; ++it) {
        const unsigned rm = row_allmax(C[0]);
        const bool win = (C[0] == rm);
        C[0] = win ? C[1] : C[0]; C[1] = win ? C[2] : C[1]; C[2] = win ? C[3] : C[2]; C[3] = win ? 0u : C[3];
        sel = (fr == it) ? rm : sel;
      }
      const float cv = key2f(sel & ~255u);
      const float cmax = __shfl(cv, rowbase);
      const float e = __expf(cv - cmax);
      const float g = e / row_allsum(e);
      const int flat = 255 - (int)(sel & 255u);
      const unsigned l0 = (unsigned)__shfl((int)Lst[0][j], rowbase + (flat >> 4));
      const unsigned l1 = (unsigned)__shfl((int)Lst[1][j], rowbase + (flat & 15));
      const int eidx = (127 - (int)(l0 & 127u)) * 128 + (127 - (int)(l1 & 127u));
      const size_t ob = ((size_t)(tok0 + 16 * w + 4 * fq + j) * 8 + h) * 16 + fr;
      EIDX[ob] = eidx;
      GATE[ob] = g;
    }
  }
  if (!qfirst) for (int qi = blockIdx.x; qi < 512; qi += gridDim.x) quant_item(p, qi);
}

__device__ __forceinline__ float dot16_fp8(u32x4 r, const float* x) {
  float d = 0.f;
  f32x2_t a;
  a = __builtin_amdgcn_cvt_pk_f32_fp8((int)r.x, false); d += a.x * x[0] + a.y * x[1];
  a = __builtin_amdgcn_cvt_pk_f32_fp8((int)r.x, true);  d += a.x * x[2] + a.y * x[3];
  a = __builtin_amdgcn_cvt_pk_f32_fp8((int)r.y, false); d += a.x * x[4] + a.y * x[5];
  a = __builtin_amdgcn_cvt_pk_f32_fp8((int)r.y, true);  d += a.x * x[6] + a.y * x[7];
  a = __builtin_amdgcn_cvt_pk_f32_fp8((int)r.z, false); d += a.x * x[8] + a.y * x[9];
  a = __builtin_amdgcn_cvt_pk_f32_fp8((int)r.z, true);  d += a.x * x[10] + a.y * x[11];
  a = __builtin_amdgcn_cvt_pk_f32_fp8((int)r.w, false); d += a.x * x[12] + a.y * x[13];
  a = __builtin_amdgcn_cvt_pk_f32_fp8((int)r.w, true);  d += a.x * x[14] + a.y * x[15];
  return d;
}
__device__ __forceinline__ void axpy16_fp8(u32x4 r, float w, float* acc) {
  f32x2_t a;
  a = __builtin_amdgcn_cvt_pk_f32_fp8((int)r.x, false); acc[0] += w * a.x; acc[1] += w * a.y;
  a = __builtin_amdgcn_cvt_pk_f32_fp8((int)r.x, true);  acc[2] += w * a.x; acc[3] += w * a.y;
  a = __builtin_amdgcn_cvt_pk_f32_fp8((int)r.y, false); acc[4] += w * a.x; acc[5] += w * a.y;
  a = __builtin_amdgcn_cvt_pk_f32_fp8((int)r.y, true);  acc[6] += w * a.x; acc[7] += w * a.y;
  a = __builtin_amdgcn_cvt_pk_f32_fp8((int)r.z, false); acc[8] += w * a.x; acc[9] += w * a.y;
  a = __builtin_amdgcn_cvt_pk_f32_fp8((int)r.z, true);  acc[10] += w * a.x; acc[11] += w * a.y;
  a = __builtin_amdgcn_cvt_pk_f32_fp8((int)r.w, false); acc[12] += w * a.x; acc[13] += w * a.y;
  a = __builtin_amdgcn_cvt_pk_f32_fp8((int)r.w, true);  acc[14] += w * a.x; acc[15] += w * a.y;
}

__device__ void phase7(const Params& p, char* lds) {
  int tid_o = threadIdx.x; asm volatile("" : "+v"(tid_o)); const int tid = tid_o, lane = tid & 63, w = tid >> 6;
  const bf16_t* X1B = (const bf16_t*)(p.ws + OFF_X1B);
  const unsigned char* U8 = (const unsigned char*)(p.ws + OFF_UB);
  const unsigned char* V8 = (const unsigned char*)(p.ws + OFF_VB);
  const float* SCL = (const float*)(p.ws + OFF_SCL);
  const int* EIDX = (const int*)(p.ws + OFF_EIDX);
  const float* GATE = (const float*)(p.ws + OFF_GATE);
  float* wgt = (float*)lds;
  float* red = (float*)(lds + 1024);
  float* part = (float*)(lds + 2048);
  for (int tok = blockIdx.x; tok < NTOK; tok += gridDim.x) {
    int tidv = threadIdx.x; asm volatile("" : "+v"(tidv));
    const int tid = tidv, lane = tid & 63, w = tid >> 6;
    const bf16_t* xr = X1B + (size_t)tok * 2048;
    float xa[2][16];
#pragma unroll
    for (int j = 0; j < 2; ++j)
#pragma unroll
      for (int q = 0; q < 2; ++q) {
        u32x4 t = *(const u32x4*)(xr + 1024 * j + 16 * lane + 8 * q);
        xa[j][8 * q] = bflo(t.x); xa[j][8 * q + 1] = bfhi(t.x); xa[j][8 * q + 2] = bflo(t.y); xa[j][8 * q + 3] = bfhi(t.y);
        xa[j][8 * q + 4] = bflo(t.z); xa[j][8 * q + 5] = bfhi(t.z); xa[j][8 * q + 6] = bflo(t.w); xa[j][8 * q + 7] = bfhi(t.w);
      }
    __syncthreads();
#ifndef UR
#define UR 16
#endif
#ifndef VR
#define VR 16
#endif
#pragma unroll 1
    for (int k6 = 0; k6 < 32; k6 += UR) {
      u32x4 r[UR][2];
      int ee[UR];
#pragma unroll
      for (int kk = 0; kk < UR; ++kk) {
        const int kq = (k6 + kk < 32) ? (k6 + kk) : 31;
        ee[kk] = __builtin_amdgcn_readfirstlane(EIDX[(size_t)tok * 128 + w * 32 + kq]);
        const unsigned char* ur = U8 + (size_t)ee[kk] * 2048 + lane * 16;
        r[kk][0] = *(const u32x4*)ur;
        r[kk][1] = *(const u32x4*)(ur + 1024);
      }
      float dot[UR];
#pragma unroll
      for (int kk = 0; kk < UR; ++kk) dot[kk] = dot16_fp8(r[kk][0], xa[0]) + dot16_fp8(r[kk][1], xa[1]);
#pragma unroll
      for (int o = 32; o >= 1; o >>= 1) {
#pragma unroll
        for (int kk = 0; kk < UR; ++kk) dot[kk] += __shfl_xor(dot[kk], o);
      }
      if (lane < UR && k6 + lane < 32) {
        float a = dot[0]; int e = ee[0];
#pragma unroll
        for (int kk = 1; kk < UR; ++kk) { if (lane == kk) { a = dot[kk]; e = ee[kk]; } }
        const int k = w * 32 + k6 + lane;
        a *= SCL[e];
        const float ge = 0.5f * a * (1.f + erff(a * 0.70710678118654752f));
        wgt[k] = GATE[(size_t)tok * 128 + k] * ge * SCL[16384 + e];
      }
    }
    __syncthreads();
#pragma unroll 1
    for (int j = 0; j < 2; ++j) {
      float acc[16];
#pragma unroll
      for (int q = 0; q < 16; ++q) acc[q] = 0.f;
#pragma unroll 1
      for (int k6 = 0; k6 < 32; k6 += VR) {
        u32x4 r[VR];
        float ww[VR];
#pragma unroll
        for (int kk = 0; kk < VR; ++kk) {
          const int kq = (k6 + kk < 32) ? (k6 + kk) : 31;
          const int k = w * 32 + kq;
          const int e = __builtin_amdgcn_readfirstlane(EIDX[(size_t)tok * 128 + k]);
          ww[kk] = (k6 + kk < 32) ? wgt[k] : 0.f;
          r[kk] = *(const u32x4*)(V8 + (size_t)e * 2048 + 1024 * j + lane * 16);
        }
#pragma unroll
        for (int kk = 0; kk < VR; ++kk) axpy16_fp8(r[kk], ww[kk], acc);
      }
#pragma unroll
      for (int q = 0; q < 4; ++q)
        *(f32x4*)(part + w * 2048 + 1024 * j + 16 * lane + 4 * q) = (f32x4){acc[4 * q], acc[4 * q + 1], acc[4 * q + 2], acc[4 * q + 3]};
    }
    __syncthreads();
    const float al = 1.189207115002721f;
    const u32x4 xt = *(const u32x4*)(xr + tid * 8);
    f32x4 x0 = {bflo(xt.x), bfhi(xt.x), bflo(xt.y), bfhi(xt.y)}, x1 = {bflo(xt.z), bfhi(xt.z), bflo(xt.w), bfhi(xt.w)};
    f32x4 s0 = {0.f, 0.f, 0.f, 0.f}, s1 = {0.f, 0.f, 0.f, 0.f};
#pragma unroll
    for (int ww2 = 0; ww2 < 4; ++ww2) {
      f32x4 a0 = *(const f32x4*)(part + ww2 * 2048 + tid * 8), a1 = *(const f32x4*)(part + ww2 * 2048 + tid * 8 + 4);
      s0.x += a0.x; s0.y += a0.y; s0.z += a0.z; s0.w += a0.w; s1.x += a1.x; s1.y += a1.y; s1.z += a1.z; s1.w += a1.w;
    }
    float val[8] = {al * x0.x + s0.x, al * x0.y + s0.y, al * x0.z + s0.z, al * x0.w + s0.w,
                    al * x1.x + s1.x, al * x1.y + s1.y, al * x1.z + s1.z, al * x1.w + s1.w};
    float s = 0.f;
#pragma unroll
    for (int j = 0; j < 8; ++j) s += val[j];
    s = wave_sum(s);
    if (lane == 0) red[w] = s;
    __syncthreads();
    const float mean = (red[0] + red[1] + red[2] + red[3]) * (1.f / 2048.f);
    float q = 0.f;
#pragma unroll
    for (int j = 0; j < 8; ++j) { const float d = val[j] - mean; q += d * d; }
    q = wave_sum(q);
    if (lane == 0) red[4 + w] = q;
    __syncthreads();
    const float rs = rsqrtf((red[4] + red[5] + red[6] + red[7]) * (1.f / 2048.f) + 1e-5f);
    f32x4 g0 = *(const f32x4*)(p.ln2_g + tid * 8), g1 = *(const f32x4*)(p.ln2_g + tid * 8 + 4);
    f32x4 b0 = *(const f32x4*)(p.ln2_b + tid * 8), b1 = *(const f32x4*)(p.ln2_b + tid * 8 + 4);
    f32x4 o0 = {(val[0] - mean) * rs * g0.x + b0.x, (val[1] - mean) * rs * g0.y + b0.y, (val[2] - mean) * rs * g0.z + b0.z, (val[3] - mean) * rs * g0.w + b0.w};
    f32x4 o1 = {(val[4] - mean) * rs * g1.x + b1.x, (val[5] - mean) * rs * g1.y + b1.y, (val[6] - mean) * rs * g1.z + b1.z, (val[7] - mean) * rs * g1.w + b1.w};
    float* yo = p.out + OUT_Y + (size_t)tok * 2048 + tid * 8;
    *(f32x4*)yo = o0;
    *(f32x4*)(yo + 4) = o1;
  }
}

__device__ __forceinline__ void grid_bar(unsigned* ctr, unsigned target) {
  asm volatile("s_waitcnt vmcnt(0)" ::: "memory");
  __syncthreads();
  if (threadIdx.x == 0) {
    __builtin_amdgcn_fence(__ATOMIC_RELEASE, "agent");
    asm volatile("s_waitcnt vmcnt(0)" ::: "memory");
    __hip_atomic_fetch_add(ctr, 1u, __ATOMIC_RELAXED, __HIP_MEMORY_SCOPE_AGENT);
    while (__hip_atomic_load(ctr, __ATOMIC_RELAXED, __HIP_MEMORY_SCOPE_AGENT) < target) __builtin_amdgcn_s_sleep(2);
    __builtin_amdgcn_fence(__ATOMIC_ACQUIRE, "agent");
    asm volatile("s_waitcnt vmcnt(0)" ::: "memory");
  }
  __syncthreads();
}

__global__ void __launch_bounds__(256, 2) mega(Params p, int ph_lo, int ph_hi, int use_sync) {
  __shared__ __attribute__((aligned(16))) char lds[LDS_BYTES];
  cg::grid_group grid = cg::this_grid();
  unsigned nbar = 0;
#ifndef DUP_PHASE
#define DUP_PHASE -1
#endif
  const int par = (use_sync == 3);
  const int nph = par ? 10 : 8;
  for (int pi = 0; pi < nph; ++pi) {
    const int ph = par ? (pi < 3 ? pi : (pi < 5 ? pi + 5 : pi - 2)) : pi;
    const int reps = (ph == DUP_PHASE) ? 2 : 1;
    for (int rep = 0; rep < reps; ++rep) {
      switch (ph) {
        case 0: phase0(p, lds); break;
        case 1: phase1(p, lds); break;
        case 2: phase2(p, lds, rep, par); break;
        case 8: phase2b(p); break;
        case 9: phase2c(p, lds); break;
        case 3: gemm23<0>(p, lds); break;
        case 4: phase4(p); break;
        case 5: gemm23<1>(p, lds); break;
        case 6: phase6(p, lds); break;
        case 7: phase7(p, lds); break;
      }
      if (pi + 1 < nph || rep + 1 < reps) {
        if (use_sync == 2) grid.sync();
        else grid_bar((unsigned*)(p.ws + 128), (unsigned)gridDim.x * (++nbar));
      }
    }
  }
}

extern "C" void kernel_launch(void* const* d_in, const int* in_sizes, int n_in, void* d_out, int out_size,
                              void* d_ws, size_t ws_size, hipStream_t stream) {
  static int grid_blocks = 0;
  if (!grid_blocks) {
    int dev = 0, cus = 0, per_cu = 0;
    hipGetDevice(&dev);
    hipDeviceGetAttribute(&cus, hipDeviceAttributeMultiprocessorCount, dev);
    hipOccupancyMaxActiveBlocksPerMultiprocessor(&per_cu, mega, 256, 0);
    if (per_cu > 2) per_cu = 2;
    if (per_cu < 1) per_cu = 1;
    grid_blocks = cus * per_cu;
    grid_blocks &= ~7;
  }
  Params p{};
  p.x_prompt = (const float*)d_in[0]; p.x_sample = (const float*)d_in[1]; p.cache_k = (const float*)d_in[2];
  p.cache_v = (const float*)d_in[3]; p.state = (const float*)d_in[4]; p.w_in = (const float*)d_in[5];
  p.hgrn_lb = (const float*)d_in[6]; p.hgrn_g = (const float*)d_in[7]; p.lq1 = (const float*)d_in[8];
  p.lk1 = (const float*)d_in[9]; p.lq2 = (const float*)d_in[10]; p.lk2 = (const float*)d_in[11];
  p.diff_g = (const float*)d_in[12]; p.w_out = (const float*)d_in[13]; p.ln1_g = (const float*)d_in[14];
  p.ln1_b = (const float*)d_in[15]; p.wq = (const float*)d_in[16]; p.subk = (const float*)d_in[17];
  p.pu = (const float*)d_in[18]; p.pv = (const float*)d_in[19]; p.ln2_g = (const float*)d_in[20];
  p.ln2_b = (const float*)d_in[21];
  p.out = (float*)d_out; p.ws = (char*)d_ws;
  hipMemsetAsync(d_ws, 0, 256, stream);
  int lo = 0, hi = 7, us = 3;
  void* args[] = {&p, &lo, &hi, &us};
  hipError_t e = hipLaunchCooperativeKernel((const void*)mega, dim3(grid_blocks), dim3(256), args, 0, stream);
  if (e != hipSuccess) fprintf(stderr, "cooperative launch failed: %s (grid %d)\n", hipGetErrorString(e), grid_blocks);
}
```

```cpp
#include <hip/hip_runtime.h>
#include <hip/hip_cooperative_groups.h>
#include <stdint.h>
#include <cstdio>
namespace cg = cooperative_groups;

typedef unsigned short bf16_t;
typedef short bf16x8 __attribute__((ext_vector_type(8)));
typedef float f32x4 __attribute__((ext_vector_type(4)));
typedef unsigned u32x4 __attribute__((ext_vector_type(4)));
typedef unsigned u32x2 __attribute__((ext_vector_type(2)));

#define NTOK 16896
#define NPTOK 16384
#define LDS_BYTES 65536

#define OUT_Y   0
#define OUT_KP  34603008
#define OUT_VP  51380224
#define OUT_SP  68157440
#define OUT_KS  68681728
#define OUT_VS  69206016
#define OUT_SS  69730304

constexpr size_t SZ_XB     = (size_t)NTOK * 2048 * 2;
constexpr size_t SZ_T1K2   = (size_t)NTOK * 1024 * 2;
constexpr size_t SZ_W2     = (size_t)2048 * 2048 * 2;
constexpr size_t SZ_KS     = (size_t)64 * 1088 * 128 * 2;
constexpr size_t SZ_KP     = (size_t)32 * 4096 * 128 * 2;
constexpr size_t OFF_CTR   = 0;
constexpr size_t OFF_LB    = 4096;
constexpr size_t OFF_XB    = 8192;
constexpr size_t OFF_WINT  = OFF_XB + SZ_XB;
constexpr size_t OFF_WOUTT = OFF_WINT + (size_t)7168 * 2048 * 2;
constexpr size_t OFF_WQT   = OFF_WOUTT + SZ_W2;
constexpr size_t OFF_SKB   = OFF_WQT + SZ_W2;
constexpr size_t OFF_KS    = OFF_SKB + 524288;
constexpr size_t OFF_VTS   = OFF_KS + SZ_KS;
constexpr size_t OFF_R4    = OFF_VTS + SZ_KS;
constexpr size_t OFF_QA    = OFF_R4;
constexpr size_t OFF_LOGF  = OFF_QA + SZ_T1K2;
constexpr size_t OFF_IAT   = OFF_LOGF + 2 * SZ_T1K2;
constexpr size_t OFF_GA    = OFF_IAT + SZ_T1K2;
constexpr size_t OFF_QB    = OFF_GA + SZ_T1K2;
constexpr size_t OFF_KP    = OFF_QB + SZ_T1K2;
constexpr size_t OFF_VTP   = OFF_KP + SZ_KP;
constexpr size_t OFF_R4END = OFF_VTP + SZ_KP;
constexpr size_t OFF_X1F   = OFF_R4;
constexpr size_t OFF_UB    = OFF_XB;
constexpr size_t OFF_VB    = OFF_UB + (size_t)16384 * 2048;
constexpr size_t OFF_SCL   = OFF_VB + (size_t)16384 * 2048;
constexpr size_t OFF_MERGED= OFF_R4END;
constexpr size_t OFF_QP    = OFF_MERGED;
constexpr size_t OFF_X1B   = OFF_X1F + (size_t)NTOK * 2048 * 4;
constexpr size_t OFF_EIDX  = OFF_WINT;
constexpr size_t OFF_GATE  = OFF_EIDX + (size_t)NTOK * 128 * 4;
constexpr size_t OFF_DBUF  = OFF_WINT + (size_t)20 * 1024 * 1024;
constexpr size_t OFF_LS    = OFF_XB;
constexpr size_t WS_NEED_PAR = OFF_MERGED + SZ_XB;
static_assert((size_t)32 * 64 * 16 * 256 * 8 <= SZ_XB, "LS fits XB");
static_assert(OFF_SCL + 32768 * 4 <= OFF_WINT, "overlay"); static_assert(OFF_X1B + SZ_XB <= OFF_R4END, "overlay");

struct Params {
  const float* x_prompt; const float* x_sample; const float* cache_k; const float* cache_v; const float* state;
  const float* w_in; const float* hgrn_lb; const float* hgrn_g; const float* lq1; const float* lk1;
  const float* lq2; const float* lk2; const float* diff_g; const float* w_out; const float* ln1_g; const float* ln1_b;
  const float* wq; const float* subk; const float* pu; const float* pv; const float* ln2_g; const float* ln2_b;
  float* out; char* ws;
};

typedef __bf16 bf16x2_t __attribute__((ext_vector_type(2)));
typedef float f32x2_t __attribute__((ext_vector_type(2)));
__device__ __forceinline__ unsigned pk_bf16(float lo, float hi) {
  f32x2_t f = {lo, hi};
  bf16x2_t b = __builtin_convertvector(f, bf16x2_t);
  return __builtin_bit_cast(unsigned, b);
}
__device__ __forceinline__ float bf2f(unsigned short x) { return __uint_as_float(((unsigned)x) << 16); }
__device__ __forceinline__ float bflo(unsigned x) { return __uint_as_float(x << 16); }
__device__ __forceinline__ float bfhi(unsigned x) { return __uint_as_float(x & 0xffff0000u); }
__device__ __forceinline__ f32x4 mfma16(bf16x8 a, bf16x8 b, f32x4 c) {
  return __builtin_amdgcn_mfma_f32_16x16x32_bf16(a, b, c, 0, 0, 0);
}
__device__ __forceinline__ bf16x8 mk8(unsigned a, unsigned b, unsigned c, unsigned d) {
  u32x4 v = {a, b, c, d}; return __builtin_bit_cast(bf16x8, v);
}
__device__ __forceinline__ bf16x8 mk8(u32x2 a, u32x2 b) {
  u32x4 v = {a.x, a.y, b.x, b.y}; return __builtin_bit_cast(bf16x8, v);
}
__device__ __forceinline__ float wave_sum(float v) {
#pragma unroll
  for (int o = 32; o >= 1; o >>= 1) v += __shfl_xor(v, o);
  return v;
}

__device__ void transpose_conv(const float* __restrict__ W, bf16_t* __restrict__ WT, int K, int N, char* lds) {
  float* tile = (float*)lds;
  int tid_o = threadIdx.x; asm volatile("" : "+v"(tid_o)); const int tid = tid_o;
  const int nkt = K / 64, nnt = N / 64;
  for (int t = blockIdx.x; t < nkt * nnt; t += gridDim.x) {
    const int kt = t / nnt, nt = t % nnt;
    const int c = tid & 63, r0 = tid >> 6;
#pragma unroll 4
    for (int i = 0; i < 16; ++i) {
      int r = i * 4 + r0;
      tile[r * 65 + c] = W[(size_t)(kt * 64 + r) * N + nt * 64 + c];
    }
    __syncthreads();
#pragma unroll 4
    for (int i = 0; i < 16; ++i) {
      int n = i * 4 + r0;
      float v = tile[c * 65 + n];
      WT[(size_t)(nt * 64 + n) * K + kt * 64 + c] = (bf16_t)(pk_bf16(v, 0.f) & 0xffff);
    }
    __syncthreads();
  }
}

__device__ __forceinline__ void conv8(const float* __restrict__ src, bf16_t* __restrict__ dst) {
  f32x4 a = *(const f32x4*)src, b = *(const f32x4*)(src + 4);
  u32x4 o = {pk_bf16(a.x, a.y), pk_bf16(a.z, a.w), pk_bf16(b.x, b.y), pk_bf16(b.z, b.w)};
  *(u32x4*)dst = o;
}

__device__ void phase0(const Params& p, char* lds) {
  int tid_o = threadIdx.x; asm volatile("" : "+v"(tid_o)); const int tid = tid_o, bid = blockIdx.x;
  const size_t gtid = (size_t)bid * 256 + tid, gsz = (size_t)gridDim.x * 256;
  if (bid == 0) {
    if (tid < 64) {
      float a = p.lq1[tid] * p.lk1[tid], b = p.lq2[tid] * p.lk2[tid];
      a = wave_sum(a); b = wave_sum(b);
      if (tid == 0) ((float*)(p.ws + OFF_CTR))[16] = expf(a) - expf(b) + 0.2f;
    }
    float* LB = (float*)(p.ws + OFF_LB);
    for (int k = tid; k < 1024; k += 256) {
      float a0 = p.hgrn_lb[k], a1 = p.hgrn_lb[1024 + k];
      LB[k] = 1.0f / (1.0f + expf(a1 - a0));
    }
  }
  {
    bf16_t* XB = (bf16_t*)(p.ws + OFF_XB);
    const size_t nch = (size_t)NTOK * 2048 / 8;
    for (size_t c = gtid; c < nch; c += gsz) {
      size_t e = c * 8;
      const float* src = (e < (size_t)NPTOK * 2048) ? (p.x_prompt + e) : (p.x_sample + (e - (size_t)NPTOK * 2048));
      conv8(src, XB + e);
    }
  }
  {
    bf16_t* KS = (bf16_t*)(p.ws + OFF_KS);
    for (size_t c = gtid; c < (size_t)1048576; c += gsz) {
      int d8 = c & 15, h = (c >> 4) & 7, s = (c >> 7) & 1023, b = (int)(c >> 17);
      conv8(p.cache_k + c * 8, KS + ((size_t)((b * 8 + h) * 1088 + s) * 128 + d8 * 8));
    }
  }
  {
    bf16_t* VTS = (bf16_t*)(p.ws + OFF_VTS);
    for (size_t i = gtid; i < (size_t)2097152; i += gsz) {
      int vc = i & 127, s4 = (i >> 7) & 255, h = (i >> 15) & 7, b = (int)(i >> 18);
      const float* src = p.cache_v + ((size_t)(b * 1024 + s4 * 4) * 8 + h) * 128 + vc;
      float v0 = src[0], v1 = src[1024], v2 = src[2048], v3 = src[3072];
      u32x2 o = {pk_bf16(v0, v1), pk_bf16(v2, v3)};
      *(u32x2*)(VTS + ((size_t)((b * 8 + h) * 128 + vc) * 1088 + s4 * 4)) = o;
    }
  }
  {
    bf16_t* SKB = (bf16_t*)(p.ws + OFF_SKB);
    for (size_t c = gtid; c < (size_t)32768; c += gsz) conv8(p.subk + c * 8, SKB + c * 8);
  }
  transpose_conv(p.w_in, (bf16_t*)(p.ws + OFF_WINT), 2048, 7168, lds);
  transpose_conv(p.w_out, (bf16_t*)(p.ws + OFF_WOUTT), 2048, 2048, lds);
  transpose_conv(p.wq, (bf16_t*)(p.ws + OFF_WQT), 2048, 2048, lds);
}

template <bool SWAP>
__device__ __forceinline__ void gemm_compute_tile(const char* cur, int aoff, int boff, int sw, int fq, f32x4 (&acc)[4][4]) {
#pragma unroll
  for (int ks = 0; ks < 2; ++ks) {
    bf16x8 af[4], bfr[4];
    const int ch = ((ks * 4 + fq) ^ sw) << 4;
#pragma unroll
    for (int m = 0; m < 4; ++m) af[m] = *(const bf16x8*)(cur + aoff + m * 2048 + ch);
#pragma unroll
    for (int n = 0; n < 4; ++n) bfr[n] = *(const bf16x8*)(cur + boff + n * 2048 + ch);
#pragma unroll
    for (int m = 0; m < 4; ++m)
#pragma unroll
      for (int n = 0; n < 4; ++n)
        acc[m][n] = SWAP ? mfma16(bfr[n], af[m], acc[m][n]) : mfma16(af[m], bfr[n], acc[m][n]);
  }
}

template <bool SWAP>
__device__ __forceinline__ void gemm_mainloop(const bf16_t* A, const bf16_t* B,
                                              int row0, int col0, int K, char* lds, f32x4 (&acc)[4][4]) {
  int tid_o = threadIdx.x; asm volatile("" : "+v"(tid_o)); const int tid = tid_o, lane = tid & 63, wave = tid >> 6;
  const int wm = wave >> 1, wn = wave & 1, fr = lane & 15, fq = lane >> 4;
  const int lrow = tid >> 3, lc = tid & 7;
  const int cl = lc ^ (lrow & 7);
  const bf16_t* ga = A + (size_t)(row0 + lrow) * K + cl * 8;
  const bf16_t* gb = B + (size_t)(col0 + lrow) * K + cl * 8;
  const int loff = tid * 16;
#define G_STAGE(BUF, KT) { _Pragma("unroll") for (int i = 0; i < 4; ++i) { \
      __builtin_amdgcn_global_load_lds((const unsigned*)(ga + (size_t)i * 32 * K + (KT) * 64), (unsigned*)((BUF) + loff + i * 4096), 16, 0, 0); \
      __builtin_amdgcn_global_load_lds((const unsigned*)(gb + (size_t)i * 32 * K + (KT) * 64), (unsigned*)((BUF) + 16384 + loff + i * 4096), 16, 0, 0); } }
  const int nkt = K >> 6;
  G_STAGE(lds, 0);
  __syncthreads();
  const int aoff = (wm * 64 + fr) * 128, boff = 16384 + (wn * 64 + fr) * 128;
  const int sw = fr & 7;
  for (int kt = 0; kt < nkt; ++kt) {
    char* cur = lds + (kt & 1) * 32768;
    char* nxt = lds + ((kt + 1) & 1) * 32768;
    if (kt + 1 < nkt) G_STAGE(nxt, kt + 1);
    gemm_compute_tile<SWAP>(cur, aoff, boff, sw, fq, acc);
    __syncthreads();
  }
#undef G_STAGE
}

template <int MT, bool SWAP>
__device__ __forceinline__ void gemm_mainloop_big(const bf16_t* A, const bf16_t* B,
                                                  int row0, int col0, int K, char* lds, f32x4 (&acc)[MT][4]) {
  int tid_o = threadIdx.x; asm volatile("" : "+v"(tid_o)); const int tid = tid_o, lane = tid & 63, wave = tid >> 6;
  const int wm = wave >> 1, wn = wave & 1, fr = lane & 15, fq = lane >> 4;
  const int lrow = tid >> 3, lc = tid & 7;
  const int cl = lc ^ (lrow & 7);
  const bf16_t* ga = A + (size_t)(row0 + lrow) * K + cl * 8;
  const bf16_t* gb = B + (size_t)(col0 + lrow) * K + cl * 8;
  const int loff = tid * 16;
  const int nkt = K >> 6;
  constexpr int BOFF = MT * 32 * 128;
  const int aoff = (wm * (MT * 16) + fr) * 128, boff = BOFF + (wn * 64 + fr) * 128;
  const int sw = fr & 7;
  for (int kt = 0; kt < nkt; ++kt) {
#pragma unroll
    for (int i = 0; i < MT; ++i)
      __builtin_amdgcn_global_load_lds((const unsigned*)(ga + (size_t)i * 32 * K + kt * 64), (unsigned*)(lds + loff + i * 4096), 16, 0, 0);
#pragma unroll
    for (int i = 0; i < 4; ++i)
      __builtin_amdgcn_global_load_lds((const unsigned*)(gb + (size_t)i * 32 * K + kt * 64), (unsigned*)(lds + BOFF + loff + i * 4096), 16, 0, 0);
    __syncthreads();
#pragma unroll
    for (int ks = 0; ks < 2; ++ks) {
      bf16x8 af[MT], bfr[4];
      const int ch = ((ks * 4 + fq) ^ sw) << 4;
#pragma unroll
      for (int m = 0; m < MT; ++m) af[m] = *(const bf16x8*)(lds + aoff + m * 2048 + ch);
#pragma unroll
      for (int n = 0; n < 4; ++n) bfr[n] = *(const bf16x8*)(lds + boff + n * 2048 + ch);
#pragma unroll
      for (int m = 0; m < MT; ++m)
#pragma unroll
        for (int n = 0; n < 4; ++n)
          acc[m][n] = SWAP ? mfma16(bfr[n], af[m], acc[m][n]) : mfma16(af[m], bfr[n], acc[m][n]);
    }
    __syncthreads();
  }
}

template <bool SWAP>
__device__ void gemm1_tile(const Params& p, int mt, int nt, char* lds) {
  f32x4 acc[8][4];
#pragma unroll
  for (int m = 0; m < 8; ++m)
#pragma unroll
    for (int n = 0; n < 4; ++n) acc[m][n] = (f32x4){0.f, 0.f, 0.f, 0.f};
  gemm_mainloop_big<8, SWAP>((const bf16_t*)(p.ws + OFF_XB), (const bf16_t*)(p.ws + OFF_WINT), mt * 256, nt * 128, 2048, lds, acc);
  int tidv = threadIdx.x; asm volatile("" : "+v"(tidv));
  const int tid = tidv, lane = tid & 63, wave = tid >> 6;
  const int wm = wave >> 1, wn = wave & 1, fr = lane & 15, fq = lane >> 4;
  const int seg = nt >> 3, h = nt & 7;
  const bool samp = (mt * 256 >= NPTOK);
  if (SWAP) {
    const float* LB = (const float*)(p.ws + OFF_LB);
#pragma unroll
    for (int m = 0; m < 8; ++m) {
      const int tok = mt * 256 + wm * 128 + m * 16 + fr;
#pragma unroll
      for (int n = 0; n < 4; ++n) {
        const int cl = wn * 64 + n * 16 + fq * 4;
        const int kidx = h * 128 + cl;
        f32x4 v = acc[m][n];
        if (seg == 0) {
          u32x2 o = {pk_bf16(v.x, v.y), pk_bf16(v.z, v.w)};
          *(u32x2*)((bf16_t*)(p.ws + OFF_QA) + (size_t)tok * 1024 + kidx) = o;
        } else if (seg == 1) {
          f32x4 lb = *(const f32x4*)(LB + kidx);
          f32x4 o;
          o.x = lb.x + (1.f - lb.x) / (1.f + __expf(-v.x));
          o.y = lb.y + (1.f - lb.y) / (1.f + __expf(-v.y));
          o.z = lb.z + (1.f - lb.z) / (1.f + __expf(-v.z));
          o.w = lb.w + (1.f - lb.w) / (1.f + __expf(-v.w));
          *(f32x4*)((float*)(p.ws + OFF_LOGF) + (size_t)tok * 1024 + kidx) = o;
        } else if (seg == 3) {
          float s0 = 1.f / (1.f + __expf(-v.x)), s1 = 1.f / (1.f + __expf(-v.y));
          float s2 = 1.f / (1.f + __expf(-v.z)), s3 = 1.f / (1.f + __expf(-v.w));
          u32x2 o = {pk_bf16(s0, s1), pk_bf16(s2, s3)};
          *(u32x2*)((bf16_t*)(p.ws + OFF_GA) + (size_t)tok * 1024 + kidx) = o;
        } else if (seg == 4) {
          const float sc = 0.18033688011112042f;
          u32x2 o = {pk_bf16(v.x * sc, v.y * sc), pk_bf16(v.z * sc, v.w * sc)};
          *(u32x2*)((bf16_t*)(p.ws + OFF_QB) + (size_t)tok * 1024 + kidx) = o;
        } else {
          u32x2 o = {pk_bf16(v.x, v.y), pk_bf16(v.z, v.w)};
          if (!samp) {
            *(f32x4*)(p.out + OUT_KP + (size_t)tok * 1024 + kidx) = v;
            const int b = tok >> 12, t = tok & 4095;
            *(u32x2*)((bf16_t*)(p.ws + OFF_KP) + ((size_t)((b * 8 + h) * 4096 + t) * 128 + cl)) = o;
          } else {
            const int ts = tok - NPTOK;
            *(f32x4*)(p.out + OUT_KS + (size_t)ts * 1024 + kidx) = v;
            const int b = ts >> 6, t = ts & 63;
            *(u32x2*)((bf16_t*)(p.ws + OFF_KS) + ((size_t)((b * 8 + h) * 1088 + 1024 + t) * 128 + cl)) = o;
          }
        }
      }
    }
  } else {
#pragma unroll
    for (int m = 0; m < 8; ++m) {
      const int tok0 = mt * 256 + wm * 128 + m * 16 + fq * 4;
#pragma unroll
      for (int n = 0; n < 4; ++n) {
        const int cl = wn * 64 + n * 16 + fr;
        f32x4 v = acc[m][n];
        u32x2 o = {pk_bf16(v.x, v.y), pk_bf16(v.z, v.w)};
        if (seg == 2) {
          bf16_t* IAT = (bf16_t*)(p.ws + OFF_IAT);
          if (!samp) {
            const int b = tok0 >> 12, t = tok0 & 4095;
            *(u32x2*)(IAT + ((size_t)((b * 8 + h) * 128 + cl) * 4096 + t)) = o;
          } else {
            const int ts = tok0 - NPTOK, b = ts >> 6, t = ts & 63;
            *(u32x2*)(IAT + (size_t)32 * 128 * 4096 + ((size_t)((b * 8 + h) * 128 + cl) * 64 + t)) = o;
          }
        } else {
          if (!samp) {
            float* ov = p.out + OUT_VP + (size_t)tok0 * 1024 + h * 128 + cl;
            ov[0] = v.x; ov[1024] = v.y; ov[2048] = v.z; ov[3072] = v.w;
            const int b = tok0 >> 12, t = tok0 & 4095;
            *(u32x2*)((bf16_t*)(p.ws + OFF_VTP) + ((size_t)((b * 8 + h) * 128 + cl) * 4096 + t)) = o;
          } else {
            const int ts = tok0 - NPTOK, b = ts >> 6, t = ts & 63;
            float* ov = p.out + OUT_VS + (size_t)ts * 1024 + h * 128 + cl;
            ov[0] = v.x; ov[1024] = v.y; ov[2048] = v.z; ov[3072] = v.w;
            *(u32x2*)((bf16_t*)(p.ws + OFF_VTS) + ((size_t)((b * 8 + h) * 128 + cl) * 1088 + 1024 + t)) = o;
          }
        }
      }
    }
  }
}

__device__ void phase1(const Params& p, char* lds) {
  const int xcd = blockIdx.x & 7, lb = blockIdx.x >> 3, nbx = gridDim.x >> 3;
  const int nM = NTOK / 256, nNx = 7;
  for (int li = lb; li < nM * nNx; li += nbx) {
    const int mt = li / nNx, nt = (li % nNx) * 8 + xcd;
    const int seg = nt >> 3;
    if (seg == 2 || seg == 6) gemm1_tile<false>(p, mt, nt, lds);
    else gemm1_tile<true>(p, mt, nt, lds);
  }
}

template <int MODE, int MT>
__device__ void gemm23_tile(const Params& p, int row0, int nt, char* lds) {
  const bf16_t* A = (const bf16_t*)(p.ws + (MODE == 0 ? OFF_MERGED : OFF_X1B));
  const bf16_t* B = (const bf16_t*)(p.ws + (MODE == 0 ? OFF_WOUTT : OFF_WQT));
  f32x4 acc[MT][4];
#pragma unroll
  for (int m = 0; m < MT; ++m)
#pragma unroll
    for (int n = 0; n < 4; ++n) acc[m][n] = (f32x4){0.f, 0.f, 0.f, 0.f};
  if (MT == 4) gemm_mainloop<true>(A, B, row0, nt * 128, 2048, lds, (f32x4(&)[4][4])acc);
  else gemm_mainloop_big<MT, true>(A, B, row0, nt * 128, 2048, lds, acc);
  int tid_o = threadIdx.x; asm volatile("" : "+v"(tid_o)); const int tid = tid_o, lane = tid & 63, wave = tid >> 6;
  const int wm = wave >> 1, wn = wave & 1, fr = lane & 15, fq = lane >> 4;
#pragma unroll
  for (int m = 0; m < MT; ++m) {
    const int tok = row0 + wm * (MT * 16) + m * 16 + fr;
#pragma unroll
    for (int n = 0; n < 4; ++n) {
      const int col = nt * 128 + wn * 64 + n * 16 + fq * 4;
      f32x4 v = acc[m][n];
      if (MODE == 0) {
        const float* xin = (tok < NPTOK) ? (p.x_prompt + (size_t)tok * 2048) : (p.x_sample + (size_t)(tok - NPTOK) * 2048);
        f32x4 xv = *(const f32x4*)(xin + col);
        const float al = 1.189207115002721f;
        u32x2 o = {pk_bf16(al * xv.x + v.x, al * xv.y + v.y), pk_bf16(al * xv.z + v.z, al * xv.w + v.w)};
        *(u32x2*)((bf16_t*)(p.ws + OFF_X1B) + (size_t)tok * 2048 + col) = o;
      } else {
        u32x2 o = {pk_bf16(v.x, v.y), pk_bf16(v.z, v.w)};
        *(u32x2*)((bf16_t*)(p.ws + OFF_QP) + (size_t)tok * 2048 + col) = o;
      }
    }
  }
}

template <int MODE>
__device__ void gemm23(const Params& p, char* lds) {
  const int xcd = blockIdx.x & 7, lb = blockIdx.x >> 3, nbx = gridDim.x >> 3;
  for (int li = lb; li < 64 * 2; li += nbx) gemm23_tile<MODE, 8>(p, (li >> 1) * 256, (li & 1) * 8 + xcd, lds);
  for (int li = lb; li < 4 * 2; li += nbx) gemm23_tile<MODE, 4>(p, NPTOK + (li >> 1) * 128, (li & 1) * 8 + xcd, lds);
}

__device__ void hgrn_item(const Params& p, int kind, int b, int h, char* lds, int mode, int c0) {
  int tid_o = threadIdx.x; asm volatile("" : "+v"(tid_o)); const int tid = tid_o, lane = tid & 63, w = tid >> 6, fr = lane & 15, fq = lane >> 4;
  const int tokbase = kind == 0 ? b * 4096 : NPTOK + b * 64;
  const int c_begin = mode == 0 ? 0 : c0, nch = mode == 0 ? (kind == 0 ? 64 : 1) : c0 + 1;
  u32x2* LSb = (u32x2*)(p.ws + OFF_LS) + ((size_t)((b * 8 + h) * 64 + c0) * 16) * 256 + tid;
  const bf16_t* IATb = (const bf16_t*)(p.ws + OFF_IAT) +
      (kind == 0 ? (size_t)((b * 8 + h) * 128) * 4096 : (size_t)32 * 128 * 4096 + (size_t)((b * 8 + h) * 128) * 64);
  const int iat_stride = kind == 0 ? 4096 : 64;
  const float* LOGF = (const float*)(p.ws + OFF_LOGF);
  const bf16_t* QA = (const bf16_t*)(p.ws + OFF_QA);
  const bf16_t* GA = (const bf16_t*)(p.ws + OFF_GA);
  bf16_t* MERGED = (bf16_t*)(p.ws + OFF_MERGED);

  f32x4 S[8][2];
  if (mode == 2) {
#pragma unroll
    for (int kt = 0; kt < 8; ++kt)
#pragma unroll
      for (int vv = 0; vv < 2; ++vv) {
        u32x2 t = LSb[(kt * 2 + vv) * 256];
        S[kt][vv] = (f32x4){bflo(t.x), bfhi(t.x), bflo(t.y), bfhi(t.y)};
      }
  } else if (kind == 0) {
#pragma unroll
    for (int kt = 0; kt < 8; ++kt)
#pragma unroll
      for (int vv = 0; vv < 2; ++vv) S[kt][vv] = (f32x4){0.f, 0.f, 0.f, 0.f};
  } else {
    const float* st = p.state + (size_t)((b * 8 + h) * 128) * 128 + (4 * fq) * 128 + 32 * w + fr;
#pragma unroll
    for (int kt = 0; kt < 8; ++kt)
#pragma unroll
      for (int vv = 0; vv < 2; ++vv)
#pragma unroll
        for (int j = 0; j < 4; ++j) S[kt][vv][j] = st[(16 * kt + j) * 128 + 16 * vv];
  }
  f32x4 gn[2];
#pragma unroll
  for (int vv = 0; vv < 2; ++vv) gn[vv] = *(const f32x4*)(p.hgrn_g + 32 * w + 16 * vv + 4 * fq);

  const int ekp = tid & 63, eq = tid >> 6;

  u32x4 gR[8];
  unsigned qn[16];
#pragma unroll
  for (int i = 0; i < 8; ++i) {
    int id = tid + 256 * i, row = id >> 5, cc = id & 31;
    gR[i] = *(const u32x4*)(LOGF + (size_t)(tokbase + c_begin * 64 + row) * 1024 + h * 128 + cc * 4);
  }
#pragma unroll
  for (int i = 0; i < 16; ++i) qn[i] = *(const unsigned*)(QA + (size_t)(tokbase + c_begin * 64 + 16 * eq + i) * 1024 + h * 128 + 2 * ekp);
  for (int c = c_begin; c < nch; ++c) {
    int zz = 0; asm volatile("" : "+v"(zz));
    int tidv = threadIdx.x; asm volatile("" : "+v"(tidv));
    const int tid = tidv, lane = tid & 63, w = tid >> 6, fr = lane & 15, fq = lane >> 4, ekp = tid & 63, eq = tid >> 6;
    char* L = lds + zz;
    float* Dl = (float*)(L + 57344);
    float* part = (float*)(L + 57856);
    const int tok0 = tokbase + c * 64 + zz;
#pragma unroll
    for (int i = 0; i < 8; ++i) {
      int id = tid + 256 * i, row = id >> 5, cc = id & 31;
      *(u32x4*)(L + row * 512 + cc * 16) = gR[i];
    }
    unsigned qv[16];
#pragma unroll
    for (int i = 0; i < 16; ++i) qv[i] = qn[i];
    if (c + 1 < nch) {
#pragma unroll
      for (int i = 0; i < 8; ++i) {
        int id = tid + 256 * i, row = id >> 5, cc = id & 31;
        gR[i] = *(const u32x4*)(LOGF + (size_t)(tok0 + 64 + row) * 1024 + h * 128 + cc * 4);
      }
    }
    bf16x8 vfr[2][2];
#pragma unroll
    for (int ss = 0; ss < 2; ++ss)
#pragma unroll
      for (int vv = 0; vv < 2; ++vv)
        vfr[ss][vv] = *(const bf16x8*)(IATb + (size_t)(32 * w + 16 * vv + fr) * iat_stride + c * 64 + zz + 32 * ss + 8 * fq);
    __syncthreads();
    typedef float f32x2 __attribute__((ext_vector_type(2)));
    f32x2 gv[16];
    const float* Gl = (const float*)L;
    float* qtot = (float*)(L + 58880);
    float tot0 = 1.f, tot1 = 1.f;
#pragma unroll
    for (int i = 0; i < 16; ++i) { gv[i] = *(const f32x2*)(Gl + (16 * eq + i) * 128 + 2 * ekp); tot0 *= gv[i].x; tot1 *= gv[i].y; }
    qtot[eq * 128 + 2 * ekp] = tot0; qtot[eq * 128 + 2 * ekp + 1] = tot1;
    __syncthreads();
    {
      float run0 = 1.f, run1 = 1.f;
      for (int qq = 0; qq < eq; ++qq) { run0 *= qtot[qq * 128 + 2 * ekp]; run1 *= qtot[qq * 128 + 2 * ekp + 1]; }
      const int k0 = 2 * ekp;
#pragma unroll
      for (int i4 = 0; i4 < 4; ++i4) {
        float ka[4], kb[4];
#pragma unroll
        for (int ii = 0; ii < 4; ++ii) {
          const int i = i4 * 4 + ii, t = 16 * eq + i;
          const float f0 = gv[i].x, f1 = gv[i].y;
          run0 *= f0; run1 *= f1;
          const float q0 = bflo(qv[i]) * run0, q1 = bfhi(qv[i]) * run1;
          const float kk0 = (1.f - f0) * __builtin_amdgcn_rcpf(run0), kk1 = (1.f - f1) * __builtin_amdgcn_rcpf(run1);
          ka[ii] = kk0; kb[ii] = kk1;
          const int o = (t * 128 + ((((k0 >> 3) ^ (t & 15)) << 3) | (k0 & 7))) * 2;
          if (mode != 1) {
            *(unsigned*)(L + o) = pk_bf16(q0, q1);
            *(unsigned*)(L + 16384 + o) = pk_bf16(kk0, kk1);
          }
        }
        const int t0 = 16 * eq + i4 * 4;
        u32x2 oa = {pk_bf16(ka[0], ka[1]), pk_bf16(ka[2], ka[3])};
        u32x2 ob = {pk_bf16(kb[0], kb[1]), pk_bf16(kb[2], kb[3])};
        if (mode != 2) {
          *(u32x2*)(L + 32768 + k0 * 128 + ((((t0 >> 3) ^ (k0 & 7)) << 4) | ((t0 & 7) << 1))) = oa;
          *(u32x2*)(L + 32768 + (k0 + 1) * 128 + ((((t0 >> 3) ^ ((k0 + 1) & 7)) << 4) | ((t0 & 7) << 1))) = ob;
        }
      }
      if (eq == 3) { Dl[k0] = run0; Dl[k0 + 1] = run1; }
    }
    if (c + 1 < nch) {
#pragma unroll
      for (int i = 0; i < 16; ++i) qn[i] = *(const unsigned*)(QA + (size_t)(tok0 + 64 + 16 * eq + i) * 1024 + h * 128 + 2 * ekp);
    }
    __syncthreads();
    if (mode != 1) {
      bf16x8 qf[4];
#pragma unroll
      for (int ks = 0; ks < 4; ++ks) {
        const int t = 16 * w + fr;
        qf[ks] = *(const bf16x8*)(L + t * 256 + (((4 * ks + fq) ^ (t & 15)) << 4));
      }
#pragma unroll
      for (int st = 0; st < 4; ++st) {
        f32x4 a = {0.f, 0.f, 0.f, 0.f};
#pragma unroll
        for (int ks = 0; ks < 4; ++ks) {
          const int s = 16 * st + fr;
          bf16x8 kf = *(const bf16x8*)(L + 16384 + s * 256 + (((4 * ks + fq) ^ (s & 15)) << 4));
          a = mfma16(kf, qf[ks], a);
        }
        const int t = 16 * w + fr, s0 = 16 * st + 4 * fq;
        float p0 = (s0 + 0 <= t) ? a.x : 0.f, p1 = (s0 + 1 <= t) ? a.y : 0.f;
        float p2 = (s0 + 2 <= t) ? a.z : 0.f, p3 = (s0 + 3 <= t) ? a.w : 0.f;
        u32x2 o2 = {pk_bf16(p0, p1), pk_bf16(p2, p3)};
        *(u32x2*)(L + 49152 + t * 128 + ((((s0 >> 3) ^ (t & 7)) << 4) | ((s0 & 7) << 1))) = o2;
      }
    }
    f32x4 O[2][4];
#pragma unroll
    for (int vv = 0; vv < 2; ++vv)
#pragma unroll
      for (int tt = 0; tt < 4; ++tt) O[vv][tt] = (f32x4){0.f, 0.f, 0.f, 0.f};
    if (mode != 1) {
#pragma unroll
    for (int ks = 0; ks < 4; ++ks) {
      bf16x8 sf[2];
#pragma unroll
      for (int vv = 0; vv < 2; ++vv)
        sf[vv] = mk8(pk_bf16(S[2 * ks][vv].x, S[2 * ks][vv].y), pk_bf16(S[2 * ks][vv].z, S[2 * ks][vv].w),
                     pk_bf16(S[2 * ks + 1][vv].x, S[2 * ks + 1][vv].y), pk_bf16(S[2 * ks + 1][vv].z, S[2 * ks + 1][vv].w));
#pragma unroll
      for (int tt = 0; tt < 4; ++tt) {
        const int t = 16 * tt + fr;
        const int c0 = 4 * ks + (fq >> 1), c1 = 4 * ks + 2 + (fq >> 1);
        u32x2 q0 = *(const u32x2*)(L + t * 256 + ((c0 ^ (t & 15)) << 4) + ((fq & 1) << 3));
        u32x2 q1 = *(const u32x2*)(L + t * 256 + ((c1 ^ (t & 15)) << 4) + ((fq & 1) << 3));
        bf16x8 qp = mk8(q0, q1);
#pragma unroll
        for (int vv = 0; vv < 2; ++vv) O[vv][tt] = mfma16(sf[vv], qp, O[vv][tt]);
      }
    }
    }
    __syncthreads();
#pragma unroll
    for (int ss = 0; ss < 2; ++ss) {
      bf16x8 vf[2];
#pragma unroll
      for (int vv = 0; vv < 2; ++vv) vf[vv] = vfr[ss][vv];
      if (mode != 1) {
#pragma unroll
      for (int tt = 0; tt < 4; ++tt) {
        const int t = 16 * tt + fr;
        bf16x8 pf = *(const bf16x8*)(L + 49152 + t * 128 + (((4 * ss + fq) ^ (t & 7)) << 4));
#pragma unroll
        for (int vv = 0; vv < 2; ++vv) O[vv][tt] = mfma16(vf[vv], pf, O[vv][tt]);
      }
      }
      if (mode != 2) {
#pragma unroll
      for (int kt = 0; kt < 8; ++kt) {
        const int r = 16 * kt + fr;
        bf16x8 kf = *(const bf16x8*)(L + 32768 + r * 128 + (((4 * ss + fq) ^ (r & 7)) << 4));
#pragma unroll
        for (int vv = 0; vv < 2; ++vv) S[kt][vv] = mfma16(kf, vf[vv], S[kt][vv]);
      }
      }
    }
    if (mode != 2) {
#pragma unroll
    for (int kt = 0; kt < 8; ++kt) {
      f32x4 d = *(const f32x4*)(Dl + 16 * kt + 4 * fq);
#pragma unroll
      for (int vv = 0; vv < 2; ++vv) { S[kt][vv].x *= d.x; S[kt][vv].y *= d.y; S[kt][vv].z *= d.z; S[kt][vv].w *= d.w; }
    }
    }
    if (mode == 1 && tid < 128) ((float*)(p.ws + OFF_DBUF))[(size_t)((b * 8 + h) * 64 + c) * 128 + tid] = Dl[tid];
    if (mode != 1) {
#pragma unroll
    for (int tt = 0; tt < 4; ++tt) {
      float ss = 0.f;
#pragma unroll
      for (int vv = 0; vv < 2; ++vv) ss += O[vv][tt].x * O[vv][tt].x + O[vv][tt].y * O[vv][tt].y + O[vv][tt].z * O[vv][tt].z + O[vv][tt].w * O[vv][tt].w;
      ss += __shfl_xor(ss, 16);
      ss += __shfl_xor(ss, 32);
      if (fq == 0) part[w * 64 + 16 * tt + fr] = ss;
    }
    __syncthreads();
#pragma unroll
    for (int tt = 0; tt < 4; ++tt) {
      const int t = 16 * tt + fr;
      const float tot = part[t] + part[64 + t] + part[128 + t] + part[192 + t];
      const float r = rsqrtf(tot * (1.f / 128.f) + 1e-5f);
      const size_t tok = (size_t)(tok0 + t);
#pragma unroll
      for (int vv = 0; vv < 2; ++vv) {
        const int v0 = h * 128 + 32 * w + 16 * vv + 4 * fq;
        u32x2 gt = *(const u32x2*)(GA + tok * 1024 + v0);
        float o0 = O[vv][tt].x * r * gn[vv].x * bflo(gt.x);
        float o1 = O[vv][tt].y * r * gn[vv].y * bfhi(gt.x);
        float o2 = O[vv][tt].z * r * gn[vv].z * bflo(gt.y);
        float o3 = O[vv][tt].w * r * gn[vv].w * bfhi(gt.y);
        u32x2 ov = {pk_bf16(o0, o1), pk_bf16(o2, o3)};
        *(u32x2*)(MERGED + tok * 2048 + v0) = ov;
      }
    }
    }
    __syncthreads();
  }
  if (mode == 1) {
#pragma unroll
    for (int kt = 0; kt < 8; ++kt)
#pragma unroll
      for (int vv = 0; vv < 2; ++vv) {
        u32x2 t = {pk_bf16(S[kt][vv].x, S[kt][vv].y), pk_bf16(S[kt][vv].z, S[kt][vv].w)};
        LSb[(kt * 2 + vv) * 256] = t;
      }
    return;
  }
  if (mode == 2) return;
  int zq = 0; asm volatile("" : "+v"(zq));
  float* so = p.out + (kind == 0 ? OUT_SP : OUT_SS) + (size_t)((b * 8 + h) * 128) * 128 + (4 * fq) * 128 + 32 * w + fr + zq;
#pragma unroll
  for (int kt = 0; kt < 8; ++kt)
#pragma unroll
    for (int vv = 0; vv < 2; ++vv)
#pragma unroll
      for (int j = 0; j < 4; ++j) so[(16 * kt + j) * 128 + 16 * vv] = S[kt][vv][j];
}


__device__ void hgrn_scan_item(const Params& p, int chain, int kt) {
  int tid_o = threadIdx.x; asm volatile("" : "+v"(tid_o)); const int tid = tid_o, lane = tid & 63, w = tid >> 6, fr = lane & 15, fq = lane >> 4;
  u32x2* LS = (u32x2*)(p.ws + OFF_LS) + ((size_t)(chain * 64) * 16 + kt * 2) * 256 + tid;
  const float* DB = (const float*)(p.ws + OFF_DBUF) + (size_t)(chain * 64) * 128 + 16 * kt + 4 * fq;
  f32x4 S0 = {0.f, 0.f, 0.f, 0.f}, S1 = {0.f, 0.f, 0.f, 0.f};
#pragma unroll 1
  for (int c8 = 0; c8 < 64; c8 += 8) {
    u32x2 l0[8], l1[8];
    f32x4 d[8];
#pragma unroll
    for (int i = 0; i < 8; ++i) {
      l0[i] = LS[(size_t)(c8 + i) * 16 * 256];
      l1[i] = LS[(size_t)(c8 + i) * 16 * 256 + 256];
      d[i] = *(const f32x4*)(DB + (c8 + i) * 128);
    }
#pragma unroll
    for (int i = 0; i < 8; ++i) {
      u32x2 o0 = {pk_bf16(S0.x, S0.y), pk_bf16(S0.z, S0.w)}, o1 = {pk_bf16(S1.x, S1.y), pk_bf16(S1.z, S1.w)};
      LS[(size_t)(c8 + i) * 16 * 256] = o0; LS[(size_t)(c8 + i) * 16 * 256 + 256] = o1;
      S0.x = d[i].x * S0.x + bflo(l0[i].x); S0.y = d[i].y * S0.y + bfhi(l0[i].x); S0.z = d[i].z * S0.z + bflo(l0[i].y); S0.w = d[i].w * S0.w + bfhi(l0[i].y);
      S1.x = d[i].x * S1.x + bflo(l1[i].x); S1.y = d[i].y * S1.y + bfhi(l1[i].x); S1.z = d[i].z * S1.z + bflo(l1[i].y); S1.w = d[i].w * S1.w + bfhi(l1[i].y);
    }
  }
  float* so = p.out + OUT_SP + (size_t)(chain * 128) * 128 + (size_t)(16 * kt + 4 * fq) * 128 + 32 * w + fr;
  so[0] = S0.x; so[128] = S0.y; so[256] = S0.z; so[384] = S0.w;
  so[16] = S1.x; so[128 + 16] = S1.y; so[256 + 16] = S1.z; so[384 + 16] = S1.w;
}

__device__ void attn_item(const Params& p, int kind, int bh, int qt, char* lds) {
  int tid_o = threadIdx.x; asm volatile("" : "+v"(tid_o)); const int tid = tid_o, lane = tid & 63, w = tid >> 6, fr = lane & 15, fq = lane >> 4;
  const int b = bh >> 3, h = bh & 7;
  const int nkt = kind == 0 ? qt + 1 : 17;
  const int tok0 = kind == 0 ? b * 4096 + qt * 64 : NPTOK + b * 64;
  const int qpos0 = kind == 0 ? qt * 64 : 1024;
  const bf16_t* Kb = kind == 0 ? (const bf16_t*)(p.ws + OFF_KP) + (size_t)bh * 4096 * 128
                               : (const bf16_t*)(p.ws + OFF_KS) + (size_t)bh * 1088 * 128;
  const bf16_t* Vb = kind == 0 ? (const bf16_t*)(p.ws + OFF_VTP) + (size_t)bh * 128 * 4096
                               : (const bf16_t*)(p.ws + OFF_VTS) + (size_t)bh * 128 * 1088;
  const int vstride = kind == 0 ? 4096 : 1088;
  const float slope2 = exp2f(-(float)(h + 1)) * 1.4426950408889634f;

  const int tok = tok0 + 16 * w + fr;
  bf16x8 qf[4];
  {
    const bf16_t* qp = (const bf16_t*)(p.ws + OFF_QB) + (size_t)tok * 1024 + h * 128;
#pragma unroll
    for (int ks = 0; ks < 4; ++ks) qf[ks] = *(const bf16x8*)(qp + 32 * ks + 8 * fq);
  }
  const float qposf = (float)(qpos0 + 16 * w + fr);
  f32x4 O0[8], O1[8];
#pragma unroll
  for (int i = 0; i < 8; ++i) { O0[i] = (f32x4){0.f, 0.f, 0.f, 0.f}; O1[i] = (f32x4){0.f, 0.f, 0.f, 0.f}; }
  float mx[2] = {-1e30f, -1e30f}, ls[2] = {0.f, 0.f};

  u32x4 rk[4], rv[4];
  {
    const int kkey = tid >> 4, kc = tid & 15, vrow = tid >> 3, vc = tid & 7;
    const int kt = nkt - 1;
#pragma unroll
    for (int i = 0; i < 4; ++i) {
      rk[i] = *(const u32x4*)(Kb + (size_t)(kt * 64 + kkey + 16 * i) * 128 + kc * 8);
      rv[i] = *(const u32x4*)(Vb + (size_t)(vrow + 32 * i) * vstride + kt * 64 + vc * 8);
    }
#pragma unroll
    for (int i = 0; i < 4; ++i) {
      const int key = kkey + 16 * i;
      *(u32x4*)(lds + key * 256 + ((kc ^ (key & 15)) << 4)) = rk[i];
      const int r = vrow + 32 * i;
      *(u32x4*)(lds + 16384 + r * 128 + ((vc ^ ((r >> 1) & 7)) << 4)) = rv[i];
    }
    if (nkt > 1) {
#pragma unroll
      for (int i = 0; i < 4; ++i) {
        rk[i] = *(const u32x4*)(Kb + (size_t)((kt - 1) * 64 + kkey + 16 * i) * 128 + kc * 8);
        rv[i] = *(const u32x4*)(Vb + (size_t)(vrow + 32 * i) * vstride + (kt - 1) * 64 + vc * 8);
      }
    }
    __syncthreads();
  }
  for (int it = 0; it < nkt; ++it) {
    int zz = 0; asm volatile("" : "+v"(zz));
    int tidv = threadIdx.x; asm volatile("" : "+v"(tidv));
    const int tid = tidv, lane = tid & 63, w = tid >> 6, fr = lane & 15, fq = lane >> 4;
    const int kkey = tid >> 4, kc = tid & 15, vrow = tid >> 3, vc = tid & 7;
    const int kt = nkt - 1 - it;
    char* L = lds + zz + (it & 1) * 32768;
    char* Ln = lds + zz + ((it + 1) & 1) * 32768;
    if (it + 1 < nkt) {
#pragma unroll
      for (int i = 0; i < 4; ++i) {
        const int key = kkey + 16 * i;
        *(u32x4*)(Ln + key * 256 + ((kc ^ (key & 15)) << 4)) = rk[i];
        const int r = vrow + 32 * i;
        *(u32x4*)(Ln + 16384 + r * 128 + ((vc ^ ((r >> 1) & 7)) << 4)) = rv[i];
      }
    }
    if (it + 2 < nkt) {
#pragma unroll
      for (int i = 0; i < 4; ++i) {
        rk[i] = *(const u32x4*)(Kb + (size_t)((kt - 2) * 64 + zz + kkey + 16 * i) * 128 + kc * 8);
        rv[i] = *(const u32x4*)(Vb + (size_t)(vrow + 32 * i) * vstride + (kt - 2) * 64 + zz + vc * 8);
      }
    }
    const float kposf = (float)(kt * 64 + 4 * fq) - qposf;
    bf16x8 pf[2][2];
    bool live[2];
#pragma unroll
    for (int m = 0; m < 2; ++m) {
      f32x4 s[4];
#pragma unroll
      for (int k16 = 0; k16 < 4; ++k16) {
        s[k16] = (f32x4){0.f, 0.f, 0.f, 0.f};
        const int key = 16 * k16 + fr;
#pragma unroll
        for (int ks2 = 0; ks2 < 2; ++ks2) {
          bf16x8 kf = *(const bf16x8*)(L + key * 256 + (((8 * m + 4 * ks2 + fq) ^ (key & 15)) << 4));
          s[k16] = mfma16(kf, qf[2 * m + ks2], s[k16]);
        }
      }
      float tmax = -1e30f;
#pragma unroll
      for (int k16 = 0; k16 < 4; ++k16)
#pragma unroll
        for (int j = 0; j < 4; ++j) {
          const float d = kposf + (float)(16 * k16 + j);
          const float v = s[k16][j] - slope2 * fabsf(d);
          s[k16][j] = v;
          tmax = fmaxf(tmax, v);
        }
      tmax = fmaxf(tmax, __shfl_xor(tmax, 16));
      tmax = fmaxf(tmax, __shfl_xor(tmax, 32));
      live[m] = !__all(tmax - mx[m] < -40.f);
      if (live[m]) {
        const float mnew = fmaxf(mx[m], tmax);
        const float alpha = __builtin_amdgcn_exp2f(mx[m] - mnew);
        mx[m] = mnew;
        float psum = 0.f;
#pragma unroll
        for (int k16 = 0; k16 < 4; ++k16)
#pragma unroll
          for (int j = 0; j < 4; ++j) { const float e = __builtin_amdgcn_exp2f(s[k16][j] - mnew); s[k16][j] = e; psum += e; }
        ls[m] = ls[m] * alpha + psum;
        if (m == 0) {
#pragma unroll
          for (int i = 0; i < 8; ++i) { O0[i].x *= alpha; O0[i].y *= alpha; O0[i].z *= alpha; O0[i].w *= alpha; }
        } else {
#pragma unroll
          for (int i = 0; i < 8; ++i) { O1[i].x *= alpha; O1[i].y *= alpha; O1[i].z *= alpha; O1[i].w *= alpha; }
        }
#pragma unroll
        for (int ks = 0; ks < 2; ++ks)
          pf[m][ks] = mk8(pk_bf16(s[2 * ks].x, s[2 * ks].y), pk_bf16(s[2 * ks].z, s[2 * ks].w),
                          pk_bf16(s[2 * ks + 1].x, s[2 * ks + 1].y), pk_bf16(s[2 * ks + 1].z, s[2 * ks + 1].w));
      } else {
#pragma unroll
        for (int ks = 0; ks < 2; ++ks) pf[m][ks] = mk8(0u, 0u, 0u, 0u);
      }
    }
    if (live[0] || live[1]) {
#pragma unroll
      for (int vt = 0; vt < 8; ++vt) {
        const int r = 16 * vt + fr;
        const int rs = (r >> 1) & 7;
#pragma unroll
        for (int ks = 0; ks < 2; ++ks) {
          const int u0 = 8 * ks + fq, u1 = 8 * ks + 4 + fq;
          u32x2 a0 = *(const u32x2*)(L + 16384 + r * 128 + (((u0 >> 1) ^ rs) << 4) + ((u0 & 1) << 3));
          u32x2 a1 = *(const u32x2*)(L + 16384 + r * 128 + (((u1 >> 1) ^ rs) << 4) + ((u1 & 1) << 3));
          bf16x8 vf = mk8(a0, a1);
          O0[vt] = mfma16(vf, pf[0][ks], O0[vt]);
          O1[vt] = mfma16(vf, pf[1][ks], O1[vt]);
        }
      }
    }
    __syncthreads();
  }
  float l0 = ls[0], l1 = ls[1];
  l0 += __shfl_xor(l0, 16); l0 += __shfl_xor(l0, 32);
  l1 += __shfl_xor(l1, 16); l1 += __shfl_xor(l1, 32);
  const float lam = ((const float*)(p.ws + OFF_CTR))[16];
  const float i0 = 1.f / l0, i1 = lam / l1;
  float ssq = 0.f;
#pragma unroll
  for (int vt = 0; vt < 8; ++vt) {
#pragma unroll
    for (int j = 0; j < 4; ++j) {
      const float o = O0[vt][j] * i0 - O1[vt][j] * i1;
      O0[vt][j] = o;
      ssq += o * o;
    }
  }
  ssq += __shfl_xor(ssq, 16);
  ssq += __shfl_xor(ssq, 32);
  const float r = rsqrtf(ssq * (1.f / 128.f) + 1e-5f) * 0.8f;
  bf16_t* mo = (bf16_t*)(p.ws + OFF_MERGED) + (size_t)tok * 2048 + 1024 + h * 128;
#pragma unroll
  for (int vt = 0; vt < 8; ++vt) {
    f32x4 g = *(const f32x4*)(p.diff_g + 16 * vt + 4 * fq);
    u32x2 ov = {pk_bf16(O0[vt].x * r * g.x, O0[vt].y * r * g.y), pk_bf16(O0[vt].z * r * g.z, O0[vt].w * r * g.w)};
    *(u32x2*)(mo + 16 * vt + 4 * fq) = ov;
  }
}


__device__ void quant_item(const Params& p, int item) {
  int tid_o = threadIdx.x; asm volatile("" : "+v"(tid_o)); const int tid = tid_o, lane = tid & 63, w = tid >> 6;
  unsigned char* U8 = (unsigned char*)(p.ws + OFF_UB);
  float* SCL = (float*)(p.ws + OFF_SCL);
  for (int rr = 0; rr < 16; ++rr) {
    const int row = item * 64 + rr * 4 + w;
    const float* srow = row < 16384 ? p.pu + (size_t)row * 2048 : p.pv + (size_t)(row - 16384) * 2048;
    f32x4 v[8];
    float am = 0.f;
#pragma unroll
    for (int i = 0; i < 8; ++i) {
      v[i] = *(const f32x4*)(srow + 256 * i + lane * 4);
      am = fmaxf(fmaxf(am, fmaxf(fabsf(v[i].x), fabsf(v[i].y))), fmaxf(fabsf(v[i].z), fabsf(v[i].w)));
    }
#pragma unroll
    for (int o = 32; o >= 1; o >>= 1) am = fmaxf(am, __shfl_xor(am, o));
    const float sc = am > 0.f ? 224.f / am : 1.f;
    unsigned char* drow = U8 + (size_t)row * 2048;
#pragma unroll
    for (int i = 0; i < 8; ++i) {
      int pk = __builtin_amdgcn_cvt_pk_fp8_f32(v[i].x * sc, v[i].y * sc, 0, false);
      pk = __builtin_amdgcn_cvt_pk_fp8_f32(v[i].z * sc, v[i].w * sc, pk, true);
      *(int*)(drow + 256 * i + lane * 4) = pk;
    }
    if (lane == 0) SCL[row] = am > 0.f ? am * (1.f / 224.f) : 1.f;
  }
}

__device__ void phase2(const Params& p, char* lds, int rep, int par) {
  unsigned* ctr = (unsigned*)(p.ws + OFF_CTR) + rep;
  int* sitem = (int*)lds;
  const int nA = par ? 2048 : 0;
  for (;;) {
    __syncthreads();
    if (threadIdx.x == 0) *sitem = (int)atomicAdd(ctr, 1u);
    __syncthreads();
    int item = *sitem;
    __syncthreads();
    if (item >= nA + 2208) break;
    if (item < nA) { hgrn_item(p, 0, (item & 31) >> 3, item & 7, lds, 1, item >> 5); continue; }
    item -= nA;
    if (item < 96) {
      const int kind = item < 32 ? 0 : 1, ii = item < 32 ? item : item - 32;
      if (kind == 0 && par) continue;
      hgrn_item(p, kind, ii >> 3, ii & 7, lds, 0, 0);
    } else {
      const int kind = item < 160 ? 1 : 0, j = item - 160;
      attn_item(p, kind, kind ? item - 96 : (j & 31), kind ? 0 : 63 - (j >> 5), lds);
    }
  }
}

__device__ void phase2b(const Params& p) {
  for (int item = blockIdx.x; item < 256; item += gridDim.x) hgrn_scan_item(p, item >> 3, item & 7);
}

__device__ void phase2c(const Params& p, char* lds) {
  for (int item = blockIdx.x; item < 2048; item += gridDim.x) {
    __syncthreads();
    hgrn_item(p, 0, (item & 31) >> 3, item & 7, lds, 2, item >> 5);
  }
}

__device__ void phase4(const Params& p) {
  int tid_o = threadIdx.x; asm volatile("" : "+v"(tid_o)); const int tid = tid_o, lane = tid & 63, w = tid >> 6;
  bf16_t* X1B = (bf16_t*)(p.ws + OFF_X1B);
  for (int row = blockIdx.x * 4 + w; row < NTOK; row += gridDim.x * 4) {
    bf16_t* xr = X1B + (size_t)row * 2048;
    float v[4][8];
    float s = 0.f;
#pragma unroll
    for (int i = 0; i < 4; ++i) {
      u32x4 t = *(const u32x4*)(xr + 512 * i + lane * 8);
      v[i][0] = bflo(t.x); v[i][1] = bfhi(t.x); v[i][2] = bflo(t.y); v[i][3] = bfhi(t.y);
      v[i][4] = bflo(t.z); v[i][5] = bfhi(t.z); v[i][6] = bflo(t.w); v[i][7] = bfhi(t.w);
#pragma unroll
      for (int e = 0; e < 8; ++e) s += v[i][e];
    }
    s = wave_sum(s);
    const float mean = s * (1.f / 2048.f);
    float q = 0.f;
#pragma unroll
    for (int i = 0; i < 4; ++i)
#pragma unroll
      for (int e = 0; e < 8; ++e) { const float d = v[i][e] - mean; q += d * d; }
    q = wave_sum(q);
    const float rs = rsqrtf(q * (1.f / 2048.f) + 1e-5f);
#pragma unroll
    for (int i = 0; i < 4; ++i) {
      const int col = 512 * i + lane * 8;
      f32x4 g0 = *(const f32x4*)(p.ln1_g + col), g1 = *(const f32x4*)(p.ln1_g + col + 4);
      f32x4 b0 = *(const f32x4*)(p.ln1_b + col), b1 = *(const f32x4*)(p.ln1_b + col + 4);
      u32x4 o;
      o.x = pk_bf16((v[i][0] - mean) * rs * g0.x + b0.x, (v[i][1] - mean) * rs * g0.y + b0.y);
      o.y = pk_bf16((v[i][2] - mean) * rs * g0.z + b0.z, (v[i][3] - mean) * rs * g0.w + b0.w);
      o.z = pk_bf16((v[i][4] - mean) * rs * g1.x + b1.x, (v[i][5] - mean) * rs * g1.y + b1.y);
      o.w = pk_bf16((v[i][6] - mean) * rs * g1.z + b1.z, (v[i][7] - mean) * rs * g1.w + b1.w);
      *(u32x4*)(xr + col) = o;
    }
  }
}

__device__ __forceinline__ unsigned f2key(float f) {
  unsigned b = __float_as_uint(f);
  return (b & 0x80000000u) ? ~b : (b | 0x80000000u);
}
__device__ __forceinline__ float key2f(unsigned k) {
  unsigned b = (k & 0x80000000u) ? (k & 0x7fffffffu) : ~k;
  return __uint_as_float(b);
}

__device__ __forceinline__ unsigned row_allmax(unsigned x) {
  x = max(x, (unsigned)__builtin_amdgcn_update_dpp(0, (int)x, 0x121, 0xF, 0xF, false));
  x = max(x, (unsigned)__builtin_amdgcn_update_dpp(0, (int)x, 0x122, 0xF, 0xF, false));
  x = max(x, (unsigned)__builtin_amdgcn_update_dpp(0, (int)x, 0x124, 0xF, 0xF, false));
  x = max(x, (unsigned)__builtin_amdgcn_update_dpp(0, (int)x, 0x128, 0xF, 0xF, false));
  return x;
}
__device__ __forceinline__ float row_allsum(float x) {
  x += __int_as_float(__builtin_amdgcn_update_dpp(0, __float_as_int(x), 0x121, 0xF, 0xF, false));
  x += __int_as_float(__builtin_amdgcn_update_dpp(0, __float_as_int(x), 0x122, 0xF, 0xF, false));
  x += __int_as_float(__builtin_amdgcn_update_dpp(0, __float_as_int(x), 0x124, 0xF, 0xF, false));
  x += __int_as_float(__builtin_amdgcn_update_dpp(0, __float_as_int(x), 0x128, 0xF, 0xF, false));
  return x;
}
#define CE_DESC(a, b) { const unsigned _hi = max(a, b), _lo = min(a, b); a = _hi; b = _lo; }

__device__ void phase6(const Params& p, char* lds) {
  int tid_o = threadIdx.x; asm volatile("" : "+v"(tid_o)); const int tid = tid_o, lane = tid & 63, w = tid >> 6, fr = lane & 15, fq = lane >> 4;
  const bf16_t* QP = (const bf16_t*)(p.ws + OFF_QP);
  const bf16_t* SKB = (const bf16_t*)(p.ws + OFF_SKB);
  int* EIDX = (int*)(p.ws + OFF_EIDX);
  float* GATE = (float*)(p.ws + OFF_GATE);
  const bool qfirst = ((blockIdx.x >> 3) & 1) != 0;
  if (qfirst) for (int qi = blockIdx.x; qi < 512; qi += gridDim.x) quant_item(p, qi);
  unsigned char* tbl = (unsigned char*)lds;
  __syncthreads();
  if (tid < 64) tbl[tid] = 0xFF;
  __syncthreads();
  {
    const int i = tid >> 4, j = tid & 15;
    if ((i + 1) * (j + 1) <= 16) {
      int rank = j;
      for (int ii = 0; ii < i; ++ii) rank += 16 / (ii + 1);
      tbl[rank] = (unsigned char)((i << 4) | j);
    }
  }
  __syncthreads();
  int pi[4], pj[4]; bool pvalid[4];
#pragma unroll
  for (int s = 0; s < 4; ++s) {
    const int pidx = fr + 16 * s;
    const unsigned code = tbl[pidx];
    pvalid[s] = (pidx < 50);
    pi[s] = pvalid[s] ? (int)(code >> 4) : 0;
    pj[s] = pvalid[s] ? (int)(code & 15) : 0;
  }
  const int rowbase = lane & 48;
  __syncthreads();
  {
    const int hh = blockIdx.x & 7;
#pragma unroll 1
    for (int c = 0; c < 2; ++c)
#pragma unroll 4
      for (int i = 0; i < 8; ++i) {
        const int id = tid + 256 * i, key = id >> 4, ch = id & 15;
        u32x4 v = *(const u32x4*)(SKB + (size_t)((hh * 2 + c) * 128 + key) * 128 + ch * 8);
        *(u32x4*)(lds + c * 32768 + key * 256 + ((ch ^ (key & 15)) << 4)) = v;
      }
  }
  __syncthreads();
  for (int item = blockIdx.x; item < 264 * 8; item += gridDim.x) {
    int zz = 0; asm volatile("" : "+v"(zz));
    const char* L = lds + zz;
    const int tile = item >> 3, h = item & 7;
    const int tok0 = tile * 64;
    unsigned Lst[2][4];
#pragma unroll
    for (int c = 0; c < 2; ++c) {
      unsigned K[8][4];
      {
        bf16x8 af[4];
        const bf16_t* qp = QP + (size_t)(tok0 + 16 * w + fr) * 2048 + h * 256 + c * 128;
#pragma unroll
        for (int ks = 0; ks < 4; ++ks) af[ks] = *(const bf16x8*)(qp + 32 * ks + 8 * fq);
#pragma unroll
        for (int kt = 0; kt < 8; ++kt) {
          f32x4 a = {0.f, 0.f, 0.f, 0.f};
#pragma unroll
          for (int ks = 0; ks < 4; ++ks) {
            const int key = 16 * kt + fr;
            bf16x8 bfr = *(const bf16x8*)(L + c * 32768 + key * 256 + (((4 * ks + fq) ^ (key & 15)) << 4));
            a = mfma16(af[ks], bfr, a);
          }
          const unsigned code = (unsigned)(127 - (16 * kt + fr));
#pragma unroll
          for (int j = 0; j < 4; ++j) K[kt][j] = (f2key(a[j]) & ~127u) | code;
        }
      }
#pragma unroll
      for (int j = 0; j < 4; ++j) {
        CE_DESC(K[0][j], K[1][j]); CE_DESC(K[2][j], K[3][j]); CE_DESC(K[4][j], K[5][j]); CE_DESC(K[6][j], K[7][j]);
        CE_DESC(K[0][j], K[2][j]); CE_DESC(K[1][j], K[3][j]); CE_DESC(K[4][j], K[6][j]); CE_DESC(K[5][j], K[7][j]);
        CE_DESC(K[1][j], K[2][j]); CE_DESC(K[5][j], K[6][j]); CE_DESC(K[0][j], K[4][j]); CE_DESC(K[3][j], K[7][j]);
        CE_DESC(K[1][j], K[5][j]); CE_DESC(K[2][j], K[6][j]);
        CE_DESC(K[1][j], K[4][j]); CE_DESC(K[3][j], K[6][j]);
        CE_DESC(K[2][j], K[4][j]); CE_DESC(K[3][j], K[5][j]);
        CE_DESC(K[3][j], K[4][j]);
      }
      unsigned best[4] = {0u, 0u, 0u, 0u};
#pragma unroll 1
      for (int it = 0; it < 16; ++it) {
#pragma unroll
        for (int j = 0; j < 4; ++j) {
          const unsigned rm = row_allmax(K[0][j]);
          const bool win = (K[0][j] == rm);
#pragma unroll
          for (int k = 0; k < 7; ++k) K[k][j] = win ? K[k + 1][j] : K[k][j];
          K[7][j] = win ? 0u : K[7][j];
          best[j] = (fr == it) ? rm : best[j];
        }
      }
#pragma unroll
      for (int j = 0; j < 4; ++j) Lst[c][j] = best[j];
    }
#pragma unroll
    for (int j = 0; j < 4; ++j) {
      unsigned C[4];
#pragma unroll
      for (int s = 0; s < 4; ++s) {
        const unsigned k0 = (unsigned)__shfl((int)Lst[0][j], rowbase + pi[s]);
        const unsigned k1 = (unsigned)__shfl((int)Lst[1][j], rowbase + pj[s]);
        const float sum = key2f(k0 & ~127u) + key2f(k1 & ~127u);
        C[s] = pvalid[s] ? ((f2key(sum) & ~255u) | (unsigned)(255 - (pi[s] * 16 + pj[s]))) : 0u;
      }
      CE_DESC(C[0], C[1]); CE_DESC(C[2], C[3]); CE_DESC(C[0], C[2]); CE_DESC(C[1], C[3]); CE_DESC(C[1], C[2]);
      unsigned sel = 0u;
#pragma unroll 1
      for (int it = 0; it < 16; ++it) {
        const unsigned rm = row_allmax(C[0]);
        const bool win = (C[0] == rm);
        C[0] = win ? C[1] : C[0]; C[1] = win ? C[2] : C[1]; C[2] = win ? C[3] : C[2]; C[3] = win ? 0u : C[3];
        sel = (fr == it) ? rm : sel;
      }
      const float cv = key2f(sel & ~255u);
      const float cmax = __shfl(cv, rowbase);
      const float e = __expf(cv - cmax);
      const float g = e / row_allsum(e);
      const int flat = 255 - (int)(sel & 255u);
      const unsigned l0 = (unsigned)__shfl((int)Lst[0][j], rowbase + (flat >> 4));
      const unsigned l1 = (unsigned)__shfl((int)Lst[1][j], rowbase + (flat & 15));
      const int eidx = (127 - (int)(l0 & 127u)) * 128 + (127 - (int)(l1 & 127u));
      const size_t ob = ((size_t)(tok0 + 16 * w + 4 * fq + j) * 8 + h) * 16 + fr;
      EIDX[ob] = eidx;
      GATE[ob] = g;
    }
  }
  if (!qfirst) for (int qi = blockIdx.x; qi < 512; qi += gridDim.x) quant_item(p, qi);
}

__device__ __forceinline__ float dot16_fp8(u32x4 r, const float* x) {
  float d = 0.f;
  f32x2_t a;
  a = __builtin_amdgcn_cvt_pk_f32_fp8((int)r.x, false); d += a.x * x[0] + a.y * x[1];
  a = __builtin_amdgcn_cvt_pk_f32_fp8((int)r.x, true);  d += a.x * x[2] + a.y * x[3];
  a = __builtin_amdgcn_cvt_pk_f32_fp8((int)r.y, false); d += a.x * x[4] + a.y * x[5];
  a = __builtin_amdgcn_cvt_pk_f32_fp8((int)r.y, true);  d += a.x * x[6] + a.y * x[7];
  a = __builtin_amdgcn_cvt_pk_f32_fp8((int)r.z, false); d += a.x * x[8] + a.y * x[9];
  a = __builtin_amdgcn_cvt_pk_f32_fp8((int)r.z, true);  d += a.x * x[10] + a.y * x[11];
  a = __builtin_amdgcn_cvt_pk_f32_fp8((int)r.w, false); d += a.x * x[12] + a.y * x[13];
  a = __builtin_amdgcn_cvt_pk_f32_fp8((int)r.w, true);  d += a.x * x[14] + a.y * x[15];
  return d;
}
__device__ __forceinline__ void axpy16_fp8(u32x4 r, float w, float* acc) {
  f32x2_t a;
  a = __builtin_amdgcn_cvt_pk_f32_fp8((int)r.x, false); acc[0] += w * a.x; acc[1] += w * a.y;
  a = __builtin_amdgcn_cvt_pk_f32_fp8((int)r.x, true);  acc[2] += w * a.x; acc[3] += w * a.y;
  a = __builtin_amdgcn_cvt_pk_f32_fp8((int)r.y, false); acc[4] += w * a.x; acc[5] += w * a.y;
  a = __builtin_amdgcn_cvt_pk_f32_fp8((int)r.y, true);  acc[6] += w * a.x; acc[7] += w * a.y;
  a = __builtin_amdgcn_cvt_pk_f32_fp8((int)r.z, false); acc[8] += w * a.x; acc[9] += w * a.y;
  a = __builtin_amdgcn_cvt_pk_f32_fp8((int)r.z, true);  acc[10] += w * a.x; acc[11] += w * a.y;
  a = __builtin_amdgcn_cvt_pk_f32_fp8((int)r.w, false); acc[12] += w * a.x; acc[13] += w * a.y;
  a = __builtin_amdgcn_cvt_pk_f32_fp8((int)r.w, true);  acc[14] += w * a.x; acc[15] += w * a.y;
}

__device__ void phase7(const Params& p, char* lds) {
  int tid_o = threadIdx.x; asm volatile("" : "+v"(tid_o)); const int tid = tid_o, lane = tid & 63, w = tid >> 6;
  const bf16_t* X1B = (const bf16_t*)(p.ws + OFF_X1B);
  const unsigned char* U8 = (const unsigned char*)(p.ws + OFF_UB);
  const unsigned char* V8 = (const unsigned char*)(p.ws + OFF_VB);
  const float* SCL = (const float*)(p.ws + OFF_SCL);
  const int* EIDX = (const int*)(p.ws + OFF_EIDX);
  const float* GATE = (const float*)(p.ws + OFF_GATE);
  float* wgt = (float*)lds;
  float* red = (float*)(lds + 1024);
  float* part = (float*)(lds + 2048);
  for (int tok = blockIdx.x; tok < NTOK; tok += gridDim.x) {
    int tidv = threadIdx.x; asm volatile("" : "+v"(tidv));
    const int tid = tidv, lane = tid & 63, w = tid >> 6;
    const bf16_t* xr = X1B + (size_t)tok * 2048;
    float xa[2][16];
#pragma unroll
    for (int j = 0; j < 2; ++j)
#pragma unroll
      for (int q = 0; q < 2; ++q) {
        u32x4 t = *(const u32x4*)(xr + 1024 * j + 16 * lane + 8 * q);
        xa[j][8 * q] = bflo(t.x); xa[j][8 * q + 1] = bfhi(t.x); xa[j][8 * q + 2] = bflo(t.y); xa[j][8 * q + 3] = bfhi(t.y);
        xa[j][8 * q + 4] = bflo(t.z); xa[j][8 * q + 5] = bfhi(t.z); xa[j][8 * q + 6] = bflo(t.w); xa[j][8 * q + 7] = bfhi(t.w);
      }
    __syncthreads();
#ifndef UR
#define UR 16
#endif
#ifndef VR
#define VR 16
#endif
#pragma unroll 1
    for (int k6 = 0; k6 < 32; k6 += UR) {
      u32x4 r[UR][2];
      int ee[UR];
#pragma unroll
      for (int kk = 0; kk < UR; ++kk) {
        const int kq = (k6 + kk < 32) ? (k6 + kk) : 31;
        ee[kk] = __builtin_amdgcn_readfirstlane(EIDX[(size_t)tok * 128 + w * 32 + kq]);
        const unsigned char* ur = U8 + (size_t)ee[kk] * 2048 + lane * 16;
        r[kk][0] = *(const u32x4*)ur;
        r[kk][1] = *(const u32x4*)(ur + 1024);
      }
      float dot[UR];
#pragma unroll
      for (int kk = 0; kk < UR; ++kk) dot[kk] = dot16_fp8(r[kk][0], xa[0]) + dot16_fp8(r[kk][1], xa[1]);
#pragma unroll
      for (int o = 32; o >= 1; o >>= 1) {
#pragma unroll
        for (int kk = 0; kk < UR; ++kk) dot[kk] += __shfl_xor(dot[kk], o);
      }
      if (lane < UR && k6 + lane < 32) {
        float a = dot[0]; int e = ee[0];
#pragma unroll
        for (int kk = 1; kk < UR; ++kk) { if (lane == kk) { a = dot[kk]; e = ee[kk]; } }
        const int k = w * 32 + k6 + lane;
        a *= SCL[e];
        const float ge = 0.5f * a * (1.f + erff(a * 0.70710678118654752f));
        wgt[k] = GATE[(size_t)tok * 128 + k] * ge * SCL[16384 + e];
      }
    }
    __syncthreads();
#pragma unroll 1
    for (int j = 0; j < 2; ++j) {
      float acc[16];
#pragma unroll
      for (int q = 0; q < 16; ++q) acc[q] = 0.f;
#pragma unroll 1
      for (int k6 = 0; k6 < 32; k6 += VR) {
        u32x4 r[VR];
        float ww[VR];
#pragma unroll
        for (int kk = 0; kk < VR; ++kk) {
          const int kq = (k6 + kk < 32) ? (k6 + kk) : 31;
          const int k = w * 32 + kq;
          const int e = __builtin_amdgcn_readfirstlane(EIDX[(size_t)tok * 128 + k]);
          ww[kk] = (k6 + kk < 32) ? wgt[k] : 0.f;
          r[kk] = *(const u32x4*)(V8 + (size_t)e * 2048 + 1024 * j + lane * 16);
        }
#pragma unroll
        for (int kk = 0; kk < VR; ++kk) axpy16_fp8(r[kk], ww[kk], acc);
      }
#pragma unroll
      for (int q = 0; q < 4; ++q)
        *(f32x4*)(part + w * 2048 + 1024 * j + 16 * lane + 4 * q) = (f32x4){acc[4 * q], acc[4 * q + 1], acc[4 * q + 2], acc[4 * q + 3]};
    }
    __syncthreads();
    const float al = 1.189207115002721f;
    const u32x4 xt = *(const u32x4*)(xr + tid * 8);
    f32x4 x0 = {bflo(xt.x), bfhi(xt.x), bflo(xt.y), bfhi(xt.y)}, x1 = {bflo(xt.z), bfhi(xt.z), bflo(xt.w), bfhi(xt.w)};
    f32x4 s0 = {0.f, 0.f, 0.f, 0.f}, s1 = {0.f, 0.f, 0.f, 0.f};
#pragma unroll
    for (int ww2 = 0; ww2 < 4; ++ww2) {
      f32x4 a0 = *(const f32x4*)(part + ww2 * 2048 + tid * 8), a1 = *(const f32x4*)(part + ww2 * 2048 + tid * 8 + 4);
      s0.x += a0.x; s0.y += a0.y; s0.z += a0.z; s0.w += a0.w; s1.x += a1.x; s1.y += a1.y; s1.z += a1.z; s1.w += a1.w;
    }
    float val[8] = {al * x0.x + s0.x, al * x0.y + s0.y, al * x0.z + s0.z, al * x0.w + s0.w,
                    al * x1.x + s1.x, al * x1.y + s1.y, al * x1.z + s1.z, al * x1.w + s1.w};
    float s = 0.f;
#pragma unroll
    for (int j = 0; j < 8; ++j) s += val[j];
    s = wave_sum(s);
    if (lane == 0) red[w] = s;
    __syncthreads();
    const float mean = (red[0] + red[1] + red[2] + red[3]) * (1.f / 2048.f);
    float q = 0.f;
#pragma unroll
    for (int j = 0; j < 8; ++j) { const float d = val[j] - mean; q += d * d; }
    q = wave_sum(q);
    if (lane == 0) red[4 + w] = q;
    __syncthreads();
    const float rs = rsqrtf((red[4] + red[5] + red[6] + red[7]) * (1.f / 2048.f) + 1e-5f);
    f32x4 g0 = *(const f32x4*)(p.ln2_g + tid * 8), g1 = *(const f32x4*)(p.ln2_g + tid * 8 + 4);
    f32x4 b0 = *(const f32x4*)(p.ln2_b + tid * 8), b1 = *(const f32x4*)(p.ln2_b + tid * 8 + 4);
    f32x4 o0 = {(val[0] - mean) * rs * g0.x + b0.x, (val[1] - mean) * rs * g0.y + b0.y, (val[2] - mean) * rs * g0.z + b0.z, (val[3] - mean) * rs * g0.w + b0.w};
    f32x4 o1 = {(val[4] - mean) * rs * g1.x + b1.x, (val[5] - mean) * rs * g1.y + b1.y, (val[6] - mean) * rs * g1.z + b1.z, (val[7] - mean) * rs * g1.w + b1.w};
    float* yo = p.out + OUT_Y + (size_t)tok * 2048 + tid * 8;
    *(f32x4*)yo = o0;
    *(f32x4*)(yo + 4) = o1;
  }
}

__device__ __forceinline__ void grid_bar(unsigned* ctr, unsigned target) {
  asm volatile("s_waitcnt vmcnt(0)" ::: "memory");
  __syncthreads();
  if (threadIdx.x == 0) {
    __builtin_amdgcn_fence(__ATOMIC_RELEASE, "agent");
    asm volatile("s_waitcnt vmcnt(0)" ::: "memory");
    __hip_atomic_fetch_add(ctr, 1u, __ATOMIC_RELAXED, __HIP_MEMORY_SCOPE_AGENT);
    while (__hip_atomic_load(ctr, __ATOMIC_RELAXED, __HIP_MEMORY_SCOPE_AGENT) < target) __builtin_amdgcn_s_sleep(2);
    __builtin_amdgcn_fence(__ATOMIC_ACQUIRE, "agent");
    asm volatile("s_waitcnt vmcnt(0)" ::: "memory");
  }
  __syncthreads();
}

__global__ void __launch_bounds__(256, 2) mega(Params p, int ph_lo, int ph_hi, int use_sync) {
  __shared__ __attribute__((aligned(16))) char lds[LDS_BYTES];
  cg::grid_group grid = cg::this_grid();
  unsigned nbar = 0;
#ifndef DUP_PHASE
#define DUP_PHASE -1
#endif
  const int par = (use_sync == 3);
  const int nph = par ? 10 : 8;
  for (int pi = 0; pi < nph; ++pi) {
    const int ph = par ? (pi < 3 ? pi : (pi < 5 ? pi + 5 : pi - 2)) : pi;
    const int reps = (ph == DUP_PHASE) ? 2 : 1;
    for (int rep = 0; rep < reps; ++rep) {
      switch (ph) {
        case 0: phase0(p, lds); break;
        case 1: phase1(p, lds); break;
        case 2: phase2(p, lds, rep, par); break;
        case 8: phase2b(p); break;
        case 9: phase2c(p, lds); break;
        case 3: gemm23<0>(p, lds); break;
        case 4: phase4(p); break;
        case 5: gemm23<1>(p, lds); break;
        case 6: phase6(p, lds); break;
        case 7: phase7(p, lds); break;
      }
      if (pi + 1 < nph || rep + 1 < reps) {
        if (use_sync == 2) grid.sync();
        else grid_bar((unsigned*)(p.ws + 128), (unsigned)gridDim.x * (++nbar));
      }
    }
  }
}

extern "C" void kernel_launch(void* const* d_in, const int* in_sizes, int n_in, void* d_out, int out_size,
                              void* d_ws, size_t ws_size, hipStream_t stream) {
  static int grid_blocks = 0;
  if (!grid_blocks) {
    int dev = 0, cus = 0, per_cu = 0;
    hipGetDevice(&dev);
    hipDeviceGetAttribute(&cus, hipDeviceAttributeMultiprocessorCount, dev);
    hipOccupancyMaxActiveBlocksPerMultiprocessor(&per_cu, mega, 256, 0);
    if (per_cu > 2) per_cu = 2;
    if (per_cu < 1) per_cu = 1;
    grid_blocks = cus * per_cu;
    grid_blocks &= ~7;
  }
  Params p{};
  p.x_prompt = (const float*)d_in[0]; p.x_sample = (const float*)d_in[1]; p.cache_k = (const float*)d_in[2];
  p.cache_v = (const float*)d_in[3]; p.state = (const float*)d_in[4]; p.w_in = (const float*)d_in[5];
  p.hgrn_lb = (const float*)d_in[6]; p.hgrn_g = (const float*)d_in[7]; p.lq1 = (const float*)d_in[8];
  p.lk1 = (const float*)d_in[9]; p.lq2 = (const float*)d_in[10]; p.lk2 = (const float*)d_in[11];
  p.diff_g = (const float*)d_in[12]; p.w_out = (const float*)d_in[13]; p.ln1_g = (const float*)d_in[14];
  p.ln1_b = (const float*)d_in[15]; p.wq = (const float*)d_in[16]; p.subk = (const float*)d_in[17];
  p.pu = (const float*)d_in[18]; p.pv = (const float*)d_in[19]; p.ln2_g = (const float*)d_in[20];
  p.ln2_b = (const float*)d_in[21];
  p.out = (float*)d_out; p.ws = (char*)d_ws;
  hipMemsetAsync(d_ws, 0, 256, stream);
  int lo = 0, hi = 7, us = 3;
  void* args[] = {&p, &lo, &hi, &us};
  hipError_t e = hipLaunchCooperativeKernel((const void*)mega, dim3(grid_blocks), dim3(256), args, 0, stream);
  if (e != hipSuccess) fprintf(stderr, "cooperative launch failed: %s (grid %d)\n", hipGetErrorString(e), grid_blocks);
}
```

```cpp
#include <hip/hip_runtime.h>
#include <hip/hip_cooperative_groups.h>
#include <stdint.h>
#include <cstdio>
namespace cg = cooperative_groups;

typedef unsigned short bf16_t;
typedef short bf16x8 __attribute__((ext_vector_type(8)));
typedef float f32x4 __attribute__((ext_vector_type(4)));
typedef unsigned u32x4 __attribute__((ext_vector_type(4)));
typedef unsigned u32x2 __attribute__((ext_vector_type(2)));

#define NTOK 16896
#define NPTOK 16384
#define LDS_BYTES 65536

#define OUT_Y   0
#define OUT_KP  34603008
#define OUT_VP  51380224
#define OUT_SP  68157440
#define OUT_KS  68681728
#define OUT_VS  69206016
#define OUT_SS  69730304

constexpr size_t SZ_XB     = (size_t)NTOK * 2048 * 2;
constexpr size_t SZ_T1K2   = (size_t)NTOK * 1024 * 2;
constexpr size_t SZ_W2     = (size_t)2048 * 2048 * 2;
constexpr size_t SZ_KS     = (size_t)64 * 1088 * 128 * 2;
constexpr size_t SZ_KP     = (size_t)32 * 4096 * 128 * 2;
constexpr size_t OFF_CTR   = 0;
constexpr size_t OFF_LB    = 4096;
constexpr size_t OFF_XB    = 8192;
constexpr size_t OFF_WINT  = OFF_XB + SZ_XB;
constexpr size_t OFF_WOUTT = OFF_WINT + (size_t)7168 * 2048 * 2;
constexpr size_t OFF_WQT   = OFF_WOUTT + SZ_W2;
constexpr size_t OFF_SKB   = OFF_WQT + SZ_W2;
constexpr size_t OFF_KS    = OFF_SKB + 524288;
constexpr size_t OFF_VTS   = OFF_KS + SZ_KS;
constexpr size_t OFF_R4    = OFF_VTS + SZ_KS;
constexpr size_t OFF_QA    = OFF_R4;
constexpr size_t OFF_LOGF  = OFF_QA + SZ_T1K2;
constexpr size_t OFF_IAT   = OFF_LOGF + 2 * SZ_T1K2;
constexpr size_t OFF_GA    = OFF_IAT + SZ_T1K2;
constexpr size_t OFF_QB    = OFF_GA + SZ_T1K2;
constexpr size_t OFF_KP    = OFF_QB + SZ_T1K2;
constexpr size_t OFF_VTP   = OFF_KP + SZ_KP;
constexpr size_t OFF_R4END = OFF_VTP + SZ_KP;
constexpr size_t OFF_X1F   = OFF_R4;
constexpr size_t OFF_UB    = OFF_XB;
constexpr size_t OFF_VB    = OFF_UB + (size_t)16384 * 2048;
constexpr size_t OFF_SCL   = OFF_VB + (size_t)16384 * 2048;
constexpr size_t OFF_MERGED= OFF_R4END;
constexpr size_t OFF_QP    = OFF_MERGED;
constexpr size_t OFF_X1B   = OFF_X1F + (size_t)NTOK * 2048 * 4;
constexpr size_t OFF_EIDX  = OFF_WINT;
constexpr size_t OFF_GATE  = OFF_EIDX + (size_t)NTOK * 128 * 4;
constexpr size_t OFF_DBUF  = OFF_WINT + (size_t)20 * 1024 * 1024;
constexpr size_t OFF_LS    = OFF_XB;
constexpr size_t WS_NEED_PAR = OFF_MERGED + SZ_XB;
static_assert((size_t)32 * 64 * 16 * 256 * 8 <= SZ_XB, "LS fits XB");
static_assert(OFF_SCL + 32768 * 4 <= OFF_WINT, "overlay"); static_assert(OFF_X1B + SZ_XB <= OFF_R4END, "overlay");

struct Params {
  const float* x_prompt; const float* x_sample; const float* cache_k; const float* cache_v; const float* state;
  const float* w_in; const float* hgrn_lb; const float* hgrn_g; const float* lq1; const float* lk1;
  const float* lq2; const float* lk2; const float* diff_g; const float* w_out; const float* ln1_g; const float* ln1_b;
  const float* wq; const float* subk; const float* pu; const float* pv; const float* ln2_g; const float* ln2_b;
  float* out; char* ws;
};

typedef __bf16 bf16x2_t __attribute__((ext_vector_type(2)));
typedef float f32x2_t __attribute__((ext_vector_type(2)));
__device__ __forceinline__ unsigned pk_bf16(float lo, float hi) {
  f32x2_t f = {lo, hi};
  bf16x2_t b = __builtin_convertvector(f, bf16x2_t);
  return __builtin_bit_cast(unsigned, b);
}
__device__ __forceinline__ float bf2f(unsigned short x) { return __uint_as_float(((unsigned)x) << 16); }
__device__ __forceinline__ float bflo(unsigned x) { return __uint_as_float(x << 16); }
__device__ __forceinline__ float bfhi(unsigned x) { return __uint_as_float(x & 0xffff0000u); }
__device__ __forceinline__ f32x4 mfma16(bf16x8 a, bf16x8 b, f32x4 c) {
  return __builtin_amdgcn_mfma_f32_16x16x32_bf16(a, b, c, 0, 0, 0);
}
__device__ __forceinline__ bf16x8 mk8(unsigned a, unsigned b, unsigned c, unsigned d) {
  u32x4 v = {a, b, c, d}; return __builtin_bit_cast(bf16x8, v);
}
__device__ __forceinline__ bf16x8 mk8(u32x2 a, u32x2 b) {
  u32x4 v = {a.x, a.y, b.x, b.y}; return __builtin_bit_cast(bf16x8, v);
}
__device__ __forceinline__ float wave_sum(float v) {
#pragma unroll
  for (int o = 32; o >= 1; o >>= 1) v += __shfl_xor(v, o);
  return v;
}

__device__ void transpose_conv(const float* __restrict__ W, bf16_t* __restrict__ WT, int K, int N, char* lds) {
  float* tile = (float*)lds;
  int tid_o = threadIdx.x; asm volatile("" : "+v"(tid_o)); const int tid = tid_o;
  const int nkt = K / 64, nnt = N / 64;
  for (int t = blockIdx.x; t < nkt * nnt; t += gridDim.x) {
    const int kt = t / nnt, nt = t % nnt;
    const int c = tid & 63, r0 = tid >> 6;
#pragma unroll 4
    for (int i = 0; i < 16; ++i) {
      int r = i * 4 + r0;
      tile[r * 65 + c] = W[(size_t)(kt * 64 + r) * N + nt * 64 + c];
    }
    __syncthreads();
#pragma unroll 4
    for (int i = 0; i < 16; ++i) {
      int n = i * 4 + r0;
      float v = tile[c * 65 + n];
      WT[(size_t)(nt * 64 + n) * K + kt * 64 + c] = (bf16_t)(pk_bf16(v, 0.f) & 0xffff);
    }
    __syncthreads();
  }
}

__device__ __forceinline__ void conv8(const float* __restrict__ src, bf16_t* __restrict__ dst) {
  f32x4 a = *(const f32x4*)src, b = *(const f32x4*)(src + 4);
  u32x4 o = {pk_bf16(a.x, a.y), pk_bf16(a.z, a.w), pk_bf16(b.x, b.y), pk_bf16(b.z, b.w)};
  *(u32x4*)dst = o;
}

__device__ void phase0(const Params& p, char* lds) {
  int tid_o = threadIdx.x; asm volatile("" : "+v"(tid_o)); const int tid = tid_o, bid = blockIdx.x;
  const size_t gtid = (size_t)bid * 256 + tid, gsz = (size_t)gridDim.x * 256;
  if (bid == 0) {
    if (tid < 64) {
      float a = p.lq1[tid] * p.lk1[tid], b = p.lq2[tid] * p.lk2[tid];
      a = wave_sum(a); b = wave_sum(b);
      if (tid == 0) ((float*)(p.ws + OFF_CTR))[16] = expf(a) - expf(b) + 0.2f;
    }
    float* LB = (float*)(p.ws + OFF_LB);
    for (int k = tid; k < 1024; k += 256) {
      float a0 = p.hgrn_lb[k], a1 = p.hgrn_lb[1024 + k];
      LB[k] = 1.0f / (1.0f + expf(a1 - a0));
    }
  }
  {
    bf16_t* XB = (bf16_t*)(p.ws + OFF_XB);
    const size_t nch = (size_t)NTOK * 2048 / 8;
    for (size_t c = gtid; c < nch; c += gsz) {
      size_t e = c * 8;
      const float* src = (e < (size_t)NPTOK * 2048) ? (p.x_prompt + e) : (p.x_sample + (e - (size_t)NPTOK * 2048));
      conv8(src, XB + e);
    }
  }
  {
    bf16_t* KS = (bf16_t*)(p.ws + OFF_KS);
    for (size_t c = gtid; c < (size_t)1048576; c += gsz) {
      int d8 = c & 15, h = (c >> 4) & 7, s = (c >> 7) & 1023, b = (int)(c >> 17);
      conv8(p.cache_k + c * 8, KS + ((size_t)((b * 8 + h) * 1088 + s) * 128 + d8 * 8));
    }
  }
  {
    bf16_t* VTS = (bf16_t*)(p.ws + OFF_VTS);
    for (size_t i = gtid; i < (size_t)2097152; i += gsz) {
      int vc = i & 127, s4 = (i >> 7) & 255, h = (i >> 15) & 7, b = (int)(i >> 18);
      const float* src = p.cache_v + ((size_t)(b * 1024 + s4 * 4) * 8 + h) * 128 + vc;
      float v0 = src[0], v1 = src[1024], v2 = src[2048], v3 = src[3072];
      u32x2 o = {pk_bf16(v0, v1), pk_bf16(v2, v3)};
      *(u32x2*)(VTS + ((size_t)((b * 8 + h) * 128 + vc) * 1088 + s4 * 4)) = o;
    }
  }
  {
    bf16_t* SKB = (bf16_t*)(p.ws + OFF_SKB);
    for (size_t c = gtid; c < (size_t)32768; c += gsz) conv8(p.subk + c * 8, SKB + c * 8);
  }
  transpose_conv(p.w_in, (bf16_t*)(p.ws + OFF_WINT), 2048, 7168, lds);
  transpose_conv(p.w_out, (bf16_t*)(p.ws + OFF_WOUTT), 2048, 2048, lds);
  transpose_conv(p.wq, (bf16_t*)(p.ws + OFF_WQT), 2048, 2048, lds);
}

template <bool SWAP>
__device__ __forceinline__ void gemm_compute_tile(const char* cur, int aoff, int boff, int sw, int fq, f32x4 (&acc)[4][4]) {
#pragma unroll
  for (int ks = 0; ks < 2; ++ks) {
    bf16x8 af[4], bfr[4];
    const int ch = ((ks * 4 + fq) ^ sw) << 4;
#pragma unroll
    for (int m = 0; m < 4; ++m) af[m] = *(const bf16x8*)(cur + aoff + m * 2048 + ch);
#pragma unroll
    for (int n = 0; n < 4; ++n) bfr[n] = *(const bf16x8*)(cur + boff + n * 2048 + ch);
#pragma unroll
    for (int m = 0; m < 4; ++m)
#pragma unroll
      for (int n = 0; n < 4; ++n)
        acc[m][n] = SWAP ? mfma16(bfr[n], af[m], acc[m][n]) : mfma16(af[m], bfr[n], acc[m][n]);
  }
}

template <bool SWAP>
__device__ __forceinline__ void gemm_mainloop(const bf16_t* A, const bf16_t* B,
                                              int row0, int col0, int K, char* lds, f32x4 (&acc)[4][4]) {
  int tid_o = threadIdx.x; asm volatile("" : "+v"(tid_o)); const int tid = tid_o, lane = tid & 63, wave = tid >> 6;
  const int wm = wave >> 1, wn = wave & 1, fr = lane & 15, fq = lane >> 4;
  const int lrow = tid >> 3, lc = tid & 7;
  const int cl = lc ^ (lrow & 7);
  const bf16_t* ga = A + (size_t)(row0 + lrow) * K + cl * 8;
  const bf16_t* gb = B + (size_t)(col0 + lrow) * K + cl * 8;
  const int loff = tid * 16;
#define G_STAGE(BUF, KT) { _Pragma("unroll") for (int i = 0; i < 4; ++i) { \
      __builtin_amdgcn_global_load_lds((const unsigned*)(ga + (size_t)i * 32 * K + (KT) * 64), (unsigned*)((BUF) + loff + i * 4096), 16, 0, 0); \
      __builtin_amdgcn_global_load_lds((const unsigned*)(gb + (size_t)i * 32 * K + (KT) * 64), (unsigned*)((BUF) + 16384 + loff + i * 4096), 16, 0, 0); } }
  const int nkt = K >> 6;
  G_STAGE(lds, 0);
  __syncthreads();
  const int aoff = (wm * 64 + fr) * 128, boff = 16384 + (wn * 64 + fr) * 128;
  const int sw = fr & 7;
  for (int kt = 0; kt < nkt; ++kt) {
    char* cur = lds + (kt & 1) * 32768;
    char* nxt = lds + ((kt + 1) & 1) * 32768;
    if (kt + 1 < nkt) G_STAGE(nxt, kt + 1);
    gemm_compute_tile<SWAP>(cur, aoff, boff, sw, fq, acc);
    __syncthreads();
  }
#undef G_STAGE
}

template <int MT, bool SWAP>
__device__ __forceinline__ void gemm_mainloop_big(const bf16_t* A, const bf16_t* B,
                                                  int row0, int col0, int K, char* lds, f32x4 (&acc)[MT][4]) {
  int tid_o = threadIdx.x; asm volatile("" : "+v"(tid_o)); const int tid = tid_o, lane = tid & 63, wave = tid >> 6;
  const int wm = wave >> 1, wn = wave & 1, fr = lane & 15, fq = lane >> 4;
  const int lrow = tid >> 3, lc = tid & 7;
  const int cl = lc ^ (lrow & 7);
  const bf16_t* ga = A + (size_t)(row0 + lrow) * K + cl * 8;
  const bf16_t* gb = B + (size_t)(col0 + lrow) * K + cl * 8;
  const int loff = tid * 16;
  const int nkt = K >> 6;
  constexpr int BOFF = MT * 32 * 128;
  const int aoff = (wm * (MT * 16) + fr) * 128, boff = BOFF + (wn * 64 + fr) * 128;
  const int sw = fr & 7;
  for (int kt = 0; kt < nkt; ++kt) {
#pragma unroll
    for (int i = 0; i < MT; ++i)
      __builtin_amdgcn_global_load_lds((const unsigned*)(ga + (size_t)i * 32 * K + kt * 64), (unsigned*)(lds + loff + i * 4096), 16, 0, 0);
#pragma unroll
    for (int i = 0; i < 4; ++i)
      __builtin_amdgcn_global_load_lds((const unsigned*)(gb + (size_t)i * 32 * K + kt * 64), (unsigned*)(lds + BOFF + loff + i * 4096), 16, 0, 0);
    __syncthreads();
#pragma unroll
    for (int ks = 0; ks < 2; ++ks) {
      bf16x8 af[MT], bfr[4];
      const int ch = ((ks * 4 + fq) ^ sw) << 4;
#pragma unroll
      for (int m = 0; m < MT; ++m) af[m] = *(const bf16x8*)(lds + aoff + m * 2048 + ch);
#pragma unroll
      for (int n = 0; n < 4; ++n) bfr[n] = *(const bf16x8*)(lds + boff + n * 2048 + ch);
#pragma unroll
      for (int m = 0; m < MT; ++m)
#pragma unroll
        for (int n = 0; n < 4; ++n)
          acc[m][n] = SWAP ? mfma16(bfr[n], af[m], acc[m][n]) : mfma16(af[m], bfr[n], acc[m][n]);
    }
    __syncthreads();
  }
}

template <bool SWAP>
__device__ void gemm1_tile(const Params& p, int mt, int nt, char* lds) {
  f32x4 acc[8][4];
#pragma unroll
  for (int m = 0; m < 8; ++m)
#pragma unroll
    for (int n = 0; n < 4; ++n) acc[m][n] = (f32x4){0.f, 0.f, 0.f, 0.f};
  gemm_mainloop_big<8, SWAP>((const bf16_t*)(p.ws + OFF_XB), (const bf16_t*)(p.ws + OFF_WINT), mt * 256, nt * 128, 2048, lds, acc);
  int tidv = threadIdx.x; asm volatile("" : "+v"(tidv));
  const int tid = tidv, lane = tid & 63, wave = tid >> 6;
  const int wm = wave >> 1, wn = wave & 1, fr = lane & 15, fq = lane >> 4;
  const int seg = nt >> 3, h = nt & 7;
  const bool samp = (mt * 256 >= NPTOK);
  if (SWAP) {
    const float* LB = (const float*)(p.ws + OFF_LB);
#pragma unroll
    for (int m = 0; m < 8; ++m) {
      const int tok = mt * 256 + wm * 128 + m * 16 + fr;
#pragma unroll
      for (int n = 0; n < 4; ++n) {
        const int cl = wn * 64 + n * 16 + fq * 4;
        const int kidx = h * 128 + cl;
        f32x4 v = acc[m][n];
        if (seg == 0) {
          u32x2 o = {pk_bf16(v.x, v.y), pk_bf16(v.z, v.w)};
          *(u32x2*)((bf16_t*)(p.ws + OFF_QA) + (size_t)tok * 1024 + kidx) = o;
        } else if (seg == 1) {
          f32x4 lb = *(const f32x4*)(LB + kidx);
          f32x4 o;
          o.x = lb.x + (1.f - lb.x) / (1.f + __expf(-v.x));
          o.y = lb.y + (1.f - lb.y) / (1.f + __expf(-v.y));
          o.z = lb.z + (1.f - lb.z) / (1.f + __expf(-v.z));
          o.w = lb.w + (1.f - lb.w) / (1.f + __expf(-v.w));
          *(f32x4*)((float*)(p.ws + OFF_LOGF) + (size_t)tok * 1024 + kidx) = o;
        } else if (seg == 3) {
          float s0 = 1.f / (1.f + __expf(-v.x)), s1 = 1.f / (1.f + __expf(-v.y));
          float s2 = 1.f / (1.f + __expf(-v.z)), s3 = 1.f / (1.f + __expf(-v.w));
          u32x2 o = {pk_bf16(s0, s1), pk_bf16(s2, s3)};
          *(u32x2*)((bf16_t*)(p.ws + OFF_GA) + (size_t)tok * 1024 + kidx) = o;
        } else if (seg == 4) {
          const float sc = 0.18033688011112042f;
          u32x2 o = {pk_bf16(v.x * sc, v.y * sc), pk_bf16(v.z * sc, v.w * sc)};
          *(u32x2*)((bf16_t*)(p.ws + OFF_QB) + (size_t)tok * 1024 + kidx) = o;
        } else {
          u32x2 o = {pk_bf16(v.x, v.y), pk_bf16(v.z, v.w)};
          if (!samp) {
            *(f32x4*)(p.out + OUT_KP + (size_t)tok * 1024 + kidx) = v;
            const int b = tok >> 12, t = tok & 4095;
            *(u32x2*)((bf16_t*)(p.ws + OFF_KP) + ((size_t)((b * 8 + h) * 4096 + t) * 128 + cl)) = o;
          } else {
            const int ts = tok - NPTOK;
            *(f32x4*)(p.out + OUT_KS + (size_t)ts * 1024 + kidx) = v;
            const int b = ts >> 6, t = ts & 63;
            *(u32x2*)((bf16_t*)(p.ws + OFF_KS) + ((size_t)((b * 8 + h) * 1088 + 1024 + t) * 128 + cl)) = o;
          }
        }
      }
    }
  } else {
#pragma unroll
    for (int m = 0; m < 8; ++m) {
      const int tok0 = mt * 256 + wm * 128 + m * 16 + fq * 4;
#pragma unroll
      for (int n = 0; n < 4; ++n) {
        const int cl = wn * 64 + n * 16 + fr;
        f32x4 v = acc[m][n];
        u32x2 o = {pk_bf16(v.x, v.y), pk_bf16(v.z, v.w)};
        if (seg == 2) {
          bf16_t* IAT = (bf16_t*)(p.ws + OFF_IAT);
          if (!samp) {
            const int b = tok0 >> 12, t = tok0 & 4095;
            *(u32x2*)(IAT + ((size_t)((b * 8 + h) * 128 + cl) * 4096 + t)) = o;
          } else {
            const int ts = tok0 - NPTOK, b = ts >> 6, t = ts & 63;
            *(u32x2*)(IAT + (size_t)32 * 128 * 4096 + ((size_t)((b * 8 + h) * 128 + cl) * 64 + t)) = o;
          }
        } else {
          if (!samp) {
            float* ov = p.out + OUT_VP + (size_t)tok0 * 1024 + h * 128 + cl;
            ov[0] = v.x; ov[1024] = v.y; ov[2048] = v.z; ov[3072] = v.w;
            const int b = tok0 >> 12, t = tok0 & 4095;
            *(u32x2*)((bf16_t*)(p.ws + OFF_VTP) + ((size_t)((b * 8 + h) * 128 + cl) * 4096 + t)) = o;
          } else {
            const int ts = tok0 - NPTOK, b = ts >> 6, t = ts & 63;
            float* ov = p.out + OUT_VS + (size_t)ts * 1024 + h * 128 + cl;
            ov[0] = v.x; ov[1024] = v.y; ov[2048] = v.z; ov[3072] = v.w;
            *(u32x2*)((bf16_t*)(p.ws + OFF_VTS) + ((size_t)((b * 8 + h) * 128 + cl) * 1088 + 1024 + t)) = o;
          }
        }
      }
    }
  }
}

__device__ void phase1(const Params& p, char* lds) {
  const int xcd = blockIdx.x & 7, lb = blockIdx.x >> 3, nbx = gridDim.x >> 3;
  const int nM = NTOK / 256, nNx = 7;
  for (int li = lb; li < nM * nNx; li += nbx) {
    const int mt = li / nNx, nt = (li % nNx) * 8 + xcd;
    const int seg = nt >> 3;
    if (seg == 2 || seg == 6) gemm1_tile<false>(p, mt, nt, lds);
    else gemm1_tile<true>(p, mt, nt, lds);
  }
}

template <int MODE, int MT>
__device__ void gemm23_tile(const Params& p, int row0, int nt, char* lds) {
  const bf16_t* A = (const bf16_t*)(p.ws + (MODE == 0 ? OFF_MERGED : OFF_X1B));
  const bf16_t* B = (const bf16_t*)(p.ws + (MODE == 0 ? OFF_WOUTT : OFF_WQT));
  f32x4 acc[MT][4];
#pragma unroll
  for (int m = 0; m < MT; ++m)
#pragma unroll
    for (int n = 0; n < 4; ++n) acc[m][n] = (f32x4){0.f, 0.f, 0.f, 0.f};
  if (MT == 4) gemm_mainloop<true>(A, B, row0, nt * 128, 2048, lds, (f32x4(&)[4][4])acc);
  else gemm_mainloop_big<MT, true>(A, B, row0, nt * 128, 2048, lds, acc);
  int tid_o = threadIdx.x; asm volatile("" : "+v"(tid_o)); const int tid = tid_o, lane = tid & 63, wave = tid >> 6;
  const int wm = wave >> 1, wn = wave & 1, fr = lane & 15, fq = lane >> 4;
#pragma unroll
  for (int m = 0; m < MT; ++m) {
    const int tok = row0 + wm * (MT * 16) + m * 16 + fr;
#pragma unroll
    for (int n = 0; n < 4; ++n) {
      const int col = nt * 128 + wn * 64 + n * 16 + fq * 4;
      f32x4 v = acc[m][n];
      if (MODE == 0) {
        const float* xin = (tok < NPTOK) ? (p.x_prompt + (size_t)tok * 2048) : (p.x_sample + (size_t)(tok - NPTOK) * 2048);
        f32x4 xv = *(const f32x4*)(xin + col);
        const float al = 1.189207115002721f;
        u32x2 o = {pk_bf16(al * xv.x + v.x, al * xv.y + v.y), pk_bf16(al * xv.z + v.z, al * xv.w + v.w)};
        *(u32x2*)((bf16_t*)(p.ws + OFF_X1B) + (size_t)tok * 2048 + col) = o;
      } else {
        u32x2 o = {pk_bf16(v.x, v.y), pk_bf16(v.z, v.w)};
        *(u32x2*)((bf16_t*)(p.ws + OFF_QP) + (size_t)tok * 2048 + col) = o;
      }
    }
  }
}

template <int MODE>
__device__ void gemm23(const Params& p, char* lds) {
  const int xcd = blockIdx.x & 7, lb = blockIdx.x >> 3, nbx = gridDim.x >> 3;
  for (int li = lb; li < 64 * 2; li += nbx) gemm23_tile<MODE, 8>(p, (li >> 1) * 256, (li & 1) * 8 + xcd, lds);
  for (int li = lb; li < 4 * 2; li += nbx) gemm23_tile<MODE, 4>(p, NPTOK + (li >> 1) * 128, (li & 1) * 8 + xcd, lds);
}

__device__ void hgrn_item(const Params& p, int kind, int b, int h, char* lds, int mode, int c0) {
  int tid_o = threadIdx.x; asm volatile("" : "+v"(tid_o)); const int tid = tid_o, lane = tid & 63, w = tid >> 6, fr = lane & 15, fq = lane >> 4;
  const int tokbase = kind == 0 ? b * 4096 : NPTOK + b * 64;
  const int c_begin = mode == 0 ? 0 : c0, nch = mode == 0 ? (kind == 0 ? 64 : 1) : c0 + 1;
  u32x2* LSb = (u32x2*)(p.ws + OFF_LS) + ((size_t)((b * 8 + h) * 64 + c0) * 16) * 256 + tid;
  const bf16_t* IATb = (const bf16_t*)(p.ws + OFF_IAT) +
      (kind == 0 ? (size_t)((b * 8 + h) * 128) * 4096 : (size_t)32 * 128 * 4096 + (size_t)((b * 8 + h) * 128) * 64);
  const int iat_stride = kind == 0 ? 4096 : 64;
  const float* LOGF = (const float*)(p.ws + OFF_LOGF);
  const bf16_t* QA = (const bf16_t*)(p.ws + OFF_QA);
  const bf16_t* GA = (const bf16_t*)(p.ws + OFF_GA);
  bf16_t* MERGED = (bf16_t*)(p.ws + OFF_MERGED);

  f32x4 S[8][2];
  if (mode == 2) {
#pragma unroll
    for (int kt = 0; kt < 8; ++kt)
#pragma unroll
      for (int vv = 0; vv < 2; ++vv) {
        u32x2 t = LSb[(kt * 2 + vv) * 256];
        S[kt][vv] = (f32x4){bflo(t.x), bfhi(t.x), bflo(t.y), bfhi(t.y)};
      }
  } else if (kind == 0) {
#pragma unroll
    for (int kt = 0; kt < 8; ++kt)
#pragma unroll
      for (int vv = 0; vv < 2; ++vv) S[kt][vv] = (f32x4){0.f, 0.f, 0.f, 0.f};
  } else {
    const float* st = p.state + (size_t)((b * 8 + h) * 128) * 128 + (4 * fq) * 128 + 32 * w + fr;
#pragma unroll
    for (int kt = 0; kt < 8; ++kt)
#pragma unroll
      for (int vv = 0; vv < 2; ++vv)
#pragma unroll
        for (int j = 0; j < 4; ++j) S[kt][vv][j] = st[(16 * kt + j) * 128 + 16 * vv];
  }
  f32x4 gn[2];
#pragma unroll
  for (int vv = 0; vv < 2; ++vv) gn[vv] = *(const f32x4*)(p.hgrn_g + 32 * w + 16 * vv + 4 * fq);

  const int ekp = tid & 63, eq = tid >> 6;

  u32x4 gR[8];
  unsigned qn[16];
#pragma unroll
  for (int i = 0; i < 8; ++i) {
    int id = tid + 256 * i, row = id >> 5, cc = id & 31;
    gR[i] = *(const u32x4*)(LOGF + (size_t)(tokbase + c_begin * 64 + row) * 1024 + h * 128 + cc * 4);
  }
#pragma unroll
  for (int i = 0; i < 16; ++i) qn[i] = *(const unsigned*)(QA + (size_t)(tokbase + c_begin * 64 + 16 * eq + i) * 1024 + h * 128 + 2 * ekp);
  for (int c = c_begin; c < nch; ++c) {
    int zz = 0; asm volatile("" : "+v"(zz));
    int tidv = threadIdx.x; asm volatile("" : "+v"(tidv));
    const int tid = tidv, lane = tid & 63, w = tid >> 6, fr = lane & 15, fq = lane >> 4, ekp = tid & 63, eq = tid >> 6;
    char* L = lds + zz;
    float* Dl = (float*)(L + 57344);
    float* part = (float*)(L + 57856);
    const int tok0 = tokbase + c * 64 + zz;
#pragma unroll
    for (int i = 0; i < 8; ++i) {
      int id = tid + 256 * i, row = id >> 5, cc = id & 31;
      *(u32x4*)(L + row * 512 + cc * 16) = gR[i];
    }
    unsigned qv[16];
#pragma unroll
    for (int i = 0; i < 16; ++i) qv[i] = qn[i];
    if (c + 1 < nch) {
#pragma unroll
      for (int i = 0; i < 8; ++i) {
        int id = tid + 256 * i, row = id >> 5, cc = id & 31;
        gR[i] = *(const u32x4*)(LOGF + (size_t)(tok0 + 64 + row) * 1024 + h * 128 + cc * 4);
      }
    }
    bf16x8 vfr[2][2];
#pragma unroll
    for (int ss = 0; ss < 2; ++ss)
#pragma unroll
      for (int vv = 0; vv < 2; ++vv)
        vfr[ss][vv] = *(const bf16x8*)(IATb + (size_t)(32 * w + 16 * vv + fr) * iat_stride + c * 64 + zz + 32 * ss + 8 * fq);
    __syncthreads();
    typedef float f32x2 __attribute__((ext_vector_type(2)));
    f32x2 gv[16];
    const float* Gl = (const float*)L;
    float* qtot = (float*)(L + 58880);
    float tot0 = 1.f, tot1 = 1.f;
#pragma unroll
    for (int i = 0; i < 16; ++i) { gv[i] = *(const f32x2*)(Gl + (16 * eq + i) * 128 + 2 * ekp); tot0 *= gv[i].x; tot1 *= gv[i].y; }
    qtot[eq * 128 + 2 * ekp] = tot0; qtot[eq * 128 + 2 * ekp + 1] = tot1;
    __syncthreads();
    {
      float run0 = 1.f, run1 = 1.f;
      for (int qq = 0; qq < eq; ++qq) { run0 *= qtot[qq * 128 + 2 * ekp]; run1 *= qtot[qq * 128 + 2 * ekp + 1]; }
      const int k0 = 2 * ekp;
#pragma unroll
      for (int i4 = 0; i4 < 4; ++i4) {
        float ka[4], kb[4];
#pragma unroll
        for (int ii = 0; ii < 4; ++ii) {
          const int i = i4 * 4 + ii, t = 16 * eq + i;
          const float f0 = gv[i].x, f1 = gv[i].y;
          run0 *= f0; run1 *= f1;
          const float q0 = bflo(qv[i]) * run0, q1 = bfhi(qv[i]) * run1;
          const float kk0 = (1.f - f0) * __builtin_amdgcn_rcpf(run0), kk1 = (1.f - f1) * __builtin_amdgcn_rcpf(run1);
          ka[ii] = kk0; kb[ii] = kk1;
          const int o = (t * 128 + ((((k0 >> 3) ^ (t & 15)) << 3) | (k0 & 7))) * 2;
          if (mode != 1) {
            *(unsigned*)(L + o) = pk_bf16(q0, q1);
            *(unsigned*)(L + 16384 + o) = pk_bf16(kk0, kk1);
          }
        }
        const int t0 = 16 * eq + i4 * 4;
        u32x2 oa = {pk_bf16(ka[0], ka[1]), pk_bf16(ka[2], ka[3])};
        u32x2 ob = {pk_bf16(kb[0], kb[1]), pk_bf16(kb[2], kb[3])};
        if (mode != 2) {
          *(u32x2*)(L + 32768 + k0 * 128 + ((((t0 >> 3) ^ (k0 & 7)) << 4) | ((t0 & 7) << 1))) = oa;
          *(u32x2*)(L + 32768 + (k0 + 1) * 128 + ((((t0 >> 3) ^ ((k0 + 1) & 7)) << 4) | ((t0 & 7) << 1))) = ob;
        }
      }
      if (eq == 3) { Dl[k0] = run0; Dl[k0 + 1] = run1; }
    }
    if (c + 1 < nch) {
#pragma unroll
      for (int i = 0; i < 16; ++i) qn[i] = *(const unsigned*)(QA + (size_t)(tok0 + 64 + 16 * eq + i) * 1024 + h * 128 + 2 * ekp);
    }
    __syncthreads();
    if (mode != 1) {
      bf16x8 qf[4];
#pragma unroll
      for (int ks = 0; ks < 4; ++ks) {
        const int t = 16 * w + fr;
        qf[ks] = *(const bf16x8*)(L + t * 256 + (((4 * ks + fq) ^ (t & 15)) << 4));
      }
#pragma unroll
      for (int st = 0; st < 4; ++st) {
        f32x4 a = {0.f, 0.f, 0.f, 0.f};
#pragma unroll
        for (int ks = 0; ks < 4; ++ks) {
          const int s = 16 * st + fr;
          bf16x8 kf = *(const bf16x8*)(L + 16384 + s * 256 + (((4 * ks + fq) ^ (s & 15)) << 4));
          a = mfma16(kf, qf[ks], a);
        }
        const int t = 16 * w + fr, s0 = 16 * st + 4 * fq;
        float p0 = (s0 + 0 <= t) ? a.x : 0.f, p1 = (s0 + 1 <= t) ? a.y : 0.f;
        float p2 = (s0 + 2 <= t) ? a.z : 0.f, p3 = (s0 + 3 <= t) ? a.w : 0.f;
        u32x2 o2 = {pk_bf16(p0, p1), pk_bf16(p2, p3)};
        *(u32x2*)(L + 49152 + t * 128 + ((((s0 >> 3) ^ (t & 7)) << 4) | ((s0 & 7) << 1))) = o2;
      }
    }
    f32x4 O[2][4];
#pragma unroll
    for (int vv = 0; vv < 2; ++vv)
#pragma unroll
      for (int tt = 0; tt < 4; ++tt) O[vv][tt] = (f32x4){0.f, 0.f, 0.f, 0.f};
    if (mode != 1) {
#pragma unroll
    for (int ks = 0; ks < 4; ++ks) {
      bf16x8 sf[2];
#pragma unroll
      for (int vv = 0; vv < 2; ++vv)
        sf[vv] = mk8(pk_bf16(S[2 * ks][vv].x, S[2 * ks][vv].y), pk_bf16(S[2 * ks][vv].z, S[2 * ks][vv].w),
                     pk_bf16(S[2 * ks + 1][vv].x, S[2 * ks + 1][vv].y), pk_bf16(S[2 * ks + 1][vv].z, S[2 * ks + 1][vv].w));
#pragma unroll
      for (int tt = 0; tt < 4; ++tt) {
        const int t = 16 * tt + fr;
        const int c0 = 4 * ks + (fq >> 1), c1 = 4 * ks + 2 + (fq >> 1);
        u32x2 q0 = *(const u32x2*)(L + t * 256 + ((c0 ^ (t & 15)) << 4) + ((fq & 1) << 3));
        u32x2 q1 = *(const u32x2*)(L + t * 256 + ((c1 ^ (t & 15)) << 4) + ((fq & 1) << 3));
        bf16x8 qp = mk8(q0, q1);
#pragma unroll
        for (int vv = 0; vv < 2; ++vv) O[vv][tt] = mfma16(sf[vv], qp, O[vv][tt]);
      }
    }
    }
    __syncthreads();
#pragma unroll
    for (int ss = 0; ss < 2; ++ss) {
      bf16x8 vf[2];
#pragma unroll
      for (int vv = 0; vv < 2; ++vv) vf[vv] = vfr[ss][vv];
      if (mode != 1) {
#pragma unroll
      for (int tt = 0; tt < 4; ++tt) {
        const int t = 16 * tt + fr;
        bf16x8 pf = *(const bf16x8*)(L + 49152 + t * 128 + (((4 * ss + fq) ^ (t & 7)) << 4));
#pragma unroll
        for (int vv = 0; vv < 2; ++vv) O[vv][tt] = mfma16(vf[vv], pf, O[vv][tt]);
      }
      }
      if (mode != 2) {
#pragma unroll
      for (int kt = 0; kt < 8; ++kt) {
        const int r = 16 * kt + fr;
        bf16x8 kf = *(const bf16x8*)(L + 32768 + r * 128 + (((4 * ss + fq) ^ (r & 7)) << 4));
#pragma unroll
        for (int vv = 0; vv < 2; ++vv) S[kt][vv] = mfma16(kf, vf[vv], S[kt][vv]);
      }
      }
    }
    if (mode != 2) {
#pragma unroll
    for (int kt = 0; kt < 8; ++kt) {
      f32x4 d = *(const f32x4*)(Dl + 16 * kt + 4 * fq);
#pragma unroll
      for (int vv = 0; vv < 2; ++vv) { S[kt][vv].x *= d.x; S[kt][vv].y *= d.y; S[kt][vv].z *= d.z; S[kt][vv].w *= d.w; }
    }
    }
    if (mode == 1 && tid < 128) ((float*)(p.ws + OFF_DBUF))[(size_t)((b * 8 + h) * 64 + c) * 128 + tid] = Dl[tid];
    if (mode != 1) {
#pragma unroll
    for (int tt = 0; tt < 4; ++tt) {
      float ss = 0.f;
#pragma unroll
      for (int vv = 0; vv < 2; ++vv) ss += O[vv][tt].x * O[vv][tt].x + O[vv][tt].y * O[vv][tt].y + O[vv][tt].z * O[vv][tt].z + O[vv][tt].w * O[vv][tt].w;
      ss += __shfl_xor(ss, 16);
      ss += __shfl_xor(ss, 32);
      if (fq == 0) part[w * 64 + 16 * tt + fr] = ss;
    }
    __syncthreads();
#pragma unroll
    for (int tt = 0; tt < 4; ++tt) {
      const int t = 16 * tt + fr;
      const float tot = part[t] + part[64 + t] + part[128 + t] + part[192 + t];
      const float r = rsqrtf(tot * (1.f / 128.f) + 1e-5f);
      const size_t tok = (size_t)(tok0 + t);
#pragma unroll
      for (int vv = 0; vv < 2; ++vv) {
        const int v0 = h * 128 + 32 * w + 16 * vv + 4 * fq;
        u32x2 gt = *(const u32x2*)(GA + tok * 1024 + v0);
        float o0 = O[vv][tt].x * r * gn[vv].x * bflo(gt.x);
        float o1 = O[vv][tt].y * r * gn[vv].y * bfhi(gt.x);
        float o2 = O[vv][tt].z * r * gn[vv].z * bflo(gt.y);
        float o3 = O[vv][tt].w * r * gn[vv].w * bfhi(gt.y);
        u32x2 ov = {pk_bf16(o0, o1), pk_bf16(o2, o3)};
        *(u32x2*)(MERGED + tok * 2048 + v0) = ov;
      }
    }
    }
    __syncthreads();
  }
  if (mode == 1) {
#pragma unroll
    for (int kt = 0; kt < 8; ++kt)
#pragma unroll
      for (int vv = 0; vv < 2; ++vv) {
        u32x2 t = {pk_bf16(S[kt][vv].x, S[kt][vv].y), pk_bf16(S[kt][vv].z, S[kt][vv].w)};
        LSb[(kt * 2 + vv) * 256] = t;
      }
    return;
  }
  if (mode == 2) return;
  int zq = 0; asm volatile("" : "+v"(zq));
  float* so = p.out + (kind == 0 ? OUT_SP : OUT_SS) + (size_t)((b * 8 + h) * 128) * 128 + (4 * fq) * 128 + 32 * w + fr + zq;
#pragma unroll
  for (int kt = 0; kt < 8; ++kt)
#pragma unroll
    for (int vv = 0; vv < 2; ++vv)
#pragma unroll
      for (int j = 0; j < 4; ++j) so[(16 * kt + j) * 128 + 16 * vv] = S[kt][vv][j];
}


__device__ void hgrn_scan_item(const Params& p, int chain, int kt) {
  int tid_o = threadIdx.x; asm volatile("" : "+v"(tid_o)); const int tid = tid_o, lane = tid & 63, w = tid >> 6, fr = lane & 15, fq = lane >> 4;
  u32x2* LS = (u32x2*)(p.ws + OFF_LS) + ((size_t)(chain * 64) * 16 + kt * 2) * 256 + tid;
  const float* DB = (const float*)(p.ws + OFF_DBUF) + (size_t)(chain * 64) * 128 + 16 * kt + 4 * fq;
  f32x4 S0 = {0.f, 0.f, 0.f, 0.f}, S1 = {0.f, 0.f, 0.f, 0.f};
#pragma unroll 1
  for (int c8 = 0; c8 < 64; c8 += 8) {
    u32x2 l0[8], l1[8];
    f32x4 d[8];
#pragma unroll
    for (int i = 0; i < 8; ++i) {
      l0[i] = LS[(size_t)(c8 + i) * 16 * 256];
      l1[i] = LS[(size_t)(c8 + i) * 16 * 256 + 256];
      d[i] = *(const f32x4*)(DB + (c8 + i) * 128);
    }
#pragma unroll
    for (int i = 0; i < 8; ++i) {
      u32x2 o0 = {pk_bf16(S0.x, S0.y), pk_bf16(S0.z, S0.w)}, o1 = {pk_bf16(S1.x, S1.y), pk_bf16(S1.z, S1.w)};
      LS[(size_t)(c8 + i) * 16 * 256] = o0; LS[(size_t)(c8 + i) * 16 * 256 + 256] = o1;
      S0.x = d[i].x * S0.x + bflo(l0[i].x); S0.y = d[i].y * S0.y + bfhi(l0[i].x); S0.z = d[i].z * S0.z + bflo(l0[i].y); S0.w = d[i].w * S0.w + bfhi(l0[i].y);
      S1.x = d[i].x * S1.x + bflo(l1[i].x); S1.y = d[i].y * S1.y + bfhi(l1[i].x); S1.z = d[i].z * S1.z + bflo(l1[i].y); S1.w = d[i].w * S1.w + bfhi(l1[i].y);
    }
  }
  float* so = p.out + OUT_SP + (size_t)(chain * 128) * 128 + (size_t)(16 * kt + 4 * fq) * 128 + 32 * w + fr;
  so[0] = S0.x; so[128] = S0.y; so[256] = S0.z; so[384] = S0.w;
  so[16] = S1.x; so[128 + 16] = S1.y; so[256 + 16] = S1.z; so[384 + 16] = S1.w;
}

__device__ void attn_item(const Params& p, int kind, int bh, int qt, char* lds) {
  int tid_o = threadIdx.x; asm volatile("" : "+v"(tid_o)); const int tid = tid_o, lane = tid & 63, w = tid >> 6, fr = lane & 15, fq = lane >> 4;
  const int b = bh >> 3, h = bh & 7;
  const int nkt = kind == 0 ? qt + 1 : 17;
  const int tok0 = kind == 0 ? b * 4096 + qt * 64 : NPTOK + b * 64;
  const int qpos0 = kind == 0 ? qt * 64 : 1024;
  const bf16_t* Kb = kind == 0 ? (const bf16_t*)(p.ws + OFF_KP) + (size_t)bh * 4096 * 128
                               : (const bf16_t*)(p.ws + OFF_KS) + (size_t)bh * 1088 * 128;
  const bf16_t* Vb = kind == 0 ? (const bf16_t*)(p.ws + OFF_VTP) + (size_t)bh * 128 * 4096
                               : (const bf16_t*)(p.ws + OFF_VTS) + (size_t)bh * 128 * 1088;
  const int vstride = kind == 0 ? 4096 : 1088;
  const float slope2 = exp2f(-(float)(h + 1)) * 1.4426950408889634f;

  const int tok = tok0 + 16 * w + fr;
  bf16x8 qf[4];
  {
    const bf16_t* qp = (const bf16_t*)(p.ws + OFF_QB) + (size_t)tok * 1024 + h * 128;
#pragma unroll
    for (int ks = 0; ks < 4; ++ks) qf[ks] = *(const bf16x8*)(qp + 32 * ks + 8 * fq);
  }
  const float qposf = (float)(qpos0 + 16 * w + fr);
  f32x4 O0[8], O1[8];
#pragma unroll
  for (int i = 0; i < 8; ++i) { O0[i] = (f32x4){0.f, 0.f, 0.f, 0.f}; O1[i] = (f32x4){0.f, 0.f, 0.f, 0.f}; }
  float mx[2] = {-1e30f, -1e30f}, ls[2] = {0.f, 0.f};

  u32x4 rk[4], rv[4];
  {
    const int kkey = tid >> 4, kc = tid & 15, vrow = tid >> 3, vc = tid & 7;
    const int kt = nkt - 1;
#pragma unroll
    for (int i = 0; i < 4; ++i) {
      rk[i] = *(const u32x4*)(Kb + (size_t)(kt * 64 + kkey + 16 * i) * 128 + kc * 8);
      rv[i] = *(const u32x4*)(Vb + (size_t)(vrow + 32 * i) * vstride + kt * 64 + vc * 8);
    }
#pragma unroll
    for (int i = 0; i < 4; ++i) {
      const int key = kkey + 16 * i;
      *(u32x4*)(lds + key * 256 + ((kc ^ (key & 15)) << 4)) = rk[i];
      const int r = vrow + 32 * i;
      *(u32x4*)(lds + 16384 + r * 128 + ((vc ^ ((r >> 1) & 7)) << 4)) = rv[i];
    }
    if (nkt > 1) {
#pragma unroll
      for (int i = 0; i < 4; ++i) {
        rk[i] = *(const u32x4*)(Kb + (size_t)((kt - 1) * 64 + kkey + 16 * i) * 128 + kc * 8);
        rv[i] = *(const u32x4*)(Vb + (size_t)(vrow + 32 * i) * vstride + (kt - 1) * 64 + vc * 8);
      }
    }
    __syncthreads();
  }
  for (int it = 0; it < nkt; ++it) {
    int zz = 0; asm volatile("" : "+v"(zz));
    int tidv = threadIdx.x; asm volatile("" : "+v"(tidv));
    const int tid = tidv, lane = tid & 63, w = tid >> 6, fr = lane & 15, fq = lane >> 4;
    const int kkey = tid >> 4, kc = tid & 15, vrow = tid >> 3, vc = tid & 7;
    const int kt = nkt - 1 - it;
    char* L = lds + zz + (it & 1) * 32768;
    char* Ln = lds + zz + ((it + 1) & 1) * 32768;
    if (it + 1 < nkt) {
#pragma unroll
      for (int i = 0; i < 4; ++i) {
        const int key = kkey + 16 * i;
        *(u32x4*)(Ln + key * 256 + ((kc ^ (key & 15)) << 4)) = rk[i];
        const int r = vrow + 32 * i;
        *(u32x4*)(Ln + 16384 + r * 128 + ((vc ^ ((r >> 1) & 7)) << 4)) = rv[i];
      }
    }
    if (it + 2 < nkt) {
#pragma unroll
      for (int i = 0; i < 4; ++i) {
        rk[i] = *(const u32x4*)(Kb + (size_t)((kt - 2) * 64 + zz + kkey + 16 * i) * 128 + kc * 8);
        rv[i] = *(const u32x4*)(Vb + (size_t)(vrow + 32 * i) * vstride + (kt - 2) * 64 + zz + vc * 8);
      }
    }
    const float kposf = (float)(kt * 64 + 4 * fq) - qposf;
    bf16x8 pf[2][2];
    bool live[2];
#pragma unroll
    for (int m = 0; m < 2; ++m) {
      f32x4 s[4];
#pragma unroll
      for (int k16 = 0; k16 < 4; ++k16) {
        s[k16] = (f32x4){0.f, 0.f, 0.f, 0.f};
        const int key = 16 * k16 + fr;
#pragma unroll
        for (int ks2 = 0; ks2 < 2; ++ks2) {
          bf16x8 kf = *(const bf16x8*)(L + key * 256 + (((8 * m + 4 * ks2 + fq) ^ (key & 15)) << 4));
          s[k16] = mfma16(kf, qf[2 * m + ks2], s[k16]);
        }
      }
      float tmax = -1e30f;
#pragma unroll
      for (int k16 = 0; k16 < 4; ++k16)
#pragma unroll
        for (int j = 0; j < 4; ++j) {
          const float d = kposf + (float)(16 * k16 + j);
          const float v = s[k16][j] - slope2 * fabsf(d);
          s[k16][j] = v;
          tmax = fmaxf(tmax, v);
        }
      tmax = fmaxf(tmax, __shfl_xor(tmax, 16));
      tmax = fmaxf(tmax, __shfl_xor(tmax, 32));
      live[m] = !__all(tmax - mx[m] < -40.f);
      if (live[m]) {
        const float mnew = fmaxf(mx[m], tmax);
        const float alpha = __builtin_amdgcn_exp2f(mx[m] - mnew);
        mx[m] = mnew;
        float psum = 0.f;
#pragma unroll
        for (int k16 = 0; k16 < 4; ++k16)
#pragma unroll
          for (int j = 0; j < 4; ++j) { const float e = __builtin_amdgcn_exp2f(s[k16][j] - mnew); s[k16][j] = e; psum += e; }
        ls[m] = ls[m] * alpha + psum;
        if (m == 0) {
#pragma unroll
          for (int i = 0; i < 8; ++i) { O0[i].x *= alpha; O0[i].y *= alpha; O0[i].z *= alpha; O0[i].w *= alpha; }
        } else {
#pragma unroll
          for (int i = 0; i < 8; ++i) { O1[i].x *= alpha; O1[i].y *= alpha; O1[i].z *= alpha; O1[i].w *= alpha; }
        }
#pragma unroll
        for (int ks = 0; ks < 2; ++ks)
          pf[m][ks] = mk8(pk_bf16(s[2 * ks].x, s[2 * ks].y), pk_bf16(s[2 * ks].z, s[2 * ks].w),
                          pk_bf16(s[2 * ks + 1].x, s[2 * ks + 1].y), pk_bf16(s[2 * ks + 1].z, s[2 * ks + 1].w));
      } else {
#pragma unroll
        for (int ks = 0; ks < 2; ++ks) pf[m][ks] = mk8(0u, 0u, 0u, 0u);
      }
    }
    if (live[0] || live[1]) {
#pragma unroll
      for (int vt = 0; vt < 8; ++vt) {
        const int r = 16 * vt + fr;
        const int rs = (r >> 1) & 7;
#pragma unroll
        for (int ks = 0; ks < 2; ++ks) {
          const int u0 = 8 * ks + fq, u1 = 8 * ks + 4 + fq;
          u32x2 a0 = *(const u32x2*)(L + 16384 + r * 128 + (((u0 >> 1) ^ rs) << 4) + ((u0 & 1) << 3));
          u32x2 a1 = *(const u32x2*)(L + 16384 + r * 128 + (((u1 >> 1) ^ rs) << 4) + ((u1 & 1) << 3));
          bf16x8 vf = mk8(a0, a1);
          O0[vt] = mfma16(vf, pf[0][ks], O0[vt]);
          O1[vt] = mfma16(vf, pf[1][ks], O1[vt]);
        }
      }
    }
    __syncthreads();
  }
  float l0 = ls[0], l1 = ls[1];
  l0 += __shfl_xor(l0, 16); l0 += __shfl_xor(l0, 32);
  l1 += __shfl_xor(l1, 16); l1 += __shfl_xor(l1, 32);
  const float lam = ((const float*)(p.ws + OFF_CTR))[16];
  const float i0 = 1.f / l0, i1 = lam / l1;
  float ssq = 0.f;
#pragma unroll
  for (int vt = 0; vt < 8; ++vt) {
#pragma unroll
    for (int j = 0; j < 4; ++j) {
      const float o = O0[vt][j] * i0 - O1[vt][j] * i1;
      O0[vt][j] = o;
      ssq += o * o;
    }
  }
  ssq += __shfl_xor(ssq, 16);
  ssq += __shfl_xor(ssq, 32);
  const float r = rsqrtf(ssq * (1.f / 128.f) + 1e-5f) * 0.8f;
  bf16_t* mo = (bf16_t*)(p.ws + OFF_MERGED) + (size_t)tok * 2048 + 1024 + h * 128;
#pragma unroll
  for (int vt = 0; vt < 8; ++vt) {
    f32x4 g = *(const f32x4*)(p.diff_g + 16 * vt + 4 * fq);
    u32x2 ov = {pk_bf16(O0[vt].x * r * g.x, O0[vt].y * r * g.y), pk_bf16(O0[vt].z * r * g.z, O0[vt].w * r * g.w)};
    *(u32x2*)(mo + 16 * vt + 4 * fq) = ov;
  }
}


__device__ void quant_item(const Params& p, int item) {
  int tid_o = threadIdx.x; asm volatile("" : "+v"(tid_o)); const int tid = tid_o, lane = tid & 63, w = tid >> 6;
  unsigned char* U8 = (unsigned char*)(p.ws + OFF_UB);
  float* SCL = (float*)(p.ws + OFF_SCL);
  for (int rr = 0; rr < 16; ++rr) {
    const int row = item * 64 + rr * 4 + w;
    const float* srow = row < 16384 ? p.pu + (size_t)row * 2048 : p.pv + (size_t)(row - 16384) * 2048;
    f32x4 v[8];
    float am = 0.f;
#pragma unroll
    for (int i = 0; i < 8; ++i) {
      v[i] = *(const f32x4*)(srow + 256 * i + lane * 4);
      am = fmaxf(fmaxf(am, fmaxf(fabsf(v[i].x), fabsf(v[i].y))), fmaxf(fabsf(v[i].z), fabsf(v[i].w)));
    }
#pragma unroll
    for (int o = 32; o >= 1; o >>= 1) am = fmaxf(am, __shfl_xor(am, o));
    const float sc = am > 0.f ? 224.f / am : 1.f;
    unsigned char* drow = U8 + (size_t)row * 2048;
#pragma unroll
    for (int i = 0; i < 8; ++i) {
      int pk = __builtin_amdgcn_cvt_pk_fp8_f32(v[i].x * sc, v[i].y * sc, 0, false);
      pk = __builtin_amdgcn_cvt_pk_fp8_f32(v[i].z * sc, v[i].w * sc, pk, true);
      *(int*)(drow + 256 * i + lane * 4) = pk;
    }
    if (lane == 0) SCL[row] = am > 0.f ? am * (1.f / 224.f) : 1.f;
  }
}

__device__ void phase2(const Params& p, char* lds, int rep, int par) {
  unsigned* ctr = (unsigned*)(p.ws + OFF_CTR) + rep;
  int* sitem = (int*)lds;
  const int nA = par ? 2048 : 0;
  for (;;) {
    __syncthreads();
    if (threadIdx.x == 0) *sitem = (int)atomicAdd(ctr, 1u);
    __syncthreads();
    int item = *sitem;
    __syncthreads();
    if (item >= nA + 2208) break;
    if (item < nA) { hgrn_item(p, 0, (item & 31) >> 3, item & 7, lds, 1, item >> 5); continue; }
    item -= nA;
    if (item < 96) {
      const int kind = item < 32 ? 0 : 1, ii = item < 32 ? item : item - 32;
      if (kind == 0 && par) continue;
      hgrn_item(p, kind, ii >> 3, ii & 7, lds, 0, 0);
    } else {
      const int kind = item < 160 ? 1 : 0, j = item - 160;
      attn_item(p, kind, kind ? item - 96 : (j & 31), kind ? 0 : 63 - (j >> 5), lds);
    }
  }
}

__device__ void phase2b(const Params& p) {
  for (int item = blockIdx.x; item < 256; item += gridDim.x) hgrn_scan_item(p, item >> 3, item & 7);
}

__device__ void phase2c(const Params& p, char* lds) {
  for (int item = blockIdx.x; item < 2048; item += gridDim.x) {
    __syncthreads();
    hgrn_item(p, 0, (item & 31) >> 3, item & 7, lds, 2, item >> 5);
  }
}

__device__ void phase4(const Params& p) {
  int tid_o = threadIdx.x; asm volatile("" : "+v"(tid_o)); const int tid = tid_o, lane = tid & 63, w = tid >> 6;
  bf16_t* X1B = (bf16_t*)(p.ws + OFF_X1B);
  for (int row = blockIdx.x * 4 + w; row < NTOK; row += gridDim.x * 4) {
    bf16_t* xr = X1B + (size_t)row * 2048;
    float v[4][8];
    float s = 0.f;
#pragma unroll
    for (int i = 0; i < 4; ++i) {
      u32x4 t = *(const u32x4*)(xr + 512 * i + lane * 8);
      v[i][0] = bflo(t.x); v[i][1] = bfhi(t.x); v[i][2] = bflo(t.y); v[i][3] = bfhi(t.y);
      v[i][4] = bflo(t.z); v[i][5] = bfhi(t.z); v[i][6] = bflo(t.w); v[i][7] = bfhi(t.w);
#pragma unroll
      for (int e = 0; e < 8; ++e) s += v[i][e];
    }
    s = wave_sum(s);
    const float mean = s * (1.f / 2048.f);
    float q = 0.f;
#pragma unroll
    for (int i = 0; i < 4; ++i)
#pragma unroll
      for (int e = 0; e < 8; ++e) { const float d = v[i][e] - mean; q += d * d; }
    q = wave_sum(q);
    const float rs = rsqrtf(q * (1.f / 2048.f) + 1e-5f);
#pragma unroll
    for (int i = 0; i < 4; ++i) {
      const int col = 512 * i + lane * 8;
      f32x4 g0 = *(const f32x4*)(p.ln1_g + col), g1 = *(const f32x4*)(p.ln1_g + col + 4);
      f32x4 b0 = *(const f32x4*)(p.ln1_b + col), b1 = *(const f32x4*)(p.ln1_b + col + 4);
      u32x4 o;
      o.x = pk_bf16((v[i][0] - mean) * rs * g0.x + b0.x, (v[i][1] - mean) * rs * g0.y + b0.y);
      o.y = pk_bf16((v[i][2] - mean) * rs * g0.z + b0.z, (v[i][3] - mean) * rs * g0.w + b0.w);
      o.z = pk_bf16((v[i][4] - mean) * rs * g1.x + b1.x, (v[i][5] - mean) * rs * g1.y + b1.y);
      o.w = pk_bf16((v[i][6] - mean) * rs * g1.z + b1.z, (v[i][7] - mean) * rs * g1.w + b1.w);
      *(u32x4*)(xr + col) = o;
    }
  }
}

__device__ __forceinline__ unsigned f2key(float f) {
  unsigned b = __float_as_uint(f);
  return (b & 0x80000000u) ? ~b : (b | 0x80000000u);
}
__device__ __forceinline__ float key2f(unsigned k) {
  unsigned b = (k & 0x80000000u) ? (k & 0x7fffffffu) : ~k;
  return __uint_as_float(b);
}

__device__ __forceinline__ unsigned row_allmax(unsigned x) {
  x = max(x, (unsigned)__builtin_amdgcn_update_dpp(0, (int)x, 0x121, 0xF, 0xF, false));
  x = max(x, (unsigned)__builtin_amdgcn_update_dpp(0, (int)x, 0x122, 0xF, 0xF, false));
  x = max(x, (unsigned)__builtin_amdgcn_update_dpp(0, (int)x, 0x124, 0xF, 0xF, false));
  x = max(x, (unsigned)__builtin_amdgcn_update_dpp(0, (int)x, 0x128, 0xF, 0xF, false));
  return x;
}
__device__ __forceinline__ float row_allsum(float x) {
  x += __int_as_float(__builtin_amdgcn_update_dpp(0, __float_as_int(x), 0x121, 0xF, 0xF, false));
  x += __int_as_float(__builtin_amdgcn_update_dpp(0, __float_as_int(x), 0x122, 0xF, 0xF, false));
  x += __int_as_float(__builtin_amdgcn_update_dpp(0, __float_as_int(x), 0x124, 0xF, 0xF, false));
  x += __int_as_float(__builtin_amdgcn_update_dpp(0, __float_as_int(x), 0x128, 0xF, 0xF, false));
  return x;
}
#define CE_DESC(a, b) { const unsigned _hi = max(a, b), _lo = min(a, b); a = _hi; b = _lo; }

__device__ void phase6(const Params& p, char* lds) {
  int tid_o = threadIdx.x; asm volatile("" : "+v"(tid_o)); const int tid = tid_o, lane = tid & 63, w = tid >> 6, fr = lane & 15, fq = lane >> 4;
  const bf16_t* QP = (const bf16_t*)(p.ws + OFF_QP);
  const bf16_t* SKB = (const bf16_t*)(p.ws + OFF_SKB);
  int* EIDX = (int*)(p.ws + OFF_EIDX);
  float* GATE = (float*)(p.ws + OFF_GATE);
  const bool qfirst = blockIdx.x >= (gridDim.x >> 1);
  if (qfirst) for (int qi = blockIdx.x; qi < 512; qi += gridDim.x) quant_item(p, qi);
  unsigned char* tbl = (unsigned char*)lds;
  __syncthreads();
  if (tid < 64) tbl[tid] = 0xFF;
  __syncthreads();
  {
    const int i = tid >> 4, j = tid & 15;
    if ((i + 1) * (j + 1) <= 16) {
      int rank = j;
      for (int ii = 0; ii < i; ++ii) rank += 16 / (ii + 1);
      tbl[rank] = (unsigned char)((i << 4) | j);
    }
  }
  __syncthreads();
  int pi[4], pj[4]; bool pvalid[4];
#pragma unroll
  for (int s = 0; s < 4; ++s) {
    const int pidx = fr + 16 * s;
    const unsigned code = tbl[pidx];
    pvalid[s] = (pidx < 50);
    pi[s] = pvalid[s] ? (int)(code >> 4) : 0;
    pj[s] = pvalid[s] ? (int)(code & 15) : 0;
  }
  const int rowbase = lane & 48;
  __syncthreads();
  {
    const int hh = blockIdx.x & 7;
#pragma unroll 1
    for (int c = 0; c < 2; ++c)
#pragma unroll 4
      for (int i = 0; i < 8; ++i) {
        const int id = tid + 256 * i, key = id >> 4, ch = id & 15;
        u32x4 v = *(const u32x4*)(SKB + (size_t)((hh * 2 + c) * 128 + key) * 128 + ch * 8);
        *(u32x4*)(lds + c * 32768 + key * 256 + ((ch ^ (key & 15)) << 4)) = v;
      }
  }
  __syncthreads();
  for (int item = blockIdx.x; item < 264 * 8; item += gridDim.x) {
    int zz = 0; asm volatile("" : "+v"(zz));
    const char* L = lds + zz;
    const int tile = item >> 3, h = item & 7;
    const int tok0 = tile * 64;
    unsigned Lst[2][4];
#pragma unroll
    for (int c = 0; c < 2; ++c) {
      unsigned K[8][4];
      {
        bf16x8 af[4];
        const bf16_t* qp = QP + (size_t)(tok0 + 16 * w + fr) * 2048 + h * 256 + c * 128;
#pragma unroll
        for (int ks = 0; ks < 4; ++ks) af[ks] = *(const bf16x8*)(qp + 32 * ks + 8 * fq);
#pragma unroll
        for (int kt = 0; kt < 8; ++kt) {
          f32x4 a = {0.f, 0.f, 0.f, 0.f};
#pragma unroll
          for (int ks = 0; ks < 4; ++ks) {
            const int key = 16 * kt + fr;
            bf16x8 bfr = *(const bf16x8*)(L + c * 32768 + key * 256 + (((4 * ks + fq) ^ (key & 15)) << 4));
            a = mfma16(af[ks], bfr, a);
          }
          const unsigned code = (unsigned)(127 - (16 * kt + fr));
#pragma unroll
          for (int j = 0; j < 4; ++j) K[kt][j] = (f2key(a[j]) & ~127u) | code;
        }
      }
#pragma unroll
      for (int j = 0; j < 4; ++j) {
        CE_DESC(K[0][j], K[1][j]); CE_DESC(K[2][j], K[3][j]); CE_DESC(K[4][j], K[5][j]); CE_DESC(K[6][j], K[7][j]);
        CE_DESC(K[0][j], K[2][j]); CE_DESC(K[1][j], K[3][j]); CE_DESC(K[4][j], K[6][j]); CE_DESC(K[5][j], K[7][j]);
        CE_DESC(K[1][j], K[2][j]); CE_DESC(K[5][j], K[6][j]); CE_DESC(K[0][j], K[4][j]); CE_DESC(K[3][j], K[7][j]);
        CE_DESC(K[1][j], K[5][j]); CE_DESC(K[2][j], K[6][j]);
        CE_DESC(K[1][j], K[4][j]); CE_DESC(K[3][j], K[6][j]);
        CE_DESC(K[2][j], K[4][j]); CE_DESC(K[3][j], K[5][j]);
        CE_DESC(K[3][j], K[4][j]);
      }
      unsigned best[4] = {0u, 0u, 0u, 0u};
#pragma unroll 1
      for (int it = 0; it < 16; ++it) {
#pragma unroll
        for (int j = 0; j < 4; ++j) {
          const unsigned rm = row_allmax(K[0][j]);
          const bool win = (K[0][j] == rm);
#pragma unroll
          for (int k = 0; k < 7; ++k) K[k][j] = win ? K[k + 1][j] : K[k][j];
          K[7][j] = win ? 0u : K[7][j];
          best[j] = (fr == it) ? rm : best[j];
        }
      }
#pragma unroll
      for (int j = 0; j < 4; ++j) Lst[c][j] = best[j];
    }
#pragma unroll
    for (int j = 0; j < 4; ++j) {
      unsigned C[4];
#pragma unroll
      for (int s = 0; s < 4; ++s) {
        const unsigned k0 = (unsigned)__shfl((int)Lst[0][j], rowbase + pi[s]);
        const unsigned k1 = (unsigned)__shfl((int)Lst[1][j], rowbase + pj[s]);
        const float sum = key2f(k0 & ~127u) + key2f(k1 & ~127u);
        C[s] = pvalid[s] ? ((f2key(sum) & ~255u) | (unsigned)(255 - (pi[s] * 16 + pj[s]))) : 0u;
      }
      CE_DESC(C[0], C[1]); CE_DESC(C[2], C[3]); CE_DESC(C[0], C[2]); CE_DESC(C[1], C[3]); CE_DESC(C[1], C[2]);
      unsigned sel = 0u;
#pragma unroll 1
      for (int it = 0; it < 16; ++it) {
        const unsigned rm = row_allmax(C[0]);
        const bool win = (C[0] == rm);
        C[0] = win ? C[1] : C[0]; C[1] = win ? C[2] : C[1]; C[2] = win ? C[3] : C[2]; C[3] = win ? 0u : C[3];
        sel = (fr == it) ? rm : sel;
      }
      const float cv = key2f(sel & ~255u);
      const float cmax = __shfl(cv, rowbase);
      const float e = __expf(cv - cmax);
      const float g = e / row_allsum(e);
      const int flat = 255 - (int)(sel & 255u);
      const unsigned l0 = (unsigned)__shfl((int)Lst[0][j], rowbase + (flat >> 4));
      const unsigned l1 = (unsigned)__shfl((int)Lst[1][j], rowbase + (flat & 15));
      const int eidx = (127 - (int)(l0 & 127u)) * 128 + (127 - (int)(l1 & 127u));
      const size_t ob = ((size_t)(tok0 + 16 * w + 4 * fq + j) * 8 + h) * 16 + fr;
      EIDX[ob] = eidx;
      GATE[ob] = g;
    }
  }
  if (!qfirst) for (int qi = blockIdx.x; qi < 512; qi += gridDim.x) quant_item(p, qi);
}

__device__ __forceinline__ float dot16_fp8(u32x4 r, const float* x) {
  float d = 0.f;
  f32x2_t a;
  a = __builtin_amdgcn_cvt_pk_f32_fp8((int)r.x, false); d += a.x * x[0] + a.y * x[1];
  a = __builtin_amdgcn_cvt_pk_f32_fp8((int)r.x, true);  d += a.x * x[2] + a.y * x[3];
  a = __builtin_amdgcn_cvt_pk_f32_fp8((int)r.y, false); d += a.x * x[4] + a.y * x[5];
  a = __builtin_amdgcn_cvt_pk_f32_fp8((int)r.y, true);  d += a.x * x[6] + a.y * x[7];
  a = __builtin_amdgcn_cvt_pk_f32_fp8((int)r.z, false); d += a.x * x[8] + a.y * x[9];
  a = __builtin_amdgcn_cvt_pk_f32_fp8((int)r.z, true);  d += a.x * x[10] + a.y * x[11];
  a = __builtin_amdgcn_cvt_pk_f32_fp8((int)r.w, false); d += a.x * x[12] + a.y * x[13];
  a = __builtin_amdgcn_cvt_pk_f32_fp8((int)r.w, true);  d += a.x * x[14] + a.y * x[15];
  return d;
}
__device__ __forceinline__ void axpy16_fp8(u32x4 r, float w, float* acc) {
  f32x2_t a;
  a = __builtin_amdgcn_cvt_pk_f32_fp8((int)r.x, false); acc[0] += w * a.x; acc[1] += w * a.y;
  a = __builtin_amdgcn_cvt_pk_f32_fp8((int)r.x, true);  acc[2] += w * a.x; acc[3] += w * a.y;
  a = __builtin_amdgcn_cvt_pk_f32_fp8((int)r.y, false); acc[4] += w * a.x; acc[5] += w * a.y;
  a = __builtin_amdgcn_cvt_pk_f32_fp8((int)r.y, true);  acc[6] += w * a.x; acc[7] += w * a.y;
  a = __builtin_amdgcn_cvt_pk_f32_fp8((int)r.z, false); acc[8] += w * a.x; acc[9] += w * a.y;
  a = __builtin_amdgcn_cvt_pk_f32_fp8((int)r.z, true);  acc[10] += w * a.x; acc[11] += w * a.y;
  a = __builtin_amdgcn_cvt_pk_f32_fp8((int)r.w, false); acc[12] += w * a.x; acc[13] += w * a.y;
  a = __builtin_amdgcn_cvt_pk_f32_fp8((int)r.w, true);  acc[14] += w * a.x; acc[15] += w * a.y;
}

__device__ void phase7(const Params& p, char* lds) {
  int tid_o = threadIdx.x; asm volatile("" : "+v"(tid_o)); const int tid = tid_o, lane = tid & 63, w = tid >> 6;
  const bf16_t* X1B = (const bf16_t*)(p.ws + OFF_X1B);
  const unsigned char* U8 = (const unsigned char*)(p.ws + OFF_UB);
  const unsigned char* V8 = (const unsigned char*)(p.ws + OFF_VB);
  const float* SCL = (const float*)(p.ws + OFF_SCL);
  const int* EIDX = (const int*)(p.ws + OFF_EIDX);
  const float* GATE = (const float*)(p.ws + OFF_GATE);
  float* wgt = (float*)lds;
  float* red = (float*)(lds + 1024);
  float* part = (float*)(lds + 2048);
  for (int tok = blockIdx.x; tok < NTOK; tok += gridDim.x) {
    int tidv = threadIdx.x; asm volatile("" : "+v"(tidv));
    const int tid = tidv, lane = tid & 63, w = tid >> 6;
    const bf16_t* xr = X1B + (size_t)tok * 2048;
    float xa[2][16];
#pragma unroll
    for (int j = 0; j < 2; ++j)
#pragma unroll
      for (int q = 0; q < 2; ++q) {
        u32x4 t = *(const u32x4*)(xr + 1024 * j + 16 * lane + 8 * q);
        xa[j][8 * q] = bflo(t.x); xa[j][8 * q + 1] = bfhi(t.x); xa[j][8 * q + 2] = bflo(t.y); xa[j][8 * q + 3] = bfhi(t.y);
        xa[j][8 * q + 4] = bflo(t.z); xa[j][8 * q + 5] = bfhi(t.z); xa[j][8 * q + 6] = bflo(t.w); xa[j][8 * q + 7] = bfhi(t.w);
      }
    __syncthreads();
#ifndef UR
#define UR 16
#endif
#ifndef VR
#define VR 16
#endif
#pragma unroll 1
    for (int k6 = 0; k6 < 32; k6 += UR) {
      u32x4 r[UR][2];
      int ee[UR];
#pragma unroll
      for (int kk = 0; kk < UR; ++kk) {
        const int kq = (k6 + kk < 32) ? (k6 + kk) : 31;
        ee[kk] = __builtin_amdgcn_readfirstlane(EIDX[(size_t)tok * 128 + w * 32 + kq]);
        const unsigned char* ur = U8 + (size_t)ee[kk] * 2048 + lane * 16;
        r[kk][0] = *(const u32x4*)ur;
        r[kk][1] = *(const u32x4*)(ur + 1024);
      }
      float dot[UR];
#pragma unroll
      for (int kk = 0; kk < UR; ++kk) dot[kk] = dot16_fp8(r[kk][0], xa[0]) + dot16_fp8(r[kk][1], xa[1]);
#pragma unroll
      for (int o = 32; o >= 1; o >>= 1) {
#pragma unroll
        for (int kk = 0; kk < UR; ++kk) dot[kk] += __shfl_xor(dot[kk], o);
      }
      if (lane < UR && k6 + lane < 32) {
        float a = dot[0]; int e = ee[0];
#pragma unroll
        for (int kk = 1; kk < UR; ++kk) { if (lane == kk) { a = dot[kk]; e = ee[kk]; } }
        const int k = w * 32 + k6 + lane;
        a *= SCL[e];
        const float ge = 0.5f * a * (1.f + erff(a * 0.70710678118654752f));
        wgt[k] = GATE[(size_t)tok * 128 + k] * ge * SCL[16384 + e];
      }
    }
    __syncthreads();
#pragma unroll 1
    for (int j = 0; j < 2; ++j) {
      float acc[16];
#pragma unroll
      for (int q = 0; q < 16; ++q) acc[q] = 0.f;
#pragma unroll 1
      for (int k6 = 0; k6 < 32; k6 += VR) {
        u32x4 r[VR];
        float ww[VR];
#pragma unroll
        for (int kk = 0; kk < VR; ++kk) {
          const int kq = (k6 + kk < 32) ? (k6 + kk) : 31;
          const int k = w * 32 + kq;
          const int e = __builtin_amdgcn_readfirstlane(EIDX[(size_t)tok * 128 + k]);
          ww[kk] = (k6 + kk < 32) ? wgt[k] : 0.f;
          r[kk] = *(const u32x4*)(V8 + (size_t)e * 2048 + 1024 * j + lane * 16);
        }
#pragma unroll
        for (int kk = 0; kk < VR; ++kk) axpy16_fp8(r[kk], ww[kk], acc);
      }
#pragma unroll
      for (int q = 0; q < 4; ++q)
        *(f32x4*)(part + w * 2048 + 1024 * j + 16 * lane + 4 * q) = (f32x4){acc[4 * q], acc[4 * q + 1], acc[4 * q + 2], acc[4 * q + 3]};
    }
    __syncthreads();
    const float al = 1.189207115002721f;
    const u32x4 xt = *(const u32x4*)(xr + tid * 8);
    f32x4 x0 = {bflo(xt.x), bfhi(xt.x), bflo(xt.y), bfhi(xt.y)}, x1 = {bflo(xt.z), bfhi(xt.z), bflo(xt.w), bfhi(xt.w)};
    f32x4 s0 = {0.f, 0.f, 0.f, 0.f}, s1 = {0.f, 0.f, 0.f, 0.f};
#pragma unroll
    for (int ww2 = 0; ww2 < 4; ++ww2) {
      f32x4 a0 = *(const f32x4*)(part + ww2 * 2048 + tid * 8), a1 = *(const f32x4*)(part + ww2 * 2048 + tid * 8 + 4);
      s0.x += a0.x; s0.y += a0.y; s0.z += a0.z; s0.w += a0.w; s1.x += a1.x; s1.y += a1.y; s1.z += a1.z; s1.w += a1.w;
    }
    float val[8] = {al * x0.x + s0.x, al * x0.y + s0.y, al * x0.z + s0.z, al * x0.w + s0.w,
                    al * x1.x + s1.x, al * x1.y + s1.y, al * x1.z + s1.z, al * x1.w + s1.w};
    float s = 0.f;
#pragma unroll
    for (int j = 0; j < 8; ++j) s += val[j];
    s = wave_sum(s);
    if (lane == 0) red[w] = s;
    __syncthreads();
    const float mean = (red[0] + red[1] + red[2] + red[3]) * (1.f / 2048.f);
    float q = 0.f;
#pragma unroll
    for (int j = 0; j < 8; ++j) { const float d = val[j] - mean; q += d * d; }
    q = wave_sum(q);
    if (lane == 0) red[4 + w] = q;
    __syncthreads();
    const float rs = rsqrtf((red[4] + red[5] + red[6] + red[7]) * (1.f / 2048.f) + 1e-5f);
    f32x4 g0 = *(const f32x4*)(p.ln2_g + tid * 8), g1 = *(const f32x4*)(p.ln2_g + tid * 8 + 4);
    f32x4 b0 = *(const f32x4*)(p.ln2_b + tid * 8), b1 = *(const f32x4*)(p.ln2_b + tid * 8 + 4);
    f32x4 o0 = {(val[0] - mean) * rs * g0.x + b0.x, (val[1] - mean) * rs * g0.y + b0.y, (val[2] - mean) * rs * g0.z + b0.z, (val[3] - mean) * rs * g0.w + b0.w};
    f32x4 o1 = {(val[4] - mean) * rs * g1.x + b1.x, (val[5] - mean) * rs * g1.y + b1.y, (val[6] - mean) * rs * g1.z + b1.z, (val[7] - mean) * rs * g1.w + b1.w};
    float* yo = p.out + OUT_Y + (size_t)tok * 2048 + tid * 8;
    *(f32x4*)yo = o0;
    *(f32x4*)(yo + 4) = o1;
  }
}

__device__ __forceinline__ void grid_bar(unsigned* ctr, unsigned target) {
  asm volatile("s_waitcnt vmcnt(0)" ::: "memory");
  __syncthreads();
  if (threadIdx.x == 0) {
    __builtin_amdgcn_fence(__ATOMIC_RELEASE, "agent");
    asm volatile("s_waitcnt vmcnt(0)" ::: "memory");
    __hip_atomic_fetch_add(ctr, 1u, __ATOMIC_RELAXED, __HIP_MEMORY_SCOPE_AGENT);
    while (__hip_atomic_load(ctr, __ATOMIC_RELAXED, __HIP_MEMORY_SCOPE_AGENT) < target) __builtin_amdgcn_s_sleep(2);
    __builtin_amdgcn_fence(__ATOMIC_ACQUIRE, "agent");
    asm volatile("s_waitcnt vmcnt(0)" ::: "memory");
  }
  __syncthreads();
}

__global__ void __launch_bounds__(256, 2) mega(Params p, int ph_lo, int ph_hi, int use_sync) {
  __shared__ __attribute__((aligned(16))) char lds[LDS_BYTES];
  cg::grid_group grid = cg::this_grid();
  unsigned nbar = 0;
#ifndef DUP_PHASE
#define DUP_PHASE -1
#endif
  const int par = (use_sync == 3);
  const int nph = par ? 10 : 8;
  for (int pi = 0; pi < nph; ++pi) {
    const int ph = par ? (pi < 3 ? pi : (pi < 5 ? pi + 5 : pi - 2)) : pi;
    const int reps = (ph == DUP_PHASE) ? 2 : 1;
    for (int rep = 0; rep < reps; ++rep) {
      switch (ph) {
        case 0: phase0(p, lds); break;
        case 1: phase1(p, lds); break;
        case 2: phase2(p, lds, rep, par); break;
        case 8: phase2b(p); break;
        case 9: phase2c(p, lds); break;
        case 3: gemm23<0>(p, lds); break;
        case 4: phase4(p); break;
        case 5: gemm23<1>(p, lds); break;
        case 6: phase6(p, lds); break;
        case 7: phase7(p, lds); break;
      }
      if (pi + 1 < nph || rep + 1 < reps) {
        if (use_sync == 2) grid.sync();
        else grid_bar((unsigned*)(p.ws + 128), (unsigned)gridDim.x * (++nbar));
      }
    }
  }
}

extern "C" void kernel_launch(void* const* d_in, const int* in_sizes, int n_in, void* d_out, int out_size,
                              void* d_ws, size_t ws_size, hipStream_t stream) {
  static int grid_blocks = 0;
  if (!grid_blocks) {
    int dev = 0, cus = 0, per_cu = 0;
    hipGetDevice(&dev);
    hipDeviceGetAttribute(&cus, hipDeviceAttributeMultiprocessorCount, dev);
    hipOccupancyMaxActiveBlocksPerMultiprocessor(&per_cu, mega, 256, 0);
    if (per_cu > 2) per_cu = 2;
    if (per_cu < 1) per_cu = 1;
    grid_blocks = cus * per_cu;
    grid_blocks &= ~7;
  }
  Params p{};
  p.x_prompt = (const float*)d_in[0]; p.x_sample = (const float*)d_in[1]; p.cache_k = (const float*)d_in[2];
  p.cache_v = (const float*)d_in[3]; p.state = (const float*)d_in[4]; p.w_in = (const float*)d_in[5];
  p.hgrn_lb = (const float*)d_in[6]; p.hgrn_g = (const float*)d_in[7]; p.lq1 = (const float*)d_in[8];
  p.lk1 = (const float*)d_in[9]; p.lq2 = (const float*)d_in[10]; p.lk2 = (const float*)d_in[11];
  p.diff_g = (const float*)d_in[12]; p.w_out = (const float*)d_in[13]; p.ln1_g = (const float*)d_in[14];
  p.ln1_b = (const float*)d_in[15]; p.wq = (const float*)d_in[16]; p.subk = (const float*)d_in[17];
  p.pu = (const float*)d_in[18]; p.pv = (const float*)d_in[19]; p.ln2_g = (const float*)d_in[20];
  p.ln2_b = (const float*)d_in[21];
  p.out = (float*)d_out; p.ws = (char*)d_ws;
  hipMemsetAsync(d_ws, 0, 256, stream);
  int lo = 0, hi = 7, us = 3;
  void* args[] = {&p, &lo, &hi, &us};
  hipError_t e = hipLaunchCooperativeKernel((const void*)mega, dim3(grid_blocks), dim3(256), args, 0, stream);
  if (e != hipSuccess) fprintf(stderr, "cooperative launch failed: %s (grid %d)\n", hipGetErrorString(e), grid_blocks);
}
```

```cpp
#include <hip/hip_runtime.h>
#include <hip/hip_cooperative_groups.h>
#include <stdint.h>
#include <cstdio>
namespace cg = cooperative_groups;

typedef unsigned short bf16_t;
typedef short bf16x8 __attribute__((ext_vector_type(8)));
typedef float f32x4 __attribute__((ext_vector_type(4)));
typedef unsigned u32x4 __attribute__((ext_vector_type(4)));
typedef unsigned u32x2 __attribute__((ext_vector_type(2)));

#define NTOK 16896
#define NPTOK 16384
#define LDS_BYTES 65536

#define OUT_Y   0
#define OUT_KP  34603008
#define OUT_VP  51380224
#define OUT_SP  68157440
#define OUT_KS  68681728
#define OUT_VS  69206016
#define OUT_SS  69730304

constexpr size_t SZ_XB     = (size_t)NTOK * 2048 * 2;
constexpr size_t SZ_T1K2   = (size_t)NTOK * 1024 * 2;
constexpr size_t SZ_W2     = (size_t)2048 * 2048 * 2;
constexpr size_t SZ_KS     = (size_t)64 * 1088 * 128 * 2;
constexpr size_t SZ_KP     = (size_t)32 * 4096 * 128 * 2;
constexpr size_t OFF_CTR   = 0;
constexpr size_t OFF_LB    = 4096;
constexpr size_t OFF_XB    = 8192;
constexpr size_t OFF_WINT  = OFF_XB + SZ_XB;
constexpr size_t OFF_WOUTT = OFF_WINT + (size_t)7168 * 2048 * 2;
constexpr size_t OFF_WQT   = OFF_WOUTT + SZ_W2;
constexpr size_t OFF_SKB   = OFF_WQT + SZ_W2;
constexpr size_t OFF_KS    = OFF_SKB + 524288;
constexpr size_t OFF_VTS   = OFF_KS + SZ_KS;
constexpr size_t OFF_R4    = OFF_VTS + SZ_KS;
constexpr size_t OFF_QA    = OFF_R4;
constexpr size_t OFF_LOGF  = OFF_QA + SZ_T1K2;
constexpr size_t OFF_IAT   = OFF_LOGF + 2 * SZ_T1K2;
constexpr size_t OFF_GA    = OFF_IAT + SZ_T1K2;
constexpr size_t OFF_QB    = OFF_GA + SZ_T1K2;
constexpr size_t OFF_KP    = OFF_QB + SZ_T1K2;
constexpr size_t OFF_VTP   = OFF_KP + SZ_KP;
constexpr size_t OFF_R4END = OFF_VTP + SZ_KP;
constexpr size_t OFF_X1F   = OFF_R4;
constexpr size_t OFF_UB    = OFF_XB;
constexpr size_t OFF_VB    = OFF_UB + (size_t)16384 * 2048;
constexpr size_t OFF_SCL   = OFF_VB + (size_t)16384 * 2048;
constexpr size_t OFF_MERGED= OFF_R4END;
constexpr size_t OFF_QP    = OFF_MERGED;
constexpr size_t OFF_X1B   = OFF_X1F + (size_t)NTOK * 2048 * 4;
constexpr size_t OFF_EIDX  = OFF_WINT;
constexpr size_t OFF_GATE  = OFF_EIDX + (size_t)NTOK * 128 * 4;
constexpr size_t OFF_DBUF  = OFF_WINT + (size_t)20 * 1024 * 1024;
constexpr size_t OFF_LS    = OFF_XB;
constexpr size_t WS_NEED_PAR = OFF_MERGED + SZ_XB;
static_assert((size_t)32 * 64 * 16 * 256 * 8 <= SZ_XB, "LS fits XB");
static_assert(OFF_SCL + 32768 * 4 <= OFF_WINT, "overlay"); static_assert(OFF_X1B + SZ_XB <= OFF_R4END, "overlay");

struct Params {
  const float* x_prompt; const float* x_sample; const float* cache_k; const float* cache_v; const float* state;
  const float* w_in; const float* hgrn_lb; const float* hgrn_g; const float* lq1; const float* lk1;
  const float* lq2; const float* lk2; const float* diff_g; const float* w_out; const float* ln1_g; const float* ln1_b;
  const float* wq; const float* subk; const float* pu; const float* pv; const float* ln2_g; const float* ln2_b;
  float* out; char* ws;
};

typedef __bf16 bf16x2_t __attribute__((ext_vector_type(2)));
typedef float f32x2_t __attribute__((ext_vector_type(2)));
__device__ __forceinline__ unsigned pk_bf16(float lo, float hi) {
  f32x2_t f = {lo, hi};
  bf16x2_t b = __builtin_convertvector(f, bf16x2_t);
  return __builtin_bit_cast(unsigned, b);
}
__device__ __forceinline__ float bf2f(unsigned short x) { return __uint_as_float(((unsigned)x) << 16); }
__device__ __forceinline__ float bflo(unsigned x) { return __uint_as_float(x << 16); }
__device__ __forceinline__ float bfhi(unsigned x) { return __uint_as_float(x & 0xffff0000u); }
__device__ __forceinline__ f32x4 mfma16(bf16x8 a, bf16x8 b, f32x4 c) {
  return __builtin_amdgcn_mfma_f32_16x16x32_bf16(a, b, c, 0, 0, 0);
}
__device__ __forceinline__ bf16x8 mk8(unsigned a, unsigned b, unsigned c, unsigned d) {
  u32x4 v = {a, b, c, d}; return __builtin_bit_cast(bf16x8, v);
}
__device__ __forceinline__ bf16x8 mk8(u32x2 a, u32x2 b) {
  u32x4 v = {a.x, a.y, b.x, b.y}; return __builtin_bit_cast(bf16x8, v);
}
__device__ __forceinline__ float wave_sum(float v) {
#pragma unroll
  for (int o = 32; o >= 1; o >>= 1) v += __shfl_xor(v, o);
  return v;
}

__device__ void transpose_conv(const float* __restrict__ W, bf16_t* __restrict__ WT, int K, int N, char* lds) {
  float* tile = (float*)lds;
  int tid_o = threadIdx.x; asm volatile("" : "+v"(tid_o)); const int tid = tid_o;
  const int nkt = K / 64, nnt = N / 64;
  for (int t = blockIdx.x; t < nkt * nnt; t += gridDim.x) {
    const int kt = t / nnt, nt = t % nnt;
    const int c = tid & 63, r0 = tid >> 6;
#pragma unroll 4
    for (int i = 0; i < 16; ++i) {
      int r = i * 4 + r0;
      tile[r * 65 + c] = W[(size_t)(kt * 64 + r) * N + nt * 64 + c];
    }
    __syncthreads();
#pragma unroll 4
    for (int i = 0; i < 16; ++i) {
      int n = i * 4 + r0;
      float v = tile[c * 65 + n];
      WT[(size_t)(nt * 64 + n) * K + kt * 64 + c] = (bf16_t)(pk_bf16(v, 0.f) & 0xffff);
    }
    __syncthreads();
  }
}

__device__ __forceinline__ void conv8(const float* __restrict__ src, bf16_t* __restrict__ dst) {
  f32x4 a = *(const f32x4*)src, b = *(const f32x4*)(src + 4);
  u32x4 o = {pk_bf16(a.x, a.y), pk_bf16(a.z, a.w), pk_bf16(b.x, b.y), pk_bf16(b.z, b.w)};
  *(u32x4*)dst = o;
}

__device__ void phase0(const Params& p, char* lds) {
  int tid_o = threadIdx.x; asm volatile("" : "+v"(tid_o)); const int tid = tid_o, bid = blockIdx.x;
  const size_t gtid = (size_t)bid * 256 + tid, gsz = (size_t)gridDim.x * 256;
  if (bid == 0) {
    if (tid < 64) {
      float a = p.lq1[tid] * p.lk1[tid], b = p.lq2[tid] * p.lk2[tid];
      a = wave_sum(a); b = wave_sum(b);
      if (tid == 0) ((float*)(p.ws + OFF_CTR))[16] = expf(a) - expf(b) + 0.2f;
    }
    float* LB = (float*)(p.ws + OFF_LB);
    for (int k = tid; k < 1024; k += 256) {
      float a0 = p.hgrn_lb[k], a1 = p.hgrn_lb[1024 + k];
      LB[k] = 1.0f / (1.0f + expf(a1 - a0));
    }
  }
  {
    bf16_t* XB = (bf16_t*)(p.ws + OFF_XB);
    const size_t nch = (size_t)NTOK * 2048 / 8;
    for (size_t c = gtid; c < nch; c += gsz) {
      size_t e = c * 8;
      const float* src = (e < (size_t)NPTOK * 2048) ? (p.x_prompt + e) : (p.x_sample + (e - (size_t)NPTOK * 2048));
      conv8(src, XB + e);
    }
  }
  {
    bf16_t* KS = (bf16_t*)(p.ws + OFF_KS);
    for (size_t c = gtid; c < (size_t)1048576; c += gsz) {
      int d8 = c & 15, h = (c >> 4) & 7, s = (c >> 7) & 1023, b = (int)(c >> 17);
      conv8(p.cache_k + c * 8, KS + ((size_t)((b * 8 + h) * 1088 + s) * 128 + d8 * 8));
    }
  }
  {
    bf16_t* VTS = (bf16_t*)(p.ws + OFF_VTS);
    for (size_t i = gtid; i < (size_t)2097152; i += gsz) {
      int vc = i & 127, s4 = (i >> 7) & 255, h = (i >> 15) & 7, b = (int)(i >> 18);
      const float* src = p.cache_v + ((size_t)(b * 1024 + s4 * 4) * 8 + h) * 128 + vc;
      float v0 = src[0], v1 = src[1024], v2 = src[2048], v3 = src[3072];
      u32x2 o = {pk_bf16(v0, v1), pk_bf16(v2, v3)};
      *(u32x2*)(VTS + ((size_t)((b * 8 + h) * 128 + vc) * 1088 + s4 * 4)) = o;
    }
  }
  {
    bf16_t* SKB = (bf16_t*)(p.ws + OFF_SKB);
    for (size_t c = gtid; c < (size_t)32768; c += gsz) conv8(p.subk + c * 8, SKB + c * 8);
  }
  transpose_conv(p.w_in, (bf16_t*)(p.ws + OFF_WINT), 2048, 7168, lds);
  transpose_conv(p.w_out, (bf16_t*)(p.ws + OFF_WOUTT), 2048, 2048, lds);
  transpose_conv(p.wq, (bf16_t*)(p.ws + OFF_WQT), 2048, 2048, lds);
}

template <bool SWAP>
__device__ __forceinline__ void gemm_compute_tile(const char* cur, int aoff, int boff, int sw, int fq, f32x4 (&acc)[4][4]) {
#pragma unroll
  for (int ks = 0; ks < 2; ++ks) {
    bf16x8 af[4], bfr[4];
    const int ch = ((ks * 4 + fq) ^ sw) << 4;
#pragma unroll
    for (int m = 0; m < 4; ++m) af[m] = *(const bf16x8*)(cur + aoff + m * 2048 + ch);
#pragma unroll
    for (int n = 0; n < 4; ++n) bfr[n] = *(const bf16x8*)(cur + boff + n * 2048 + ch);
#pragma unroll
    for (int m = 0; m < 4; ++m)
#pragma unroll
      for (int n = 0; n < 4; ++n)
        acc[m][n] = SWAP ? mfma16(bfr[n], af[m], acc[m][n]) : mfma16(af[m], bfr[n], acc[m][n]);
  }
}

template <bool SWAP>
__device__ __forceinline__ void gemm_mainloop(const bf16_t* A, const bf16_t* B,
                                              int row0, int col0, int K, char* lds, f32x4 (&acc)[4][4]) {
  int tid_o = threadIdx.x; asm volatile("" : "+v"(tid_o)); const int tid = tid_o, lane = tid & 63, wave = tid >> 6;
  const int wm = wave >> 1, wn = wave & 1, fr = lane & 15, fq = lane >> 4;
  const int lrow = tid >> 3, lc = tid & 7;
  const int cl = lc ^ (lrow & 7);
  const bf16_t* ga = A + (size_t)(row0 + lrow) * K + cl * 8;
  const bf16_t* gb = B + (size_t)(col0 + lrow) * K + cl * 8;
  const int loff = tid * 16;
#define G_STAGE(BUF, KT) { _Pragma("unroll") for (int i = 0; i < 4; ++i) { \
      __builtin_amdgcn_global_load_lds((const unsigned*)(ga + (size_t)i * 32 * K + (KT) * 64), (unsigned*)((BUF) + loff + i * 4096), 16, 0, 0); \
      __builtin_amdgcn_global_load_lds((const unsigned*)(gb + (size_t)i * 32 * K + (KT) * 64), (unsigned*)((BUF) + 16384 + loff + i * 4096), 16, 0, 0); } }
  const int nkt = K >> 6;
  G_STAGE(lds, 0);
  __syncthreads();
  const int aoff = (wm * 64 + fr) * 128, boff = 16384 + (wn * 64 + fr) * 128;
  const int sw = fr & 7;
  for (int kt = 0; kt < nkt; ++kt) {
    char* cur = lds + (kt & 1) * 32768;
    char* nxt = lds + ((kt + 1) & 1) * 32768;
    if (kt + 1 < nkt) G_STAGE(nxt, kt + 1);
    gemm_compute_tile<SWAP>(cur, aoff, boff, sw, fq, acc);
    __syncthreads();
  }
#undef G_STAGE
}

template <int MT, bool SWAP>
__device__ __forceinline__ void gemm_mainloop_big(const bf16_t* A, const bf16_t* B,
                                                  int row0, int col0, int K, char* lds, f32x4 (&acc)[MT][4]) {
  int tid_o = threadIdx.x; asm volatile("" : "+v"(tid_o)); const int tid = tid_o, lane = tid & 63, wave = tid >> 6;
  const int wm = wave >> 1, wn = wave & 1, fr = lane & 15, fq = lane >> 4;
  const int lrow = tid >> 3, lc = tid & 7;
  const int cl = lc ^ (lrow & 7);
  const bf16_t* ga = A + (size_t)(row0 + lrow) * K + cl * 8;
  const bf16_t* gb = B + (size_t)(col0 + lrow) * K + cl * 8;
  const int loff = tid * 16;
  const int nkt = K >> 6;
  constexpr int BOFF = MT * 32 * 128;
  const int aoff = (wm * (MT * 16) + fr) * 128, boff = BOFF + (wn * 64 + fr) * 128;
  const int sw = fr & 7;
  for (int kt = 0; kt < nkt; ++kt) {
#pragma unroll
    for (int i = 0; i < MT; ++i)
      __builtin_amdgcn_global_load_lds((const unsigned*)(ga + (size_t)i * 32 * K + kt * 64), (unsigned*)(lds + loff + i * 4096), 16, 0, 0);
#pragma unroll
    for (int i = 0; i < 4; ++i)
      __builtin_amdgcn_global_load_lds((const unsigned*)(gb + (size_t)i * 32 * K + kt * 64), (unsigned*)(lds + BOFF + loff + i * 4096), 16, 0, 0);
    __syncthreads();
#pragma unroll
    for (int ks = 0; ks < 2; ++ks) {
      bf16x8 af[MT], bfr[4];
      const int ch = ((ks * 4 + fq) ^ sw) << 4;
#pragma unroll
      for (int m = 0; m < MT; ++m) af[m] = *(const bf16x8*)(lds + aoff + m * 2048 + ch);
#pragma unroll
      for (int n = 0; n < 4; ++n) bfr[n] = *(const bf16x8*)(lds + boff + n * 2048 + ch);
#pragma unroll
      for (int m = 0; m < MT; ++m)
#pragma unroll
        for (int n = 0; n < 4; ++n)
          acc[m][n] = SWAP ? mfma16(bfr[n], af[m], acc[m][n]) : mfma16(af[m], bfr[n], acc[m][n]);
    }
    __syncthreads();
  }
}

template <bool SWAP>
__device__ void gemm1_tile(const Params& p, int mt, int nt, char* lds) {
  f32x4 acc[8][4];
#pragma unroll
  for (int m = 0; m < 8; ++m)
#pragma unroll
    for (int n = 0; n < 4; ++n) acc[m][n] = (f32x4){0.f, 0.f, 0.f, 0.f};
  gemm_mainloop_big<8, SWAP>((const bf16_t*)(p.ws + OFF_XB), (const bf16_t*)(p.ws + OFF_WINT), mt * 256, nt * 128, 2048, lds, acc);
  int tidv = threadIdx.x; asm volatile("" : "+v"(tidv));
  const int tid = tidv, lane = tid & 63, wave = tid >> 6;
  const int wm = wave >> 1, wn = wave & 1, fr = lane & 15, fq = lane >> 4;
  const int seg = nt >> 3, h = nt & 7;
  const bool samp = (mt * 256 >= NPTOK);
  if (SWAP) {
    const float* LB = (const float*)(p.ws + OFF_LB);
    if (seg == 5 && !samp) {
      float nmax = 0.f;
#pragma unroll
      for (int m = 0; m < 8; ++m) {
        float s2 = 0.f;
#pragma unroll
        for (int n = 0; n < 4; ++n) s2 += acc[m][n].x * acc[m][n].x + acc[m][n].y * acc[m][n].y + acc[m][n].z * acc[m][n].z + acc[m][n].w * acc[m][n].w;
        s2 += __shfl_xor(s2, 16);
        s2 += __shfl_xor(s2, 32);
        nmax = fmaxf(nmax, s2);
      }
#pragma unroll
      for (int o = 8; o >= 1; o >>= 1) nmax = fmaxf(nmax, __shfl_xor(nmax, o));
      if (lane == 0) atomicMax((unsigned*)(p.ws + 256) + ((mt * 256) >> 12) * 16 + h * 2 + wn, __float_as_uint(nmax));
    }
#pragma unroll
    for (int m = 0; m < 8; ++m) {
      const int tok = mt * 256 + wm * 128 + m * 16 + fr;
#pragma unroll
      for (int n = 0; n < 4; ++n) {
        const int cl = wn * 64 + n * 16 + fq * 4;
        const int kidx = h * 128 + cl;
        f32x4 v = acc[m][n];
        if (seg == 0) {
          u32x2 o = {pk_bf16(v.x, v.y), pk_bf16(v.z, v.w)};
          *(u32x2*)((bf16_t*)(p.ws + OFF_QA) + (size_t)tok * 1024 + kidx) = o;
        } else if (seg == 1) {
          f32x4 lb = *(const f32x4*)(LB + kidx);
          f32x4 o;
          o.x = lb.x + (1.f - lb.x) / (1.f + __expf(-v.x));
          o.y = lb.y + (1.f - lb.y) / (1.f + __expf(-v.y));
          o.z = lb.z + (1.f - lb.z) / (1.f + __expf(-v.z));
          o.w = lb.w + (1.f - lb.w) / (1.f + __expf(-v.w));
          *(f32x4*)((float*)(p.ws + OFF_LOGF) + (size_t)tok * 1024 + kidx) = o;
        } else if (seg == 3) {
          float s0 = 1.f / (1.f + __expf(-v.x)), s1 = 1.f / (1.f + __expf(-v.y));
          float s2 = 1.f / (1.f + __expf(-v.z)), s3 = 1.f / (1.f + __expf(-v.w));
          u32x2 o = {pk_bf16(s0, s1), pk_bf16(s2, s3)};
          *(u32x2*)((bf16_t*)(p.ws + OFF_GA) + (size_t)tok * 1024 + kidx) = o;
        } else if (seg == 4) {
          const float sc = 0.18033688011112042f;
          u32x2 o = {pk_bf16(v.x * sc, v.y * sc), pk_bf16(v.z * sc, v.w * sc)};
          *(u32x2*)((bf16_t*)(p.ws + OFF_QB) + (size_t)tok * 1024 + kidx) = o;
        } else {
          u32x2 o = {pk_bf16(v.x, v.y), pk_bf16(v.z, v.w)};
          if (!samp) {
            *(f32x4*)(p.out + OUT_KP + (size_t)tok * 1024 + kidx) = v;
            const int b = tok >> 12, t = tok & 4095;
            *(u32x2*)((bf16_t*)(p.ws + OFF_KP) + ((size_t)((b * 8 + h) * 4096 + t) * 128 + cl)) = o;
          } else {
            const int ts = tok - NPTOK;
            *(f32x4*)(p.out + OUT_KS + (size_t)ts * 1024 + kidx) = v;
            const int b = ts >> 6, t = ts & 63;
            *(u32x2*)((bf16_t*)(p.ws + OFF_KS) + ((size_t)((b * 8 + h) * 1088 + 1024 + t) * 128 + cl)) = o;
          }
        }
      }
    }
  } else {
#pragma unroll
    for (int m = 0; m < 8; ++m) {
      const int tok0 = mt * 256 + wm * 128 + m * 16 + fq * 4;
#pragma unroll
      for (int n = 0; n < 4; ++n) {
        const int cl = wn * 64 + n * 16 + fr;
        f32x4 v = acc[m][n];
        u32x2 o = {pk_bf16(v.x, v.y), pk_bf16(v.z, v.w)};
        if (seg == 2) {
          bf16_t* IAT = (bf16_t*)(p.ws + OFF_IAT);
          if (!samp) {
            const int b = tok0 >> 12, t = tok0 & 4095;
            *(u32x2*)(IAT + ((size_t)((b * 8 + h) * 128 + cl) * 4096 + t)) = o;
          } else {
            const int ts = tok0 - NPTOK, b = ts >> 6, t = ts & 63;
            *(u32x2*)(IAT + (size_t)32 * 128 * 4096 + ((size_t)((b * 8 + h) * 128 + cl) * 64 + t)) = o;
          }
        } else {
          if (!samp) {
            float* ov = p.out + OUT_VP + (size_t)tok0 * 1024 + h * 128 + cl;
            ov[0] = v.x; ov[1024] = v.y; ov[2048] = v.z; ov[3072] = v.w;
            const int b = tok0 >> 12, t = tok0 & 4095;
            *(u32x2*)((bf16_t*)(p.ws + OFF_VTP) + ((size_t)((b * 8 + h) * 128 + cl) * 4096 + t)) = o;
          } else {
            const int ts = tok0 - NPTOK, b = ts >> 6, t = ts & 63;
            float* ov = p.out + OUT_VS + (size_t)ts * 1024 + h * 128 + cl;
            ov[0] = v.x; ov[1024] = v.y; ov[2048] = v.z; ov[3072] = v.w;
            *(u32x2*)((bf16_t*)(p.ws + OFF_VTS) + ((size_t)((b * 8 + h) * 128 + cl) * 1088 + 1024 + t)) = o;
          }
        }
      }
    }
  }
}

__device__ void phase1(const Params& p, char* lds) {
  const int xcd = blockIdx.x & 7, lb = blockIdx.x >> 3, nbx = gridDim.x >> 3;
  const int nM = NTOK / 256, nNx = 7;
  for (int li = lb; li < nM * nNx; li += nbx) {
    const int mt = li / nNx, nt = (li % nNx) * 8 + xcd;
    const int seg = nt >> 3;
    if (seg == 2 || seg == 6) gemm1_tile<false>(p, mt, nt, lds);
    else gemm1_tile<true>(p, mt, nt, lds);
  }
}

template <int MODE, int MT>
__device__ void gemm23_tile(const Params& p, int row0, int nt, char* lds) {
  const bf16_t* A = (const bf16_t*)(p.ws + (MODE == 0 ? OFF_MERGED : OFF_X1B));
  const bf16_t* B = (const bf16_t*)(p.ws + (MODE == 0 ? OFF_WOUTT : OFF_WQT));
  f32x4 acc[MT][4];
#pragma unroll
  for (int m = 0; m < MT; ++m)
#pragma unroll
    for (int n = 0; n < 4; ++n) acc[m][n] = (f32x4){0.f, 0.f, 0.f, 0.f};
  if (MT == 4) gemm_mainloop<true>(A, B, row0, nt * 128, 2048, lds, (f32x4(&)[4][4])acc);
  else gemm_mainloop_big<MT, true>(A, B, row0, nt * 128, 2048, lds, acc);
  int tid_o = threadIdx.x; asm volatile("" : "+v"(tid_o)); const int tid = tid_o, lane = tid & 63, wave = tid >> 6;
  const int wm = wave >> 1, wn = wave & 1, fr = lane & 15, fq = lane >> 4;
#pragma unroll
  for (int m = 0; m < MT; ++m) {
    const int tok = row0 + wm * (MT * 16) + m * 16 + fr;
#pragma unroll
    for (int n = 0; n < 4; ++n) {
      const int col = nt * 128 + wn * 64 + n * 16 + fq * 4;
      f32x4 v = acc[m][n];
      if (MODE == 0) {
        const float* xin = (tok < NPTOK) ? (p.x_prompt + (size_t)tok * 2048) : (p.x_sample + (size_t)(tok - NPTOK) * 2048);
        f32x4 xv = *(const f32x4*)(xin + col);
        const float al = 1.189207115002721f;
        u32x2 o = {pk_bf16(al * xv.x + v.x, al * xv.y + v.y), pk_bf16(al * xv.z + v.z, al * xv.w + v.w)};
        *(u32x2*)((bf16_t*)(p.ws + OFF_X1B) + (size_t)tok * 2048 + col) = o;
      } else {
        u32x2 o = {pk_bf16(v.x, v.y), pk_bf16(v.z, v.w)};
        *(u32x2*)((bf16_t*)(p.ws + OFF_QP) + (size_t)tok * 2048 + col) = o;
      }
    }
  }
}

template <int MODE>
__device__ void gemm23(const Params& p, char* lds) {
  const int xcd = blockIdx.x & 7, lb = blockIdx.x >> 3, nbx = gridDim.x >> 3;
  for (int li = lb; li < 64 * 2; li += nbx) gemm23_tile<MODE, 8>(p, (li >> 1) * 256, (li & 1) * 8 + xcd, lds);
  for (int li = lb; li < 4 * 2; li += nbx) gemm23_tile<MODE, 4>(p, NPTOK + (li >> 1) * 128, (li & 1) * 8 + xcd, lds);
}

__device__ void hgrn_item(const Params& p, int kind, int b, int h, char* lds, int mode, int c0) {
  int tid_o = threadIdx.x; asm volatile("" : "+v"(tid_o)); const int tid = tid_o, lane = tid & 63, w = tid >> 6, fr = lane & 15, fq = lane >> 4;
  const int tokbase = kind == 0 ? b * 4096 : NPTOK + b * 64;
  const int c_begin = mode == 0 ? 0 : c0, nch = mode == 0 ? (kind == 0 ? 64 : 1) : c0 + 1;
  u32x2* LSb = (u32x2*)(p.ws + OFF_LS) + ((size_t)((b * 8 + h) * 64 + c0) * 16) * 256 + tid;
  const bf16_t* IATb = (const bf16_t*)(p.ws + OFF_IAT) +
      (kind == 0 ? (size_t)((b * 8 + h) * 128) * 4096 : (size_t)32 * 128 * 4096 + (size_t)((b * 8 + h) * 128) * 64);
  const int iat_stride = kind == 0 ? 4096 : 64;
  const float* LOGF = (const float*)(p.ws + OFF_LOGF);
  const bf16_t* QA = (const bf16_t*)(p.ws + OFF_QA);
  const bf16_t* GA = (const bf16_t*)(p.ws + OFF_GA);
  bf16_t* MERGED = (bf16_t*)(p.ws + OFF_MERGED);

  f32x4 S[8][2];
  if (mode == 2) {
#pragma unroll
    for (int kt = 0; kt < 8; ++kt)
#pragma unroll
      for (int vv = 0; vv < 2; ++vv) {
        u32x2 t = LSb[(kt * 2 + vv) * 256];
        S[kt][vv] = (f32x4){bflo(t.x), bfhi(t.x), bflo(t.y), bfhi(t.y)};
      }
  } else if (kind == 0) {
#pragma unroll
    for (int kt = 0; kt < 8; ++kt)
#pragma unroll
      for (int vv = 0; vv < 2; ++vv) S[kt][vv] = (f32x4){0.f, 0.f, 0.f, 0.f};
  } else {
    const float* st = p.state + (size_t)((b * 8 + h) * 128) * 128 + (4 * fq) * 128 + 32 * w + fr;
#pragma unroll
    for (int kt = 0; kt < 8; ++kt)
#pragma unroll
      for (int vv = 0; vv < 2; ++vv)
#pragma unroll
        for (int j = 0; j < 4; ++j) S[kt][vv][j] = st[(16 * kt + j) * 128 + 16 * vv];
  }
  f32x4 gn[2];
#pragma unroll
  for (int vv = 0; vv < 2; ++vv) gn[vv] = *(const f32x4*)(p.hgrn_g + 32 * w + 16 * vv + 4 * fq);

  const int ekp = tid & 63, eq = tid >> 6;

  u32x4 gR[8];
  unsigned qn[16];
#pragma unroll
  for (int i = 0; i < 8; ++i) {
    int id = tid + 256 * i, row = id >> 5, cc = id & 31;
    gR[i] = *(const u32x4*)(LOGF + (size_t)(tokbase + c_begin * 64 + row) * 1024 + h * 128 + cc * 4);
  }
#pragma unroll
  for (int i = 0; i < 16; ++i) qn[i] = *(const unsigned*)(QA + (size_t)(tokbase + c_begin * 64 + 16 * eq + i) * 1024 + h * 128 + 2 * ekp);
  for (int c = c_begin; c < nch; ++c) {
    int zz = 0; asm volatile("" : "+v"(zz));
    int tidv = threadIdx.x; asm volatile("" : "+v"(tidv));
    const int tid = tidv, lane = tid & 63, w = tid >> 6, fr = lane & 15, fq = lane >> 4, ekp = tid & 63, eq = tid >> 6;
    char* L = lds + zz;
    float* Dl = (float*)(L + 57344);
    float* part = (float*)(L + 57856);
    const int tok0 = tokbase + c * 64 + zz;
#pragma unroll
    for (int i = 0; i < 8; ++i) {
      int id = tid + 256 * i, row = id >> 5, cc = id & 31;
      *(u32x4*)(L + row * 512 + cc * 16) = gR[i];
    }
    unsigned qv[16];
#pragma unroll
    for (int i = 0; i < 16; ++i) qv[i] = qn[i];
    if (c + 1 < nch) {
#pragma unroll
      for (int i = 0; i < 8; ++i) {
        int id = tid + 256 * i, row = id >> 5, cc = id & 31;
        gR[i] = *(const u32x4*)(LOGF + (size_t)(tok0 + 64 + row) * 1024 + h * 128 + cc * 4);
      }
    }
    bf16x8 vfr[2][2];
#pragma unroll
    for (int ss = 0; ss < 2; ++ss)
#pragma unroll
      for (int vv = 0; vv < 2; ++vv)
        vfr[ss][vv] = *(const bf16x8*)(IATb + (size_t)(32 * w + 16 * vv + fr) * iat_stride + c * 64 + zz + 32 * ss + 8 * fq);
    __syncthreads();
    typedef float f32x2 __attribute__((ext_vector_type(2)));
    f32x2 gv[16];
    const float* Gl = (const float*)L;
    float* qtot = (float*)(L + 58880);
    float tot0 = 1.f, tot1 = 1.f;
#pragma unroll
    for (int i = 0; i < 16; ++i) { gv[i] = *(const f32x2*)(Gl + (16 * eq + i) * 128 + 2 * ekp); tot0 *= gv[i].x; tot1 *= gv[i].y; }
    qtot[eq * 128 + 2 * ekp] = tot0; qtot[eq * 128 + 2 * ekp + 1] = tot1;
    __syncthreads();
    {
      float run0 = 1.f, run1 = 1.f;
      for (int qq = 0; qq < eq; ++qq) { run0 *= qtot[qq * 128 + 2 * ekp]; run1 *= qtot[qq * 128 + 2 * ekp + 1]; }
      const int k0 = 2 * ekp;
#pragma unroll
      for (int i4 = 0; i4 < 4; ++i4) {
        float ka[4], kb[4];
#pragma unroll
        for (int ii = 0; ii < 4; ++ii) {
          const int i = i4 * 4 + ii, t = 16 * eq + i;
          const float f0 = gv[i].x, f1 = gv[i].y;
          run0 *= f0; run1 *= f1;
          const float q0 = bflo(qv[i]) * run0, q1 = bfhi(qv[i]) * run1;
          const float kk0 = (1.f - f0) * __builtin_amdgcn_rcpf(run0), kk1 = (1.f - f1) * __builtin_amdgcn_rcpf(run1);
          ka[ii] = kk0; kb[ii] = kk1;
          const int o = (t * 128 + ((((k0 >> 3) ^ (t & 15)) << 3) | (k0 & 7))) * 2;
          if (mode != 1) {
            *(unsigned*)(L + o) = pk_bf16(q0, q1);
            *(unsigned*)(L + 16384 + o) = pk_bf16(kk0, kk1);
          }
        }
        const int t0 = 16 * eq + i4 * 4;
        u32x2 oa = {pk_bf16(ka[0], ka[1]), pk_bf16(ka[2], ka[3])};
        u32x2 ob = {pk_bf16(kb[0], kb[1]), pk_bf16(kb[2], kb[3])};
        if (mode != 2) {
          *(u32x2*)(L + 32768 + k0 * 128 + ((((t0 >> 3) ^ (k0 & 7)) << 4) | ((t0 & 7) << 1))) = oa;
          *(u32x2*)(L + 32768 + (k0 + 1) * 128 + ((((t0 >> 3) ^ ((k0 + 1) & 7)) << 4) | ((t0 & 7) << 1))) = ob;
        }
      }
      if (eq == 3) { Dl[k0] = run0; Dl[k0 + 1] = run1; }
    }
    if (c + 1 < nch) {
#pragma unroll
      for (int i = 0; i < 16; ++i) qn[i] = *(const unsigned*)(QA + (size_t)(tok0 + 64 + 16 * eq + i) * 1024 + h * 128 + 2 * ekp);
    }
    __syncthreads();
    if (mode != 1) {
      bf16x8 qf[4];
#pragma unroll
      for (int ks = 0; ks < 4; ++ks) {
        const int t = 16 * w + fr;
        qf[ks] = *(const bf16x8*)(L + t * 256 + (((4 * ks + fq) ^ (t & 15)) << 4));
      }
#pragma unroll
      for (int st = 0; st < 4; ++st) {
        f32x4 a = {0.f, 0.f, 0.f, 0.f};
#pragma unroll
        for (int ks = 0; ks < 4; ++ks) {
          const int s = 16 * st + fr;
          bf16x8 kf = *(const bf16x8*)(L + 16384 + s * 256 + (((4 * ks + fq) ^ (s & 15)) << 4));
          a = mfma16(kf, qf[ks], a);
        }
        const int t = 16 * w + fr, s0 = 16 * st + 4 * fq;
        float p0 = (s0 + 0 <= t) ? a.x : 0.f, p1 = (s0 + 1 <= t) ? a.y : 0.f;
        float p2 = (s0 + 2 <= t) ? a.z : 0.f, p3 = (s0 + 3 <= t) ? a.w : 0.f;
        u32x2 o2 = {pk_bf16(p0, p1), pk_bf16(p2, p3)};
        *(u32x2*)(L + 49152 + t * 128 + ((((s0 >> 3) ^ (t & 7)) << 4) | ((s0 & 7) << 1))) = o2;
      }
    }
    f32x4 O[2][4];
#pragma unroll
    for (int vv = 0; vv < 2; ++vv)
#pragma unroll
      for (int tt = 0; tt < 4; ++tt) O[vv][tt] = (f32x4){0.f, 0.f, 0.f, 0.f};
    if (mode != 1) {
#pragma unroll
    for (int ks = 0; ks < 4; ++ks) {
      bf16x8 sf[2];
#pragma unroll
      for (int vv = 0; vv < 2; ++vv)
        sf[vv] = mk8(pk_bf16(S[2 * ks][vv].x, S[2 * ks][vv].y), pk_bf16(S[2 * ks][vv].z, S[2 * ks][vv].w),
                     pk_bf16(S[2 * ks + 1][vv].x, S[2 * ks + 1][vv].y), pk_bf16(S[2 * ks + 1][vv].z, S[2 * ks + 1][vv].w));
#pragma unroll
      for (int tt = 0; tt < 4; ++tt) {
        const int t = 16 * tt + fr;
        const int c0 = 4 * ks + (fq >> 1), c1 = 4 * ks + 2 + (fq >> 1);
        u32x2 q0 = *(const u32x2*)(L + t * 256 + ((c0 ^ (t & 15)) << 4) + ((fq & 1) << 3));
        u32x2 q1 = *(const u32x2*)(L + t * 256 + ((c1 ^ (t & 15)) << 4) + ((fq & 1) << 3));
        bf16x8 qp = mk8(q0, q1);
#pragma unroll
        for (int vv = 0; vv < 2; ++vv) O[vv][tt] = mfma16(sf[vv], qp, O[vv][tt]);
      }
    }
    }
    __syncthreads();
#pragma unroll
    for (int ss = 0; ss < 2; ++ss) {
      bf16x8 vf[2];
#pragma unroll
      for (int vv = 0; vv < 2; ++vv) vf[vv] = vfr[ss][vv];
      if (mode != 1) {
#pragma unroll
      for (int tt = 0; tt < 4; ++tt) {
        const int t = 16 * tt + fr;
        bf16x8 pf = *(const bf16x8*)(L + 49152 + t * 128 + (((4 * ss + fq) ^ (t & 7)) << 4));
#pragma unroll
        for (int vv = 0; vv < 2; ++vv) O[vv][tt] = mfma16(vf[vv], pf, O[vv][tt]);
      }
      }
      if (mode != 2) {
#pragma unroll
      for (int kt = 0; kt < 8; ++kt) {
        const int r = 16 * kt + fr;
        bf16x8 kf = *(const bf16x8*)(L + 32768 + r * 128 + (((4 * ss + fq) ^ (r & 7)) << 4));
#pragma unroll
        for (int vv = 0; vv < 2; ++vv) S[kt][vv] = mfma16(kf, vf[vv], S[kt][vv]);
      }
      }
    }
    if (mode != 2) {
#pragma unroll
    for (int kt = 0; kt < 8; ++kt) {
      f32x4 d = *(const f32x4*)(Dl + 16 * kt + 4 * fq);
#pragma unroll
      for (int vv = 0; vv < 2; ++vv) { S[kt][vv].x *= d.x; S[kt][vv].y *= d.y; S[kt][vv].z *= d.z; S[kt][vv].w *= d.w; }
    }
    }
    if (mode == 1 && tid < 128) ((float*)(p.ws + OFF_DBUF))[(size_t)((b * 8 + h) * 64 + c) * 128 + tid] = Dl[tid];
    if (mode != 1) {
#pragma unroll
    for (int tt = 0; tt < 4; ++tt) {
      float ss = 0.f;
#pragma unroll
      for (int vv = 0; vv < 2; ++vv) ss += O[vv][tt].x * O[vv][tt].x + O[vv][tt].y * O[vv][tt].y + O[vv][tt].z * O[vv][tt].z + O[vv][tt].w * O[vv][tt].w;
      ss += __shfl_xor(ss, 16);
      ss += __shfl_xor(ss, 32);
      if (fq == 0) part[w * 64 + 16 * tt + fr] = ss;
    }
    __syncthreads();
#pragma unroll
    for (int tt = 0; tt < 4; ++tt) {
      const int t = 16 * tt + fr;
      const float tot = part[t] + part[64 + t] + part[128 + t] + part[192 + t];
      const float r = rsqrtf(tot * (1.f / 128.f) + 1e-5f);
      const size_t tok = (size_t)(tok0 + t);
#pragma unroll
      for (int vv = 0; vv < 2; ++vv) {
        const int v0 = h * 128 + 32 * w + 16 * vv + 4 * fq;
        u32x2 gt = *(const u32x2*)(GA + tok * 1024 + v0);
        float o0 = O[vv][tt].x * r * gn[vv].x * bflo(gt.x);
        float o1 = O[vv][tt].y * r * gn[vv].y * bfhi(gt.x);
        float o2 = O[vv][tt].z * r * gn[vv].z * bflo(gt.y);
        float o3 = O[vv][tt].w * r * gn[vv].w * bfhi(gt.y);
        u32x2 ov = {pk_bf16(o0, o1), pk_bf16(o2, o3)};
        *(u32x2*)(MERGED + tok * 2048 + v0) = ov;
      }
    }
    }
    __syncthreads();
  }
  if (mode == 1) {
#pragma unroll
    for (int kt = 0; kt < 8; ++kt)
#pragma unroll
      for (int vv = 0; vv < 2; ++vv) {
        u32x2 t = {pk_bf16(S[kt][vv].x, S[kt][vv].y), pk_bf16(S[kt][vv].z, S[kt][vv].w)};
        LSb[(kt * 2 + vv) * 256] = t;
      }
    return;
  }
  if (mode == 2) return;
  int zq = 0; asm volatile("" : "+v"(zq));
  float* so = p.out + (kind == 0 ? OUT_SP : OUT_SS) + (size_t)((b * 8 + h) * 128) * 128 + (4 * fq) * 128 + 32 * w + fr + zq;
#pragma unroll
  for (int kt = 0; kt < 8; ++kt)
#pragma unroll
    for (int vv = 0; vv < 2; ++vv)
#pragma unroll
      for (int j = 0; j < 4; ++j) so[(16 * kt + j) * 128 + 16 * vv] = S[kt][vv][j];
}


__device__ void hgrn_scan_item(const Params& p, int chain, int kt) {
  int tid_o = threadIdx.x; asm volatile("" : "+v"(tid_o)); const int tid = tid_o, lane = tid & 63, w = tid >> 6, fr = lane & 15, fq = lane >> 4;
  u32x2* LS = (u32x2*)(p.ws + OFF_LS) + ((size_t)(chain * 64) * 16 + kt * 2) * 256 + tid;
  const float* DB = (const float*)(p.ws + OFF_DBUF) + (size_t)(chain * 64) * 128 + 16 * kt + 4 * fq;
  f32x4 S0 = {0.f, 0.f, 0.f, 0.f}, S1 = {0.f, 0.f, 0.f, 0.f};
#pragma unroll 1
  for (int c8 = 0; c8 < 64; c8 += 8) {
    u32x2 l0[8], l1[8];
    f32x4 d[8];
#pragma unroll
    for (int i = 0; i < 8; ++i) {
      l0[i] = LS[(size_t)(c8 + i) * 16 * 256];
      l1[i] = LS[(size_t)(c8 + i) * 16 * 256 + 256];
      d[i] = *(const f32x4*)(DB + (c8 + i) * 128);
    }
#pragma unroll
    for (int i = 0; i < 8; ++i) {
      u32x2 o0 = {pk_bf16(S0.x, S0.y), pk_bf16(S0.z, S0.w)}, o1 = {pk_bf16(S1.x, S1.y), pk_bf16(S1.z, S1.w)};
      LS[(size_t)(c8 + i) * 16 * 256] = o0; LS[(size_t)(c8 + i) * 16 * 256 + 256] = o1;
      S0.x = d[i].x * S0.x + bflo(l0[i].x); S0.y = d[i].y * S0.y + bfhi(l0[i].x); S0.z = d[i].z * S0.z + bflo(l0[i].y); S0.w = d[i].w * S0.w + bfhi(l0[i].y);
      S1.x = d[i].x * S1.x + bflo(l1[i].x); S1.y = d[i].y * S1.y + bfhi(l1[i].x); S1.z = d[i].z * S1.z + bflo(l1[i].y); S1.w = d[i].w * S1.w + bfhi(l1[i].y);
    }
  }
  float* so = p.out + OUT_SP + (size_t)(chain * 128) * 128 + (size_t)(16 * kt + 4 * fq) * 128 + 32 * w + fr;
  so[0] = S0.x; so[128] = S0.y; so[256] = S0.z; so[384] = S0.w;
  so[16] = S1.x; so[128 + 16] = S1.y; so[256 + 16] = S1.z; so[384 + 16] = S1.w;
}

__device__ void attn_item(const Params& p, int kind, int bh, int qt, char* lds) {
  int tid_o = threadIdx.x; asm volatile("" : "+v"(tid_o)); const int tid = tid_o, lane = tid & 63, w = tid >> 6, fr = lane & 15, fq = lane >> 4;
  const int b = bh >> 3, h = bh & 7;
  const int nkt = kind == 0 ? qt + 1 : 17;
  const int tok0 = kind == 0 ? b * 4096 + qt * 64 : NPTOK + b * 64;
  const int qpos0 = kind == 0 ? qt * 64 : 1024;
  const bf16_t* Kb = kind == 0 ? (const bf16_t*)(p.ws + OFF_KP) + (size_t)bh * 4096 * 128
                               : (const bf16_t*)(p.ws + OFF_KS) + (size_t)bh * 1088 * 128;
  const bf16_t* Vb = kind == 0 ? (const bf16_t*)(p.ws + OFF_VTP) + (size_t)bh * 128 * 4096
                               : (const bf16_t*)(p.ws + OFF_VTS) + (size_t)bh * 128 * 1088;
  const int vstride = kind == 0 ? 4096 : 1088;
  const float slope2 = exp2f(-(float)(h + 1)) * 1.4426950408889634f;

  const int tok = tok0 + 16 * w + fr;
  bf16x8 qf[4];
  {
    const bf16_t* qp = (const bf16_t*)(p.ws + OFF_QB) + (size_t)tok * 1024 + h * 128;
#pragma unroll
    for (int ks = 0; ks < 4; ++ks) qf[ks] = *(const bf16x8*)(qp + 32 * ks + 8 * fq);
  }
  const float qposf = (float)(qpos0 + 16 * w + fr);
  float qk[2];
#pragma unroll
  for (int m = 0; m < 2; ++m) {
    float s2 = 0.f;
#pragma unroll
    for (int ks2 = 0; ks2 < 2; ++ks2)
#pragma unroll
      for (int e = 0; e < 8; ++e) { const float qv = bf2f((unsigned short)qf[2 * m + ks2][e]); s2 += qv * qv; }
    s2 += __shfl_xor(s2, 16);
    s2 += __shfl_xor(s2, 32);
    const float kmax2 = kind == 0 ? __uint_as_float(((const unsigned*)(p.ws + 256))[b * 16 + h * 2 + m]) : 3.0e38f;
    qk[m] = sqrtf(s2) * sqrtf(kmax2) * 1.02f;
  }
  f32x4 O0[8], O1[8];
#pragma unroll
  for (int i = 0; i < 8; ++i) { O0[i] = (f32x4){0.f, 0.f, 0.f, 0.f}; O1[i] = (f32x4){0.f, 0.f, 0.f, 0.f}; }
  float mx[2] = {-1e30f, -1e30f}, ls[2] = {0.f, 0.f};

  u32x4 rk[4], rv[4];
  {
    const int kkey = tid >> 4, kc = tid & 15, vrow = tid >> 3, vc = tid & 7;
    const int kt = nkt - 1;
#pragma unroll
    for (int i = 0; i < 4; ++i) {
      rk[i] = *(const u32x4*)(Kb + (size_t)(kt * 64 + kkey + 16 * i) * 128 + kc * 8);
      rv[i] = *(const u32x4*)(Vb + (size_t)(vrow + 32 * i) * vstride + kt * 64 + vc * 8);
    }
#pragma unroll
    for (int i = 0; i < 4; ++i) {
      const int key = kkey + 16 * i;
      *(u32x4*)(lds + key * 256 + ((kc ^ (key & 15)) << 4)) = rk[i];
      const int r = vrow + 32 * i;
      *(u32x4*)(lds + 16384 + r * 128 + ((vc ^ ((r >> 1) & 7)) << 4)) = rv[i];
    }
    if (nkt > 1) {
#pragma unroll
      for (int i = 0; i < 4; ++i) {
        rk[i] = *(const u32x4*)(Kb + (size_t)((kt - 1) * 64 + kkey + 16 * i) * 128 + kc * 8);
        rv[i] = *(const u32x4*)(Vb + (size_t)(vrow + 32 * i) * vstride + (kt - 1) * 64 + vc * 8);
      }
    }
    __syncthreads();
  }
  for (int it = 0; it < nkt; ++it) {
    int zz = 0; asm volatile("" : "+v"(zz));
    int tidv = threadIdx.x; asm volatile("" : "+v"(tidv));
    const int tid = tidv, lane = tid & 63, w = tid >> 6, fr = lane & 15, fq = lane >> 4;
    const int kkey = tid >> 4, kc = tid & 15, vrow = tid >> 3, vc = tid & 7;
    const int kt = nkt - 1 - it;
    char* L = lds + zz + (it & 1) * 32768;
    char* Ln = lds + zz + ((it + 1) & 1) * 32768;
    if (it + 1 < nkt) {
#pragma unroll
      for (int i = 0; i < 4; ++i) {
        const int key = kkey + 16 * i;
        *(u32x4*)(Ln + key * 256 + ((kc ^ (key & 15)) << 4)) = rk[i];
        const int r = vrow + 32 * i;
        *(u32x4*)(Ln + 16384 + r * 128 + ((vc ^ ((r >> 1) & 7)) << 4)) = rv[i];
      }
    }
    if (it + 2 < nkt) {
#pragma unroll
      for (int i = 0; i < 4; ++i) {
        rk[i] = *(const u32x4*)(Kb + (size_t)((kt - 2) * 64 + zz + kkey + 16 * i) * 128 + kc * 8);
        rv[i] = *(const u32x4*)(Vb + (size_t)(vrow + 32 * i) * vstride + (kt - 2) * 64 + zz + vc * 8);
      }
    }
    const float kposf = (float)(kt * 64 + 4 * fq) - qposf;
    bf16x8 pf[2][2];
    bool live[2];
#pragma unroll
    for (int m = 0; m < 2; ++m) {
      f32x4 s[4];
#pragma unroll
      for (int k16 = 0; k16 < 4; ++k16) {
        s[k16] = (f32x4){0.f, 0.f, 0.f, 0.f};
        const int key = 16 * k16 + fr;
#pragma unroll
        for (int ks2 = 0; ks2 < 2; ++ks2) {
          bf16x8 kf = *(const bf16x8*)(L + key * 256 + (((8 * m + 4 * ks2 + fq) ^ (key & 15)) << 4));
          s[k16] = mfma16(kf, qf[2 * m + ks2], s[k16]);
        }
      }
      float tmax = -1e30f;
#pragma unroll
      for (int k16 = 0; k16 < 4; ++k16)
#pragma unroll
        for (int j = 0; j < 4; ++j) {
          const float d = kposf + (float)(16 * k16 + j);
          const float v = s[k16][j] - slope2 * fabsf(d);
          s[k16][j] = v;
          tmax = fmaxf(tmax, v);
        }
      tmax = fmaxf(tmax, __shfl_xor(tmax, 16));
      tmax = fmaxf(tmax, __shfl_xor(tmax, 32));
      live[m] = !__all(tmax - mx[m] < -40.f);
      if (live[m]) {
        const float mnew = fmaxf(mx[m], tmax);
        const float alpha = __builtin_amdgcn_exp2f(mx[m] - mnew);
        mx[m] = mnew;
        float psum = 0.f;
#pragma unroll
        for (int k16 = 0; k16 < 4; ++k16)
#pragma unroll
          for (int j = 0; j < 4; ++j) { const float e = __builtin_amdgcn_exp2f(s[k16][j] - mnew); s[k16][j] = e; psum += e; }
        ls[m] = ls[m] * alpha + psum;
        if (m == 0) {
#pragma unroll
          for (int i = 0; i < 8; ++i) { O0[i].x *= alpha; O0[i].y *= alpha; O0[i].z *= alpha; O0[i].w *= alpha; }
        } else {
#pragma unroll
          for (int i = 0; i < 8; ++i) { O1[i].x *= alpha; O1[i].y *= alpha; O1[i].z *= alpha; O1[i].w *= alpha; }
        }
#pragma unroll
        for (int ks = 0; ks < 2; ++ks)
          pf[m][ks] = mk8(pk_bf16(s[2 * ks].x, s[2 * ks].y), pk_bf16(s[2 * ks].z, s[2 * ks].w),
                          pk_bf16(s[2 * ks + 1].x, s[2 * ks + 1].y), pk_bf16(s[2 * ks + 1].z, s[2 * ks + 1].w));
      } else {
#pragma unroll
        for (int ks = 0; ks < 2; ++ks) pf[m][ks] = mk8(0u, 0u, 0u, 0u);
      }
    }
    if (live[0] || live[1]) {
#pragma unroll
      for (int vt = 0; vt < 8; ++vt) {
        const int r = 16 * vt + fr;
        const int rs = (r >> 1) & 7;
#pragma unroll
        for (int ks = 0; ks < 2; ++ks) {
          const int u0 = 8 * ks + fq, u1 = 8 * ks + 4 + fq;
          u32x2 a0 = *(const u32x2*)(L + 16384 + r * 128 + (((u0 >> 1) ^ rs) << 4) + ((u0 & 1) << 3));
          u32x2 a1 = *(const u32x2*)(L + 16384 + r * 128 + (((u1 >> 1) ^ rs) << 4) + ((u1 & 1) << 3));
          bf16x8 vf = mk8(a0, a1);
          O0[vt] = mfma16(vf, pf[0][ks], O0[vt]);
          O1[vt] = mfma16(vf, pf[1][ks], O1[vt]);
        }
      }
    }
    const float dmin = qposf - (float)((kt - 1) * 64 + 63);
    const bool done = (kind == 0) && (qk[0] - slope2 * dmin - mx[0] < -40.f) && (qk[1] - slope2 * dmin - mx[1] < -40.f);
    if (__syncthreads_and(done ? 1 : 0)) break;
  }
  float l0 = ls[0], l1 = ls[1];
  l0 += __shfl_xor(l0, 16); l0 += __shfl_xor(l0, 32);
  l1 += __shfl_xor(l1, 16); l1 += __shfl_xor(l1, 32);
  const float lam = ((const float*)(p.ws + OFF_CTR))[16];
  const float i0 = 1.f / l0, i1 = lam / l1;
  float ssq = 0.f;
#pragma unroll
  for (int vt = 0; vt < 8; ++vt) {
#pragma unroll
    for (int j = 0; j < 4; ++j) {
      const float o = O0[vt][j] * i0 - O1[vt][j] * i1;
      O0[vt][j] = o;
      ssq += o * o;
    }
  }
  ssq += __shfl_xor(ssq, 16);
  ssq += __shfl_xor(ssq, 32);
  const float r = rsqrtf(ssq * (1.f / 128.f) + 1e-5f) * 0.8f;
  bf16_t* mo = (bf16_t*)(p.ws + OFF_MERGED) + (size_t)tok * 2048 + 1024 + h * 128;
#pragma unroll
  for (int vt = 0; vt < 8; ++vt) {
    f32x4 g = *(const f32x4*)(p.diff_g + 16 * vt + 4 * fq);
    u32x2 ov = {pk_bf16(O0[vt].x * r * g.x, O0[vt].y * r * g.y), pk_bf16(O0[vt].z * r * g.z, O0[vt].w * r * g.w)};
    *(u32x2*)(mo + 16 * vt + 4 * fq) = ov;
  }
}


__device__ void quant_item(const Params& p, int item) {
  int tid_o = threadIdx.x; asm volatile("" : "+v"(tid_o)); const int tid = tid_o, lane = tid & 63, w = tid >> 6;
  unsigned char* U8 = (unsigned char*)(p.ws + OFF_UB);
  float* SCL = (float*)(p.ws + OFF_SCL);
  for (int rr = 0; rr < 16; ++rr) {
    const int row = item * 64 + rr * 4 + w;
    const float* srow = row < 16384 ? p.pu + (size_t)row * 2048 : p.pv + (size_t)(row - 16384) * 2048;
    f32x4 v[8];
    float am = 0.f;
#pragma unroll
    for (int i = 0; i < 8; ++i) {
      v[i] = *(const f32x4*)(srow + 256 * i + lane * 4);
      am = fmaxf(fmaxf(am, fmaxf(fabsf(v[i].x), fabsf(v[i].y))), fmaxf(fabsf(v[i].z), fabsf(v[i].w)));
    }
#pragma unroll
    for (int o = 32; o >= 1; o >>= 1) am = fmaxf(am, __shfl_xor(am, o));
    const float sc = am > 0.f ? 224.f / am : 1.f;
    unsigned char* drow = U8 + (size_t)row * 2048;
#pragma unroll
    for (int i = 0; i < 8; ++i) {
      int pk = __builtin_amdgcn_cvt_pk_fp8_f32(v[i].x * sc, v[i].y * sc, 0, false);
      pk = __builtin_amdgcn_cvt_pk_fp8_f32(v[i].z * sc, v[i].w * sc, pk, true);
      *(int*)(drow + 256 * i + lane * 4) = pk;
    }
    if (lane == 0) SCL[row] = am > 0.f ? am * (1.f / 224.f) : 1.f;
  }
}

__device__ void phase2(const Params& p, char* lds, int rep, int par) {
  unsigned* ctr = (unsigned*)(p.ws + OFF_CTR) + rep;
  int* sitem = (int*)lds;
  const int nA = par ? 2048 : 0;
  for (;;) {
    __syncthreads();
    if (threadIdx.x == 0) *sitem = (int)atomicAdd(ctr, 1u);
    __syncthreads();
    int item = *sitem;
    __syncthreads();
    if (item >= nA + 2208) break;
    if (item < nA) { hgrn_item(p, 0, (item & 31) >> 3, item & 7, lds, 1, item >> 5); continue; }
    item -= nA;
    if (item < 96) {
      const int kind = item < 32 ? 0 : 1, ii = item < 32 ? item : item - 32;
      if (kind == 0 && par) continue;
      hgrn_item(p, kind, ii >> 3, ii & 7, lds, 0, 0);
    } else {
      const int kind = item < 160 ? 1 : 0, j = item - 160;
      attn_item(p, kind, kind ? item - 96 : (j & 31), kind ? 0 : 63 - (j >> 5), lds);
    }
  }
}

__device__ void phase2b(const Params& p) {
  for (int item = blockIdx.x; item < 256; item += gridDim.x) hgrn_scan_item(p, item >> 3, item & 7);
}

__device__ void phase2c(const Params& p, char* lds) {
  for (int item = blockIdx.x; item < 2048; item += gridDim.x) {
    __syncthreads();
    hgrn_item(p, 0, (item & 31) >> 3, item & 7, lds, 2, item >> 5);
  }
}

__device__ void phase4(const Params& p) {
  int tid_o = threadIdx.x; asm volatile("" : "+v"(tid_o)); const int tid = tid_o, lane = tid & 63, w = tid >> 6;
  bf16_t* X1B = (bf16_t*)(p.ws + OFF_X1B);
  for (int row = blockIdx.x * 4 + w; row < NTOK; row += gridDim.x * 4) {
    bf16_t* xr = X1B + (size_t)row * 2048;
    float v[4][8];
    float s = 0.f;
#pragma unroll
    for (int i = 0; i < 4; ++i) {
      u32x4 t = *(const u32x4*)(xr + 512 * i + lane * 8);
      v[i][0] = bflo(t.x); v[i][1] = bfhi(t.x); v[i][2] = bflo(t.y); v[i][3] = bfhi(t.y);
      v[i][4] = bflo(t.z); v[i][5] = bfhi(t.z); v[i][6] = bflo(t.w); v[i][7] = bfhi(t.w);
#pragma unroll
      for (int e = 0; e < 8; ++e) s += v[i][e];
    }
    s = wave_sum(s);
    const float mean = s * (1.f / 2048.f);
    float q = 0.f;
#pragma unroll
    for (int i = 0; i < 4; ++i)
#pragma unroll
      for (int e = 0; e < 8; ++e) { const float d = v[i][e] - mean; q += d * d; }
    q = wave_sum(q);
    const float rs = rsqrtf(q * (1.f / 2048.f) + 1e-5f);
#pragma unroll
    for (int i = 0; i < 4; ++i) {
      const int col = 512 * i + lane * 8;
      f32x4 g0 = *(const f32x4*)(p.ln1_g + col), g1 = *(const f32x4*)(p.ln1_g + col + 4);
      f32x4 b0 = *(const f32x4*)(p.ln1_b + col), b1 = *(const f32x4*)(p.ln1_b + col + 4);
      u32x4 o;
      o.x = pk_bf16((v[i][0] - mean) * rs * g0.x + b0.x, (v[i][1] - mean) * rs * g0.y + b0.y);
      o.y = pk_bf16((v[i][2] - mean) * rs * g0.z + b0.z, (v[i][3] - mean) * rs * g0.w + b0.w);
      o.z = pk_bf16((v[i][4] - mean) * rs * g1.x + b1.x, (v[i][5] - mean) * rs * g1.y + b1.y);
      o.w = pk_bf16((v[i][6] - mean) * rs * g1.z + b1.z, (v[i][7] - mean) * rs * g1.w + b1.w);
      *(u32x4*)(xr + col) = o;
    }
  }
}

__device__ __forceinline__ unsigned f2key(float f) {
  unsigned b = __float_as_uint(f);
  return (b & 0x80000000u) ? ~b : (b | 0x80000000u);
}
__device__ __forceinline__ float key2f(unsigned k) {
  unsigned b = (k & 0x80000000u) ? (k & 0x7fffffffu) : ~k;
  return __uint_as_float(b);
}

__device__ __forceinline__ unsigned row_allmax(unsigned x) {
  x = max(x, (unsigned)__builtin_amdgcn_update_dpp(0, (int)x, 0x121, 0xF, 0xF, false));
  x = max(x, (unsigned)__builtin_amdgcn_update_dpp(0, (int)x, 0x122, 0xF, 0xF, false));
  x = max(x, (unsigned)__builtin_amdgcn_update_dpp(0, (int)x, 0x124, 0xF, 0xF, false));
  x = max(x, (unsigned)__builtin_amdgcn_update_dpp(0, (int)x, 0x128, 0xF, 0xF, false));
  return x;
}
__device__ __forceinline__ float row_allsum(float x) {
  x += __int_as_float(__builtin_amdgcn_update_dpp(0, __float_as_int(x), 0x121, 0xF, 0xF, false));
  x += __int_as_float(__builtin_amdgcn_update_dpp(0, __float_as_int(x), 0x122, 0xF, 0xF, false));
  x += __int_as_float(__builtin_amdgcn_update_dpp(0, __float_as_int(x), 0x124, 0xF, 0xF, false));
  x += __int_as_float(__builtin_amdgcn_update_dpp(0, __float_as_int(x), 0x128, 0xF, 0xF, false));
  return x;
}
#define CE_DESC(a, b) { const unsigned _hi = max(a, b), _lo = min(a, b); a = _hi; b = _lo; }

__device__ void phase6(const Params& p, char* lds) {
  int tid_o = threadIdx.x; asm volatile("" : "+v"(tid_o)); const int tid = tid_o, lane = tid & 63, w = tid >> 6, fr = lane & 15, fq = lane >> 4;
  const bf16_t* QP = (const bf16_t*)(p.ws + OFF_QP);
  const bf16_t* SKB = (const bf16_t*)(p.ws + OFF_SKB);
  int* EIDX = (int*)(p.ws + OFF_EIDX);
  float* GATE = (float*)(p.ws + OFF_GATE);
  const bool qfirst = blockIdx.x >= (gridDim.x >> 1);
  if (qfirst) for (int qi = blockIdx.x; qi < 512; qi += gridDim.x) quant_item(p, qi);
  unsigned char* tbl = (unsigned char*)lds;
  __syncthreads();
  if (tid < 64) tbl[tid] = 0xFF;
  __syncthreads();
  {
    const int i = tid >> 4, j = tid & 15;
    if ((i + 1) * (j + 1) <= 16) {
      int rank = j;
      for (int ii = 0; ii < i; ++ii) rank += 16 / (ii + 1);
      tbl[rank] = (unsigned char)((i << 4) | j);
    }
  }
  __syncthreads();
  int pi[4], pj[4]; bool pvalid[4];
#pragma unroll
  for (int s = 0; s < 4; ++s) {
    const int pidx = fr + 16 * s;
    const unsigned code = tbl[pidx];
    pvalid[s] = (pidx < 50);
    pi[s] = pvalid[s] ? (int)(code >> 4) : 0;
    pj[s] = pvalid[s] ? (int)(code & 15) : 0;
  }
  const int rowbase = lane & 48;
  __syncthreads();
  {
    const int hh = blockIdx.x & 7;
#pragma unroll 1
    for (int c = 0; c < 2; ++c)
#pragma unroll 4
      for (int i = 0; i < 8; ++i) {
        const int id = tid + 256 * i, key = id >> 4, ch = id & 15;
        u32x4 v = *(const u32x4*)(SKB + (size_t)((hh * 2 + c) * 128 + key) * 128 + ch * 8);
        *(u32x4*)(lds + c * 32768 + key * 256 + ((ch ^ (key & 15)) << 4)) = v;
      }
  }
  __syncthreads();
  for (int item = blockIdx.x; item < 264 * 8; item += gridDim.x) {
    int zz = 0; asm volatile("" : "+v"(zz));
    const char* L = lds + zz;
    const int tile = item >> 3, h = item & 7;
    const int tok0 = tile * 64;
    unsigned Lst[2][4];
#pragma unroll
    for (int c = 0; c < 2; ++c) {
      unsigned K[8][4];
      {
        bf16x8 af[4];
        const bf16_t* qp = QP + (size_t)(tok0 + 16 * w + fr) * 2048 + h * 256 + c * 128;
#pragma unroll
        for (int ks = 0; ks < 4; ++ks) af[ks] = *(const bf16x8*)(qp + 32 * ks + 8 * fq);
#pragma unroll
        for (int kt = 0; kt < 8; ++kt) {
          f32x4 a = {0.f, 0.f, 0.f, 0.f};
#pragma unroll
          for (int ks = 0; ks < 4; ++ks) {
            const int key = 16 * kt + fr;
            bf16x8 bfr = *(const bf16x8*)(L + c * 32768 + key * 256 + (((4 * ks + fq) ^ (key & 15)) << 4));
            a = mfma16(af[ks], bfr, a);
          }
          const unsigned code = (unsigned)(127 - (16 * kt + fr));
#pragma unroll
          for (int j = 0; j < 4; ++j) K[kt][j] = (f2key(a[j]) & ~127u) | code;
        }
      }
#pragma unroll
      for (int j = 0; j < 4; ++j) {
        CE_DESC(K[0][j], K[1][j]); CE_DESC(K[2][j], K[3][j]); CE_DESC(K[4][j], K[5][j]); CE_DESC(K[6][j], K[7][j]);
        CE_DESC(K[0][j], K[2][j]); CE_DESC(K[1][j], K[3][j]); CE_DESC(K[4][j], K[6][j]); CE_DESC(K[5][j], K[7][j]);
        CE_DESC(K[1][j], K[2][j]); CE_DESC(K[5][j], K[6][j]); CE_DESC(K[0][j], K[4][j]); CE_DESC(K[3][j], K[7][j]);
        CE_DESC(K[1][j], K[5][j]); CE_DESC(K[2][j], K[6][j]);
        CE_DESC(K[1][j], K[4][j]); CE_DESC(K[3][j], K[6][j]);
        CE_DESC(K[2][j], K[4][j]); CE_DESC(K[3][j], K[5][j]);
        CE_DESC(K[3][j], K[4][j]);
      }
      unsigned best[4] = {0u, 0u, 0u, 0u};
#pragma unroll 1
      for (int it = 0; it < 16; ++it) {
#pragma unroll
        for (int j = 0; j < 4; ++j) {
          const unsigned rm = row_allmax(K[0][j]);
          const bool win = (K[0][j] == rm);
#pragma unroll
          for (int k = 0; k < 7; ++k) K[k][j] = win ? K[k + 1][j] : K[k][j];
          K[7][j] = win ? 0u : K[7][j];
          best[j] = (fr == it) ? rm : best[j];
        }
      }
#pragma unroll
      for (int j = 0; j < 4; ++j) Lst[c][j] = best[j];
    }
#pragma unroll
    for (int j = 0; j < 4; ++j) {
      unsigned C[4];
#pragma unroll
      for (int s = 0; s < 4; ++s) {
        const unsigned k0 = (unsigned)__shfl((int)Lst[0][j], rowbase + pi[s]);
        const unsigned k1 = (unsigned)__shfl((int)Lst[1][j], rowbase + pj[s]);
        const float sum = key2f(k0 & ~127u) + key2f(k1 & ~127u);
        C[s] = pvalid[s] ? ((f2key(sum) & ~255u) | (unsigned)(255 - (pi[s] * 16 + pj[s]))) : 0u;
      }
      CE_DESC(C[0], C[1]); CE_DESC(C[2], C[3]); CE_DESC(C[0], C[2]); CE_DESC(C[1], C[3]); CE_DESC(C[1], C[2]);
      unsigned sel = 0u;
#pragma unroll 1
      for (int it = 0; it < 16; ++it) {
        const unsigned rm = row_allmax(C[0]);
        const bool win = (C[0] == rm);
        C[0] = win ? C[1] : C[0]; C[1] = win ? C[2] : C[1]; C[2] = win ? C[3] : C[2]; C[3] = win ? 0u : C[3];
        sel = (fr == it) ? rm : sel;
      }
      const float cv = key2f(sel & ~255u);
      const float cmax = __shfl(cv, rowbase);
      const float e = __expf(cv - cmax);
      const float g = e / row_allsum(e);
      const int flat = 255 - (int)(sel & 255u);
      const unsigned l0 = (unsigned)__shfl((int)Lst[0][j], rowbase + (flat >> 4));
      const unsigned l1 = (unsigned)__shfl((int)Lst[1][j], rowbase + (flat & 15));
      const int eidx = (127 - (int)(l0 & 127u)) * 128 + (127 - (int)(l1 & 127u));
      const size_t ob = ((size_t)(tok0 + 16 * w + 4 * fq + j) * 8 + h) * 16 + fr;
      EIDX[ob] = eidx;
      GATE[ob] = g;
    }
  }
  if (!qfirst) for (int qi = blockIdx.x; qi < 512; qi += gridDim.x) quant_item(p, qi);
}

__device__ __forceinline__ float dot16_fp8(u32x4 r, const float* x) {
  float d = 0.f;
  f32x2_t a;
  a = __builtin_amdgcn_cvt_pk_f32_fp8((int)r.x, false); d += a.x * x[0] + a.y * x[1];
  a = __builtin_amdgcn_cvt_pk_f32_fp8((int)r.x, true);  d += a.x * x[2] + a.y * x[3];
  a = __builtin_amdgcn_cvt_pk_f32_fp8((int)r.y, false); d += a.x * x[4] + a.y * x[5];
  a = __builtin_amdgcn_cvt_pk_f32_fp8((int)r.y, true);  d += a.x * x[6] + a.y * x[7];
  a = __builtin_amdgcn_cvt_pk_f32_fp8((int)r.z, false); d += a.x * x[8] + a.y * x[9];
  a = __builtin_amdgcn_cvt_pk_f32_fp8((int)r.z, true);  d += a.x * x[10] + a.y * x[11];
  a = __builtin_amdgcn_cvt_pk_f32_fp8((int)r.w, false); d += a.x * x[12] + a.y * x[13];
  a = __builtin_amdgcn_cvt_pk_f32_fp8((int)r.w, true);  d += a.x * x[14] + a.y * x[15];
  return d;
}
__device__ __forceinline__ void axpy16_fp8(u32x4 r, float w, float* acc) {
  f32x2_t a;
  a = __builtin_amdgcn_cvt_pk_f32_fp8((int)r.x, false); acc[0] += w * a.x; acc[1] += w * a.y;
  a = __builtin_amdgcn_cvt_pk_f32_fp8((int)r.x, true);  acc[2] += w * a.x; acc[3] += w * a.y;
  a = __builtin_amdgcn_cvt_pk_f32_fp8((int)r.y, false); acc[4] += w * a.x; acc[5] += w * a.y;
  a = __builtin_amdgcn_cvt_pk_f32_fp8((int)r.y, true);  acc[6] += w * a.x; acc[7] += w * a.y;
  a = __builtin_amdgcn_cvt_pk_f32_fp8((int)r.z, false); acc[8] += w * a.x; acc[9] += w * a.y;
  a = __builtin_amdgcn_cvt_pk_f32_fp8((int)r.z, true);  acc[10] += w * a.x; acc[11] += w * a.y;
  a = __builtin_amdgcn_cvt_pk_f32_fp8((int)r.w, false); acc[12] += w * a.x; acc[13] += w * a.y;
  a = __builtin_amdgcn_cvt_pk_f32_fp8((int)r.w, true);  acc[14] += w * a.x; acc[15] += w * a.y;
}

__device__ void phase7(const Params& p, char* lds) {
  int tid_o = threadIdx.x; asm volatile("" : "+v"(tid_o)); const int tid = tid_o, lane = tid & 63, w = tid >> 6;
  const bf16_t* X1B = (const bf16_t*)(p.ws + OFF_X1B);
  const unsigned char* U8 = (const unsigned char*)(p.ws + OFF_UB);
  const unsigned char* V8 = (const unsigned char*)(p.ws + OFF_VB);
  const float* SCL = (const float*)(p.ws + OFF_SCL);
  const int* EIDX = (const int*)(p.ws + OFF_EIDX);
  const float* GATE = (const float*)(p.ws + OFF_GATE);
  float* wgt = (float*)lds;
  float* red = (float*)(lds + 1024);
  float* part = (float*)(lds + 2048);
  for (int tok = blockIdx.x; tok < NTOK; tok += gridDim.x) {
    int tidv = threadIdx.x; asm volatile("" : "+v"(tidv));
    const int tid = tidv, lane = tid & 63, w = tid >> 6;
    const bf16_t* xr = X1B + (size_t)tok * 2048;
    float xa[2][16];
#pragma unroll
    for (int j = 0; j < 2; ++j)
#pragma unroll
      for (int q = 0; q < 2; ++q) {
        u32x4 t = *(const u32x4*)(xr + 1024 * j + 16 * lane + 8 * q);
        xa[j][8 * q] = bflo(t.x); xa[j][8 * q + 1] = bfhi(t.x); xa[j][8 * q + 2] = bflo(t.y); xa[j][8 * q + 3] = bfhi(t.y);
        xa[j][8 * q + 4] = bflo(t.z); xa[j][8 * q + 5] = bfhi(t.z); xa[j][8 * q + 6] = bflo(t.w); xa[j][8 * q + 7] = bfhi(t.w);
      }
    __syncthreads();
#ifndef UR
#define UR 16
#endif
#ifndef VR
#define VR 16
#endif
#pragma unroll 1
    for (int k6 = 0; k6 < 32; k6 += UR) {
      u32x4 r[UR][2];
      int ee[UR];
#pragma unroll
      for (int kk = 0; kk < UR; ++kk) {
        const int kq = (k6 + kk < 32) ? (k6 + kk) : 31;
        ee[kk] = __builtin_amdgcn_readfirstlane(EIDX[(size_t)tok * 128 + w * 32 + kq]);
        const unsigned char* ur = U8 + (size_t)ee[kk] * 2048 + lane * 16;
        r[kk][0] = *(const u32x4*)ur;
        r[kk][1] = *(const u32x4*)(ur + 1024);
      }
      float dot[UR];
#pragma unroll
      for (int kk = 0; kk < UR; ++kk) dot[kk] = dot16_fp8(r[kk][0], xa[0]) + dot16_fp8(r[kk][1], xa[1]);
#pragma unroll
      for (int o = 32; o >= 1; o >>= 1) {
#pragma unroll
        for (int kk = 0; kk < UR; ++kk) dot[kk] += __shfl_xor(dot[kk], o);
      }
      if (lane < UR && k6 + lane < 32) {
        float a = dot[0]; int e = ee[0];
#pragma unroll
        for (int kk = 1; kk < UR; ++kk) { if (lane == kk) { a = dot[kk]; e = ee[kk]; } }
        const int k = w * 32 + k6 + lane;
        a *= SCL[e];
        const float ge = 0.5f * a * (1.f + erff(a * 0.70710678118654752f));
        wgt[k] = GATE[(size_t)tok * 128 + k] * ge * SCL[16384 + e];
      }
    }
    __syncthreads();
#pragma unroll 1
    for (int j = 0; j < 2; ++j) {
      float acc[16];
#pragma unroll
      for (int q = 0; q < 16; ++q) acc[q] = 0.f;
#pragma unroll 1
      for (int k6 = 0; k6 < 32; k6 += VR) {
        u32x4 r[VR];
        float ww[VR];
#pragma unroll
        for (int kk = 0; kk < VR; ++kk) {
          const int kq = (k6 + kk < 32) ? (k6 + kk) : 31;
          const int k = w * 32 + kq;
          const int e = __builtin_amdgcn_readfirstlane(EIDX[(size_t)tok * 128 + k]);
          ww[kk] = (k6 + kk < 32) ? wgt[k] : 0.f;
          r[kk] = *(const u32x4*)(V8 + (size_t)e * 2048 + 1024 * j + lane * 16);
        }
#pragma unroll
        for (int kk = 0; kk < VR; ++kk) axpy16_fp8(r[kk], ww[kk], acc);
      }
#pragma unroll
      for (int q = 0; q < 4; ++q)
        *(f32x4*)(part + w * 2048 + 1024 * j + 16 * lane + 4 * q) = (f32x4){acc[4 * q], acc[4 * q + 1], acc[4 * q + 2], acc[4 * q + 3]};
    }
    __syncthreads();
    const float al = 1.189207115002721f;
    const u32x4 xt = *(const u32x4*)(xr + tid * 8);
    f32x4 x0 = {bflo(xt.x), bfhi(xt.x), bflo(xt.y), bfhi(xt.y)}, x1 = {bflo(xt.z), bfhi(xt.z), bflo(xt.w), bfhi(xt.w)};
    f32x4 s0 = {0.f, 0.f, 0.f, 0.f}, s1 = {0.f, 0.f, 0.f, 0.f};
#pragma unroll
    for (int ww2 = 0; ww2 < 4; ++ww2) {
      f32x4 a0 = *(const f32x4*)(part + ww2 * 2048 + tid * 8), a1 = *(const f32x4*)(part + ww2 * 2048 + tid * 8 + 4);
      s0.x += a0.x; s0.y += a0.y; s0.z += a0.z; s0.w += a0.w; s1.x += a1.x; s1.y += a1.y; s1.z += a1.z; s1.w += a1.w;
    }
    float val[8] = {al * x0.x + s0.x, al * x0.y + s0.y, al * x0.z + s0.z, al * x0.w + s0.w,
                    al * x1.x + s1.x, al * x1.y + s1.y, al * x1.z + s1.z, al * x1.w + s1.w};
    float s = 0.f;
#pragma unroll
    for (int j = 0; j < 8; ++j) s += val[j];
    s = wave_sum(s);
    if (lane == 0) red[w] = s;
    __syncthreads();
    const float mean = (red[0] + red[1] + red[2] + red[3]) * (1.f / 2048.f);
    float q = 0.f;
#pragma unroll
    for (int j = 0; j < 8; ++j) { const float d = val[j] - mean; q += d * d; }
    q = wave_sum(q);
    if (lane == 0) red[4 + w] = q;
    __syncthreads();
    const float rs = rsqrtf((red[4] + red[5] + red[6] + red[7]) * (1.f / 2048.f) + 1e-5f);
    f32x4 g0 = *(const f32x4*)(p.ln2_g + tid * 8), g1 = *(const f32x4*)(p.ln2_g + tid * 8 + 4);
    f32x4 b0 = *(const f32x4*)(p.ln2_b + tid * 8), b1 = *(const f32x4*)(p.ln2_b + tid * 8 + 4);
    f32x4 o0 = {(val[0] - mean) * rs * g0.x + b0.x, (val[1] - mean) * rs * g0.y + b0.y, (val[2] - mean) * rs * g0.z + b0.z, (val[3] - mean) * rs * g0.w + b0.w};
    f32x4 o1 = {(val[4] - mean) * rs * g1.x + b1.x, (val[5] - mean) * rs * g1.y + b1.y, (val[6] - mean) * rs * g1.z + b1.z, (val[7] - mean) * rs * g1.w + b1.w};
    float* yo = p.out + OUT_Y + (size_t)tok * 2048 + tid * 8;
    *(f32x4*)yo = o0;
    *(f32x4*)(yo + 4) = o1;
  }
}

__device__ __forceinline__ void grid_bar(unsigned* ctr, unsigned target) {
  asm volatile("s_waitcnt vmcnt(0)" ::: "memory");
  __syncthreads();
  if (threadIdx.x == 0) {
    __builtin_amdgcn_fence(__ATOMIC_RELEASE, "agent");
    asm volatile("s_waitcnt vmcnt(0)" ::: "memory");
    __hip_atomic_fetch_add(ctr, 1u, __ATOMIC_RELAXED, __HIP_MEMORY_SCOPE_AGENT);
    while (__hip_atomic_load(ctr, __ATOMIC_RELAXED, __HIP_MEMORY_SCOPE_AGENT) < target) __builtin_amdgcn_s_sleep(2);
    __builtin_amdgcn_fence(__ATOMIC_ACQUIRE, "agent");
    asm volatile("s_waitcnt vmcnt(0)" ::: "memory");
  }
  __syncthreads();
}

__global__ void __launch_bounds__(256, 2) mega(Params p, int ph_lo, int ph_hi, int use_sync) {
  __shared__ __attribute__((aligned(16))) char lds[LDS_BYTES];
  cg::grid_group grid = cg::this_grid();
  unsigned nbar = 0;
#ifndef DUP_PHASE
#define DUP_PHASE -1
#endif
  const int par = (use_sync == 3);
  const int nph = par ? 10 : 8;
  for (int pi = 0; pi < nph; ++pi) {
    const int ph = par ? (pi < 3 ? pi : (pi < 5 ? pi + 5 : pi - 2)) : pi;
    const int reps = (ph == DUP_PHASE) ? 2 : 1;
    for (int rep = 0; rep < reps; ++rep) {
      switch (ph) {
        case 0: phase0(p, lds); break;
        case 1: phase1(p, lds); break;
        case 2: phase2(p, lds, rep, par); break;
        case 8: phase2b(p); break;
        case 9: phase2c(p, lds); break;
        case 3: gemm23<0>(p, lds); break;
        case 4: phase4(p); break;
        case 5: gemm23<1>(p, lds); break;
        case 6: phase6(p, lds); break;
        case 7: phase7(p, lds); break;
      }
      if (pi + 1 < nph || rep + 1 < reps) {
        if (use_sync == 2) grid.sync();
        else grid_bar((unsigned*)(p.ws + 128), (unsigned)gridDim.x * (++nbar));
      }
    }
  }
}

extern "C" void kernel_launch(void* const* d_in, const int* in_sizes, int n_in, void* d_out, int out_size,
                              void* d_ws, size_t ws_size, hipStream_t stream) {
  static int grid_blocks = 0;
  if (!grid_blocks) {
    int dev = 0, cus = 0, per_cu = 0;
    hipGetDevice(&dev);
    hipDeviceGetAttribute(&cus, hipDeviceAttributeMultiprocessorCount, dev);
    hipOccupancyMaxActiveBlocksPerMultiprocessor(&per_cu, mega, 256, 0);
    if (per_cu > 2) per_cu = 2;
    if (per_cu < 1) per_cu = 1;
    grid_blocks = cus * per_cu;
    grid_blocks &= ~7;
  }
  Params p{};
  p.x_prompt = (const float*)d_in[0]; p.x_sample = (const float*)d_in[1]; p.cache_k = (const float*)d_in[2];
  p.cache_v = (const float*)d_in[3]; p.state = (const float*)d_in[4]; p.w_in = (const float*)d_in[5];
  p.hgrn_lb = (const float*)d_in[6]; p.hgrn_g = (const float*)d_in[7]; p.lq1 = (const float*)d_in[8];
  p.lk1 = (const float*)d_in[9]; p.lq2 = (const float*)d_in[10]; p.lk2 = (const float*)d_in[11];
  p.diff_g = (const float*)d_in[12]; p.w_out = (const float*)d_in[13]; p.ln1_g = (const float*)d_in[14];
  p.ln1_b = (const float*)d_in[15]; p.wq = (const float*)d_in[16]; p.subk = (const float*)d_in[17];
  p.pu = (const float*)d_in[18]; p.pv = (const float*)d_in[19]; p.ln2_g = (const float*)d_in[20];
  p.ln2_b = (const float*)d_in[21];
  p.out = (float*)d_out; p.ws = (char*)d_ws;
  hipMemsetAsync(d_ws, 0, 512, stream);
  int lo = 0, hi = 7, us = 3;
  void* args[] = {&p, &lo, &hi, &us};
  hipError_t e = hipLaunchCooperativeKernel((const void*)mega, dim3(grid_blocks), dim3(256), args, 0, stream);
  if (e != hipSuccess) fprintf(stderr, "cooperative launch failed: %s (grid %d)\n", hipGetErrorString(e), grid_blocks);
}
```

```cpp
#include <hip/hip_runtime.h>
#include <hip/hip_cooperative_groups.h>
#include <stdint.h>
#include <cstdio>
namespace cg = cooperative_groups;

typedef unsigned short bf16_t;
typedef short bf16x8 __attribute__((ext_vector_type(8)));
typedef float f32x4 __attribute__((ext_vector_type(4)));
typedef unsigned u32x4 __attribute__((ext_vector_type(4)));
typedef unsigned u32x2 __attribute__((ext_vector_type(2)));

#define NTOK 16896
#define NPTOK 16384
#define LDS_BYTES 65536

#define OUT_Y   0
#define OUT_KP  34603008
#define OUT_VP  51380224
#define OUT_SP  68157440
#define OUT_KS  68681728
#define OUT_VS  69206016
#define OUT_SS  69730304

constexpr size_t SZ_XB     = (size_t)NTOK * 2048 * 2;
constexpr size_t SZ_T1K2   = (size_t)NTOK * 1024 * 2;
constexpr size_t SZ_W2     = (size_t)2048 * 2048 * 2;
constexpr size_t SZ_KS     = (size_t)64 * 1088 * 128 * 2;
constexpr size_t SZ_KP     = (size_t)32 * 4096 * 128 * 2;
constexpr size_t OFF_CTR   = 0;
constexpr size_t OFF_LB    = 4096;
constexpr size_t OFF_XB    = 8192;
constexpr size_t OFF_WINT  = OFF_XB + SZ_XB;
constexpr size_t OFF_WOUTT = OFF_WINT + (size_t)7168 * 2048 * 2;
constexpr size_t OFF_WQT   = OFF_WOUTT + SZ_W2;
constexpr size_t OFF_SKB   = OFF_WQT + SZ_W2;
constexpr size_t OFF_KS    = OFF_SKB + 524288;
constexpr size_t OFF_VTS   = OFF_KS + SZ_KS;
constexpr size_t OFF_R4    = OFF_VTS + SZ_KS;
constexpr size_t OFF_QA    = OFF_R4;
constexpr size_t OFF_LOGF  = OFF_QA + SZ_T1K2;
constexpr size_t OFF_IAT   = OFF_LOGF + 2 * SZ_T1K2;
constexpr size_t OFF_GA    = OFF_IAT + SZ_T1K2;
constexpr size_t OFF_QB    = OFF_GA + SZ_T1K2;
constexpr size_t OFF_KP    = OFF_QB + SZ_T1K2;
constexpr size_t OFF_VTP   = OFF_KP + SZ_KP;
constexpr size_t OFF_R4END = OFF_VTP + SZ_KP;
constexpr size_t OFF_X1F   = OFF_R4;
constexpr size_t OFF_UB    = OFF_XB;
constexpr size_t OFF_VB    = OFF_UB + (size_t)16384 * 2048;
constexpr size_t OFF_SCL   = OFF_VB + (size_t)16384 * 2048;
constexpr size_t OFF_MERGED= OFF_R4END;
constexpr size_t OFF_QP    = OFF_MERGED;
constexpr size_t OFF_X1B   = OFF_X1F + (size_t)NTOK * 2048 * 4;
constexpr size_t OFF_EIDX  = OFF_WINT;
constexpr size_t OFF_GATE  = OFF_EIDX + (size_t)NTOK * 128 * 4;
constexpr size_t OFF_DBUF  = OFF_WINT + (size_t)20 * 1024 * 1024;
constexpr size_t OFF_LS    = OFF_XB;
constexpr size_t WS_NEED_PAR = OFF_MERGED + SZ_XB;
static_assert((size_t)32 * 64 * 16 * 256 * 8 <= SZ_XB, "LS fits XB");
static_assert(OFF_SCL + 32768 * 4 <= OFF_WINT, "overlay"); static_assert(OFF_X1B + SZ_XB <= OFF_R4END, "overlay");

struct Params {
  const float* x_prompt; const float* x_sample; const float* cache_k; const float* cache_v; const float* state;
  const float* w_in; const float* hgrn_lb; const float* hgrn_g; const float* lq1; const float* lk1;
  const float* lq2; const float* lk2; const float* diff_g; const float* w_out; const float* ln1_g; const float* ln1_b;
  const float* wq; const float* subk; const float* pu; const float* pv; const float* ln2_g; const float* ln2_b;
  float* out; char* ws;
};

typedef __bf16 bf16x2_t __attribute__((ext_vector_type(2)));
typedef float f32x2_t __attribute__((ext_vector_type(2)));
__device__ __forceinline__ unsigned pk_bf16(float lo, float hi) {
  f32x2_t f = {lo, hi};
  bf16x2_t b = __builtin_convertvector(f, bf16x2_t);
  return __builtin_bit_cast(unsigned, b);
}
__device__ __forceinline__ float bf2f(unsigned short x) { return __uint_as_float(((unsigned)x) << 16); }
__device__ __forceinline__ float bflo(unsigned x) { return __uint_as_float(x << 16); }
__device__ __forceinline__ float bfhi(unsigned x) { return __uint_as_float(x & 0xffff0000u); }
__device__ __forceinline__ f32x4 mfma16(bf16x8 a, bf16x8 b, f32x4 c) {
  return __builtin_amdgcn_mfma_f32_16x16x32_bf16(a, b, c, 0, 0, 0);
}
__device__ __forceinline__ bf16x8 mk8(unsigned a, unsigned b, unsigned c, unsigned d) {
  u32x4 v = {a, b, c, d}; return __builtin_bit_cast(bf16x8, v);
}
__device__ __forceinline__ bf16x8 mk8(u32x2 a, u32x2 b) {
  u32x4 v = {a.x, a.y, b.x, b.y}; return __builtin_bit_cast(bf16x8, v);
}
__device__ __forceinline__ float wave_sum(float v) {
#pragma unroll
  for (int o = 32; o >= 1; o >>= 1) v += __shfl_xor(v, o);
  return v;
}

__device__ void transpose_conv(const float* __restrict__ W, bf16_t* __restrict__ WT, int K, int N, char* lds) {
  float* tile = (float*)lds;
  int tid_o = threadIdx.x; asm volatile("" : "+v"(tid_o)); const int tid = tid_o;
  const int nkt = K / 64, nnt = N / 64;
  for (int t = blockIdx.x; t < nkt * nnt; t += gridDim.x) {
    const int kt = t / nnt, nt = t % nnt;
    const int c = tid & 63, r0 = tid >> 6;
#pragma unroll 4
    for (int i = 0; i < 16; ++i) {
      int r = i * 4 + r0;
      tile[r * 65 + c] = W[(size_t)(kt * 64 + r) * N + nt * 64 + c];
    }
    __syncthreads();
#pragma unroll 4
    for (int i = 0; i < 16; ++i) {
      int n = i * 4 + r0;
      float v = tile[c * 65 + n];
      WT[(size_t)(nt * 64 + n) * K + kt * 64 + c] = (bf16_t)(pk_bf16(v, 0.f) & 0xffff);
    }
    __syncthreads();
  }
}

__device__ __forceinline__ void conv8(const float* __restrict__ src, bf16_t* __restrict__ dst) {
  f32x4 a = __builtin_nontemporal_load((const f32x4*)src), b = __builtin_nontemporal_load((const f32x4*)(src + 4));
  u32x4 o = {pk_bf16(a.x, a.y), pk_bf16(a.z, a.w), pk_bf16(b.x, b.y), pk_bf16(b.z, b.w)};
  *(u32x4*)dst = o;
}

__device__ void phase0(const Params& p, char* lds) {
  int tid_o = threadIdx.x; asm volatile("" : "+v"(tid_o)); const int tid = tid_o, bid = blockIdx.x;
  const size_t gtid = (size_t)bid * 256 + tid, gsz = (size_t)gridDim.x * 256;
  if (bid == 0) {
    if (tid < 64) {
      float a = p.lq1[tid] * p.lk1[tid], b = p.lq2[tid] * p.lk2[tid];
      a = wave_sum(a); b = wave_sum(b);
      if (tid == 0) ((float*)(p.ws + OFF_CTR))[16] = expf(a) - expf(b) + 0.2f;
    }
    float* LB = (float*)(p.ws + OFF_LB);
    for (int k = tid; k < 1024; k += 256) {
      float a0 = p.hgrn_lb[k], a1 = p.hgrn_lb[1024 + k];
      LB[k] = 1.0f / (1.0f + expf(a1 - a0));
    }
  }
  {
    bf16_t* XB = (bf16_t*)(p.ws + OFF_XB);
    const size_t nch = (size_t)NTOK * 2048 / 8;
    for (size_t c = gtid; c < nch; c += gsz) {
      size_t e = c * 8;
      const float* src = (e < (size_t)NPTOK * 2048) ? (p.x_prompt + e) : (p.x_sample + (e - (size_t)NPTOK * 2048));
      conv8(src, XB + e);
    }
  }
  {
    bf16_t* KS = (bf16_t*)(p.ws + OFF_KS);
    for (size_t c = gtid; c < (size_t)1048576; c += gsz) {
      int d8 = c & 15, h = (c >> 4) & 7, s = (c >> 7) & 1023, b = (int)(c >> 17);
      conv8(p.cache_k + c * 8, KS + ((size_t)((b * 8 + h) * 1088 + s) * 128 + d8 * 8));
    }
  }
  {
    bf16_t* VTS = (bf16_t*)(p.ws + OFF_VTS);
    for (size_t i = gtid; i < (size_t)2097152; i += gsz) {
      int vc = i & 127, s4 = (i >> 7) & 255, h = (i >> 15) & 7, b = (int)(i >> 18);
      const float* src = p.cache_v + ((size_t)(b * 1024 + s4 * 4) * 8 + h) * 128 + vc;
      float v0 = src[0], v1 = src[1024], v2 = src[2048], v3 = src[3072];
      u32x2 o = {pk_bf16(v0, v1), pk_bf16(v2, v3)};
      *(u32x2*)(VTS + ((size_t)((b * 8 + h) * 128 + vc) * 1088 + s4 * 4)) = o;
    }
  }
  {
    bf16_t* SKB = (bf16_t*)(p.ws + OFF_SKB);
    for (size_t c = gtid; c < (size_t)32768; c += gsz) conv8(p.subk + c * 8, SKB + c * 8);
  }
  transpose_conv(p.w_in, (bf16_t*)(p.ws + OFF_WINT), 2048, 7168, lds);
  transpose_conv(p.w_out, (bf16_t*)(p.ws + OFF_WOUTT), 2048, 2048, lds);
  transpose_conv(p.wq, (bf16_t*)(p.ws + OFF_WQT), 2048, 2048, lds);
}

template <bool SWAP>
__device__ __forceinline__ void gemm_compute_tile(const char* cur, int aoff, int boff, int sw, int fq, f32x4 (&acc)[4][4]) {
#pragma unroll
  for (int ks = 0; ks < 2; ++ks) {
    bf16x8 af[4], bfr[4];
    const int ch = ((ks * 4 + fq) ^ sw) << 4;
#pragma unroll
    for (int m = 0; m < 4; ++m) af[m] = *(const bf16x8*)(cur + aoff + m * 2048 + ch);
#pragma unroll
    for (int n = 0; n < 4; ++n) bfr[n] = *(const bf16x8*)(cur + boff + n * 2048 + ch);
#pragma unroll
    for (int m = 0; m < 4; ++m)
#pragma unroll
      for (int n = 0; n < 4; ++n)
        acc[m][n] = SWAP ? mfma16(bfr[n], af[m], acc[m][n]) : mfma16(af[m], bfr[n], acc[m][n]);
  }
}

template <bool SWAP>
__device__ __forceinline__ void gemm_mainloop(const bf16_t* A, const bf16_t* B,
                                              int row0, int col0, int K, char* lds, f32x4 (&acc)[4][4]) {
  int tid_o = threadIdx.x; asm volatile("" : "+v"(tid_o)); const int tid = tid_o, lane = tid & 63, wave = tid >> 6;
  const int wm = wave >> 1, wn = wave & 1, fr = lane & 15, fq = lane >> 4;
  const int lrow = tid >> 3, lc = tid & 7;
  const int cl = lc ^ (lrow & 7);
  const bf16_t* ga = A + (size_t)(row0 + lrow) * K + cl * 8;
  const bf16_t* gb = B + (size_t)(col0 + lrow) * K + cl * 8;
  const int loff = tid * 16;
#define G_STAGE(BUF, KT) { _Pragma("unroll") for (int i = 0; i < 4; ++i) { \
      __builtin_amdgcn_global_load_lds((const unsigned*)(ga + (size_t)i * 32 * K + (KT) * 64), (unsigned*)((BUF) + loff + i * 4096), 16, 0, 0); \
      __builtin_amdgcn_global_load_lds((const unsigned*)(gb + (size_t)i * 32 * K + (KT) * 64), (unsigned*)((BUF) + 16384 + loff + i * 4096), 16, 0, 0); } }
  const int nkt = K >> 6;
  G_STAGE(lds, 0);
  __syncthreads();
  const int aoff = (wm * 64 + fr) * 128, boff = 16384 + (wn * 64 + fr) * 128;
  const int sw = fr & 7;
  for (int kt = 0; kt < nkt; ++kt) {
    char* cur = lds + (kt & 1) * 32768;
    char* nxt = lds + ((kt + 1) & 1) * 32768;
    if (kt + 1 < nkt) G_STAGE(nxt, kt + 1);
    gemm_compute_tile<SWAP>(cur, aoff, boff, sw, fq, acc);
    __syncthreads();
  }
#undef G_STAGE
}

template <int MT, bool SWAP>
__device__ __forceinline__ void gemm_mainloop_big(const bf16_t* A, const bf16_t* B,
                                                  int row0, int col0, int K, char* lds, f32x4 (&acc)[MT][4]) {
  int tid_o = threadIdx.x; asm volatile("" : "+v"(tid_o)); const int tid = tid_o, lane = tid & 63, wave = tid >> 6;
  const int wm = wave >> 1, wn = wave & 1, fr = lane & 15, fq = lane >> 4;
  const int lrow = tid >> 3, lc = tid & 7;
  const int cl = lc ^ (lrow & 7);
  const bf16_t* ga = A + (size_t)(row0 + lrow) * K + cl * 8;
  const bf16_t* gb = B + (size_t)(col0 + lrow) * K + cl * 8;
  const int loff = tid * 16;
  const int nkt = K >> 6;
  constexpr int BOFF = MT * 32 * 128;
  const int aoff = (wm * (MT * 16) + fr) * 128, boff = BOFF + (wn * 64 + fr) * 128;
  const int sw = fr & 7;
  for (int kt = 0; kt < nkt; ++kt) {
#pragma unroll
    for (int i = 0; i < MT; ++i)
      __builtin_amdgcn_global_load_lds((const unsigned*)(ga + (size_t)i * 32 * K + kt * 64), (unsigned*)(lds + loff + i * 4096), 16, 0, 0);
#pragma unroll
    for (int i = 0; i < 4; ++i)
      __builtin_amdgcn_global_load_lds((const unsigned*)(gb + (size_t)i * 32 * K + kt * 64), (unsigned*)(lds + BOFF + loff + i * 4096), 16, 0, 0);
    __syncthreads();
#pragma unroll
    for (int ks = 0; ks < 2; ++ks) {
      bf16x8 af[MT], bfr[4];
      const int ch = ((ks * 4 + fq) ^ sw) << 4;
#pragma unroll
      for (int m = 0; m < MT; ++m) af[m] = *(const bf16x8*)(lds + aoff + m * 2048 + ch);
#pragma unroll
      for (int n = 0; n < 4; ++n) bfr[n] = *(const bf16x8*)(lds + boff + n * 2048 + ch);
#pragma unroll
      for (int m = 0; m < MT; ++m)
#pragma unroll
        for (int n = 0; n < 4; ++n)
          acc[m][n] = SWAP ? mfma16(bfr[n], af[m], acc[m][n]) : mfma16(af[m], bfr[n], acc[m][n]);
    }
    __syncthreads();
  }
}

template <bool SWAP>
__device__ void gemm1_tile(const Params& p, int mt, int nt, char* lds) {
  f32x4 acc[8][4];
#pragma unroll
  for (int m = 0; m < 8; ++m)
#pragma unroll
    for (int n = 0; n < 4; ++n) acc[m][n] = (f32x4){0.f, 0.f, 0.f, 0.f};
  gemm_mainloop_big<8, SWAP>((const bf16_t*)(p.ws + OFF_XB), (const bf16_t*)(p.ws + OFF_WINT), mt * 256, nt * 128, 2048, lds, acc);
  int tidv = threadIdx.x; asm volatile("" : "+v"(tidv));
  const int tid = tidv, lane = tid & 63, wave = tid >> 6;
  const int wm = wave >> 1, wn = wave & 1, fr = lane & 15, fq = lane >> 4;
  const int seg = nt >> 3, h = nt & 7;
  const bool samp = (mt * 256 >= NPTOK);
  if (SWAP) {
    const float* LB = (const float*)(p.ws + OFF_LB);
    if (seg == 5 && !samp) {
      float nmax = 0.f;
#pragma unroll
      for (int m = 0; m < 8; ++m) {
        float s2 = 0.f;
#pragma unroll
        for (int n = 0; n < 4; ++n) s2 += acc[m][n].x * acc[m][n].x + acc[m][n].y * acc[m][n].y + acc[m][n].z * acc[m][n].z + acc[m][n].w * acc[m][n].w;
        s2 += __shfl_xor(s2, 16);
        s2 += __shfl_xor(s2, 32);
        nmax = fmaxf(nmax, s2);
      }
#pragma unroll
      for (int o = 8; o >= 1; o >>= 1) nmax = fmaxf(nmax, __shfl_xor(nmax, o));
      if (lane == 0) atomicMax((unsigned*)(p.ws + 256) + ((mt * 256) >> 12) * 16 + h * 2 + wn, __float_as_uint(nmax));
    }
#pragma unroll
    for (int m = 0; m < 8; ++m) {
      const int tok = mt * 256 + wm * 128 + m * 16 + fr;
#pragma unroll
      for (int n = 0; n < 4; ++n) {
        const int cl = wn * 64 + n * 16 + fq * 4;
        const int kidx = h * 128 + cl;
        f32x4 v = acc[m][n];
        if (seg == 0) {
          u32x2 o = {pk_bf16(v.x, v.y), pk_bf16(v.z, v.w)};
          *(u32x2*)((bf16_t*)(p.ws + OFF_QA) + (size_t)tok * 1024 + kidx) = o;
        } else if (seg == 1) {
          f32x4 lb = *(const f32x4*)(LB + kidx);
          f32x4 o;
          o.x = lb.x + (1.f - lb.x) / (1.f + __expf(-v.x));
          o.y = lb.y + (1.f - lb.y) / (1.f + __expf(-v.y));
          o.z = lb.z + (1.f - lb.z) / (1.f + __expf(-v.z));
          o.w = lb.w + (1.f - lb.w) / (1.f + __expf(-v.w));
          *(f32x4*)((float*)(p.ws + OFF_LOGF) + (size_t)tok * 1024 + kidx) = o;
        } else if (seg == 3) {
          float s0 = 1.f / (1.f + __expf(-v.x)), s1 = 1.f / (1.f + __expf(-v.y));
          float s2 = 1.f / (1.f + __expf(-v.z)), s3 = 1.f / (1.f + __expf(-v.w));
          u32x2 o = {pk_bf16(s0, s1), pk_bf16(s2, s3)};
          *(u32x2*)((bf16_t*)(p.ws + OFF_GA) + (size_t)tok * 1024 + kidx) = o;
        } else if (seg == 4) {
          const float sc = 0.18033688011112042f;
          u32x2 o = {pk_bf16(v.x * sc, v.y * sc), pk_bf16(v.z * sc, v.w * sc)};
          *(u32x2*)((bf16_t*)(p.ws + OFF_QB) + (size_t)tok * 1024 + kidx) = o;
        } else {
          u32x2 o = {pk_bf16(v.x, v.y), pk_bf16(v.z, v.w)};
          if (!samp) {
            __builtin_nontemporal_store(v, (f32x4*)(p.out + OUT_KP + (size_t)tok * 1024 + kidx));
            const int b = tok >> 12, t = tok & 4095;
            *(u32x2*)((bf16_t*)(p.ws + OFF_KP) + ((size_t)((b * 8 + h) * 4096 + t) * 128 + cl)) = o;
          } else {
            const int ts = tok - NPTOK;
            __builtin_nontemporal_store(v, (f32x4*)(p.out + OUT_KS + (size_t)ts * 1024 + kidx));
            const int b = ts >> 6, t = ts & 63;
            *(u32x2*)((bf16_t*)(p.ws + OFF_KS) + ((size_t)((b * 8 + h) * 1088 + 1024 + t) * 128 + cl)) = o;
          }
        }
      }
    }
  } else {
#pragma unroll
    for (int m = 0; m < 8; ++m) {
      const int tok0 = mt * 256 + wm * 128 + m * 16 + fq * 4;
#pragma unroll
      for (int n = 0; n < 4; ++n) {
        const int cl = wn * 64 + n * 16 + fr;
        f32x4 v = acc[m][n];
        u32x2 o = {pk_bf16(v.x, v.y), pk_bf16(v.z, v.w)};
        if (seg == 2) {
          bf16_t* IAT = (bf16_t*)(p.ws + OFF_IAT);
          if (!samp) {
            const int b = tok0 >> 12, t = tok0 & 4095;
            *(u32x2*)(IAT + ((size_t)((b * 8 + h) * 128 + cl) * 4096 + t)) = o;
          } else {
            const int ts = tok0 - NPTOK, b = ts >> 6, t = ts & 63;
            *(u32x2*)(IAT + (size_t)32 * 128 * 4096 + ((size_t)((b * 8 + h) * 128 + cl) * 64 + t)) = o;
          }
        } else {
          if (!samp) {
            float* ov = p.out + OUT_VP + (size_t)tok0 * 1024 + h * 128 + cl;
            __builtin_nontemporal_store(v.x, ov); __builtin_nontemporal_store(v.y, ov + 1024); __builtin_nontemporal_store(v.z, ov + 2048); __builtin_nontemporal_store(v.w, ov + 3072);
            const int b = tok0 >> 12, t = tok0 & 4095;
            *(u32x2*)((bf16_t*)(p.ws + OFF_VTP) + ((size_t)((b * 8 + h) * 128 + cl) * 4096 + t)) = o;
          } else {
            const int ts = tok0 - NPTOK, b = ts >> 6, t = ts & 63;
            float* ov = p.out + OUT_VS + (size_t)ts * 1024 + h * 128 + cl;
            __builtin_nontemporal_store(v.x, ov); __builtin_nontemporal_store(v.y, ov + 1024); __builtin_nontemporal_store(v.z, ov + 2048); __builtin_nontemporal_store(v.w, ov + 3072);
            *(u32x2*)((bf16_t*)(p.ws + OFF_VTS) + ((size_t)((b * 8 + h) * 128 + cl) * 1088 + 1024 + t)) = o;
          }
        }
      }
    }
  }
}

__device__ void phase1(const Params& p, char* lds) {
  const int xcd = blockIdx.x & 7, lb = blockIdx.x >> 3, nbx = gridDim.x >> 3;
  const int nM = NTOK / 256, nNx = 7;
  for (int li = lb; li < nM * nNx; li += nbx) {
    const int mt = li / nNx, nt = (li % nNx) * 8 + xcd;
    const int seg = nt >> 3;
    if (seg == 2 || seg == 6) gemm1_tile<false>(p, mt, nt, lds);
    else gemm1_tile<true>(p, mt, nt, lds);
  }
}

template <int MODE, int MT>
__device__ void gemm23_tile(const Params& p, int row0, int nt, char* lds) {
  const bf16_t* A = (const bf16_t*)(p.ws + (MODE == 0 ? OFF_MERGED : OFF_X1B));
  const bf16_t* B = (const bf16_t*)(p.ws + (MODE == 0 ? OFF_WOUTT : OFF_WQT));
  f32x4 acc[MT][4];
#pragma unroll
  for (int m = 0; m < MT; ++m)
#pragma unroll
    for (int n = 0; n < 4; ++n) acc[m][n] = (f32x4){0.f, 0.f, 0.f, 0.f};
  if (MT == 4) gemm_mainloop<true>(A, B, row0, nt * 128, 2048, lds, (f32x4(&)[4][4])acc);
  else gemm_mainloop_big<MT, true>(A, B, row0, nt * 128, 2048, lds, acc);
  int tid_o = threadIdx.x; asm volatile("" : "+v"(tid_o)); const int tid = tid_o, lane = tid & 63, wave = tid >> 6;
  const int wm = wave >> 1, wn = wave & 1, fr = lane & 15, fq = lane >> 4;
#pragma unroll
  for (int m = 0; m < MT; ++m) {
    const int tok = row0 + wm * (MT * 16) + m * 16 + fr;
#pragma unroll
    for (int n = 0; n < 4; ++n) {
      const int col = nt * 128 + wn * 64 + n * 16 + fq * 4;
      f32x4 v = acc[m][n];
      if (MODE == 0) {
        const float* xin = (tok < NPTOK) ? (p.x_prompt + (size_t)tok * 2048) : (p.x_sample + (size_t)(tok - NPTOK) * 2048);
        f32x4 xv = *(const f32x4*)(xin + col);
        const float al = 1.189207115002721f;
        u32x2 o = {pk_bf16(al * xv.x + v.x, al * xv.y + v.y), pk_bf16(al * xv.z + v.z, al * xv.w + v.w)};
        *(u32x2*)((bf16_t*)(p.ws + OFF_X1B) + (size_t)tok * 2048 + col) = o;
      } else {
        u32x2 o = {pk_bf16(v.x, v.y), pk_bf16(v.z, v.w)};
        *(u32x2*)((bf16_t*)(p.ws + OFF_QP) + (size_t)tok * 2048 + col) = o;
      }
    }
  }
}

template <int MODE>
__device__ void gemm23(const Params& p, char* lds) {
  const int xcd = blockIdx.x & 7, lb = blockIdx.x >> 3, nbx = gridDim.x >> 3;
  for (int li = lb; li < 64 * 2; li += nbx) gemm23_tile<MODE, 8>(p, (li >> 1) * 256, (li & 1) * 8 + xcd, lds);
  for (int li = lb; li < 4 * 2; li += nbx) gemm23_tile<MODE, 4>(p, NPTOK + (li >> 1) * 128, (li & 1) * 8 + xcd, lds);
}

__device__ void hgrn_item(const Params& p, int kind, int b, int h, char* lds, int mode, int c0) {
  int tid_o = threadIdx.x; asm volatile("" : "+v"(tid_o)); const int tid = tid_o, lane = tid & 63, w = tid >> 6, fr = lane & 15, fq = lane >> 4;
  const int tokbase = kind == 0 ? b * 4096 : NPTOK + b * 64;
  const int c_begin = mode == 0 ? 0 : c0, nch = mode == 0 ? (kind == 0 ? 64 : 1) : c0 + 1;
  u32x2* LSb = (u32x2*)(p.ws + OFF_LS) + ((size_t)((b * 8 + h) * 64 + c0) * 16) * 256 + tid;
  const bf16_t* IATb = (const bf16_t*)(p.ws + OFF_IAT) +
      (kind == 0 ? (size_t)((b * 8 + h) * 128) * 4096 : (size_t)32 * 128 * 4096 + (size_t)((b * 8 + h) * 128) * 64);
  const int iat_stride = kind == 0 ? 4096 : 64;
  const float* LOGF = (const float*)(p.ws + OFF_LOGF);
  const bf16_t* QA = (const bf16_t*)(p.ws + OFF_QA);
  const bf16_t* GA = (const bf16_t*)(p.ws + OFF_GA);
  bf16_t* MERGED = (bf16_t*)(p.ws + OFF_MERGED);

  f32x4 S[8][2];
  if (mode == 2) {
#pragma unroll
    for (int kt = 0; kt < 8; ++kt)
#pragma unroll
      for (int vv = 0; vv < 2; ++vv) {
        u32x2 t = LSb[(kt * 2 + vv) * 256];
        S[kt][vv] = (f32x4){bflo(t.x), bfhi(t.x), bflo(t.y), bfhi(t.y)};
      }
  } else if (kind == 0) {
#pragma unroll
    for (int kt = 0; kt < 8; ++kt)
#pragma unroll
      for (int vv = 0; vv < 2; ++vv) S[kt][vv] = (f32x4){0.f, 0.f, 0.f, 0.f};
  } else {
    const float* st = p.state + (size_t)((b * 8 + h) * 128) * 128 + (4 * fq) * 128 + 32 * w + fr;
#pragma unroll
    for (int kt = 0; kt < 8; ++kt)
#pragma unroll
      for (int vv = 0; vv < 2; ++vv)
#pragma unroll
        for (int j = 0; j < 4; ++j) S[kt][vv][j] = st[(16 * kt + j) * 128 + 16 * vv];
  }
  f32x4 gn[2];
#pragma unroll
  for (int vv = 0; vv < 2; ++vv) gn[vv] = *(const f32x4*)(p.hgrn_g + 32 * w + 16 * vv + 4 * fq);

  const int ekp = tid & 63, eq = tid >> 6;

  u32x4 gR[8];
  unsigned qn[16];
#pragma unroll
  for (int i = 0; i < 8; ++i) {
    int id = tid + 256 * i, row = id >> 5, cc = id & 31;
    gR[i] = *(const u32x4*)(LOGF + (size_t)(tokbase + c_begin * 64 + row) * 1024 + h * 128 + cc * 4);
  }
#pragma unroll
  for (int i = 0; i < 16; ++i) qn[i] = *(const unsigned*)(QA + (size_t)(tokbase + c_begin * 64 + 16 * eq + i) * 1024 + h * 128 + 2 * ekp);
  for (int c = c_begin; c < nch; ++c) {
    int zz = 0; asm volatile("" : "+v"(zz));
    int tidv = threadIdx.x; asm volatile("" : "+v"(tidv));
    const int tid = tidv, lane = tid & 63, w = tid >> 6, fr = lane & 15, fq = lane >> 4, ekp = tid & 63, eq = tid >> 6;
    char* L = lds + zz;
    float* Dl = (float*)(L + 57344);
    float* part = (float*)(L + 57856);
    const int tok0 = tokbase + c * 64 + zz;
#pragma unroll
    for (int i = 0; i < 8; ++i) {
      int id = tid + 256 * i, row = id >> 5, cc = id & 31;
      *(u32x4*)(L + row * 512 + cc * 16) = gR[i];
    }
    unsigned qv[16];
#pragma unroll
    for (int i = 0; i < 16; ++i) qv[i] = qn[i];
    if (c + 1 < nch) {
#pragma unroll
      for (int i = 0; i < 8; ++i) {
        int id = tid + 256 * i, row = id >> 5, cc = id & 31;
        gR[i] = *(const u32x4*)(LOGF + (size_t)(tok0 + 64 + row) * 1024 + h * 128 + cc * 4);
      }
    }
    bf16x8 vfr[2][2];
#pragma unroll
    for (int ss = 0; ss < 2; ++ss)
#pragma unroll
      for (int vv = 0; vv < 2; ++vv)
        vfr[ss][vv] = *(const bf16x8*)(IATb + (size_t)(32 * w + 16 * vv + fr) * iat_stride + c * 64 + zz + 32 * ss + 8 * fq);
    __syncthreads();
    typedef float f32x2 __attribute__((ext_vector_type(2)));
    f32x2 gv[16];
    const float* Gl = (const float*)L;
    float* qtot = (float*)(L + 58880);
    float tot0 = 1.f, tot1 = 1.f;
#pragma unroll
    for (int i = 0; i < 16; ++i) { gv[i] = *(const f32x2*)(Gl + (16 * eq + i) * 128 + 2 * ekp); tot0 *= gv[i].x; tot1 *= gv[i].y; }
    qtot[eq * 128 + 2 * ekp] = tot0; qtot[eq * 128 + 2 * ekp + 1] = tot1;
    __syncthreads();
    {
      float run0 = 1.f, run1 = 1.f;
      for (int qq = 0; qq < eq; ++qq) { run0 *= qtot[qq * 128 + 2 * ekp]; run1 *= qtot[qq * 128 + 2 * ekp + 1]; }
      const int k0 = 2 * ekp;
#pragma unroll
      for (int i4 = 0; i4 < 4; ++i4) {
        float ka[4], kb[4];
#pragma unroll
        for (int ii = 0; ii < 4; ++ii) {
          const int i = i4 * 4 + ii, t = 16 * eq + i;
          const float f0 = gv[i].x, f1 = gv[i].y;
          run0 *= f0; run1 *= f1;
          const float q0 = bflo(qv[i]) * run0, q1 = bfhi(qv[i]) * run1;
          const float kk0 = (1.f - f0) * __builtin_amdgcn_rcpf(run0), kk1 = (1.f - f1) * __builtin_amdgcn_rcpf(run1);
          ka[ii] = kk0; kb[ii] = kk1;
          const int o = (t * 128 + ((((k0 >> 3) ^ (t & 15)) << 3) | (k0 & 7))) * 2;
          if (mode != 1) {
            *(unsigned*)(L + o) = pk_bf16(q0, q1);
            *(unsigned*)(L + 16384 + o) = pk_bf16(kk0, kk1);
          }
        }
        const int t0 = 16 * eq + i4 * 4;
        u32x2 oa = {pk_bf16(ka[0], ka[1]), pk_bf16(ka[2], ka[3])};
        u32x2 ob = {pk_bf16(kb[0], kb[1]), pk_bf16(kb[2], kb[3])};
        if (mode != 2) {
          *(u32x2*)(L + 32768 + k0 * 128 + ((((t0 >> 3) ^ (k0 & 7)) << 4) | ((t0 & 7) << 1))) = oa;
          *(u32x2*)(L + 32768 + (k0 + 1) * 128 + ((((t0 >> 3) ^ ((k0 + 1) & 7)) << 4) | ((t0 & 7) << 1))) = ob;
        }
      }
      if (eq == 3) { Dl[k0] = run0; Dl[k0 + 1] = run1; }
    }
    if (c + 1 < nch) {
#pragma unroll
      for (int i = 0; i < 16; ++i) qn[i] = *(const unsigned*)(QA + (size_t)(tok0 + 64 + 16 * eq + i) * 1024 + h * 128 + 2 * ekp);
    }
    __syncthreads();
    if (mode != 1) {
      bf16x8 qf[4];
#pragma unroll
      for (int ks = 0; ks < 4; ++ks) {
        const int t = 16 * w + fr;
        qf[ks] = *(const bf16x8*)(L + t * 256 + (((4 * ks + fq) ^ (t & 15)) << 4));
      }
#pragma unroll
      for (int st = 0; st < 4; ++st) {
        f32x4 a = {0.f, 0.f, 0.f, 0.f};
#pragma unroll
        for (int ks = 0; ks < 4; ++ks) {
          const int s = 16 * st + fr;
          bf16x8 kf = *(const bf16x8*)(L + 16384 + s * 256 + (((4 * ks + fq) ^ (s & 15)) << 4));
          a = mfma16(kf, qf[ks], a);
        }
        const int t = 16 * w + fr, s0 = 16 * st + 4 * fq;
        float p0 = (s0 + 0 <= t) ? a.x : 0.f, p1 = (s0 + 1 <= t) ? a.y : 0.f;
        float p2 = (s0 + 2 <= t) ? a.z : 0.f, p3 = (s0 + 3 <= t) ? a.w : 0.f;
        u32x2 o2 = {pk_bf16(p0, p1), pk_bf16(p2, p3)};
        *(u32x2*)(L + 49152 + t * 128 + ((((s0 >> 3) ^ (t & 7)) << 4) | ((s0 & 7) << 1))) = o2;
      }
    }
    f32x4 O[2][4];
#pragma unroll
    for (int vv = 0; vv < 2; ++vv)
#pragma unroll
      for (int tt = 0; tt < 4; ++tt) O[vv][tt] = (f32x4){0.f, 0.f, 0.f, 0.f};
    if (mode != 1) {
#pragma unroll
    for (int ks = 0; ks < 4; ++ks) {
      bf16x8 sf[2];
#pragma unroll
      for (int vv = 0; vv < 2; ++vv)
        sf[vv] = mk8(pk_bf16(S[2 * ks][vv].x, S[2 * ks][vv].y), pk_bf16(S[2 * ks][vv].z, S[2 * ks][vv].w),
                     pk_bf16(S[2 * ks + 1][vv].x, S[2 * ks + 1][vv].y), pk_bf16(S[2 * ks + 1][vv].z, S[2 * ks + 1][vv].w));
#pragma unroll
      for (int tt = 0; tt < 4; ++tt) {
        const int t = 16 * tt + fr;
        const int c0 = 4 * ks + (fq >> 1), c1 = 4 * ks + 2 + (fq >> 1);
        u32x2 q0 = *(const u32x2*)(L + t * 256 + ((c0 ^ (t & 15)) << 4) + ((fq & 1) << 3));
        u32x2 q1 = *(const u32x2*)(L + t * 256 + ((c1 ^ (t & 15)) << 4) + ((fq & 1) << 3));
        bf16x8 qp = mk8(q0, q1);
#pragma unroll
        for (int vv = 0; vv < 2; ++vv) O[vv][tt] = mfma16(sf[vv], qp, O[vv][tt]);
      }
    }
    }
    __syncthreads();
#pragma unroll
    for (int ss = 0; ss < 2; ++ss) {
      bf16x8 vf[2];
#pragma unroll
      for (int vv = 0; vv < 2; ++vv) vf[vv] = vfr[ss][vv];
      if (mode != 1) {
#pragma unroll
      for (int tt = 0; tt < 4; ++tt) {
        const int t = 16 * tt + fr;
        bf16x8 pf = *(const bf16x8*)(L + 49152 + t * 128 + (((4 * ss + fq) ^ (t & 7)) << 4));
#pragma unroll
        for (int vv = 0; vv < 2; ++vv) O[vv][tt] = mfma16(vf[vv], pf, O[vv][tt]);
      }
      }
      if (mode != 2) {
#pragma unroll
      for (int kt = 0; kt < 8; ++kt) {
        const int r = 16 * kt + fr;
        bf16x8 kf = *(const bf16x8*)(L + 32768 + r * 128 + (((4 * ss + fq) ^ (r & 7)) << 4));
#pragma unroll
        for (int vv = 0; vv < 2; ++vv) S[kt][vv] = mfma16(kf, vf[vv], S[kt][vv]);
      }
      }
    }
    if (mode != 2) {
#pragma unroll
    for (int kt = 0; kt < 8; ++kt) {
      f32x4 d = *(const f32x4*)(Dl + 16 * kt + 4 * fq);
#pragma unroll
      for (int vv = 0; vv < 2; ++vv) { S[kt][vv].x *= d.x; S[kt][vv].y *= d.y; S[kt][vv].z *= d.z; S[kt][vv].w *= d.w; }
    }
    }
    if (mode == 1 && tid < 128) ((float*)(p.ws + OFF_DBUF))[(size_t)((b * 8 + h) * 64 + c) * 128 + tid] = Dl[tid];
    if (mode != 1) {
#pragma unroll
    for (int tt = 0; tt < 4; ++tt) {
      float ss = 0.f;
#pragma unroll
      for (int vv = 0; vv < 2; ++vv) ss += O[vv][tt].x * O[vv][tt].x + O[vv][tt].y * O[vv][tt].y + O[vv][tt].z * O[vv][tt].z + O[vv][tt].w * O[vv][tt].w;
      ss += __shfl_xor(ss, 16);
      ss += __shfl_xor(ss, 32);
      if (fq == 0) part[w * 64 + 16 * tt + fr] = ss;
    }
    __syncthreads();
#pragma unroll
    for (int tt = 0; tt < 4; ++tt) {
      const int t = 16 * tt + fr;
      const float tot = part[t] + part[64 + t] + part[128 + t] + part[192 + t];
      const float r = rsqrtf(tot * (1.f / 128.f) + 1e-5f);
      const size_t tok = (size_t)(tok0 + t);
#pragma unroll
      for (int vv = 0; vv < 2; ++vv) {
        const int v0 = h * 128 + 32 * w + 16 * vv + 4 * fq;
        u32x2 gt = *(const u32x2*)(GA + tok * 1024 + v0);
        float o0 = O[vv][tt].x * r * gn[vv].x * bflo(gt.x);
        float o1 = O[vv][tt].y * r * gn[vv].y * bfhi(gt.x);
        float o2 = O[vv][tt].z * r * gn[vv].z * bflo(gt.y);
        float o3 = O[vv][tt].w * r * gn[vv].w * bfhi(gt.y);
        u32x2 ov = {pk_bf16(o0, o1), pk_bf16(o2, o3)};
        *(u32x2*)(MERGED + tok * 2048 + v0) = ov;
      }
    }
    }
    __syncthreads();
  }
  if (mode == 1) {
#pragma unroll
    for (int kt = 0; kt < 8; ++kt)
#pragma unroll
      for (int vv = 0; vv < 2; ++vv) {
        u32x2 t = {pk_bf16(S[kt][vv].x, S[kt][vv].y), pk_bf16(S[kt][vv].z, S[kt][vv].w)};
        LSb[(kt * 2 + vv) * 256] = t;
      }
    return;
  }
  if (mode == 2) return;
  int zq = 0; asm volatile("" : "+v"(zq));
  float* so = p.out + (kind == 0 ? OUT_SP : OUT_SS) + (size_t)((b * 8 + h) * 128) * 128 + (4 * fq) * 128 + 32 * w + fr + zq;
#pragma unroll
  for (int kt = 0; kt < 8; ++kt)
#pragma unroll
    for (int vv = 0; vv < 2; ++vv)
#pragma unroll
      for (int j = 0; j < 4; ++j) so[(16 * kt + j) * 128 + 16 * vv] = S[kt][vv][j];
}


__device__ void hgrn_scan_item(const Params& p, int chain, int kt) {
  int tid_o = threadIdx.x; asm volatile("" : "+v"(tid_o)); const int tid = tid_o, lane = tid & 63, w = tid >> 6, fr = lane & 15, fq = lane >> 4;
  u32x2* LS = (u32x2*)(p.ws + OFF_LS) + ((size_t)(chain * 64) * 16 + kt * 2) * 256 + tid;
  const float* DB = (const float*)(p.ws + OFF_DBUF) + (size_t)(chain * 64) * 128 + 16 * kt + 4 * fq;
  f32x4 S0 = {0.f, 0.f, 0.f, 0.f}, S1 = {0.f, 0.f, 0.f, 0.f};
#pragma unroll 1
  for (int c8 = 0; c8 < 64; c8 += 8) {
    u32x2 l0[8], l1[8];
    f32x4 d[8];
#pragma unroll
    for (int i = 0; i < 8; ++i) {
      l0[i] = LS[(size_t)(c8 + i) * 16 * 256];
      l1[i] = LS[(size_t)(c8 + i) * 16 * 256 + 256];
      d[i] = *(const f32x4*)(DB + (c8 + i) * 128);
    }
#pragma unroll
    for (int i = 0; i < 8; ++i) {
      u32x2 o0 = {pk_bf16(S0.x, S0.y), pk_bf16(S0.z, S0.w)}, o1 = {pk_bf16(S1.x, S1.y), pk_bf16(S1.z, S1.w)};
      LS[(size_t)(c8 + i) * 16 * 256] = o0; LS[(size_t)(c8 + i) * 16 * 256 + 256] = o1;
      S0.x = d[i].x * S0.x + bflo(l0[i].x); S0.y = d[i].y * S0.y + bfhi(l0[i].x); S0.z = d[i].z * S0.z + bflo(l0[i].y); S0.w = d[i].w * S0.w + bfhi(l0[i].y);
      S1.x = d[i].x * S1.x + bflo(l1[i].x); S1.y = d[i].y * S1.y + bfhi(l1[i].x); S1.z = d[i].z * S1.z + bflo(l1[i].y); S1.w = d[i].w * S1.w + bfhi(l1[i].y);
    }
  }
  float* so = p.out + OUT_SP + (size_t)(chain * 128) * 128 + (size_t)(16 * kt + 4 * fq) * 128 + 32 * w + fr;
  so[0] = S0.x; so[128] = S0.y; so[256] = S0.z; so[384] = S0.w;
  so[16] = S1.x; so[128 + 16] = S1.y; so[256 + 16] = S1.z; so[384 + 16] = S1.w;
}

__device__ void attn_item(const Params& p, int kind, int bh, int qt, char* lds) {
  int tid_o = threadIdx.x; asm volatile("" : "+v"(tid_o)); const int tid = tid_o, lane = tid & 63, w = tid >> 6, fr = lane & 15, fq = lane >> 4;
  const int b = bh >> 3, h = bh & 7;
  const int nkt = kind == 0 ? qt + 1 : 17;
  const int tok0 = kind == 0 ? b * 4096 + qt * 64 : NPTOK + b * 64;
  const int qpos0 = kind == 0 ? qt * 64 : 1024;
  const bf16_t* Kb = kind == 0 ? (const bf16_t*)(p.ws + OFF_KP) + (size_t)bh * 4096 * 128
                               : (const bf16_t*)(p.ws + OFF_KS) + (size_t)bh * 1088 * 128;
  const bf16_t* Vb = kind == 0 ? (const bf16_t*)(p.ws + OFF_VTP) + (size_t)bh * 128 * 4096
                               : (const bf16_t*)(p.ws + OFF_VTS) + (size_t)bh * 128 * 1088;
  const int vstride = kind == 0 ? 4096 : 1088;
  const float slope2 = exp2f(-(float)(h + 1)) * 1.4426950408889634f;

  const int tok = tok0 + 16 * w + fr;
  bf16x8 qf[4];
  {
    const bf16_t* qp = (const bf16_t*)(p.ws + OFF_QB) + (size_t)tok * 1024 + h * 128;
#pragma unroll
    for (int ks = 0; ks < 4; ++ks) qf[ks] = *(const bf16x8*)(qp + 32 * ks + 8 * fq);
  }
  const float qposf = (float)(qpos0 + 16 * w + fr);
  float qk[2];
#pragma unroll
  for (int m = 0; m < 2; ++m) {
    float s2 = 0.f;
#pragma unroll
    for (int ks2 = 0; ks2 < 2; ++ks2)
#pragma unroll
      for (int e = 0; e < 8; ++e) { const float qv = bf2f((unsigned short)qf[2 * m + ks2][e]); s2 += qv * qv; }
    s2 += __shfl_xor(s2, 16);
    s2 += __shfl_xor(s2, 32);
    const float kmax2 = kind == 0 ? __uint_as_float(((const unsigned*)(p.ws + 256))[b * 16 + h * 2 + m]) : 3.0e38f;
    qk[m] = sqrtf(s2) * sqrtf(kmax2) * 1.02f;
  }
  f32x4 O0[8], O1[8];
#pragma unroll
  for (int i = 0; i < 8; ++i) { O0[i] = (f32x4){0.f, 0.f, 0.f, 0.f}; O1[i] = (f32x4){0.f, 0.f, 0.f, 0.f}; }
  float mx[2] = {-1e30f, -1e30f}, ls[2] = {0.f, 0.f};

  u32x4 rk[4], rv[4];
  {
    const int kkey = tid >> 4, kc = tid & 15, vrow = tid >> 3, vc = tid & 7;
    const int kt = nkt - 1;
#pragma unroll
    for (int i = 0; i < 4; ++i) {
      rk[i] = *(const u32x4*)(Kb + (size_t)(kt * 64 + kkey + 16 * i) * 128 + kc * 8);
      rv[i] = *(const u32x4*)(Vb + (size_t)(vrow + 32 * i) * vstride + kt * 64 + vc * 8);
    }
#pragma unroll
    for (int i = 0; i < 4; ++i) {
      const int key = kkey + 16 * i;
      *(u32x4*)(lds + key * 256 + ((kc ^ (key & 15)) << 4)) = rk[i];
      const int r = vrow + 32 * i;
      *(u32x4*)(lds + 16384 + r * 128 + ((vc ^ ((r >> 1) & 7)) << 4)) = rv[i];
    }
    if (nkt > 1) {
#pragma unroll
      for (int i = 0; i < 4; ++i) {
        rk[i] = *(const u32x4*)(Kb + (size_t)((kt - 1) * 64 + kkey + 16 * i) * 128 + kc * 8);
        rv[i] = *(const u32x4*)(Vb + (size_t)(vrow + 32 * i) * vstride + (kt - 1) * 64 + vc * 8);
      }
    }
    __syncthreads();
  }
  for (int it = 0; it < nkt; ++it) {
    int zz = 0; asm volatile("" : "+v"(zz));
    int tidv = threadIdx.x; asm volatile("" : "+v"(tidv));
    const int tid = tidv, lane = tid & 63, w = tid >> 6, fr = lane & 15, fq = lane >> 4;
    const int kkey = tid >> 4, kc = tid & 15, vrow = tid >> 3, vc = tid & 7;
    const int kt = nkt - 1 - it;
    char* L = lds + zz + (it & 1) * 32768;
    char* Ln = lds + zz + ((it + 1) & 1) * 32768;
    if (it + 1 < nkt) {
#pragma unroll
      for (int i = 0; i < 4; ++i) {
        const int key = kkey + 16 * i;
        *(u32x4*)(Ln + key * 256 + ((kc ^ (key & 15)) << 4)) = rk[i];
        const int r = vrow + 32 * i;
        *(u32x4*)(Ln + 16384 + r * 128 + ((vc ^ ((r >> 1) & 7)) << 4)) = rv[i];
      }
    }
    if (it + 2 < nkt) {
#pragma unroll
      for (int i = 0; i < 4; ++i) {
        rk[i] = *(const u32x4*)(Kb + (size_t)((kt - 2) * 64 + zz + kkey + 16 * i) * 128 + kc * 8);
        rv[i] = *(const u32x4*)(Vb + (size_t)(vrow + 32 * i) * vstride + (kt - 2) * 64 + zz + vc * 8);
      }
    }
    const float kposf = (float)(kt * 64 + 4 * fq) - qposf;
    bf16x8 pf[2][2];
    bool live[2];
#pragma unroll
    for (int m = 0; m < 2; ++m) {
      f32x4 s[4];
#pragma unroll
      for (int k16 = 0; k16 < 4; ++k16) {
        s[k16] = (f32x4){0.f, 0.f, 0.f, 0.f};
        const int key = 16 * k16 + fr;
#pragma unroll
        for (int ks2 = 0; ks2 < 2; ++ks2) {
          bf16x8 kf = *(const bf16x8*)(L + key * 256 + (((8 * m + 4 * ks2 + fq) ^ (key & 15)) << 4));
          s[k16] = mfma16(kf, qf[2 * m + ks2], s[k16]);
        }
      }
      float tmax = -1e30f;
#pragma unroll
      for (int k16 = 0; k16 < 4; ++k16)
#pragma unroll
        for (int j = 0; j < 4; ++j) {
          const float d = kposf + (float)(16 * k16 + j);
          const float v = s[k16][j] - slope2 * fabsf(d);
          s[k16][j] = v;
          tmax = fmaxf(tmax, v);
        }
      tmax = fmaxf(tmax, __shfl_xor(tmax, 16));
      tmax = fmaxf(tmax, __shfl_xor(tmax, 32));
      live[m] = !__all(tmax - mx[m] < -40.f);
      if (live[m]) {
        const float mnew = fmaxf(mx[m], tmax);
        const float alpha = __builtin_amdgcn_exp2f(mx[m] - mnew);
        mx[m] = mnew;
        float psum = 0.f;
#pragma unroll
        for (int k16 = 0; k16 < 4; ++k16)
#pragma unroll
          for (int j = 0; j < 4; ++j) { const float e = __builtin_amdgcn_exp2f(s[k16][j] - mnew); s[k16][j] = e; psum += e; }
        ls[m] = ls[m] * alpha + psum;
        if (m == 0) {
#pragma unroll
          for (int i = 0; i < 8; ++i) { O0[i].x *= alpha; O0[i].y *= alpha; O0[i].z *= alpha; O0[i].w *= alpha; }
        } else {
#pragma unroll
          for (int i = 0; i < 8; ++i) { O1[i].x *= alpha; O1[i].y *= alpha; O1[i].z *= alpha; O1[i].w *= alpha; }
        }
#pragma unroll
        for (int ks = 0; ks < 2; ++ks)
          pf[m][ks] = mk8(pk_bf16(s[2 * ks].x, s[2 * ks].y), pk_bf16(s[2 * ks].z, s[2 * ks].w),
                          pk_bf16(s[2 * ks + 1].x, s[2 * ks + 1].y), pk_bf16(s[2 * ks + 1].z, s[2 * ks + 1].w));
      } else {
#pragma unroll
        for (int ks = 0; ks < 2; ++ks) pf[m][ks] = mk8(0u, 0u, 0u, 0u);
      }
    }
    if (live[0] || live[1]) {
#pragma unroll
      for (int vt = 0; vt < 8; ++vt) {
        const int r = 16 * vt + fr;
        const int rs = (r >> 1) & 7;
#pragma unroll
        for (int ks = 0; ks < 2; ++ks) {
          const int u0 = 8 * ks + fq, u1 = 8 * ks + 4 + fq;
          u32x2 a0 = *(const u32x2*)(L + 16384 + r * 128 + (((u0 >> 1) ^ rs) << 4) + ((u0 & 1) << 3));
          u32x2 a1 = *(const u32x2*)(L + 16384 + r * 128 + (((u1 >> 1) ^ rs) << 4) + ((u1 & 1) << 3));
          bf16x8 vf = mk8(a0, a1);
          O0[vt] = mfma16(vf, pf[0][ks], O0[vt]);
          O1[vt] = mfma16(vf, pf[1][ks], O1[vt]);
        }
      }
    }
    const float dmin = qposf - (float)((kt - 1) * 64 + 63);
    const bool done = (kind == 0) && (qk[0] - slope2 * dmin - mx[0] < -40.f) && (qk[1] - slope2 * dmin - mx[1] < -40.f);
    if (__syncthreads_and(done ? 1 : 0)) break;
  }
  float l0 = ls[0], l1 = ls[1];
  l0 += __shfl_xor(l0, 16); l0 += __shfl_xor(l0, 32);
  l1 += __shfl_xor(l1, 16); l1 += __shfl_xor(l1, 32);
  const float lam = ((const float*)(p.ws + OFF_CTR))[16];
  const float i0 = 1.f / l0, i1 = lam / l1;
  float ssq = 0.f;
#pragma unroll
  for (int vt = 0; vt < 8; ++vt) {
#pragma unroll
    for (int j = 0; j < 4; ++j) {
      const float o = O0[vt][j] * i0 - O1[vt][j] * i1;
      O0[vt][j] = o;
      ssq += o * o;
    }
  }
  ssq += __shfl_xor(ssq, 16);
  ssq += __shfl_xor(ssq, 32);
  const float r = rsqrtf(ssq * (1.f / 128.f) + 1e-5f) * 0.8f;
  bf16_t* mo = (bf16_t*)(p.ws + OFF_MERGED) + (size_t)tok * 2048 + 1024 + h * 128;
#pragma unroll
  for (int vt = 0; vt < 8; ++vt) {
    f32x4 g = *(const f32x4*)(p.diff_g + 16 * vt + 4 * fq);
    u32x2 ov = {pk_bf16(O0[vt].x * r * g.x, O0[vt].y * r * g.y), pk_bf16(O0[vt].z * r * g.z, O0[vt].w * r * g.w)};
    *(u32x2*)(mo + 16 * vt + 4 * fq) = ov;
  }
}


__device__ void quant_item(const Params& p, int item) {
  int tid_o = threadIdx.x; asm volatile("" : "+v"(tid_o)); const int tid = tid_o, lane = tid & 63, w = tid >> 6;
  unsigned char* U8 = (unsigned char*)(p.ws + OFF_UB);
  float* SCL = (float*)(p.ws + OFF_SCL);
  for (int rr = 0; rr < 16; ++rr) {
    const int row = item * 64 + rr * 4 + w;
    const float* srow = row < 16384 ? p.pu + (size_t)row * 2048 : p.pv + (size_t)(row - 16384) * 2048;
    f32x4 v[8];
    float am = 0.f;
#pragma unroll
    for (int i = 0; i < 8; ++i) {
      v[i] = __builtin_nontemporal_load((const f32x4*)(srow + 256 * i + lane * 4));
      am = fmaxf(fmaxf(am, fmaxf(fabsf(v[i].x), fabsf(v[i].y))), fmaxf(fabsf(v[i].z), fabsf(v[i].w)));
    }
#pragma unroll
    for (int o = 32; o >= 1; o >>= 1) am = fmaxf(am, __shfl_xor(am, o));
    const float sc = am > 0.f ? 224.f / am : 1.f;
    unsigned char* drow = U8 + (size_t)row * 2048;
#pragma unroll
    for (int i = 0; i < 8; ++i) {
      int pk = __builtin_amdgcn_cvt_pk_fp8_f32(v[i].x * sc, v[i].y * sc, 0, false);
      pk = __builtin_amdgcn_cvt_pk_fp8_f32(v[i].z * sc, v[i].w * sc, pk, true);
      *(int*)(drow + 256 * i + lane * 4) = pk;
    }
    if (lane == 0) SCL[row] = am > 0.f ? am * (1.f / 224.f) : 1.f;
  }
}

__device__ void phase2(const Params& p, char* lds, int rep, int par) {
  unsigned* ctr = (unsigned*)(p.ws + OFF_CTR) + rep;
  int* sitem = (int*)lds;
  const int nA = par ? 2048 : 0;
  for (;;) {
    __syncthreads();
    if (threadIdx.x == 0) *sitem = (int)atomicAdd(ctr, 1u);
    __syncthreads();
    int item = *sitem;
    __syncthreads();
    if (item >= nA + 2208) break;
    if (item < nA) { hgrn_item(p, 0, (item & 31) >> 3, item & 7, lds, 1, item >> 5); continue; }
    item -= nA;
    if (item < 96) {
      const int kind = item < 32 ? 0 : 1, ii = item < 32 ? item : item - 32;
      if (kind == 0 && par) continue;
      hgrn_item(p, kind, ii >> 3, ii & 7, lds, 0, 0);
    } else {
      const int kind = item < 160 ? 1 : 0, j = item - 160;
      attn_item(p, kind, kind ? item - 96 : (j & 31), kind ? 0 : 63 - (j >> 5), lds);
    }
  }
}

__device__ void phase2b(const Params& p) {
  for (int item = blockIdx.x; item < 256; item += gridDim.x) hgrn_scan_item(p, item >> 3, item & 7);
}

__device__ void phase2c(const Params& p, char* lds) {
  for (int item = blockIdx.x; item < 2048; item += gridDim.x) {
    __syncthreads();
    hgrn_item(p, 0, (item & 31) >> 3, item & 7, lds, 2, item >> 5);
  }
}

__device__ void phase4(const Params& p) {
  int tid_o = threadIdx.x; asm volatile("" : "+v"(tid_o)); const int tid = tid_o, lane = tid & 63, w = tid >> 6;
  bf16_t* X1B = (bf16_t*)(p.ws + OFF_X1B);
  for (int row = blockIdx.x * 4 + w; row < NTOK; row += gridDim.x * 4) {
    bf16_t* xr = X1B + (size_t)row * 2048;
    float v[4][8];
    float s = 0.f;
#pragma unroll
    for (int i = 0; i < 4; ++i) {
      u32x4 t = *(const u32x4*)(xr + 512 * i + lane * 8);
      v[i][0] = bflo(t.x); v[i][1] = bfhi(t.x); v[i][2] = bflo(t.y); v[i][3] = bfhi(t.y);
      v[i][4] = bflo(t.z); v[i][5] = bfhi(t.z); v[i][6] = bflo(t.w); v[i][7] = bfhi(t.w);
#pragma unroll
      for (int e = 0; e < 8; ++e) s += v[i][e];
    }
    s = wave_sum(s);
    const float mean = s * (1.f / 2048.f);
    float q = 0.f;
#pragma unroll
    for (int i = 0; i < 4; ++i)
#pragma unroll
      for (int e = 0; e < 8; ++e) { const float d = v[i][e] - mean; q += d * d; }
    q = wave_sum(q);
    const float rs = rsqrtf(q * (1.f / 2048.f) + 1e-5f);
#pragma unroll
    for (int i = 0; i < 4; ++i) {
      const int col = 512 * i + lane * 8;
      f32x4 g0 = *(const f32x4*)(p.ln1_g + col), g1 = *(const f32x4*)(p.ln1_g + col + 4);
      f32x4 b0 = *(const f32x4*)(p.ln1_b + col), b1 = *(const f32x4*)(p.ln1_b + col + 4);
      u32x4 o;
      o.x = pk_bf16((v[i][0] - mean) * rs * g0.x + b0.x, (v[i][1] - mean) * rs * g0.y + b0.y);
      o.y = pk_bf16((v[i][2] - mean) * rs * g0.z + b0.z, (v[i][3] - mean) * rs * g0.w + b0.w);
      o.z = pk_bf16((v[i][4] - mean) * rs * g1.x + b1.x, (v[i][5] - mean) * rs * g1.y + b1.y);
      o.w = pk_bf16((v[i][6] - mean) * rs * g1.z + b1.z, (v[i][7] - mean) * rs * g1.w + b1.w);
      *(u32x4*)(xr + col) = o;
    }
  }
}

__device__ __forceinline__ unsigned f2key(float f) {
  unsigned b = __float_as_uint(f);
  return (b & 0x80000000u) ? ~b : (b | 0x80000000u);
}
__device__ __forceinline__ float key2f(unsigned k) {
  unsigned b = (k & 0x80000000u) ? (k & 0x7fffffffu) : ~k;
  return __uint_as_float(b);
}

__device__ __forceinline__ unsigned row_allmax(unsigned x) {
  x = max(x, (unsigned)__builtin_amdgcn_update_dpp(0, (int)x, 0x121, 0xF, 0xF, false));
  x = max(x, (unsigned)__builtin_amdgcn_update_dpp(0, (int)x, 0x122, 0xF, 0xF, false));
  x = max(x, (unsigned)__builtin_amdgcn_update_dpp(0, (int)x, 0x124, 0xF, 0xF, false));
  x = max(x, (unsigned)__builtin_amdgcn_update_dpp(0, (int)x, 0x128, 0xF, 0xF, false));
  return x;
}
__device__ __forceinline__ float row_allsum(float x) {
  x += __int_as_float(__builtin_amdgcn_update_dpp(0, __float_as_int(x), 0x121, 0xF, 0xF, false));
  x += __int_as_float(__builtin_amdgcn_update_dpp(0, __float_as_int(x), 0x122, 0xF, 0xF, false));
  x += __int_as_float(__builtin_amdgcn_update_dpp(0, __float_as_int(x), 0x124, 0xF, 0xF, false));
  x += __int_as_float(__builtin_amdgcn_update_dpp(0, __float_as_int(x), 0x128, 0xF, 0xF, false));
  return x;
}
#define CE_DESC(a, b) { const unsigned _hi = max(a, b), _lo = min(a, b); a = _hi; b = _lo; }

__device__ void phase6(const Params& p, char* lds) {
  int tid_o = threadIdx.x; asm volatile("" : "+v"(tid_o)); const int tid = tid_o, lane = tid & 63, w = tid >> 6, fr = lane & 15, fq = lane >> 4;
  const bf16_t* QP = (const bf16_t*)(p.ws + OFF_QP);
  const bf16_t* SKB = (const bf16_t*)(p.ws + OFF_SKB);
  int* EIDX = (int*)(p.ws + OFF_EIDX);
  float* GATE = (float*)(p.ws + OFF_GATE);
  const bool qfirst = blockIdx.x >= (gridDim.x >> 1);
  if (qfirst) for (int qi = blockIdx.x; qi < 512; qi += gridDim.x) quant_item(p, qi);
  unsigned char* tbl = (unsigned char*)lds;
  __syncthreads();
  if (tid < 64) tbl[tid] = 0xFF;
  __syncthreads();
  {
    const int i = tid >> 4, j = tid & 15;
    if ((i + 1) * (j + 1) <= 16) {
      int rank = j;
      for (int ii = 0; ii < i; ++ii) rank += 16 / (ii + 1);
      tbl[rank] = (unsigned char)((i << 4) | j);
    }
  }
  __syncthreads();
  int pi[4], pj[4]; bool pvalid[4];
#pragma unroll
  for (int s = 0; s < 4; ++s) {
    const int pidx = fr + 16 * s;
    const unsigned code = tbl[pidx];
    pvalid[s] = (pidx < 50);
    pi[s] = pvalid[s] ? (int)(code >> 4) : 0;
    pj[s] = pvalid[s] ? (int)(code & 15) : 0;
  }
  const int rowbase = lane & 48;
  __syncthreads();
  {
    const int hh = blockIdx.x & 7;
#pragma unroll 1
    for (int c = 0; c < 2; ++c)
#pragma unroll 4
      for (int i = 0; i < 8; ++i) {
        const int id = tid + 256 * i, key = id >> 4, ch = id & 15;
        u32x4 v = *(const u32x4*)(SKB + (size_t)((hh * 2 + c) * 128 + key) * 128 + ch * 8);
        *(u32x4*)(lds + c * 32768 + key * 256 + ((ch ^ (key & 15)) << 4)) = v;
      }
  }
  __syncthreads();
  for (int item = blockIdx.x; item < 264 * 8; item += gridDim.x) {
    int zz = 0; asm volatile("" : "+v"(zz));
    const char* L = lds + zz;
    const int tile = item >> 3, h = item & 7;
    const int tok0 = tile * 64;
    unsigned Lst[2][4];
#pragma unroll
    for (int c = 0; c < 2; ++c) {
      unsigned K[8][4];
      {
        bf16x8 af[4];
        const bf16_t* qp = QP + (size_t)(tok0 + 16 * w + fr) * 2048 + h * 256 + c * 128;
#pragma unroll
        for (int ks = 0; ks < 4; ++ks) af[ks] = *(const bf16x8*)(qp + 32 * ks + 8 * fq);
#pragma unroll
        for (int kt = 0; kt < 8; ++kt) {
          f32x4 a = {0.f, 0.f, 0.f, 0.f};
#pragma unroll
          for (int ks = 0; ks < 4; ++ks) {
            const int key = 16 * kt + fr;
            bf16x8 bfr = *(const bf16x8*)(L + c * 32768 + key * 256 + (((4 * ks + fq) ^ (key & 15)) << 4));
            a = mfma16(af[ks], bfr, a);
          }
          const unsigned code = (unsigned)(127 - (16 * kt + fr));
#pragma unroll
          for (int j = 0; j < 4; ++j) K[kt][j] = (f2key(a[j]) & ~127u) | code;
        }
      }
#pragma unroll
      for (int j = 0; j < 4; ++j) {
        CE_DESC(K[0][j], K[1][j]); CE_DESC(K[2][j], K[3][j]); CE_DESC(K[4][j], K[5][j]); CE_DESC(K[6][j], K[7][j]);
        CE_DESC(K[0][j], K[2][j]); CE_DESC(K[1][j], K[3][j]); CE_DESC(K[4][j], K[6][j]); CE_DESC(K[5][j], K[7][j]);
        CE_DESC(K[1][j], K[2][j]); CE_DESC(K[5][j], K[6][j]); CE_DESC(K[0][j], K[4][j]); CE_DESC(K[3][j], K[7][j]);
        CE_DESC(K[1][j], K[5][j]); CE_DESC(K[2][j], K[6][j]);
        CE_DESC(K[1][j], K[4][j]); CE_DESC(K[3][j], K[6][j]);
        CE_DESC(K[2][j], K[4][j]); CE_DESC(K[3][j], K[5][j]);
        CE_DESC(K[3][j], K[4][j]);
      }
      unsigned best[4] = {0u, 0u, 0u, 0u};
#pragma unroll 1
      for (int it = 0; it < 16; ++it) {
#pragma unroll
        for (int j = 0; j < 4; ++j) {
          const unsigned rm = row_allmax(K[0][j]);
          const bool win = (K[0][j] == rm);
#pragma unroll
          for (int k = 0; k < 7; ++k) K[k][j] = win ? K[k + 1][j] : K[k][j];
          K[7][j] = win ? 0u : K[7][j];
          best[j] = (fr == it) ? rm : best[j];
        }
      }
#pragma unroll
      for (int j = 0; j < 4; ++j) Lst[c][j] = best[j];
    }
#pragma unroll
    for (int j = 0; j < 4; ++j) {
      unsigned C[4];
#pragma unroll
      for (int s = 0; s < 4; ++s) {
        const unsigned k0 = (unsigned)__shfl((int)Lst[0][j], rowbase + pi[s]);
        const unsigned k1 = (unsigned)__shfl((int)Lst[1][j], rowbase + pj[s]);
        const float sum = key2f(k0 & ~127u) + key2f(k1 & ~127u);
        C[s] = pvalid[s] ? ((f2key(sum) & ~255u) | (unsigned)(255 - (pi[s] * 16 + pj[s]))) : 0u;
      }
      CE_DESC(C[0], C[1]); CE_DESC(C[2], C[3]); CE_DESC(C[0], C[2]); CE_DESC(C[1], C[3]); CE_DESC(C[1], C[2]);
      unsigned sel = 0u;
#pragma unroll 1
      for (int it = 0; it < 16; ++it) {
        const unsigned rm = row_allmax(C[0]);
        const bool win = (C[0] == rm);
        C[0] = win ? C[1] : C[0]; C[1] = win ? C[2] : C[1]; C[2] = win ? C[3] : C[2]; C[3] = win ? 0u : C[3];
        sel = (fr == it) ? rm : sel;
      }
      const float cv = key2f(sel & ~255u);
      const float cmax = __shfl(cv, rowbase);
      const float e = __expf(cv - cmax);
      const float g = e / row_allsum(e);
      const int flat = 255 - (int)(sel & 255u);
      const unsigned l0 = (unsigned)__shfl((int)Lst[0][j], rowbase + (flat >> 4));
      const unsigned l1 = (unsigned)__shfl((int)Lst[1][j], rowbase + (flat & 15));
      const int eidx = (127 - (int)(l0 & 127u)) * 128 + (127 - (int)(l1 & 127u));
      const size_t ob = ((size_t)(tok0 + 16 * w + 4 * fq + j) * 8 + h) * 16 + fr;
      EIDX[ob] = eidx;
      GATE[ob] = g;
    }
  }
  if (!qfirst) for (int qi = blockIdx.x; qi < 512; qi += gridDim.x) quant_item(p, qi);
}

__device__ __forceinline__ float dot16_fp8(u32x4 r, const float* x) {
  float d = 0.f;
  f32x2_t a;
  a = __builtin_amdgcn_cvt_pk_f32_fp8((int)r.x, false); d += a.x * x[0] + a.y * x[1];
  a = __builtin_amdgcn_cvt_pk_f32_fp8((int)r.x, true);  d += a.x * x[2] + a.y * x[3];
  a = __builtin_amdgcn_cvt_pk_f32_fp8((int)r.y, false); d += a.x * x[4] + a.y * x[5];
  a = __builtin_amdgcn_cvt_pk_f32_fp8((int)r.y, true);  d += a.x * x[6] + a.y * x[7];
  a = __builtin_amdgcn_cvt_pk_f32_fp8((int)r.z, false); d += a.x * x[8] + a.y * x[9];
  a = __builtin_amdgcn_cvt_pk_f32_fp8((int)r.z, true);  d += a.x * x[10] + a.y * x[11];
  a = __builtin_amdgcn_cvt_pk_f32_fp8((int)r.w, false); d += a.x * x[12] + a.y * x[13];
  a = __builtin_amdgcn_cvt_pk_f32_fp8((int)r.w, true);  d += a.x * x[14] + a.y * x[15];
  return d;
}
__device__ __forceinline__ void axpy16_fp8(u32x4 r, float w, float* acc) {
  f32x2_t a;
  a = __builtin_amdgcn_cvt_pk_f32_fp8((int)r.x, false); acc[0] += w * a.x; acc[1] += w * a.y;
  a = __builtin_amdgcn_cvt_pk_f32_fp8((int)r.x, true);  acc[2] += w * a.x; acc[3] += w * a.y;
  a = __builtin_amdgcn_cvt_pk_f32_fp8((int)r.y, false); acc[4] += w * a.x; acc[5] += w * a.y;
  a = __builtin_amdgcn_cvt_pk_f32_fp8((int)r.y, true);  acc[6] += w * a.x; acc[7] += w * a.y;
  a = __builtin_amdgcn_cvt_pk_f32_fp8((int)r.z, false); acc[8] += w * a.x; acc[9] += w * a.y;
  a = __builtin_amdgcn_cvt_pk_f32_fp8((int)r.z, true);  acc[10] += w * a.x; acc[11] += w * a.y;
  a = __builtin_amdgcn_cvt_pk_f32_fp8((int)r.w, false); acc[12] += w * a.x; acc[13] += w * a.y;
  a = __builtin_amdgcn_cvt_pk_f32_fp8((int)r.w, true);  acc[14] += w * a.x; acc[15] += w * a.y;
}

__device__ void phase7(const Params& p, char* lds) {
  int tid_o = threadIdx.x; asm volatile("" : "+v"(tid_o)); const int tid = tid_o, lane = tid & 63, w = tid >> 6;
  const bf16_t* X1B = (const bf16_t*)(p.ws + OFF_X1B);
  const unsigned char* U8 = (const unsigned char*)(p.ws + OFF_UB);
  const unsigned char* V8 = (const unsigned char*)(p.ws + OFF_VB);
  const float* SCL = (const float*)(p.ws + OFF_SCL);
  const int* EIDX = (const int*)(p.ws + OFF_EIDX);
  const float* GATE = (const float*)(p.ws + OFF_GATE);
  float* wgt = (float*)lds;
  float* red = (float*)(lds + 1024);
  float* part = (float*)(lds + 2048);
  for (int tok = blockIdx.x; tok < NTOK; tok += gridDim.x) {
    int tidv = threadIdx.x; asm volatile("" : "+v"(tidv));
    const int tid = tidv, lane = tid & 63, w = tid >> 6;
    const bf16_t* xr = X1B + (size_t)tok * 2048;
    float xa[2][16];
#pragma unroll
    for (int j = 0; j < 2; ++j)
#pragma unroll
      for (int q = 0; q < 2; ++q) {
        u32x4 t = *(const u32x4*)(xr + 1024 * j + 16 * lane + 8 * q);
        xa[j][8 * q] = bflo(t.x); xa[j][8 * q + 1] = bfhi(t.x); xa[j][8 * q + 2] = bflo(t.y); xa[j][8 * q + 3] = bfhi(t.y);
        xa[j][8 * q + 4] = bflo(t.z); xa[j][8 * q + 5] = bfhi(t.z); xa[j][8 * q + 6] = bflo(t.w); xa[j][8 * q + 7] = bfhi(t.w);
      }
    __syncthreads();
#ifndef UR
#define UR 16
#endif
#ifndef VR
#define VR 16
#endif
#pragma unroll 1
    for (int k6 = 0; k6 < 32; k6 += UR) {
      u32x4 r[UR][2];
      int ee[UR];
#pragma unroll
      for (int kk = 0; kk < UR; ++kk) {
        const int kq = (k6 + kk < 32) ? (k6 + kk) : 31;
        ee[kk] = __builtin_amdgcn_readfirstlane(EIDX[(size_t)tok * 128 + w * 32 + kq]);
        const unsigned char* ur = U8 + (size_t)ee[kk] * 2048 + lane * 16;
        r[kk][0] = *(const u32x4*)ur;
        r[kk][1] = *(const u32x4*)(ur + 1024);
      }
      float dot[UR];
#pragma unroll
      for (int kk = 0; kk < UR; ++kk) dot[kk] = dot16_fp8(r[kk][0], xa[0]) + dot16_fp8(r[kk][1], xa[1]);
#pragma unroll
      for (int o = 32; o >= 1; o >>= 1) {
#pragma unroll
        for (int kk = 0; kk < UR; ++kk) dot[kk] += __shfl_xor(dot[kk], o);
      }
      if (lane < UR && k6 + lane < 32) {
        float a = dot[0]; int e = ee[0];
#pragma unroll
        for (int kk = 1; kk < UR; ++kk) { if (lane == kk) { a = dot[kk]; e = ee[kk]; } }
        const int k = w * 32 + k6 + lane;
        a *= SCL[e];
        const float ge = 0.5f * a * (1.f + erff(a * 0.70710678118654752f));
        wgt[k] = GATE[(size_t)tok * 128 + k] * ge * SCL[16384 + e];
      }
    }
    __syncthreads();
#pragma unroll 1
    for (int j = 0; j < 2; ++j) {
      float acc[16];
#pragma unroll
      for (int q = 0; q < 16; ++q) acc[q] = 0.f;
#pragma unroll 1
      for (int k6 = 0; k6 < 32; k6 += VR) {
        u32x4 r[VR];
        float ww[VR];
#pragma unroll
        for (int kk = 0; kk < VR; ++kk) {
          const int kq = (k6 + kk < 32) ? (k6 + kk) : 31;
          const int k = w * 32 + kq;
          const int e = __builtin_amdgcn_readfirstlane(EIDX[(size_t)tok * 128 + k]);
          ww[kk] = (k6 + kk < 32) ? wgt[k] : 0.f;
          r[kk] = *(const u32x4*)(V8 + (size_t)e * 2048 + 1024 * j + lane * 16);
        }
#pragma unroll
        for (int kk = 0; kk < VR; ++kk) axpy16_fp8(r[kk], ww[kk], acc);
      }
#pragma unroll
      for (int q = 0; q < 4; ++q)
        *(f32x4*)(part + w * 2048 + 1024 * j + 16 * lane + 4 * q) = (f32x4){acc[4 * q], acc[4 * q + 1], acc[4 * q + 2], acc[4 * q + 3]};
    }
    __syncthreads();
    const float al = 1.189207115002721f;
    const u32x4 xt = *(const u32x4*)(xr + tid * 8);
    f32x4 x0 = {bflo(xt.x), bfhi(xt.x), bflo(xt.y), bfhi(xt.y)}, x1 = {bflo(xt.z), bfhi(xt.z), bflo(xt.w), bfhi(xt.w)};
    f32x4 s0 = {0.f, 0.f, 0.f, 0.f}, s1 = {0.f, 0.f, 0.f, 0.f};
#pragma unroll
    for (int ww2 = 0; ww2 < 4; ++ww2) {
      f32x4 a0 = *(const f32x4*)(part + ww2 * 2048 + tid * 8), a1 = *(const f32x4*)(part + ww2 * 2048 + tid * 8 + 4);
      s0.x += a0.x; s0.y += a0.y; s0.z += a0.z; s0.w += a0.w; s1.x += a1.x; s1.y += a1.y; s1.z += a1.z; s1.w += a1.w;
    }
    float val[8] = {al * x0.x + s0.x, al * x0.y + s0.y, al * x0.z + s0.z, al * x0.w + s0.w,
                    al * x1.x + s1.x, al * x1.y + s1.y, al * x1.z + s1.z, al * x1.w + s1.w};
    float s = 0.f;
#pragma unroll
    for (int j = 0; j < 8; ++j) s += val[j];
    s = wave_sum(s);
    if (lane == 0) red[w] = s;
    __syncthreads();
    const float mean = (red[0] + red[1] + red[2] + red[3]) * (1.f / 2048.f);
    float q = 0.f;
#pragma unroll
    for (int j = 0; j < 8; ++j) { const float d = val[j] - mean; q += d * d; }
    q = wave_sum(q);
    if (lane == 0) red[4 + w] = q;
    __syncthreads();
    const float rs = rsqrtf((red[4] + red[5] + red[6] + red[7]) * (1.f / 2048.f) + 1e-5f);
    f32x4 g0 = *(const f32x4*)(p.ln2_g + tid * 8), g1 = *(const f32x4*)(p.ln2_g + tid * 8 + 4);
    f32x4 b0 = *(const f32x4*)(p.ln2_b + tid * 8), b1 = *(const f32x4*)(p.ln2_b + tid * 8 + 4);
    f32x4 o0 = {(val[0] - mean) * rs * g0.x + b0.x, (val[1] - mean) * rs * g0.y + b0.y, (val[2] - mean) * rs * g0.z + b0.z, (val[3] - mean) * rs * g0.w + b0.w};
    f32x4 o1 = {(val[4] - mean) * rs * g1.x + b1.x, (val[5] - mean) * rs * g1.y + b1.y, (val[6] - mean) * rs * g1.z + b1.z, (val[7] - mean) * rs * g1.w + b1.w};
    float* yo = p.out + OUT_Y + (size_t)tok * 2048 + tid * 8;
    __builtin_nontemporal_store(o0, (f32x4*)yo);
    __builtin_nontemporal_store(o1, (f32x4*)(yo + 4));
  }
}

__device__ __forceinline__ void grid_bar(unsigned* ctr, unsigned target) {
  asm volatile("s_waitcnt vmcnt(0)" ::: "memory");
  __syncthreads();
  if (threadIdx.x == 0) {
    __builtin_amdgcn_fence(__ATOMIC_RELEASE, "agent");
    asm volatile("s_waitcnt vmcnt(0)" ::: "memory");
    __hip_atomic_fetch_add(ctr, 1u, __ATOMIC_RELAXED, __HIP_MEMORY_SCOPE_AGENT);
    while (__hip_atomic_load(ctr, __ATOMIC_RELAXED, __HIP_MEMORY_SCOPE_AGENT) < target) __builtin_amdgcn_s_sleep(2);
    __builtin_amdgcn_fence(__ATOMIC_ACQUIRE, "agent");
    asm volatile("s_waitcnt vmcnt(0)" ::: "memory");
  }
  __syncthreads();
}

__global__ void __launch_bounds__(256, 2) mega(Params p, int ph_lo, int ph_hi, int use_sync) {
  __shared__ __attribute__((aligned(16))) char lds[LDS_BYTES];
  cg::grid_group grid = cg::this_grid();
  unsigned nbar = 0;
#ifndef DUP_PHASE
#define DUP_PHASE -1
#endif
  const int par = (use_sync == 3);
  const int nph = par ? 10 : 8;
  for (int pi = 0; pi < nph; ++pi) {
    const int ph = par ? (pi < 3 ? pi : (pi < 5 ? pi + 5 : pi - 2)) : pi;
    const int reps = (ph == DUP_PHASE) ? 2 : 1;
    for (int rep = 0; rep < reps; ++rep) {
      switch (ph) {
        case 0: phase0(p, lds); break;
        case 1: phase1(p, lds); break;
        case 2: phase2(p, lds, rep, par); break;
        case 8: phase2b(p); break;
        case 9: phase2c(p, lds); break;
        case 3: gemm23<0>(p, lds); break;
        case 4: phase4(p); break;
        case 5: gemm23<1>(p, lds); break;
        case 6: phase6(p, lds); break;
        case 7: phase7(p, lds); break;
      }
      if (pi + 1 < nph || rep + 1 < reps) {
        if (use_sync == 2) grid.sync();
        else grid_bar((unsigned*)(p.ws + 128), (unsigned)gridDim.x * (++nbar));
      }
    }
  }
}

extern "C" void kernel_launch(void* const* d_in, const int* in_sizes, int n_in, void* d_out, int out_size,
                              void* d_ws, size_t ws_size, hipStream_t stream) {
  static int grid_blocks = 0;
  if (!grid_blocks) {
    int dev = 0, cus = 0, per_cu = 0;
    hipGetDevice(&dev);
    hipDeviceGetAttribute(&cus, hipDeviceAttributeMultiprocessorCount, dev);
    hipOccupancyMaxActiveBlocksPerMultiprocessor(&per_cu, mega, 256, 0);
    if (per_cu > 2) per_cu = 2;
    if (per_cu < 1) per_cu = 1;
    grid_blocks = cus * per_cu;
    grid_blocks &= ~7;
  }
  Params p{};
  p.x_prompt = (const float*)d_in[0]; p.x_sample = (const float*)d_in[1]; p.cache_k = (const float*)d_in[2];
  p.cache_v = (const float*)d_in[3]; p.state = (const float*)d_in[4]; p.w_in = (const float*)d_in[5];
  p.hgrn_lb = (const float*)d_in[6]; p.hgrn_g = (const float*)d_in[7]; p.lq1 = (const float*)d_in[8];
  p.lk1 = (const float*)d_in[9]; p.lq2 = (const float*)d_in[10]; p.lk2 = (const float*)d_in[11];
  p.diff_g = (const float*)d_in[12]; p.w_out = (const float*)d_in[13]; p.ln1_g = (const float*)d_in[14];
  p.ln1_b = (const float*)d_in[15]; p.wq = (const float*)d_in[16]; p.subk = (const float*)d_in[17];
  p.pu = (const float*)d_in[18]; p.pv = (const float*)d_in[19]; p.ln2_g = (const float*)d_in[20];
  p.ln2_b = (const float*)d_in[21];
  p.out = (float*)d_out; p.ws = (char*)d_ws;
  hipMemsetAsync(d_ws, 0, 512, stream);
  int lo = 0, hi = 7, us = 3;
  void* args[] = {&p, &lo, &hi, &us};
  hipError_t e = hipLaunchCooperativeKernel((const void*)mega, dim3(grid_blocks), dim3(256), args, 0, stream);
  if (e != hipSuccess) fprintf(stderr, "cooperative launch failed: %s (grid %d)\n", hipGetErrorString(e), grid_blocks);
}
```

```cpp
#include <hip/hip_runtime.h>
#include <hip/hip_cooperative_groups.h>
#include <stdint.h>
#include <cstdio>
namespace cg = cooperative_groups;

typedef unsigned short bf16_t;
typedef short bf16x8 __attribute__((ext_vector_type(8)));
typedef float f32x4 __attribute__((ext_vector_type(4)));
typedef unsigned u32x4 __attribute__((ext_vector_type(4)));
typedef unsigned u32x2 __attribute__((ext_vector_type(2)));

#define NTOK 16896
#define NPTOK 16384
#define LDS_BYTES 65536

#define OUT_Y   0
#define OUT_KP  34603008
#define OUT_VP  51380224
#define OUT_SP  68157440
#define OUT_KS  68681728
#define OUT_VS  69206016
#define OUT_SS  69730304

constexpr size_t SZ_XB     = (size_t)NTOK * 2048 * 2;
constexpr size_t SZ_T1K2   = (size_t)NTOK * 1024 * 2;
constexpr size_t SZ_W2     = (size_t)2048 * 2048 * 2;
constexpr size_t SZ_KS     = (size_t)64 * 1088 * 128 * 2;
constexpr size_t SZ_KP     = (size_t)32 * 4096 * 128 * 2;
constexpr size_t OFF_CTR   = 0;
constexpr size_t OFF_LB    = 4096;
constexpr size_t OFF_XB    = 8192;
constexpr size_t OFF_WINT  = OFF_XB + SZ_XB;
constexpr size_t OFF_WOUTT = OFF_WINT + (size_t)7168 * 2048 * 2;
constexpr size_t OFF_WQT   = OFF_WOUTT + SZ_W2;
constexpr size_t OFF_SKB   = OFF_WQT + SZ_W2;
constexpr size_t OFF_KS    = OFF_SKB + 524288;
constexpr size_t OFF_VTS   = OFF_KS + SZ_KS;
constexpr size_t OFF_R4    = OFF_VTS + SZ_KS;
constexpr size_t OFF_QA    = OFF_R4;
constexpr size_t OFF_LOGF  = OFF_QA + SZ_T1K2;
constexpr size_t OFF_IAT   = OFF_LOGF + 2 * SZ_T1K2;
constexpr size_t OFF_GA    = OFF_IAT + SZ_T1K2;
constexpr size_t OFF_QB    = OFF_GA + SZ_T1K2;
constexpr size_t OFF_KP    = OFF_QB + SZ_T1K2;
constexpr size_t OFF_VTP   = OFF_KP + SZ_KP;
constexpr size_t OFF_R4END = OFF_VTP + SZ_KP;
constexpr size_t OFF_X1F   = OFF_R4;
constexpr size_t OFF_UB    = OFF_XB;
constexpr size_t OFF_VB    = OFF_UB + (size_t)16384 * 2048;
constexpr size_t OFF_SCL   = OFF_VB + (size_t)16384 * 2048;
constexpr size_t OFF_MERGED= OFF_R4END;
constexpr size_t OFF_QP    = OFF_MERGED;
constexpr size_t OFF_X1B   = OFF_X1F + (size_t)NTOK * 2048 * 4;
constexpr size_t OFF_EIDX  = OFF_WINT;
constexpr size_t OFF_GATE  = OFF_EIDX + (size_t)NTOK * 128 * 4;
constexpr size_t OFF_DBUF  = OFF_WINT + (size_t)20 * 1024 * 1024;
constexpr size_t OFF_LS    = OFF_XB;
constexpr size_t WS_NEED_PAR = OFF_MERGED + SZ_XB;
static_assert((size_t)32 * 64 * 16 * 256 * 8 <= SZ_XB, "LS fits XB");
static_assert(OFF_SCL + 32768 * 4 <= OFF_WINT, "overlay"); static_assert(OFF_X1B + SZ_XB <= OFF_R4END, "overlay");

struct Params {
  const float* x_prompt; const float* x_sample; const float* cache_k; const float* cache_v; const float* state;
  const float* w_in; const float* hgrn_lb; const float* hgrn_g; const float* lq1; const float* lk1;
  const float* lq2; const float* lk2; const float* diff_g; const float* w_out; const float* ln1_g; const float* ln1_b;
  const float* wq; const float* subk; const float* pu; const float* pv; const float* ln2_g; const float* ln2_b;
  float* out; char* ws;
};

typedef __bf16 bf16x2_t __attribute__((ext_vector_type(2)));
typedef float f32x2_t __attribute__((ext_vector_type(2)));
__device__ __forceinline__ unsigned pk_bf16(float lo, float hi) {
  f32x2_t f = {lo, hi};
  bf16x2_t b = __builtin_convertvector(f, bf16x2_t);
  return __builtin_bit_cast(unsigned, b);
}
__device__ __forceinline__ float bf2f(unsigned short x) { return __uint_as_float(((unsigned)x) << 16); }
__device__ __forceinline__ float bflo(unsigned x) { return __uint_as_float(x << 16); }
__device__ __forceinline__ float bfhi(unsigned x) { return __uint_as_float(x & 0xffff0000u); }
__device__ __forceinline__ f32x4 mfma16(bf16x8 a, bf16x8 b, f32x4 c) {
  return __builtin_amdgcn_mfma_f32_16x16x32_bf16(a, b, c, 0, 0, 0);
}
__device__ __forceinline__ bf16x8 mk8(unsigned a, unsigned b, unsigned c, unsigned d) {
  u32x4 v = {a, b, c, d}; return __builtin_bit_cast(bf16x8, v);
}
__device__ __forceinline__ bf16x8 mk8(u32x2 a, u32x2 b) {
  u32x4 v = {a.x, a.y, b.x, b.y}; return __builtin_bit_cast(bf16x8, v);
}
__device__ __forceinline__ float wave_sum(float v) {
#pragma unroll
  for (int o = 32; o >= 1; o >>= 1) v += __shfl_xor(v, o);
  return v;
}

__device__ void transpose_conv(const float* __restrict__ W, bf16_t* __restrict__ WT, int K, int N, char* lds) {
  float* tile = (float*)lds;
  int tid_o = threadIdx.x; asm volatile("" : "+v"(tid_o)); const int tid = tid_o;
  const int nkt = K / 64, nnt = N / 64;
  for (int t = blockIdx.x; t < nkt * nnt; t += gridDim.x) {
    const int kt = t / nnt, nt = t % nnt;
    const int c = tid & 63, r0 = tid >> 6;
#pragma unroll 4
    for (int i = 0; i < 16; ++i) {
      int r = i * 4 + r0;
      tile[r * 65 + c] = W[(size_t)(kt * 64 + r) * N + nt * 64 + c];
    }
    __syncthreads();
#pragma unroll 4
    for (int i = 0; i < 16; ++i) {
      int n = i * 4 + r0;
      float v = tile[c * 65 + n];
      WT[(size_t)(nt * 64 + n) * K + kt * 64 + c] = (bf16_t)(pk_bf16(v, 0.f) & 0xffff);
    }
    __syncthreads();
  }
}

__device__ __forceinline__ void conv8(const float* __restrict__ src, bf16_t* __restrict__ dst) {
  f32x4 a = __builtin_nontemporal_load((const f32x4*)src), b = __builtin_nontemporal_load((const f32x4*)(src + 4));
  u32x4 o = {pk_bf16(a.x, a.y), pk_bf16(a.z, a.w), pk_bf16(b.x, b.y), pk_bf16(b.z, b.w)};
  *(u32x4*)dst = o;
}

__device__ void phase0(const Params& p, char* lds) {
  int tid_o = threadIdx.x; asm volatile("" : "+v"(tid_o)); const int tid = tid_o, bid = blockIdx.x;
  const size_t gtid = (size_t)bid * 256 + tid, gsz = (size_t)gridDim.x * 256;
  if (bid == 0) {
    if (tid < 64) {
      float a = p.lq1[tid] * p.lk1[tid], b = p.lq2[tid] * p.lk2[tid];
      a = wave_sum(a); b = wave_sum(b);
      if (tid == 0) ((float*)(p.ws + OFF_CTR))[16] = expf(a) - expf(b) + 0.2f;
    }
    float* LB = (float*)(p.ws + OFF_LB);
    for (int k = tid; k < 1024; k += 256) {
      float a0 = p.hgrn_lb[k], a1 = p.hgrn_lb[1024 + k];
      LB[k] = 1.0f / (1.0f + expf(a1 - a0));
    }
  }
  {
    bf16_t* XB = (bf16_t*)(p.ws + OFF_XB);
    const size_t nch = (size_t)NTOK * 2048 / 8;
    for (size_t c = gtid; c < nch; c += gsz) {
      size_t e = c * 8;
      const float* src = (e < (size_t)NPTOK * 2048) ? (p.x_prompt + e) : (p.x_sample + (e - (size_t)NPTOK * 2048));
      conv8(src, XB + e);
    }
  }
  {
    bf16_t* KS = (bf16_t*)(p.ws + OFF_KS);
    for (size_t c = gtid; c < (size_t)1048576; c += gsz) {
      int d8 = c & 15, h = (c >> 4) & 7, s = (c >> 7) & 1023, b = (int)(c >> 17);
      conv8(p.cache_k + c * 8, KS + ((size_t)((b * 8 + h) * 1088 + s) * 128 + d8 * 8));
    }
  }
  {
    bf16_t* VTS = (bf16_t*)(p.ws + OFF_VTS);
    for (size_t i = gtid; i < (size_t)2097152; i += gsz) {
      int vc = i & 127, s4 = (i >> 7) & 255, h = (i >> 15) & 7, b = (int)(i >> 18);
      const float* src = p.cache_v + ((size_t)(b * 1024 + s4 * 4) * 8 + h) * 128 + vc;
      float v0 = src[0], v1 = src[1024], v2 = src[2048], v3 = src[3072];
      u32x2 o = {pk_bf16(v0, v1), pk_bf16(v2, v3)};
      *(u32x2*)(VTS + ((size_t)((b * 8 + h) * 128 + vc) * 1088 + s4 * 4)) = o;
    }
  }
  {
    bf16_t* SKB = (bf16_t*)(p.ws + OFF_SKB);
    for (size_t c = gtid; c < (size_t)32768; c += gsz) conv8(p.subk + c * 8, SKB + c * 8);
  }
  transpose_conv(p.w_in, (bf16_t*)(p.ws + OFF_WINT), 2048, 7168, lds);
  transpose_conv(p.w_out, (bf16_t*)(p.ws + OFF_WOUTT), 2048, 2048, lds);
  transpose_conv(p.wq, (bf16_t*)(p.ws + OFF_WQT), 2048, 2048, lds);
}

template <bool SWAP>
__device__ __forceinline__ void gemm_compute_tile(const char* cur, int aoff, int boff, int sw, int fq, f32x4 (&acc)[4][4]) {
#pragma unroll
  for (int ks = 0; ks < 2; ++ks) {
    bf16x8 af[4], bfr[4];
    const int ch = ((ks * 4 + fq) ^ sw) << 4;
#pragma unroll
    for (int m = 0; m < 4; ++m) af[m] = *(const bf16x8*)(cur + aoff + m * 2048 + ch);
#pragma unroll
    for (int n = 0; n < 4; ++n) bfr[n] = *(const bf16x8*)(cur + boff + n * 2048 + ch);
    __builtin_amdgcn_s_setprio(1);
#pragma unroll
    for (int m = 0; m < 4; ++m)
#pragma unroll
      for (int n = 0; n < 4; ++n)
        acc[m][n] = SWAP ? mfma16(bfr[n], af[m], acc[m][n]) : mfma16(af[m], bfr[n], acc[m][n]);
    __builtin_amdgcn_s_setprio(0);
  }
}

template <bool SWAP>
__device__ __forceinline__ void gemm_mainloop(const bf16_t* A, const bf16_t* B,
                                              int row0, int col0, int K, char* lds, f32x4 (&acc)[4][4]) {
  int tid_o = threadIdx.x; asm volatile("" : "+v"(tid_o)); const int tid = tid_o, lane = tid & 63, wave = tid >> 6;
  const int wm = wave >> 1, wn = wave & 1, fr = lane & 15, fq = lane >> 4;
  const int lrow = tid >> 3, lc = tid & 7;
  const int cl = lc ^ (lrow & 7);
  const bf16_t* ga = A + (size_t)(row0 + lrow) * K + cl * 8;
  const bf16_t* gb = B + (size_t)(col0 + lrow) * K + cl * 8;
  const int loff = tid * 16;
#define G_STAGE(BUF, KT) { _Pragma("unroll") for (int i = 0; i < 4; ++i) { \
      __builtin_amdgcn_global_load_lds((const unsigned*)(ga + (size_t)i * 32 * K + (KT) * 64), (unsigned*)((BUF) + loff + i * 4096), 16, 0, 0); \
      __builtin_amdgcn_global_load_lds((const unsigned*)(gb + (size_t)i * 32 * K + (KT) * 64), (unsigned*)((BUF) + 16384 + loff + i * 4096), 16, 0, 0); } }
  const int nkt = K >> 6;
  G_STAGE(lds, 0);
  __syncthreads();
  const int aoff = (wm * 64 + fr) * 128, boff = 16384 + (wn * 64 + fr) * 128;
  const int sw = fr & 7;
  for (int kt = 0; kt < nkt; ++kt) {
    char* cur = lds + (kt & 1) * 32768;
    char* nxt = lds + ((kt + 1) & 1) * 32768;
    if (kt + 1 < nkt) G_STAGE(nxt, kt + 1);
    gemm_compute_tile<SWAP>(cur, aoff, boff, sw, fq, acc);
    __syncthreads();
  }
#undef G_STAGE
}

template <int MT, bool SWAP>
__device__ __forceinline__ void gemm_mainloop_big(const bf16_t* A, const bf16_t* B,
                                                  int row0, int col0, int K, char* lds, f32x4 (&acc)[MT][4]) {
  int tid_o = threadIdx.x; asm volatile("" : "+v"(tid_o)); const int tid = tid_o, lane = tid & 63, wave = tid >> 6;
  const int wm = wave >> 1, wn = wave & 1, fr = lane & 15, fq = lane >> 4;
  const int lrow = tid >> 3, lc = tid & 7;
  const int cl = lc ^ (lrow & 7);
  const bf16_t* ga = A + (size_t)(row0 + lrow) * K + cl * 8;
  const bf16_t* gb = B + (size_t)(col0 + lrow) * K + cl * 8;
  const int loff = tid * 16;
  const int nkt = K >> 6;
  constexpr int BOFF = MT * 32 * 128;
  const int aoff = (wm * (MT * 16) + fr) * 128, boff = BOFF + (wn * 64 + fr) * 128;
  const int sw = fr & 7;
  for (int kt = 0; kt < nkt; ++kt) {
#pragma unroll
    for (int i = 0; i < MT; ++i)
      __builtin_amdgcn_global_load_lds((const unsigned*)(ga + (size_t)i * 32 * K + kt * 64), (unsigned*)(lds + loff + i * 4096), 16, 0, 0);
#pragma unroll
    for (int i = 0; i < 4; ++i)
      __builtin_amdgcn_global_load_lds((const unsigned*)(gb + (size_t)i * 32 * K + kt * 64), (unsigned*)(lds + BOFF + loff + i * 4096), 16, 0, 0);
    __syncthreads();
#pragma unroll
    for (int ks = 0; ks < 2; ++ks) {
      bf16x8 af[MT], bfr[4];
      const int ch = ((ks * 4 + fq) ^ sw) << 4;
#pragma unroll
      for (int m = 0; m < MT; ++m) af[m] = *(const bf16x8*)(lds + aoff + m * 2048 + ch);
#pragma unroll
      for (int n = 0; n < 4; ++n) bfr[n] = *(const bf16x8*)(lds + boff + n * 2048 + ch);
      __builtin_amdgcn_s_setprio(1);
#pragma unroll
      for (int m = 0; m < MT; ++m)
#pragma unroll
        for (int n = 0; n < 4; ++n)
          acc[m][n] = SWAP ? mfma16(bfr[n], af[m], acc[m][n]) : mfma16(af[m], bfr[n], acc[m][n]);
      __builtin_amdgcn_s_setprio(0);
    }
    __syncthreads();
  }
}

template <bool SWAP>
__device__ void gemm1_tile(const Params& p, int mt, int nt, char* lds) {
  f32x4 acc[8][4];
#pragma unroll
  for (int m = 0; m < 8; ++m)
#pragma unroll
    for (int n = 0; n < 4; ++n) acc[m][n] = (f32x4){0.f, 0.f, 0.f, 0.f};
  gemm_mainloop_big<8, SWAP>((const bf16_t*)(p.ws + OFF_XB), (const bf16_t*)(p.ws + OFF_WINT), mt * 256, nt * 128, 2048, lds, acc);
  int tidv = threadIdx.x; asm volatile("" : "+v"(tidv));
  const int tid = tidv, lane = tid & 63, wave = tid >> 6;
  const int wm = wave >> 1, wn = wave & 1, fr = lane & 15, fq = lane >> 4;
  const int seg = nt >> 3, h = nt & 7;
  const bool samp = (mt * 256 >= NPTOK);
  if (SWAP) {
    const float* LB = (const float*)(p.ws + OFF_LB);
    if (seg == 5 && !samp) {
      float nmax = 0.f;
#pragma unroll
      for (int m = 0; m < 8; ++m) {
        float s2 = 0.f;
#pragma unroll
        for (int n = 0; n < 4; ++n) s2 += acc[m][n].x * acc[m][n].x + acc[m][n].y * acc[m][n].y + acc[m][n].z * acc[m][n].z + acc[m][n].w * acc[m][n].w;
        s2 += __shfl_xor(s2, 16);
        s2 += __shfl_xor(s2, 32);
        nmax = fmaxf(nmax, s2);
      }
#pragma unroll
      for (int o = 8; o >= 1; o >>= 1) nmax = fmaxf(nmax, __shfl_xor(nmax, o));
      if (lane == 0) atomicMax((unsigned*)(p.ws + 256) + ((mt * 256) >> 12) * 16 + h * 2 + wn, __float_as_uint(nmax));
    }
#pragma unroll
    for (int m = 0; m < 8; ++m) {
      const int tok = mt * 256 + wm * 128 + m * 16 + fr;
#pragma unroll
      for (int n = 0; n < 4; ++n) {
        const int cl = wn * 64 + n * 16 + fq * 4;
        const int kidx = h * 128 + cl;
        f32x4 v = acc[m][n];
        if (seg == 0) {
          u32x2 o = {pk_bf16(v.x, v.y), pk_bf16(v.z, v.w)};
          *(u32x2*)((bf16_t*)(p.ws + OFF_QA) + (size_t)tok * 1024 + kidx) = o;
        } else if (seg == 1) {
          f32x4 lb = *(const f32x4*)(LB + kidx);
          f32x4 o;
          o.x = lb.x + (1.f - lb.x) / (1.f + __expf(-v.x));
          o.y = lb.y + (1.f - lb.y) / (1.f + __expf(-v.y));
          o.z = lb.z + (1.f - lb.z) / (1.f + __expf(-v.z));
          o.w = lb.w + (1.f - lb.w) / (1.f + __expf(-v.w));
          *(f32x4*)((float*)(p.ws + OFF_LOGF) + (size_t)tok * 1024 + kidx) = o;
        } else if (seg == 3) {
          float s0 = 1.f / (1.f + __expf(-v.x)), s1 = 1.f / (1.f + __expf(-v.y));
          float s2 = 1.f / (1.f + __expf(-v.z)), s3 = 1.f / (1.f + __expf(-v.w));
          u32x2 o = {pk_bf16(s0, s1), pk_bf16(s2, s3)};
          *(u32x2*)((bf16_t*)(p.ws + OFF_GA) + (size_t)tok * 1024 + kidx) = o;
        } else if (seg == 4) {
          const float sc = 0.18033688011112042f;
          u32x2 o = {pk_bf16(v.x * sc, v.y * sc), pk_bf16(v.z * sc, v.w * sc)};
          *(u32x2*)((bf16_t*)(p.ws + OFF_QB) + (size_t)tok * 1024 + kidx) = o;
        } else {
          u32x2 o = {pk_bf16(v.x, v.y), pk_bf16(v.z, v.w)};
          if (!samp) {
            __builtin_nontemporal_store(v, (f32x4*)(p.out + OUT_KP + (size_t)tok * 1024 + kidx));
            const int b = tok >> 12, t = tok & 4095;
            *(u32x2*)((bf16_t*)(p.ws + OFF_KP) + ((size_t)((b * 8 + h) * 4096 + t) * 128 + cl)) = o;
          } else {
            const int ts = tok - NPTOK;
            __builtin_nontemporal_store(v, (f32x4*)(p.out + OUT_KS + (size_t)ts * 1024 + kidx));
            const int b = ts >> 6, t = ts & 63;
            *(u32x2*)((bf16_t*)(p.ws + OFF_KS) + ((size_t)((b * 8 + h) * 1088 + 1024 + t) * 128 + cl)) = o;
          }
        }
      }
    }
  } else {
#pragma unroll
    for (int m = 0; m < 8; ++m) {
      const int tok0 = mt * 256 + wm * 128 + m * 16 + fq * 4;
#pragma unroll
      for (int n = 0; n < 4; ++n) {
        const int cl = wn * 64 + n * 16 + fr;
        f32x4 v = acc[m][n];
        u32x2 o = {pk_bf16(v.x, v.y), pk_bf16(v.z, v.w)};
        if (seg == 2) {
          bf16_t* IAT = (bf16_t*)(p.ws + OFF_IAT);
          if (!samp) {
            const int b = tok0 >> 12, t = tok0 & 4095;
            *(u32x2*)(IAT + ((size_t)((b * 8 + h) * 128 + cl) * 4096 + t)) = o;
          } else {
            const int ts = tok0 - NPTOK, b = ts >> 6, t = ts & 63;
            *(u32x2*)(IAT + (size_t)32 * 128 * 4096 + ((size_t)((b * 8 + h) * 128 + cl) * 64 + t)) = o;
          }
        } else {
          if (!samp) {
            float* ov = p.out + OUT_VP + (size_t)tok0 * 1024 + h * 128 + cl;
            __builtin_nontemporal_store(v.x, ov); __builtin_nontemporal_store(v.y, ov + 1024); __builtin_nontemporal_store(v.z, ov + 2048); __builtin_nontemporal_store(v.w, ov + 3072);
            const int b = tok0 >> 12, t = tok0 & 4095;
            *(u32x2*)((bf16_t*)(p.ws + OFF_VTP) + ((size_t)((b * 8 + h) * 128 + cl) * 4096 + t)) = o;
          } else {
            const int ts = tok0 - NPTOK, b = ts >> 6, t = ts & 63;
            float* ov = p.out + OUT_VS + (size_t)ts * 1024 + h * 128 + cl;
            __builtin_nontemporal_store(v.x, ov); __builtin_nontemporal_store(v.y, ov + 1024); __builtin_nontemporal_store(v.z, ov + 2048); __builtin_nontemporal_store(v.w, ov + 3072);
            *(u32x2*)((bf16_t*)(p.ws + OFF_VTS) + ((size_t)((b * 8 + h) * 128 + cl) * 1088 + 1024 + t)) = o;
          }
        }
      }
    }
  }
}

__device__ void phase1(const Params& p, char* lds) {
  const int xcd = blockIdx.x & 7, lb = blockIdx.x >> 3, nbx = gridDim.x >> 3;
  const int nM = NTOK / 256, nNx = 7;
  for (int li = lb; li < nM * nNx; li += nbx) {
    const int mt = li / nNx, nt = (li % nNx) * 8 + xcd;
    const int seg = nt >> 3;
    if (seg == 2 || seg == 6) gemm1_tile<false>(p, mt, nt, lds);
    else gemm1_tile<true>(p, mt, nt, lds);
  }
}

template <int MODE, int MT>
__device__ void gemm23_tile(const Params& p, int row0, int nt, char* lds) {
  const bf16_t* A = (const bf16_t*)(p.ws + (MODE == 0 ? OFF_MERGED : OFF_X1B));
  const bf16_t* B = (const bf16_t*)(p.ws + (MODE == 0 ? OFF_WOUTT : OFF_WQT));
  f32x4 acc[MT][4];
#pragma unroll
  for (int m = 0; m < MT; ++m)
#pragma unroll
    for (int n = 0; n < 4; ++n) acc[m][n] = (f32x4){0.f, 0.f, 0.f, 0.f};
  if (MT == 4) gemm_mainloop<true>(A, B, row0, nt * 128, 2048, lds, (f32x4(&)[4][4])acc);
  else gemm_mainloop_big<MT, true>(A, B, row0, nt * 128, 2048, lds, acc);
  int tid_o = threadIdx.x; asm volatile("" : "+v"(tid_o)); const int tid = tid_o, lane = tid & 63, wave = tid >> 6;
  const int wm = wave >> 1, wn = wave & 1, fr = lane & 15, fq = lane >> 4;
#pragma unroll
  for (int m = 0; m < MT; ++m) {
    const int tok = row0 + wm * (MT * 16) + m * 16 + fr;
#pragma unroll
    for (int n = 0; n < 4; ++n) {
      const int col = nt * 128 + wn * 64 + n * 16 + fq * 4;
      f32x4 v = acc[m][n];
      if (MODE == 0) {
        const float* xin = (tok < NPTOK) ? (p.x_prompt + (size_t)tok * 2048) : (p.x_sample + (size_t)(tok - NPTOK) * 2048);
        f32x4 xv = *(const f32x4*)(xin + col);
        const float al = 1.189207115002721f;
        u32x2 o = {pk_bf16(al * xv.x + v.x, al * xv.y + v.y), pk_bf16(al * xv.z + v.z, al * xv.w + v.w)};
        *(u32x2*)((bf16_t*)(p.ws + OFF_X1B) + (size_t)tok * 2048 + col) = o;
      } else {
        u32x2 o = {pk_bf16(v.x, v.y), pk_bf16(v.z, v.w)};
        *(u32x2*)((bf16_t*)(p.ws + OFF_QP) + (size_t)tok * 2048 + col) = o;
      }
    }
  }
}

template <int MODE>
__device__ void gemm23(const Params& p, char* lds) {
  const int xcd = blockIdx.x & 7, lb = blockIdx.x >> 3, nbx = gridDim.x >> 3;
  for (int li = lb; li < 64 * 2; li += nbx) gemm23_tile<MODE, 8>(p, (li >> 1) * 256, (li & 1) * 8 + xcd, lds);
  for (int li = lb; li < 4 * 2; li += nbx) gemm23_tile<MODE, 4>(p, NPTOK + (li >> 1) * 128, (li & 1) * 8 + xcd, lds);
}

__device__ void hgrn_item(const Params& p, int kind, int b, int h, char* lds, int mode, int c0) {
  int tid_o = threadIdx.x; asm volatile("" : "+v"(tid_o)); const int tid = tid_o, lane = tid & 63, w = tid >> 6, fr = lane & 15, fq = lane >> 4;
  const int tokbase = kind == 0 ? b * 4096 : NPTOK + b * 64;
  const int c_begin = mode == 0 ? 0 : c0, nch = mode == 0 ? (kind == 0 ? 64 : 1) : c0 + 1;
  u32x2* LSb = (u32x2*)(p.ws + OFF_LS) + ((size_t)((b * 8 + h) * 64 + c0) * 16) * 256 + tid;
  const bf16_t* IATb = (const bf16_t*)(p.ws + OFF_IAT) +
      (kind == 0 ? (size_t)((b * 8 + h) * 128) * 4096 : (size_t)32 * 128 * 4096 + (size_t)((b * 8 + h) * 128) * 64);
  const int iat_stride = kind == 0 ? 4096 : 64;
  const float* LOGF = (const float*)(p.ws + OFF_LOGF);
  const bf16_t* QA = (const bf16_t*)(p.ws + OFF_QA);
  const bf16_t* GA = (const bf16_t*)(p.ws + OFF_GA);
  bf16_t* MERGED = (bf16_t*)(p.ws + OFF_MERGED);

  f32x4 S[8][2];
  if (mode == 2) {
#pragma unroll
    for (int kt = 0; kt < 8; ++kt)
#pragma unroll
      for (int vv = 0; vv < 2; ++vv) {
        u32x2 t = LSb[(kt * 2 + vv) * 256];
        S[kt][vv] = (f32x4){bflo(t.x), bfhi(t.x), bflo(t.y), bfhi(t.y)};
      }
  } else if (kind == 0) {
#pragma unroll
    for (int kt = 0; kt < 8; ++kt)
#pragma unroll
      for (int vv = 0; vv < 2; ++vv) S[kt][vv] = (f32x4){0.f, 0.f, 0.f, 0.f};
  } else {
    const float* st = p.state + (size_t)((b * 8 + h) * 128) * 128 + (4 * fq) * 128 + 32 * w + fr;
#pragma unroll
    for (int kt = 0; kt < 8; ++kt)
#pragma unroll
      for (int vv = 0; vv < 2; ++vv)
#pragma unroll
        for (int j = 0; j < 4; ++j) S[kt][vv][j] = st[(16 * kt + j) * 128 + 16 * vv];
  }
  f32x4 gn[2];
#pragma unroll
  for (int vv = 0; vv < 2; ++vv) gn[vv] = *(const f32x4*)(p.hgrn_g + 32 * w + 16 * vv + 4 * fq);

  const int ekp = tid & 63, eq = tid >> 6;

  u32x4 gR[8];
  unsigned qn[16];
#pragma unroll
  for (int i = 0; i < 8; ++i) {
    int id = tid + 256 * i, row = id >> 5, cc = id & 31;
    gR[i] = *(const u32x4*)(LOGF + (size_t)(tokbase + c_begin * 64 + row) * 1024 + h * 128 + cc * 4);
  }
#pragma unroll
  for (int i = 0; i < 16; ++i) qn[i] = *(const unsigned*)(QA + (size_t)(tokbase + c_begin * 64 + 16 * eq + i) * 1024 + h * 128 + 2 * ekp);
  for (int c = c_begin; c < nch; ++c) {
    int zz = 0; asm volatile("" : "+v"(zz));
    int tidv = threadIdx.x; asm volatile("" : "+v"(tidv));
    const int tid = tidv, lane = tid & 63, w = tid >> 6, fr = lane & 15, fq = lane >> 4, ekp = tid & 63, eq = tid >> 6;
    char* L = lds + zz;
    float* Dl = (float*)(L + 57344);
    float* part = (float*)(L + 57856);
    const int tok0 = tokbase + c * 64 + zz;
#pragma unroll
    for (int i = 0; i < 8; ++i) {
      int id = tid + 256 * i, row = id >> 5, cc = id & 31;
      *(u32x4*)(L + row * 512 + cc * 16) = gR[i];
    }
    unsigned qv[16];
#pragma unroll
    for (int i = 0; i < 16; ++i) qv[i] = qn[i];
    if (c + 1 < nch) {
#pragma unroll
      for (int i = 0; i < 8; ++i) {
        int id = tid + 256 * i, row = id >> 5, cc = id & 31;
        gR[i] = *(const u32x4*)(LOGF + (size_t)(tok0 + 64 + row) * 1024 + h * 128 + cc * 4);
      }
    }
    bf16x8 vfr[2][2];
#pragma unroll
    for (int ss = 0; ss < 2; ++ss)
#pragma unroll
      for (int vv = 0; vv < 2; ++vv)
        vfr[ss][vv] = *(const bf16x8*)(IATb + (size_t)(32 * w + 16 * vv + fr) * iat_stride + c * 64 + zz + 32 * ss + 8 * fq);
    __syncthreads();
    typedef float f32x2 __attribute__((ext_vector_type(2)));
    f32x2 gv[16];
    const float* Gl = (const float*)L;
    float* qtot = (float*)(L + 58880);
    float tot0 = 1.f, tot1 = 1.f;
#pragma unroll
    for (int i = 0; i < 16; ++i) { gv[i] = *(const f32x2*)(Gl + (16 * eq + i) * 128 + 2 * ekp); tot0 *= gv[i].x; tot1 *= gv[i].y; }
    qtot[eq * 128 + 2 * ekp] = tot0; qtot[eq * 128 + 2 * ekp + 1] = tot1;
    __syncthreads();
    {
      float run0 = 1.f, run1 = 1.f;
      for (int qq = 0; qq < eq; ++qq) { run0 *= qtot[qq * 128 + 2 * ekp]; run1 *= qtot[qq * 128 + 2 * ekp + 1]; }
      const int k0 = 2 * ekp;
#pragma unroll
      for (int i4 = 0; i4 < 4; ++i4) {
        float ka[4], kb[4];
#pragma unroll
        for (int ii = 0; ii < 4; ++ii) {
          const int i = i4 * 4 + ii, t = 16 * eq + i;
          const float f0 = gv[i].x, f1 = gv[i].y;
          run0 *= f0; run1 *= f1;
          const float q0 = bflo(qv[i]) * run0, q1 = bfhi(qv[i]) * run1;
          const float kk0 = (1.f - f0) * __builtin_amdgcn_rcpf(run0), kk1 = (1.f - f1) * __builtin_amdgcn_rcpf(run1);
          ka[ii] = kk0; kb[ii] = kk1;
          const int o = (t * 128 + ((((k0 >> 3) ^ (t & 15)) << 3) | (k0 & 7))) * 2;
          if (mode != 1) {
            *(unsigned*)(L + o) = pk_bf16(q0, q1);
            *(unsigned*)(L + 16384 + o) = pk_bf16(kk0, kk1);
          }
        }
        const int t0 = 16 * eq + i4 * 4;
        u32x2 oa = {pk_bf16(ka[0], ka[1]), pk_bf16(ka[2], ka[3])};
        u32x2 ob = {pk_bf16(kb[0], kb[1]), pk_bf16(kb[2], kb[3])};
        if (mode != 2) {
          *(u32x2*)(L + 32768 + k0 * 128 + ((((t0 >> 3) ^ (k0 & 7)) << 4) | ((t0 & 7) << 1))) = oa;
          *(u32x2*)(L + 32768 + (k0 + 1) * 128 + ((((t0 >> 3) ^ ((k0 + 1) & 7)) << 4) | ((t0 & 7) << 1))) = ob;
        }
      }
      if (eq == 3) { Dl[k0] = run0; Dl[k0 + 1] = run1; }
    }
    if (c + 1 < nch) {
#pragma unroll
      for (int i = 0; i < 16; ++i) qn[i] = *(const unsigned*)(QA + (size_t)(tok0 + 64 + 16 * eq + i) * 1024 + h * 128 + 2 * ekp);
    }
    __syncthreads();
    if (mode != 1) {
      bf16x8 qf[4];
#pragma unroll
      for (int ks = 0; ks < 4; ++ks) {
        const int t = 16 * w + fr;
        qf[ks] = *(const bf16x8*)(L + t * 256 + (((4 * ks + fq) ^ (t & 15)) << 4));
      }
#pragma unroll
      for (int st = 0; st < 4; ++st) {
        f32x4 a = {0.f, 0.f, 0.f, 0.f};
#pragma unroll
        for (int ks = 0; ks < 4; ++ks) {
          const int s = 16 * st + fr;
          bf16x8 kf = *(const bf16x8*)(L + 16384 + s * 256 + (((4 * ks + fq) ^ (s & 15)) << 4));
          a = mfma16(kf, qf[ks], a);
        }
        const int t = 16 * w + fr, s0 = 16 * st + 4 * fq;
        float p0 = (s0 + 0 <= t) ? a.x : 0.f, p1 = (s0 + 1 <= t) ? a.y : 0.f;
        float p2 = (s0 + 2 <= t) ? a.z : 0.f, p3 = (s0 + 3 <= t) ? a.w : 0.f;
        u32x2 o2 = {pk_bf16(p0, p1), pk_bf16(p2, p3)};
        *(u32x2*)(L + 49152 + t * 128 + ((((s0 >> 3) ^ (t & 7)) << 4) | ((s0 & 7) << 1))) = o2;
      }
    }
    f32x4 O[2][4];
#pragma unroll
    for (int vv = 0; vv < 2; ++vv)
#pragma unroll
      for (int tt = 0; tt < 4; ++tt) O[vv][tt] = (f32x4){0.f, 0.f, 0.f, 0.f};
    if (mode != 1) {
#pragma unroll
    for (int ks = 0; ks < 4; ++ks) {
      bf16x8 sf[2];
#pragma unroll
      for (int vv = 0; vv < 2; ++vv)
        sf[vv] = mk8(pk_bf16(S[2 * ks][vv].x, S[2 * ks][vv].y), pk_bf16(S[2 * ks][vv].z, S[2 * ks][vv].w),
                     pk_bf16(S[2 * ks + 1][vv].x, S[2 * ks + 1][vv].y), pk_bf16(S[2 * ks + 1][vv].z, S[2 * ks + 1][vv].w));
#pragma unroll
      for (int tt = 0; tt < 4; ++tt) {
        const int t = 16 * tt + fr;
        const int c0 = 4 * ks + (fq >> 1), c1 = 4 * ks + 2 + (fq >> 1);
        u32x2 q0 = *(const u32x2*)(L + t * 256 + ((c0 ^ (t & 15)) << 4) + ((fq & 1) << 3));
        u32x2 q1 = *(const u32x2*)(L + t * 256 + ((c1 ^ (t & 15)) << 4) + ((fq & 1) << 3));
        bf16x8 qp = mk8(q0, q1);
#pragma unroll
        for (int vv = 0; vv < 2; ++vv) O[vv][tt] = mfma16(sf[vv], qp, O[vv][tt]);
      }
    }
    }
    __syncthreads();
#pragma unroll
    for (int ss = 0; ss < 2; ++ss) {
      bf16x8 vf[2];
#pragma unroll
      for (int vv = 0; vv < 2; ++vv) vf[vv] = vfr[ss][vv];
      if (mode != 1) {
#pragma unroll
      for (int tt = 0; tt < 4; ++tt) {
        const int t = 16 * tt + fr;
        bf16x8 pf = *(const bf16x8*)(L + 49152 + t * 128 + (((4 * ss + fq) ^ (t & 7)) << 4));
#pragma unroll
        for (int vv = 0; vv < 2; ++vv) O[vv][tt] = mfma16(vf[vv], pf, O[vv][tt]);
      }
      }
      if (mode != 2) {
#pragma unroll
      for (int kt = 0; kt < 8; ++kt) {
        const int r = 16 * kt + fr;
        bf16x8 kf = *(const bf16x8*)(L + 32768 + r * 128 + (((4 * ss + fq) ^ (r & 7)) << 4));
#pragma unroll
        for (int vv = 0; vv < 2; ++vv) S[kt][vv] = mfma16(kf, vf[vv], S[kt][vv]);
      }
      }
    }
    if (mode != 2) {
#pragma unroll
    for (int kt = 0; kt < 8; ++kt) {
      f32x4 d = *(const f32x4*)(Dl + 16 * kt + 4 * fq);
#pragma unroll
      for (int vv = 0; vv < 2; ++vv) { S[kt][vv].x *= d.x; S[kt][vv].y *= d.y; S[kt][vv].z *= d.z; S[kt][vv].w *= d.w; }
    }
    }
    if (mode == 1 && tid < 128) ((float*)(p.ws + OFF_DBUF))[(size_t)((b * 8 + h) * 64 + c) * 128 + tid] = Dl[tid];
    if (mode != 1) {
#pragma unroll
    for (int tt = 0; tt < 4; ++tt) {
      float ss = 0.f;
#pragma unroll
      for (int vv = 0; vv < 2; ++vv) ss += O[vv][tt].x * O[vv][tt].x + O[vv][tt].y * O[vv][tt].y + O[vv][tt].z * O[vv][tt].z + O[vv][tt].w * O[vv][tt].w;
      ss += __shfl_xor(ss, 16);
      ss += __shfl_xor(ss, 32);
      if (fq == 0) part[w * 64 + 16 * tt + fr] = ss;
    }
    __syncthreads();
#pragma unroll
    for (int tt = 0; tt < 4; ++tt) {
      const int t = 16 * tt + fr;
      const float tot = part[t] + part[64 + t] + part[128 + t] + part[192 + t];
      const float r = rsqrtf(tot * (1.f / 128.f) + 1e-5f);
      const size_t tok = (size_t)(tok0 + t);
#pragma unroll
      for (int vv = 0; vv < 2; ++vv) {
        const int v0 = h * 128 + 32 * w + 16 * vv + 4 * fq;
        u32x2 gt = *(const u32x2*)(GA + tok * 1024 + v0);
        float o0 = O[vv][tt].x * r * gn[vv].x * bflo(gt.x);
        float o1 = O[vv][tt].y * r * gn[vv].y * bfhi(gt.x);
        float o2 = O[vv][tt].z * r * gn[vv].z * bflo(gt.y);
        float o3 = O[vv][tt].w * r * gn[vv].w * bfhi(gt.y);
        u32x2 ov = {pk_bf16(o0, o1), pk_bf16(o2, o3)};
        *(u32x2*)(MERGED + tok * 2048 + v0) = ov;
      }
    }
    }
    __syncthreads();
  }
  if (mode == 1) {
#pragma unroll
    for (int kt = 0; kt < 8; ++kt)
#pragma unroll
      for (int vv = 0; vv < 2; ++vv) {
        u32x2 t = {pk_bf16(S[kt][vv].x, S[kt][vv].y), pk_bf16(S[kt][vv].z, S[kt][vv].w)};
        LSb[(kt * 2 + vv) * 256] = t;
      }
    return;
  }
  if (mode == 2) return;
  int zq = 0; asm volatile("" : "+v"(zq));
  float* so = p.out + (kind == 0 ? OUT_SP : OUT_SS) + (size_t)((b * 8 + h) * 128) * 128 + (4 * fq) * 128 + 32 * w + fr + zq;
#pragma unroll
  for (int kt = 0; kt < 8; ++kt)
#pragma unroll
    for (int vv = 0; vv < 2; ++vv)
#pragma unroll
      for (int j = 0; j < 4; ++j) so[(16 * kt + j) * 128 + 16 * vv] = S[kt][vv][j];
}


__device__ void hgrn_scan_item(const Params& p, int chain, int kt) {
  int tid_o = threadIdx.x; asm volatile("" : "+v"(tid_o)); const int tid = tid_o, lane = tid & 63, w = tid >> 6, fr = lane & 15, fq = lane >> 4;
  u32x2* LS = (u32x2*)(p.ws + OFF_LS) + ((size_t)(chain * 64) * 16 + kt * 2) * 256 + tid;
  const float* DB = (const float*)(p.ws + OFF_DBUF) + (size_t)(chain * 64) * 128 + 16 * kt + 4 * fq;
  f32x4 S0 = {0.f, 0.f, 0.f, 0.f}, S1 = {0.f, 0.f, 0.f, 0.f};
#pragma unroll 1
  for (int c8 = 0; c8 < 64; c8 += 8) {
    u32x2 l0[8], l1[8];
    f32x4 d[8];
#pragma unroll
    for (int i = 0; i < 8; ++i) {
      l0[i] = LS[(size_t)(c8 + i) * 16 * 256];
      l1[i] = LS[(size_t)(c8 + i) * 16 * 256 + 256];
      d[i] = *(const f32x4*)(DB + (c8 + i) * 128);
    }
#pragma unroll
    for (int i = 0; i < 8; ++i) {
      u32x2 o0 = {pk_bf16(S0.x, S0.y), pk_bf16(S0.z, S0.w)}, o1 = {pk_bf16(S1.x, S1.y), pk_bf16(S1.z, S1.w)};
      LS[(size_t)(c8 + i) * 16 * 256] = o0; LS[(size_t)(c8 + i) * 16 * 256 + 256] = o1;
      S0.x = d[i].x * S0.x + bflo(l0[i].x); S0.y = d[i].y * S0.y + bfhi(l0[i].x); S0.z = d[i].z * S0.z + bflo(l0[i].y); S0.w = d[i].w * S0.w + bfhi(l0[i].y);
      S1.x = d[i].x * S1.x + bflo(l1[i].x); S1.y = d[i].y * S1.y + bfhi(l1[i].x); S1.z = d[i].z * S1.z + bflo(l1[i].y); S1.w = d[i].w * S1.w + bfhi(l1[i].y);
    }
  }
  float* so = p.out + OUT_SP + (size_t)(chain * 128) * 128 + (size_t)(16 * kt + 4 * fq) * 128 + 32 * w + fr;
  so[0] = S0.x; so[128] = S0.y; so[256] = S0.z; so[384] = S0.w;
  so[16] = S1.x; so[128 + 16] = S1.y; so[256 + 16] = S1.z; so[384 + 16] = S1.w;
}

__device__ void attn_item(const Params& p, int kind, int bh, int qt, char* lds) {
  int tid_o = threadIdx.x; asm volatile("" : "+v"(tid_o)); const int tid = tid_o, lane = tid & 63, w = tid >> 6, fr = lane & 15, fq = lane >> 4;
  const int b = bh >> 3, h = bh & 7;
  const int nkt = kind == 0 ? qt + 1 : 17;
  const int tok0 = kind == 0 ? b * 4096 + qt * 64 : NPTOK + b * 64;
  const int qpos0 = kind == 0 ? qt * 64 : 1024;
  const bf16_t* Kb = kind == 0 ? (const bf16_t*)(p.ws + OFF_KP) + (size_t)bh * 4096 * 128
                               : (const bf16_t*)(p.ws + OFF_KS) + (size_t)bh * 1088 * 128;
  const bf16_t* Vb = kind == 0 ? (const bf16_t*)(p.ws + OFF_VTP) + (size_t)bh * 128 * 4096
                               : (const bf16_t*)(p.ws + OFF_VTS) + (size_t)bh * 128 * 1088;
  const int vstride = kind == 0 ? 4096 : 1088;
  const float slope2 = exp2f(-(float)(h + 1)) * 1.4426950408889634f;

  const int tok = tok0 + 16 * w + fr;
  bf16x8 qf[4];
  {
    const bf16_t* qp = (const bf16_t*)(p.ws + OFF_QB) + (size_t)tok * 1024 + h * 128;
#pragma unroll
    for (int ks = 0; ks < 4; ++ks) qf[ks] = *(const bf16x8*)(qp + 32 * ks + 8 * fq);
  }
  const float qposf = (float)(qpos0 + 16 * w + fr);
  float qk[2];
#pragma unroll
  for (int m = 0; m < 2; ++m) {
    float s2 = 0.f;
#pragma unroll
    for (int ks2 = 0; ks2 < 2; ++ks2)
#pragma unroll
      for (int e = 0; e < 8; ++e) { const float qv = bf2f((unsigned short)qf[2 * m + ks2][e]); s2 += qv * qv; }
    s2 += __shfl_xor(s2, 16);
    s2 += __shfl_xor(s2, 32);
    const float kmax2 = kind == 0 ? __uint_as_float(((const unsigned*)(p.ws + 256))[b * 16 + h * 2 + m]) : 3.0e38f;
    qk[m] = sqrtf(s2) * sqrtf(kmax2) * 1.02f;
  }
  f32x4 O0[8], O1[8];
#pragma unroll
  for (int i = 0; i < 8; ++i) { O0[i] = (f32x4){0.f, 0.f, 0.f, 0.f}; O1[i] = (f32x4){0.f, 0.f, 0.f, 0.f}; }
  float mx[2] = {-1e30f, -1e30f}, ls[2] = {0.f, 0.f};

  u32x4 rk[4], rv[4];
  {
    const int kkey = tid >> 4, kc = tid & 15, vrow = tid >> 3, vc = tid & 7;
    const int kt = nkt - 1;
#pragma unroll
    for (int i = 0; i < 4; ++i) {
      rk[i] = *(const u32x4*)(Kb + (size_t)(kt * 64 + kkey + 16 * i) * 128 + kc * 8);
      rv[i] = *(const u32x4*)(Vb + (size_t)(vrow + 32 * i) * vstride + kt * 64 + vc * 8);
    }
#pragma unroll
    for (int i = 0; i < 4; ++i) {
      const int key = kkey + 16 * i;
      *(u32x4*)(lds + key * 256 + ((kc ^ (key & 15)) << 4)) = rk[i];
      const int r = vrow + 32 * i;
      *(u32x4*)(lds + 16384 + r * 128 + ((vc ^ ((r >> 1) & 7)) << 4)) = rv[i];
    }
    if (nkt > 1) {
#pragma unroll
      for (int i = 0; i < 4; ++i) {
        rk[i] = *(const u32x4*)(Kb + (size_t)((kt - 1) * 64 + kkey + 16 * i) * 128 + kc * 8);
        rv[i] = *(const u32x4*)(Vb + (size_t)(vrow + 32 * i) * vstride + (kt - 1) * 64 + vc * 8);
      }
    }
    __syncthreads();
  }
  for (int it = 0; it < nkt; ++it) {
    int zz = 0; asm volatile("" : "+v"(zz));
    int tidv = threadIdx.x; asm volatile("" : "+v"(tidv));
    const int tid = tidv, lane = tid & 63, w = tid >> 6, fr = lane & 15, fq = lane >> 4;
    const int kkey = tid >> 4, kc = tid & 15, vrow = tid >> 3, vc = tid & 7;
    const int kt = nkt - 1 - it;
    char* L = lds + zz + (it & 1) * 32768;
    char* Ln = lds + zz + ((it + 1) & 1) * 32768;
    if (it + 1 < nkt) {
#pragma unroll
      for (int i = 0; i < 4; ++i) {
        const int key = kkey + 16 * i;
        *(u32x4*)(Ln + key * 256 + ((kc ^ (key & 15)) << 4)) = rk[i];
        const int r = vrow + 32 * i;
        *(u32x4*)(Ln + 16384 + r * 128 + ((vc ^ ((r >> 1) & 7)) << 4)) = rv[i];
      }
    }
    if (it + 2 < nkt) {
#pragma unroll
      for (int i = 0; i < 4; ++i) {
        rk[i] = *(const u32x4*)(Kb + (size_t)((kt - 2) * 64 + zz + kkey + 16 * i) * 128 + kc * 8);
        rv[i] = *(const u32x4*)(Vb + (size_t)(vrow + 32 * i) * vstride + (kt - 2) * 64 + zz + vc * 8);
      }
    }
    const float kposf = (float)(kt * 64 + 4 * fq) - qposf;
    bf16x8 pf[2][2];
    bool live[2];
#pragma unroll
    for (int m = 0; m < 2; ++m) {
      f32x4 s[4];
#pragma unroll
      for (int k16 = 0; k16 < 4; ++k16) {
        s[k16] = (f32x4){0.f, 0.f, 0.f, 0.f};
        const int key = 16 * k16 + fr;
#pragma unroll
        for (int ks2 = 0; ks2 < 2; ++ks2) {
          bf16x8 kf = *(const bf16x8*)(L + key * 256 + (((8 * m + 4 * ks2 + fq) ^ (key & 15)) << 4));
          s[k16] = mfma16(kf, qf[2 * m + ks2], s[k16]);
        }
      }
      float tmax = -1e30f;
#pragma unroll
      for (int k16 = 0; k16 < 4; ++k16)
#pragma unroll
        for (int j = 0; j < 4; ++j) {
          const float d = kposf + (float)(16 * k16 + j);
          const float v = s[k16][j] - slope2 * fabsf(d);
          s[k16][j] = v;
          tmax = fmaxf(tmax, v);
        }
      tmax = fmaxf(tmax, __shfl_xor(tmax, 16));
      tmax = fmaxf(tmax, __shfl_xor(tmax, 32));
      live[m] = !__all(tmax - mx[m] < -40.f);
      if (live[m]) {
        const float mnew = fmaxf(mx[m], tmax);
        const float alpha = __builtin_amdgcn_exp2f(mx[m] - mnew);
        mx[m] = mnew;
        float psum = 0.f;
#pragma unroll
        for (int k16 = 0; k16 < 4; ++k16)
#pragma unroll
          for (int j = 0; j < 4; ++j) { const float e = __builtin_amdgcn_exp2f(s[k16][j] - mnew); s[k16][j] = e; psum += e; }
        ls[m] = ls[m] * alpha + psum;
        if (m == 0) {
#pragma unroll
          for (int i = 0; i < 8; ++i) { O0[i].x *= alpha; O0[i].y *= alpha; O0[i].z *= alpha; O0[i].w *= alpha; }
        } else {
#pragma unroll
          for (int i = 0; i < 8; ++i) { O1[i].x *= alpha; O1[i].y *= alpha; O1[i].z *= alpha; O1[i].w *= alpha; }
        }
#pragma unroll
        for (int ks = 0; ks < 2; ++ks)
          pf[m][ks] = mk8(pk_bf16(s[2 * ks].x, s[2 * ks].y), pk_bf16(s[2 * ks].z, s[2 * ks].w),
                          pk_bf16(s[2 * ks + 1].x, s[2 * ks + 1].y), pk_bf16(s[2 * ks + 1].z, s[2 * ks + 1].w));
      } else {
#pragma unroll
        for (int ks = 0; ks < 2; ++ks) pf[m][ks] = mk8(0u, 0u, 0u, 0u);
      }
    }
    if (live[0] || live[1]) {
#pragma unroll
      for (int vt = 0; vt < 8; ++vt) {
        const int r = 16 * vt + fr;
        const int rs = (r >> 1) & 7;
#pragma unroll
        for (int ks = 0; ks < 2; ++ks) {
          const int u0 = 8 * ks + fq, u1 = 8 * ks + 4 + fq;
          u32x2 a0 = *(const u32x2*)(L + 16384 + r * 128 + (((u0 >> 1) ^ rs) << 4) + ((u0 & 1) << 3));
          u32x2 a1 = *(const u32x2*)(L + 16384 + r * 128 + (((u1 >> 1) ^ rs) << 4) + ((u1 & 1) << 3));
          bf16x8 vf = mk8(a0, a1);
          O0[vt] = mfma16(vf, pf[0][ks], O0[vt]);
          O1[vt] = mfma16(vf, pf[1][ks], O1[vt]);
        }
      }
    }
    const float dmin = qposf - (float)((kt - 1) * 64 + 63);
    const bool done = (kind == 0) && (qk[0] - slope2 * dmin - mx[0] < -40.f) && (qk[1] - slope2 * dmin - mx[1] < -40.f);
    if (__syncthreads_and(done ? 1 : 0)) break;
  }
  float l0 = ls[0], l1 = ls[1];
  l0 += __shfl_xor(l0, 16); l0 += __shfl_xor(l0, 32);
  l1 += __shfl_xor(l1, 16); l1 += __shfl_xor(l1, 32);
  const float lam = ((const float*)(p.ws + OFF_CTR))[16];
  const float i0 = 1.f / l0, i1 = lam / l1;
  float ssq = 0.f;
#pragma unroll
  for (int vt = 0; vt < 8; ++vt) {
#pragma unroll
    for (int j = 0; j < 4; ++j) {
      const float o = O0[vt][j] * i0 - O1[vt][j] * i1;
      O0[vt][j] = o;
      ssq += o * o;
    }
  }
  ssq += __shfl_xor(ssq, 16);
  ssq += __shfl_xor(ssq, 32);
  const float r = rsqrtf(ssq * (1.f / 128.f) + 1e-5f) * 0.8f;
  bf16_t* mo = (bf16_t*)(p.ws + OFF_MERGED) + (size_t)tok * 2048 + 1024 + h * 128;
#pragma unroll
  for (int vt = 0; vt < 8; ++vt) {
    f32x4 g = *(const f32x4*)(p.diff_g + 16 * vt + 4 * fq);
    u32x2 ov = {pk_bf16(O0[vt].x * r * g.x, O0[vt].y * r * g.y), pk_bf16(O0[vt].z * r * g.z, O0[vt].w * r * g.w)};
    *(u32x2*)(mo + 16 * vt + 4 * fq) = ov;
  }
}


__device__ void quant_item(const Params& p, int item) {
  int tid_o = threadIdx.x; asm volatile("" : "+v"(tid_o)); const int tid = tid_o, lane = tid & 63, w = tid >> 6;
  unsigned char* U8 = (unsigned char*)(p.ws + OFF_UB);
  float* SCL = (float*)(p.ws + OFF_SCL);
  for (int rr = 0; rr < 16; ++rr) {
    const int row = item * 64 + rr * 4 + w;
    const float* srow = row < 16384 ? p.pu + (size_t)row * 2048 : p.pv + (size_t)(row - 16384) * 2048;
    f32x4 v[8];
    float am = 0.f;
#pragma unroll
    for (int i = 0; i < 8; ++i) {
      v[i] = __builtin_nontemporal_load((const f32x4*)(srow + 256 * i + lane * 4));
      am = fmaxf(fmaxf(am, fmaxf(fabsf(v[i].x), fabsf(v[i].y))), fmaxf(fabsf(v[i].z), fabsf(v[i].w)));
    }
#pragma unroll
    for (int o = 32; o >= 1; o >>= 1) am = fmaxf(am, __shfl_xor(am, o));
    const float sc = am > 0.f ? 224.f / am : 1.f;
    unsigned char* drow = U8 + (size_t)row * 2048;
#pragma unroll
    for (int i = 0; i < 8; ++i) {
      int pk = __builtin_amdgcn_cvt_pk_fp8_f32(v[i].x * sc, v[i].y * sc, 0, false);
      pk = __builtin_amdgcn_cvt_pk_fp8_f32(v[i].z * sc, v[i].w * sc, pk, true);
      *(int*)(drow + 256 * i + lane * 4) = pk;
    }
    if (lane == 0) SCL[row] = am > 0.f ? am * (1.f / 224.f) : 1.f;
  }
}

__device__ void phase2(const Params& p, char* lds, int rep, int par) {
  unsigned* ctr = (unsigned*)(p.ws + OFF_CTR) + rep;
  int* sitem = (int*)lds;
  const int nA = par ? 2048 : 0;
  for (;;) {
    __syncthreads();
    if (threadIdx.x == 0) *sitem = (int)atomicAdd(ctr, 1u);
    __syncthreads();
    int item = *sitem;
    __syncthreads();
    if (item >= nA + 2208) break;
    if (item < nA) { hgrn_item(p, 0, (item & 31) >> 3, item & 7, lds, 1, item >> 5); continue; }
    item -= nA;
    if (item < 96) {
      const int kind = item < 32 ? 0 : 1, ii = item < 32 ? item : item - 32;
      if (kind == 0 && par) continue;
      hgrn_item(p, kind, ii >> 3, ii & 7, lds, 0, 0);
    } else {
      const int kind = item < 160 ? 1 : 0, j = item - 160;
      attn_item(p, kind, kind ? item - 96 : (j & 31), kind ? 0 : 63 - (j >> 5), lds);
    }
  }
}

__device__ void phase2b(const Params& p) {
  for (int item = blockIdx.x; item < 256; item += gridDim.x) hgrn_scan_item(p, item >> 3, item & 7);
}

__device__ void phase2c(const Params& p, char* lds) {
  for (int item = blockIdx.x; item < 2048; item += gridDim.x) {
    __syncthreads();
    hgrn_item(p, 0, (item & 31) >> 3, item & 7, lds, 2, item >> 5);
  }
}

__device__ void phase4(const Params& p) {
  int tid_o = threadIdx.x; asm volatile("" : "+v"(tid_o)); const int tid = tid_o, lane = tid & 63, w = tid >> 6;
  bf16_t* X1B = (bf16_t*)(p.ws + OFF_X1B);
  for (int row = blockIdx.x * 4 + w; row < NTOK; row += gridDim.x * 4) {
    bf16_t* xr = X1B + (size_t)row * 2048;
    float v[4][8];
    float s = 0.f;
#pragma unroll
    for (int i = 0; i < 4; ++i) {
      u32x4 t = *(const u32x4*)(xr + 512 * i + lane * 8);
      v[i][0] = bflo(t.x); v[i][1] = bfhi(t.x); v[i][2] = bflo(t.y); v[i][3] = bfhi(t.y);
      v[i][4] = bflo(t.z); v[i][5] = bfhi(t.z); v[i][6] = bflo(t.w); v[i][7] = bfhi(t.w);
#pragma unroll
      for (int e = 0; e < 8; ++e) s += v[i][e];
    }
    s = wave_sum(s);
    const float mean = s * (1.f / 2048.f);
    float q = 0.f;
#pragma unroll
    for (int i = 0; i < 4; ++i)
#pragma unroll
      for (int e = 0; e < 8; ++e) { const float d = v[i][e] - mean; q += d * d; }
    q = wave_sum(q);
    const float rs = rsqrtf(q * (1.f / 2048.f) + 1e-5f);
#pragma unroll
    for (int i = 0; i < 4; ++i) {
      const int col = 512 * i + lane * 8;
      f32x4 g0 = *(const f32x4*)(p.ln1_g + col), g1 = *(const f32x4*)(p.ln1_g + col + 4);
      f32x4 b0 = *(const f32x4*)(p.ln1_b + col), b1 = *(const f32x4*)(p.ln1_b + col + 4);
      u32x4 o;
      o.x = pk_bf16((v[i][0] - mean) * rs * g0.x + b0.x, (v[i][1] - mean) * rs * g0.y + b0.y);
      o.y = pk_bf16((v[i][2] - mean) * rs * g0.z + b0.z, (v[i][3] - mean) * rs * g0.w + b0.w);
      o.z = pk_bf16((v[i][4] - mean) * rs * g1.x + b1.x, (v[i][5] - mean) * rs * g1.y + b1.y);
      o.w = pk_bf16((v[i][6] - mean) * rs * g1.z + b1.z, (v[i][7] - mean) * rs * g1.w + b1.w);
      *(u32x4*)(xr + col) = o;
    }
  }
}

__device__ __forceinline__ unsigned f2key(float f) {
  unsigned b = __float_as_uint(f);
  return (b & 0x80000000u) ? ~b : (b | 0x80000000u);
}
__device__ __forceinline__ float key2f(unsigned k) {
  unsigned b = (k & 0x80000000u) ? (k & 0x7fffffffu) : ~k;
  return __uint_as_float(b);
}

__device__ __forceinline__ unsigned row_allmax(unsigned x) {
  x = max(x, (unsigned)__builtin_amdgcn_update_dpp(0, (int)x, 0x121, 0xF, 0xF, false));
  x = max(x, (unsigned)__builtin_amdgcn_update_dpp(0, (int)x, 0x122, 0xF, 0xF, false));
  x = max(x, (unsigned)__builtin_amdgcn_update_dpp(0, (int)x, 0x124, 0xF, 0xF, false));
  x = max(x, (unsigned)__builtin_amdgcn_update_dpp(0, (int)x, 0x128, 0xF, 0xF, false));
  return x;
}
__device__ __forceinline__ float row_allsum(float x) {
  x += __int_as_float(__builtin_amdgcn_update_dpp(0, __float_as_int(x), 0x121, 0xF, 0xF, false));
  x += __int_as_float(__builtin_amdgcn_update_dpp(0, __float_as_int(x), 0x122, 0xF, 0xF, false));
  x += __int_as_float(__builtin_amdgcn_update_dpp(0, __float_as_int(x), 0x124, 0xF, 0xF, false));
  x += __int_as_float(__builtin_amdgcn_update_dpp(0, __float_as_int(x), 0x128, 0xF, 0xF, false));
  return x;
}
#define CE_DESC(a, b) { const unsigned _hi = max(a, b), _lo = min(a, b); a = _hi; b = _lo; }

__device__ void phase6(const Params& p, char* lds) {
  int tid_o = threadIdx.x; asm volatile("" : "+v"(tid_o)); const int tid = tid_o, lane = tid & 63, w = tid >> 6, fr = lane & 15, fq = lane >> 4;
  const bf16_t* QP = (const bf16_t*)(p.ws + OFF_QP);
  const bf16_t* SKB = (const bf16_t*)(p.ws + OFF_SKB);
  int* EIDX = (int*)(p.ws + OFF_EIDX);
  float* GATE = (float*)(p.ws + OFF_GATE);
  const bool qfirst = blockIdx.x >= (gridDim.x >> 1);
  if (qfirst) for (int qi = blockIdx.x; qi < 512; qi += gridDim.x) quant_item(p, qi);
  unsigned char* tbl = (unsigned char*)lds;
  __syncthreads();
  if (tid < 64) tbl[tid] = 0xFF;
  __syncthreads();
  {
    const int i = tid >> 4, j = tid & 15;
    if ((i + 1) * (j + 1) <= 16) {
      int rank = j;
      for (int ii = 0; ii < i; ++ii) rank += 16 / (ii + 1);
      tbl[rank] = (unsigned char)((i << 4) | j);
    }
  }
  __syncthreads();
  int pi[4], pj[4]; bool pvalid[4];
#pragma unroll
  for (int s = 0; s < 4; ++s) {
    const int pidx = fr + 16 * s;
    const unsigned code = tbl[pidx];
    pvalid[s] = (pidx < 50);
    pi[s] = pvalid[s] ? (int)(code >> 4) : 0;
    pj[s] = pvalid[s] ? (int)(code & 15) : 0;
  }
  const int rowbase = lane & 48;
  __syncthreads();
  {
    const int hh = blockIdx.x & 7;
#pragma unroll 1
    for (int c = 0; c < 2; ++c)
#pragma unroll 4
      for (int i = 0; i < 8; ++i) {
        const int id = tid + 256 * i, key = id >> 4, ch = id & 15;
        u32x4 v = *(const u32x4*)(SKB + (size_t)((hh * 2 + c) * 128 + key) * 128 + ch * 8);
        *(u32x4*)(lds + c * 32768 + key * 256 + ((ch ^ (key & 15)) << 4)) = v;
      }
  }
  __syncthreads();
  for (int item = blockIdx.x; item < 264 * 8; item += gridDim.x) {
    int zz = 0; asm volatile("" : "+v"(zz));
    const char* L = lds + zz;
    const int tile = item >> 3, h = item & 7;
    const int tok0 = tile * 64;
    unsigned Lst[2][4];
#pragma unroll
    for (int c = 0; c < 2; ++c) {
      unsigned K[8][4];
      {
        bf16x8 af[4];
        const bf16_t* qp = QP + (size_t)(tok0 + 16 * w + fr) * 2048 + h * 256 + c * 128;
#pragma unroll
        for (int ks = 0; ks < 4; ++ks) af[ks] = *(const bf16x8*)(qp + 32 * ks + 8 * fq);
#pragma unroll
        for (int kt = 0; kt < 8; ++kt) {
          f32x4 a = {0.f, 0.f, 0.f, 0.f};
#pragma unroll
          for (int ks = 0; ks < 4; ++ks) {
            const int key = 16 * kt + fr;
            bf16x8 bfr = *(const bf16x8*)(L + c * 32768 + key * 256 + (((4 * ks + fq) ^ (key & 15)) << 4));
            a = mfma16(af[ks], bfr, a);
          }
          const unsigned code = (unsigned)(127 - (16 * kt + fr));
#pragma unroll
          for (int j = 0; j < 4; ++j) K[kt][j] = (f2key(a[j]) & ~127u) | code;
        }
      }
#pragma unroll
      for (int j = 0; j < 4; ++j) {
        CE_DESC(K[0][j], K[1][j]); CE_DESC(K[2][j], K[3][j]); CE_DESC(K[4][j], K[5][j]); CE_DESC(K[6][j], K[7][j]);
        CE_DESC(K[0][j], K[2][j]); CE_DESC(K[1][j], K[3][j]); CE_DESC(K[4][j], K[6][j]); CE_DESC(K[5][j], K[7][j]);
        CE_DESC(K[1][j], K[2][j]); CE_DESC(K[5][j], K[6][j]); CE_DESC(K[0][j], K[4][j]); CE_DESC(K[3][j], K[7][j]);
        CE_DESC(K[1][j], K[5][j]); CE_DESC(K[2][j], K[6][j]);
        CE_DESC(K[1][j], K[4][j]); CE_DESC(K[3][j], K[6][j]);
        CE_DESC(K[2][j], K[4][j]); CE_DESC(K[3][j], K[5][j]);
        CE_DESC(K[3][j], K[4][j]);
      }
      unsigned best[4] = {0u, 0u, 0u, 0u};
#pragma unroll 1
      for (int it = 0; it < 16; ++it) {
#pragma unroll
        for (int j = 0; j < 4; ++j) {
          const unsigned rm = row_allmax(K[0][j]);
          const bool win = (K[0][j] == rm);
#pragma unroll
          for (int k = 0; k < 7; ++k) K[k][j] = win ? K[k + 1][j] : K[k][j];
          K[7][j] = win ? 0u : K[7][j];
          best[j] = (fr == it) ? rm : best[j];
        }
      }
#pragma unroll
      for (int j = 0; j < 4; ++j) Lst[c][j] = best[j];
    }
#pragma unroll
    for (int j = 0; j < 4; ++j) {
      unsigned C[4];
#pragma unroll
      for (int s = 0; s < 4; ++s) {
        const unsigned k0 = (unsigned)__shfl((int)Lst[0][j], rowbase + pi[s]);
        const unsigned k1 = (unsigned)__shfl((int)Lst[1][j], rowbase + pj[s]);
        const float sum = key2f(k0 & ~127u) + key2f(k1 & ~127u);
        C[s] = pvalid[s] ? ((f2key(sum) & ~255u) | (unsigned)(255 - (pi[s] * 16 + pj[s]))) : 0u;
      }
      CE_DESC(C[0], C[1]); CE_DESC(C[2], C[3]); CE_DESC(C[0], C[2]); CE_DESC(C[1], C[3]); CE_DESC(C[1], C[2]);
      unsigned sel = 0u;
#pragma unroll 1
      for (int it = 0; it < 16; ++it) {
        const unsigned rm = row_allmax(C[0]);
        const bool win = (C[0] == rm);
        C[0] = win ? C[1] : C[0]; C[1] = win ? C[2] : C[1]; C[2] = win ? C[3] : C[2]; C[3] = win ? 0u : C[3];
        sel = (fr == it) ? rm : sel;
      }
      const float cv = key2f(sel & ~255u);
      const float cmax = __shfl(cv, rowbase);
      const float e = __expf(cv - cmax);
      const float g = e / row_allsum(e);
      const int flat = 255 - (int)(sel & 255u);
      const unsigned l0 = (unsigned)__shfl((int)Lst[0][j], rowbase + (flat >> 4));
      const unsigned l1 = (unsigned)__shfl((int)Lst[1][j], rowbase + (flat & 15));
      const int eidx = (127 - (int)(l0 & 127u)) * 128 + (127 - (int)(l1 & 127u));
      const size_t ob = ((size_t)(tok0 + 16 * w + 4 * fq + j) * 8 + h) * 16 + fr;
      EIDX[ob] = eidx;
      GATE[ob] = g;
    }
  }
  if (!qfirst) for (int qi = blockIdx.x; qi < 512; qi += gridDim.x) quant_item(p, qi);
}

__device__ __forceinline__ float dot16_fp8(u32x4 r, const float* x) {
  float d = 0.f;
  f32x2_t a;
  a = __builtin_amdgcn_cvt_pk_f32_fp8((int)r.x, false); d += a.x * x[0] + a.y * x[1];
  a = __builtin_amdgcn_cvt_pk_f32_fp8((int)r.x, true);  d += a.x * x[2] + a.y * x[3];
  a = __builtin_amdgcn_cvt_pk_f32_fp8((int)r.y, false); d += a.x * x[4] + a.y * x[5];
  a = __builtin_amdgcn_cvt_pk_f32_fp8((int)r.y, true);  d += a.x * x[6] + a.y * x[7];
  a = __builtin_amdgcn_cvt_pk_f32_fp8((int)r.z, false); d += a.x * x[8] + a.y * x[9];
  a = __builtin_amdgcn_cvt_pk_f32_fp8((int)r.z, true);  d += a.x * x[10] + a.y * x[11];
  a = __builtin_amdgcn_cvt_pk_f32_fp8((int)r.w, false); d += a.x * x[12] + a.y * x[13];
  a = __builtin_amdgcn_cvt_pk_f32_fp8((int)r.w, true);  d += a.x * x[14] + a.y * x[15];
  return d;
}
__device__ __forceinline__ void axpy16_fp8(u32x4 r, float w, float* acc) {
  f32x2_t a;
  a = __builtin_amdgcn_cvt_pk_f32_fp8((int)r.x, false); acc[0] += w * a.x; acc[1] += w * a.y;
  a = __builtin_amdgcn_cvt_pk_f32_fp8((int)r.x, true);  acc[2] += w * a.x; acc[3] += w * a.y;
  a = __builtin_amdgcn_cvt_pk_f32_fp8((int)r.y, false); acc[4] += w * a.x; acc[5] += w * a.y;
  a = __builtin_amdgcn_cvt_pk_f32_fp8((int)r.y, true);  acc[6] += w * a.x; acc[7] += w * a.y;
  a = __builtin_amdgcn_cvt_pk_f32_fp8((int)r.z, false); acc[8] += w * a.x; acc[9] += w * a.y;
  a = __builtin_amdgcn_cvt_pk_f32_fp8((int)r.z, true);  acc[10] += w * a.x; acc[11] += w * a.y;
  a = __builtin_amdgcn_cvt_pk_f32_fp8((int)r.w, false); acc[12] += w * a.x; acc[13] += w * a.y;
  a = __builtin_amdgcn_cvt_pk_f32_fp8((int)r.w, true);  acc[14] += w * a.x; acc[15] += w * a.y;
}

__device__ void phase7(const Params& p, char* lds) {
  int tid_o = threadIdx.x; asm volatile("" : "+v"(tid_o)); const int tid = tid_o, lane = tid & 63, w = tid >> 6;
  const bf16_t* X1B = (const bf16_t*)(p.ws + OFF_X1B);
  const unsigned char* U8 = (const unsigned char*)(p.ws + OFF_UB);
  const unsigned char* V8 = (const unsigned char*)(p.ws + OFF_VB);
  const float* SCL = (const float*)(p.ws + OFF_SCL);
  const int* EIDX = (const int*)(p.ws + OFF_EIDX);
  const float* GATE = (const float*)(p.ws + OFF_GATE);
  float* wgt = (float*)lds;
  float* red = (float*)(lds + 1024);
  float* part = (float*)(lds + 2048);
  for (int tok = blockIdx.x; tok < NTOK; tok += gridDim.x) {
    int tidv = threadIdx.x; asm volatile("" : "+v"(tidv));
    const int tid = tidv, lane = tid & 63, w = tid >> 6;
    const bf16_t* xr = X1B + (size_t)tok * 2048;
    float xa[2][16];
#pragma unroll
    for (int j = 0; j < 2; ++j)
#pragma unroll
      for (int q = 0; q < 2; ++q) {
        u32x4 t = *(const u32x4*)(xr + 1024 * j + 16 * lane + 8 * q);
        xa[j][8 * q] = bflo(t.x); xa[j][8 * q + 1] = bfhi(t.x); xa[j][8 * q + 2] = bflo(t.y); xa[j][8 * q + 3] = bfhi(t.y);
        xa[j][8 * q + 4] = bflo(t.z); xa[j][8 * q + 5] = bfhi(t.z); xa[j][8 * q + 6] = bflo(t.w); xa[j][8 * q + 7] = bfhi(t.w);
      }
    __syncthreads();
#ifndef UR
#define UR 16
#endif
#ifndef VR
#define VR 16
#endif
#pragma unroll 1
    for (int k6 = 0; k6 < 32; k6 += UR) {
      u32x4 r[UR][2];
      int ee[UR];
#pragma unroll
      for (int kk = 0; kk < UR; ++kk) {
        const int kq = (k6 + kk < 32) ? (k6 + kk) : 31;
        ee[kk] = __builtin_amdgcn_readfirstlane(EIDX[(size_t)tok * 128 + w * 32 + kq]);
        const unsigned char* ur = U8 + (size_t)ee[kk] * 2048 + lane * 16;
        r[kk][0] = *(const u32x4*)ur;
        r[kk][1] = *(const u32x4*)(ur + 1024);
      }
      float dot[UR];
#pragma unroll
      for (int kk = 0; kk < UR; ++kk) dot[kk] = dot16_fp8(r[kk][0], xa[0]) + dot16_fp8(r[kk][1], xa[1]);
#pragma unroll
      for (int o = 32; o >= 1; o >>= 1) {
#pragma unroll
        for (int kk = 0; kk < UR; ++kk) dot[kk] += __shfl_xor(dot[kk], o);
      }
      if (lane < UR && k6 + lane < 32) {
        float a = dot[0]; int e = ee[0];
#pragma unroll
        for (int kk = 1; kk < UR; ++kk) { if (lane == kk) { a = dot[kk]; e = ee[kk]; } }
        const int k = w * 32 + k6 + lane;
        a *= SCL[e];
        const float ge = 0.5f * a * (1.f + erff(a * 0.70710678118654752f));
        wgt[k] = GATE[(size_t)tok * 128 + k] * ge * SCL[16384 + e];
      }
    }
    __syncthreads();
#pragma unroll 1
    for (int j = 0; j < 2; ++j) {
      float acc[16];
#pragma unroll
      for (int q = 0; q < 16; ++q) acc[q] = 0.f;
#pragma unroll 1
      for (int k6 = 0; k6 < 32; k6 += VR) {
        u32x4 r[VR];
        float ww[VR];
#pragma unroll
        for (int kk = 0; kk < VR; ++kk) {
          const int kq = (k6 + kk < 32) ? (k6 + kk) : 31;
          const int k = w * 32 + kq;
          const int e = __builtin_amdgcn_readfirstlane(EIDX[(size_t)tok * 128 + k]);
          ww[kk] = (k6 + kk < 32) ? wgt[k] : 0.f;
          r[kk] = *(const u32x4*)(V8 + (size_t)e * 2048 + 1024 * j + lane * 16);
        }
#pragma unroll
        for (int kk = 0; kk < VR; ++kk) axpy16_fp8(r[kk], ww[kk], acc);
      }
#pragma unroll
      for (int q = 0; q < 4; ++q)
        *(f32x4*)(part + w * 2048 + 1024 * j + 16 * lane + 4 * q) = (f32x4){acc[4 * q], acc[4 * q + 1], acc[4 * q + 2], acc[4 * q + 3]};
    }
    __syncthreads();
    const float al = 1.189207115002721f;
    const u32x4 xt = *(const u32x4*)(xr + tid * 8);
    f32x4 x0 = {bflo(xt.x), bfhi(xt.x), bflo(xt.y), bfhi(xt.y)}, x1 = {bflo(xt.z), bfhi(xt.z), bflo(xt.w), bfhi(xt.w)};
    f32x4 s0 = {0.f, 0.f, 0.f, 0.f}, s1 = {0.f, 0.f, 0.f, 0.f};
#pragma unroll
    for (int ww2 = 0; ww2 < 4; ++ww2) {
      f32x4 a0 = *(const f32x4*)(part + ww2 * 2048 + tid * 8), a1 = *(const f32x4*)(part + ww2 * 2048 + tid * 8 + 4);
      s0.x += a0.x; s0.y += a0.y; s0.z += a0.z; s0.w += a0.w; s1.x += a1.x; s1.y += a1.y; s1.z += a1.z; s1.w += a1.w;
    }
    float val[8] = {al * x0.x + s0.x, al * x0.y + s0.y, al * x0.z + s0.z, al * x0.w + s0.w,
                    al * x1.x + s1.x, al * x1.y + s1.y, al * x1.z + s1.z, al * x1.w + s1.w};
    float s = 0.f;
#pragma unroll
    for (int j = 0; j < 8; ++j) s += val[j];
    s = wave_sum(s);
    if (lane == 0) red[w] = s;
    __syncthreads();
    const float mean = (red[0] + red[1] + red[2] + red[3]) * (1.f / 2048.f);
    float q = 0.f;
#pragma unroll
    for (int j = 0; j < 8; ++j) { const float d = val[j] - mean; q += d * d; }
    q = wave_sum(q);
    if (lane == 0) red[4 + w] = q;
    __syncthreads();
    const float rs = rsqrtf((red[4] + red[5] + red[6] + red[7]) * (1.f / 2048.f) + 1e-5f);
    f32x4 g0 = *(const f32x4*)(p.ln2_g + tid * 8), g1 = *(const f32x4*)(p.ln2_g + tid * 8 + 4);
    f32x4 b0 = *(const f32x4*)(p.ln2_b + tid * 8), b1 = *(const f32x4*)(p.ln2_b + tid * 8 + 4);
    f32x4 o0 = {(val[0] - mean) * rs * g0.x + b0.x, (val[1] - mean) * rs * g0.y + b0.y, (val[2] - mean) * rs * g0.z + b0.z, (val[3] - mean) * rs * g0.w + b0.w};
    f32x4 o1 = {(val[4] - mean) * rs * g1.x + b1.x, (val[5] - mean) * rs * g1.y + b1.y, (val[6] - mean) * rs * g1.z + b1.z, (val[7] - mean) * rs * g1.w + b1.w};
    float* yo = p.out + OUT_Y + (size_t)tok * 2048 + tid * 8;
    __builtin_nontemporal_store(o0, (f32x4*)yo);
    __builtin_nontemporal_store(o1, (f32x4*)(yo + 4));
  }
}

__device__ __forceinline__ void grid_bar(unsigned* ctr, unsigned target) {
  asm volatile("s_waitcnt vmcnt(0)" ::: "memory");
  __syncthreads();
  if (threadIdx.x == 0) {
    __builtin_amdgcn_fence(__ATOMIC_RELEASE, "agent");
    asm volatile("s_waitcnt vmcnt(0)" ::: "memory");
    __hip_atomic_fetch_add(ctr, 1u, __ATOMIC_RELAXED, __HIP_MEMORY_SCOPE_AGENT);
    while (__hip_atomic_load(ctr, __ATOMIC_RELAXED, __HIP_MEMORY_SCOPE_AGENT) < target) __builtin_amdgcn_s_sleep(2);
    __builtin_amdgcn_fence(__ATOMIC_ACQUIRE, "agent");
    asm volatile("s_waitcnt vmcnt(0)" ::: "memory");
  }
  __syncthreads();
}

__global__ void __launch_bounds__(256, 2) mega(Params p, int ph_lo, int ph_hi, int use_sync) {
  __shared__ __attribute__((aligned(16))) char lds[LDS_BYTES];
  cg::grid_group grid = cg::this_grid();
  unsigned nbar = 0;
#ifndef DUP_PHASE
#define DUP_PHASE -1
#endif
  const int par = (use_sync == 3);
  const int nph = par ? 10 : 8;
  for (int pi = 0; pi < nph; ++pi) {
    const int ph = par ? (pi < 3 ? pi : (pi < 5 ? pi + 5 : pi - 2)) : pi;
    const int reps = (ph == DUP_PHASE) ? 2 : 1;
    for (int rep = 0; rep < reps; ++rep) {
      switch (ph) {
        case 0: phase0(p, lds); break;
        case 1: phase1(p, lds); break;
        case 2: phase2(p, lds, rep, par); break;
        case 8: phase2b(p); break;
        case 9: phase2c(p, lds); break;
        case 3: gemm23<0>(p, lds); break;
        case 4: phase4(p); break;
        case 5: gemm23<1>(p, lds); break;
        case 6: phase6(p, lds); break;
        case 7: phase7(p, lds); break;
      }
      if (pi + 1 < nph || rep + 1 < reps) {
        if (use_sync == 2) grid.sync();
        else grid_bar((unsigned*)(p.ws + 128), (unsigned)gridDim.x * (++nbar));
      }
    }
  }
}

extern "C" void kernel_launch(void* const* d_in, const int* in_sizes, int n_in, void* d_out, int out_size,
                              void* d_ws, size_t ws_size, hipStream_t stream) {
  static int grid_blocks = 0;
  if (!grid_blocks) {
    int dev = 0, cus = 0, per_cu = 0;
    hipGetDevice(&dev);
    hipDeviceGetAttribute(&cus, hipDeviceAttributeMultiprocessorCount, dev);
    hipOccupancyMaxActiveBlocksPerMultiprocessor(&per_cu, mega, 256, 0);
    if (per_cu > 2) per_cu = 2;
    if (per_cu < 1) per_cu = 1;
    grid_blocks = cus * per_cu;
    grid_blocks &= ~7;
  }
  Params p{};
  p.x_prompt = (const float*)d_in[0]; p.x_sample = (const float*)d_in[1]; p.cache_k = (const float*)d_in[2];
  p.cache_v = (const float*)d_in[3]; p.state = (const float*)d_in[4]; p.w_in = (const float*)d_in[5];
  p.hgrn_lb = (const float*)d_in[6]; p.hgrn_g = (const float*)d_in[7]; p.lq1 = (const float*)d_in[8];
  p.lk1 = (const float*)d_in[9]; p.lq2 = (const float*)d_in[10]; p.lk2 = (const float*)d_in[11];
  p.diff_g = (const float*)d_in[12]; p.w_out = (const float*)d_in[13]; p.ln1_g = (const float*)d_in[14];
  p.ln1_b = (const float*)d_in[15]; p.wq = (const float*)d_in[16]; p.subk = (const float*)d_in[17];
  p.pu = (const float*)d_in[18]; p.pv = (const float*)d_in[19]; p.ln2_g = (const float*)d_in[20];
  p.ln2_b = (const float*)d_in[21];
  p.out = (float*)d_out; p.ws = (char*)d_ws;
  hipMemsetAsync(d_ws, 0, 512, stream);
  int lo = 0, hi = 7, us = 3;
  void* args[] = {&p, &lo, &hi, &us};
  hipError_t e = hipLaunchCooperativeKernel((const void*)mega, dim3(grid_blocks), dim3(256), args, 0, stream);
  if (e != hipSuccess) fprintf(stderr, "cooperative launch failed: %s (grid %d)\n", hipGetErrorString(e), grid_blocks);
}
```

```cpp
#include <hip/hip_runtime.h>
#include <hip/hip_cooperative_groups.h>
#include <stdint.h>
#include <cstdio>
namespace cg = cooperative_groups;

typedef unsigned short bf16_t;
typedef short bf16x8 __attribute__((ext_vector_type(8)));
typedef float f32x4 __attribute__((ext_vector_type(4)));
typedef unsigned u32x4 __attribute__((ext_vector_type(4)));
typedef unsigned u32x2 __attribute__((ext_vector_type(2)));

#define NTOK 16896
#define NPTOK 16384
#define LDS_BYTES 65536

#define OUT_Y   0
#define OUT_KP  34603008
#define OUT_VP  51380224
#define OUT_SP  68157440
#define OUT_KS  68681728
#define OUT_VS  69206016
#define OUT_SS  69730304

constexpr size_t SZ_XB     = (size_t)NTOK * 2048 * 2;
constexpr size_t SZ_T1K2   = (size_t)NTOK * 1024 * 2;
constexpr size_t SZ_W2     = (size_t)2048 * 2048 * 2;
constexpr size_t SZ_KS     = (size_t)64 * 1088 * 128 * 2;
constexpr size_t SZ_KP     = (size_t)32 * 4096 * 128 * 2;
constexpr size_t OFF_CTR   = 0;
constexpr size_t OFF_LB    = 4096;
constexpr size_t OFF_XB    = 8192;
constexpr size_t OFF_WINT  = OFF_XB + SZ_XB;
constexpr size_t OFF_WOUTT = OFF_WINT + (size_t)7168 * 2048 * 2;
constexpr size_t OFF_WQT   = OFF_WOUTT + SZ_W2;
constexpr size_t OFF_SKB   = OFF_WQT + SZ_W2;
constexpr size_t OFF_KS    = OFF_SKB + 524288;
constexpr size_t OFF_VTS   = OFF_KS + SZ_KS;
constexpr size_t OFF_R4    = OFF_VTS + SZ_KS;
constexpr size_t OFF_QA    = OFF_R4;
constexpr size_t OFF_LOGF  = OFF_QA + SZ_T1K2;
constexpr size_t OFF_IAT   = OFF_LOGF + 2 * SZ_T1K2;
constexpr size_t OFF_GA    = OFF_IAT + SZ_T1K2;
constexpr size_t OFF_QB    = OFF_GA + SZ_T1K2;
constexpr size_t OFF_KP    = OFF_QB + SZ_T1K2;
constexpr size_t OFF_VTP   = OFF_KP + SZ_KP;
constexpr size_t OFF_R4END = OFF_VTP + SZ_KP;
constexpr size_t OFF_X1F   = OFF_R4;
constexpr size_t OFF_UB    = OFF_XB;
constexpr size_t OFF_VB    = OFF_UB + (size_t)16384 * 2048;
constexpr size_t OFF_SCL   = OFF_VB + (size_t)16384 * 2048;
constexpr size_t OFF_MERGED= OFF_R4END;
constexpr size_t OFF_QP    = OFF_MERGED;
constexpr size_t OFF_X1B   = OFF_X1F + (size_t)NTOK * 2048 * 4;
constexpr size_t OFF_EIDX  = OFF_WINT;
constexpr size_t OFF_GATE  = OFF_EIDX + (size_t)NTOK * 128 * 4;
constexpr size_t OFF_DBUF  = OFF_WINT + (size_t)20 * 1024 * 1024;
constexpr size_t OFF_LS    = OFF_XB;
constexpr size_t WS_NEED_PAR = OFF_MERGED + SZ_XB;
static_assert((size_t)32 * 64 * 16 * 256 * 8 <= SZ_XB, "LS fits XB");
static_assert(OFF_SCL + 32768 * 4 <= OFF_WINT, "overlay"); static_assert(OFF_X1B + SZ_XB <= OFF_R4END, "overlay");

struct Params {
  const float* x_prompt; const float* x_sample; const float* cache_k; const float* cache_v; const float* state;
  const float* w_in; const float* hgrn_lb; const float* hgrn_g; const float* lq1; const float* lk1;
  const float* lq2; const float* lk2; const float* diff_g; const float* w_out; const float* ln1_g; const float* ln1_b;
  const float* wq; const float* subk; const float* pu; const float* pv; const float* ln2_g; const float* ln2_b;
  float* out; char* ws;
};

typedef __bf16 bf16x2_t __attribute__((ext_vector_type(2)));
typedef float f32x2_t __attribute__((ext_vector_type(2)));
__device__ __forceinline__ unsigned pk_bf16(float lo, float hi) {
  f32x2_t f = {lo, hi};
  bf16x2_t b = __builtin_convertvector(f, bf16x2_t);
  return __builtin_bit_cast(unsigned, b);
}
__device__ __forceinline__ float bf2f(unsigned short x) { return __uint_as_float(((unsigned)x) << 16); }
__device__ __forceinline__ float bflo(unsigned x) { return __uint_as_float(x << 16); }
__device__ __forceinline__ float bfhi(unsigned x) { return __uint_as_float(x & 0xffff0000u); }
__device__ __forceinline__ f32x4 mfma16(bf16x8 a, bf16x8 b, f32x4 c) {
  return __builtin_amdgcn_mfma_f32_16x16x32_bf16(a, b, c, 0, 0, 0);
}
__device__ __forceinline__ bf16x8 mk8(unsigned a, unsigned b, unsigned c, unsigned d) {
  u32x4 v = {a, b, c, d}; return __builtin_bit_cast(bf16x8, v);
}
__device__ __forceinline__ bf16x8 mk8(u32x2 a, u32x2 b) {
  u32x4 v = {a.x, a.y, b.x, b.y}; return __builtin_bit_cast(bf16x8, v);
}
__device__ __forceinline__ float wave_sum(float v) {
#pragma unroll
  for (int o = 32; o >= 1; o >>= 1) v += __shfl_xor(v, o);
  return v;
}

__device__ void transpose_conv(const float* __restrict__ W, bf16_t* __restrict__ WT, int K, int N, char* lds) {
  float* tile = (float*)lds;
  int tid_o = threadIdx.x; asm volatile("" : "+v"(tid_o)); const int tid = tid_o;
  const int nkt = K / 64, nnt = N / 64;
  for (int t = blockIdx.x; t < nkt * nnt; t += gridDim.x) {
    const int kt = t / nnt, nt = t % nnt;
    const int c = tid & 63, r0 = tid >> 6;
#pragma unroll 4
    for (int i = 0; i < 16; ++i) {
      int r = i * 4 + r0;
      tile[r * 65 + c] = W[(size_t)(kt * 64 + r) * N + nt * 64 + c];
    }
    __syncthreads();
#pragma unroll 4
    for (int i = 0; i < 16; ++i) {
      int n = i * 4 + r0;
      float v = tile[c * 65 + n];
      WT[(size_t)(nt * 64 + n) * K + kt * 64 + c] = (bf16_t)(pk_bf16(v, 0.f) & 0xffff);
    }
    __syncthreads();
  }
}

__device__ __forceinline__ void conv8(const float* __restrict__ src, bf16_t* __restrict__ dst) {
  f32x4 a = __builtin_nontemporal_load((const f32x4*)src), b = __builtin_nontemporal_load((const f32x4*)(src + 4));
  u32x4 o = {pk_bf16(a.x, a.y), pk_bf16(a.z, a.w), pk_bf16(b.x, b.y), pk_bf16(b.z, b.w)};
  *(u32x4*)dst = o;
}

__device__ void phase0(const Params& p, char* lds) {
  int tid_o = threadIdx.x; asm volatile("" : "+v"(tid_o)); const int tid = tid_o, bid = blockIdx.x;
  const size_t gtid = (size_t)bid * 256 + tid, gsz = (size_t)gridDim.x * 256;
  if (bid == 0) {
    if (tid < 64) {
      float a = p.lq1[tid] * p.lk1[tid], b = p.lq2[tid] * p.lk2[tid];
      a = wave_sum(a); b = wave_sum(b);
      if (tid == 0) ((float*)(p.ws + OFF_CTR))[16] = expf(a) - expf(b) + 0.2f;
    }
    float* LB = (float*)(p.ws + OFF_LB);
    for (int k = tid; k < 1024; k += 256) {
      float a0 = p.hgrn_lb[k], a1 = p.hgrn_lb[1024 + k];
      LB[k] = 1.0f / (1.0f + expf(a1 - a0));
    }
  }
  {
    bf16_t* XB = (bf16_t*)(p.ws + OFF_XB);
    const size_t nch = (size_t)NTOK * 2048 / 8;
    for (size_t c = gtid; c < nch; c += gsz) {
      size_t e = c * 8;
      const float* src = (e < (size_t)NPTOK * 2048) ? (p.x_prompt + e) : (p.x_sample + (e - (size_t)NPTOK * 2048));
      conv8(src, XB + e);
    }
  }
  {
    bf16_t* KS = (bf16_t*)(p.ws + OFF_KS);
    for (size_t c = gtid; c < (size_t)1048576; c += gsz) {
      int d8 = c & 15, h = (c >> 4) & 7, s = (c >> 7) & 1023, b = (int)(c >> 17);
      conv8(p.cache_k + c * 8, KS + ((size_t)((b * 8 + h) * 1088 + s) * 128 + d8 * 8));
    }
  }
  {
    bf16_t* VTS = (bf16_t*)(p.ws + OFF_VTS);
    for (size_t i = gtid; i < (size_t)2097152; i += gsz) {
      int vc = i & 127, s4 = (i >> 7) & 255, h = (i >> 15) & 7, b = (int)(i >> 18);
      const float* src = p.cache_v + ((size_t)(b * 1024 + s4 * 4) * 8 + h) * 128 + vc;
      float v0 = src[0], v1 = src[1024], v2 = src[2048], v3 = src[3072];
      u32x2 o = {pk_bf16(v0, v1), pk_bf16(v2, v3)};
      *(u32x2*)(VTS + ((size_t)((b * 8 + h) * 128 + vc) * 1088 + s4 * 4)) = o;
    }
  }
  {
    bf16_t* SKB = (bf16_t*)(p.ws + OFF_SKB);
    for (size_t c = gtid; c < (size_t)32768; c += gsz) conv8(p.subk + c * 8, SKB + c * 8);
  }
  transpose_conv(p.w_in, (bf16_t*)(p.ws + OFF_WINT), 2048, 7168, lds);
  transpose_conv(p.w_out, (bf16_t*)(p.ws + OFF_WOUTT), 2048, 2048, lds);
  transpose_conv(p.wq, (bf16_t*)(p.ws + OFF_WQT), 2048, 2048, lds);
}

template <bool SWAP>
__device__ __forceinline__ void gemm_compute_tile(const char* cur, int aoff, int boff, int sw, int fq, f32x4 (&acc)[4][4]) {
#pragma unroll
  for (int ks = 0; ks < 2; ++ks) {
    bf16x8 af[4], bfr[4];
    const int ch = ((ks * 4 + fq) ^ sw) << 4;
#pragma unroll
    for (int m = 0; m < 4; ++m) af[m] = *(const bf16x8*)(cur + aoff + m * 2048 + ch);
#pragma unroll
    for (int n = 0; n < 4; ++n) bfr[n] = *(const bf16x8*)(cur + boff + n * 2048 + ch);
    __builtin_amdgcn_s_setprio(1);
#pragma unroll
    for (int m = 0; m < 4; ++m)
#pragma unroll
      for (int n = 0; n < 4; ++n)
        acc[m][n] = SWAP ? mfma16(bfr[n], af[m], acc[m][n]) : mfma16(af[m], bfr[n], acc[m][n]);
    __builtin_amdgcn_s_setprio(0);
  }
}

template <bool SWAP>
__device__ __forceinline__ void gemm_mainloop(const bf16_t* A, const bf16_t* B,
                                              int row0, int col0, int K, char* lds, f32x4 (&acc)[4][4]) {
  int tid_o = threadIdx.x; asm volatile("" : "+v"(tid_o)); const int tid = tid_o, lane = tid & 63, wave = tid >> 6;
  const int wm = wave >> 1, wn = wave & 1, fr = lane & 15, fq = lane >> 4;
  const int lrow = tid >> 3, lc = tid & 7;
  const int cl = lc ^ (lrow & 7);
  const bf16_t* ga = A + (size_t)(row0 + lrow) * K + cl * 8;
  const bf16_t* gb = B + (size_t)(col0 + lrow) * K + cl * 8;
  const int loff = tid * 16;
#define G_STAGE(BUF, KT) { _Pragma("unroll") for (int i = 0; i < 4; ++i) { \
      __builtin_amdgcn_global_load_lds((const unsigned*)(ga + (size_t)i * 32 * K + (KT) * 64), (unsigned*)((BUF) + loff + i * 4096), 16, 0, 0); \
      __builtin_amdgcn_global_load_lds((const unsigned*)(gb + (size_t)i * 32 * K + (KT) * 64), (unsigned*)((BUF) + 16384 + loff + i * 4096), 16, 0, 0); } }
  const int nkt = K >> 6;
  G_STAGE(lds, 0);
  __syncthreads();
  const int aoff = (wm * 64 + fr) * 128, boff = 16384 + (wn * 64 + fr) * 128;
  const int sw = fr & 7;
  for (int kt = 0; kt < nkt; ++kt) {
    char* cur = lds + (kt & 1) * 32768;
    char* nxt = lds + ((kt + 1) & 1) * 32768;
    if (kt + 1 < nkt) G_STAGE(nxt, kt + 1);
    gemm_compute_tile<SWAP>(cur, aoff, boff, sw, fq, acc);
    __syncthreads();
  }
#undef G_STAGE
}

template <int MT, bool SWAP>
__device__ __forceinline__ void gemm_mainloop_big(const bf16_t* A, const bf16_t* B,
                                                  int row0, int col0, int K, char* lds, f32x4 (&acc)[MT][4]) {
  int tid_o = threadIdx.x; asm volatile("" : "+v"(tid_o)); const int tid = tid_o, lane = tid & 63, wave = tid >> 6;
  const int wm = wave >> 1, wn = wave & 1, fr = lane & 15, fq = lane >> 4;
  const int lrow = tid >> 3, lc = tid & 7;
  const int cl = lc ^ (lrow & 7);
  const bf16_t* ga = A + (size_t)(row0 + lrow) * K + cl * 8;
  const bf16_t* gb = B + (size_t)(col0 + lrow) * K + cl * 8;
  const int loff = tid * 16;
  const int nkt = K >> 6;
  constexpr int BOFF = MT * 32 * 128;
  const int aoff = (wm * (MT * 16) + fr) * 128, boff = BOFF + (wn * 64 + fr) * 128;
  const int sw = fr & 7;
  for (int kt = 0; kt < nkt; ++kt) {
#pragma unroll
    for (int i = 0; i < MT; ++i)
      __builtin_amdgcn_global_load_lds((const unsigned*)(ga + (size_t)i * 32 * K + kt * 64), (unsigned*)(lds + loff + i * 4096), 16, 0, 0);
#pragma unroll
    for (int i = 0; i < 4; ++i)
      __builtin_amdgcn_global_load_lds((const unsigned*)(gb + (size_t)i * 32 * K + kt * 64), (unsigned*)(lds + BOFF + loff + i * 4096), 16, 0, 0);
    __syncthreads();
#pragma unroll
    for (int ks = 0; ks < 2; ++ks) {
      bf16x8 af[MT], bfr[4];
      const int ch = ((ks * 4 + fq) ^ sw) << 4;
#pragma unroll
      for (int m = 0; m < MT; ++m) af[m] = *(const bf16x8*)(lds + aoff + m * 2048 + ch);
#pragma unroll
      for (int n = 0; n < 4; ++n) bfr[n] = *(const bf16x8*)(lds + boff + n * 2048 + ch);
      __builtin_amdgcn_s_setprio(1);
#pragma unroll
      for (int m = 0; m < MT; ++m)
#pragma unroll
        for (int n = 0; n < 4; ++n)
          acc[m][n] = SWAP ? mfma16(bfr[n], af[m], acc[m][n]) : mfma16(af[m], bfr[n], acc[m][n]);
      __builtin_amdgcn_s_setprio(0);
    }
    __syncthreads();
  }
}

template <bool SWAP>
__device__ void gemm1_tile(const Params& p, int mt, int nt, char* lds) {
  f32x4 acc[8][4];
#pragma unroll
  for (int m = 0; m < 8; ++m)
#pragma unroll
    for (int n = 0; n < 4; ++n) acc[m][n] = (f32x4){0.f, 0.f, 0.f, 0.f};
  gemm_mainloop_big<8, SWAP>((const bf16_t*)(p.ws + OFF_XB), (const bf16_t*)(p.ws + OFF_WINT), mt * 256, nt * 128, 2048, lds, acc);
  int tidv = threadIdx.x; asm volatile("" : "+v"(tidv));
  const int tid = tidv, lane = tid & 63, wave = tid >> 6;
  const int wm = wave >> 1, wn = wave & 1, fr = lane & 15, fq = lane >> 4;
  const int seg = nt >> 3, h = nt & 7;
  const bool samp = (mt * 256 >= NPTOK);
  if (SWAP) {
    const float* LB = (const float*)(p.ws + OFF_LB);
    if (seg == 5 && !samp) {
      float nmax = 0.f;
#pragma unroll
      for (int m = 0; m < 8; ++m) {
        float s2 = 0.f;
#pragma unroll
        for (int n = 0; n < 4; ++n) s2 += acc[m][n].x * acc[m][n].x + acc[m][n].y * acc[m][n].y + acc[m][n].z * acc[m][n].z + acc[m][n].w * acc[m][n].w;
        s2 += __shfl_xor(s2, 16);
        s2 += __shfl_xor(s2, 32);
        nmax = fmaxf(nmax, s2);
      }
#pragma unroll
      for (int o = 8; o >= 1; o >>= 1) nmax = fmaxf(nmax, __shfl_xor(nmax, o));
      if (lane == 0) atomicMax((unsigned*)(p.ws + 256) + ((mt * 256) >> 12) * 16 + h * 2 + wn, __float_as_uint(nmax));
    }
#pragma unroll
    for (int m = 0; m < 8; ++m) {
      const int tok = mt * 256 + wm * 128 + m * 16 + fr;
#pragma unroll
      for (int n = 0; n < 4; ++n) {
        const int cl = wn * 64 + n * 16 + fq * 4;
        const int kidx = h * 128 + cl;
        f32x4 v = acc[m][n];
        if (seg == 0) {
          u32x2 o = {pk_bf16(v.x, v.y), pk_bf16(v.z, v.w)};
          *(u32x2*)((bf16_t*)(p.ws + OFF_QA) + (size_t)tok * 1024 + kidx) = o;
        } else if (seg == 1) {
          f32x4 lb = *(const f32x4*)(LB + kidx);
          f32x4 o;
          o.x = lb.x + (1.f - lb.x) / (1.f + __expf(-v.x));
          o.y = lb.y + (1.f - lb.y) / (1.f + __expf(-v.y));
          o.z = lb.z + (1.f - lb.z) / (1.f + __expf(-v.z));
          o.w = lb.w + (1.f - lb.w) / (1.f + __expf(-v.w));
          *(f32x4*)((float*)(p.ws + OFF_LOGF) + (size_t)tok * 1024 + kidx) = o;
        } else if (seg == 3) {
          float s0 = 1.f / (1.f + __expf(-v.x)), s1 = 1.f / (1.f + __expf(-v.y));
          float s2 = 1.f / (1.f + __expf(-v.z)), s3 = 1.f / (1.f + __expf(-v.w));
          u32x2 o = {pk_bf16(s0, s1), pk_bf16(s2, s3)};
          *(u32x2*)((bf16_t*)(p.ws + OFF_GA) + (size_t)tok * 1024 + kidx) = o;
        } else if (seg == 4) {
          const float sc = 0.18033688011112042f;
          u32x2 o = {pk_bf16(v.x * sc, v.y * sc), pk_bf16(v.z * sc, v.w * sc)};
          *(u32x2*)((bf16_t*)(p.ws + OFF_QB) + (size_t)tok * 1024 + kidx) = o;
        } else {
          u32x2 o = {pk_bf16(v.x, v.y), pk_bf16(v.z, v.w)};
          if (!samp) {
            __builtin_nontemporal_store(v, (f32x4*)(p.out + OUT_KP + (size_t)tok * 1024 + kidx));
            const int b = tok >> 12, t = tok & 4095;
            *(u32x2*)((bf16_t*)(p.ws + OFF_KP) + ((size_t)((b * 8 + h) * 4096 + t) * 128 + cl)) = o;
          } else {
            const int ts = tok - NPTOK;
            __builtin_nontemporal_store(v, (f32x4*)(p.out + OUT_KS + (size_t)ts * 1024 + kidx));
            const int b = ts >> 6, t = ts & 63;
            *(u32x2*)((bf16_t*)(p.ws + OFF_KS) + ((size_t)((b * 8 + h) * 1088 + 1024 + t) * 128 + cl)) = o;
          }
        }
      }
    }
  } else {
#pragma unroll
    for (int m = 0; m < 8; ++m) {
      const int tok0 = mt * 256 + wm * 128 + m * 16 + fq * 4;
#pragma unroll
      for (int n = 0; n < 4; ++n) {
        const int cl = wn * 64 + n * 16 + fr;
        f32x4 v = acc[m][n];
        u32x2 o = {pk_bf16(v.x, v.y), pk_bf16(v.z, v.w)};
        if (seg == 2) {
          bf16_t* IAT = (bf16_t*)(p.ws + OFF_IAT);
          if (!samp) {
            const int b = tok0 >> 12, t = tok0 & 4095;
            *(u32x2*)(IAT + ((size_t)((b * 8 + h) * 128 + cl) * 4096 + t)) = o;
          } else {
            const int ts = tok0 - NPTOK, b = ts >> 6, t = ts & 63;
            *(u32x2*)(IAT + (size_t)32 * 128 * 4096 + ((size_t)((b * 8 + h) * 128 + cl) * 64 + t)) = o;
          }
        } else {
          if (!samp) {
            float* ov = p.out + OUT_VP + (size_t)tok0 * 1024 + h * 128 + cl;
            __builtin_nontemporal_store(v.x, ov); __builtin_nontemporal_store(v.y, ov + 1024); __builtin_nontemporal_store(v.z, ov + 2048); __builtin_nontemporal_store(v.w, ov + 3072);
            const int b = tok0 >> 12, t = tok0 & 4095;
            *(u32x2*)((bf16_t*)(p.ws + OFF_VTP) + ((size_t)((b * 8 + h) * 128 + cl) * 4096 + t)) = o;
          } else {
            const int ts = tok0 - NPTOK, b = ts >> 6, t = ts & 63;
            float* ov = p.out + OUT_VS + (size_t)ts * 1024 + h * 128 + cl;
            __builtin_nontemporal_store(v.x, ov); __builtin_nontemporal_store(v.y, ov + 1024); __builtin_nontemporal_store(v.z, ov + 2048); __builtin_nontemporal_store(v.w, ov + 3072);
            *(u32x2*)((bf16_t*)(p.ws + OFF_VTS) + ((size_t)((b * 8 + h) * 128 + cl) * 1088 + 1024 + t)) = o;
          }
        }
      }
    }
  }
}

__device__ void phase1(const Params& p, char* lds) {
  const int xcd = blockIdx.x & 7, lb = blockIdx.x >> 3, nbx = gridDim.x >> 3;
  const int nM = NTOK / 256, nNx = 7;
  for (int li = lb; li < nM * nNx; li += nbx) {
    const int mt = li / nNx, nt = (li % nNx) * 8 + xcd;
    const int seg = nt >> 3;
    if (seg == 2 || seg == 6) gemm1_tile<false>(p, mt, nt, lds);
    else gemm1_tile<true>(p, mt, nt, lds);
  }
}

template <int MODE, int MT>
__device__ void gemm23_tile(const Params& p, int row0, int nt, char* lds) {
  const bf16_t* A = (const bf16_t*)(p.ws + (MODE == 0 ? OFF_MERGED : OFF_X1B));
  const bf16_t* B = (const bf16_t*)(p.ws + (MODE == 0 ? OFF_WOUTT : OFF_WQT));
  f32x4 acc[MT][4];
#pragma unroll
  for (int m = 0; m < MT; ++m)
#pragma unroll
    for (int n = 0; n < 4; ++n) acc[m][n] = (f32x4){0.f, 0.f, 0.f, 0.f};
  if (MT == 4) gemm_mainloop<true>(A, B, row0, nt * 128, 2048, lds, (f32x4(&)[4][4])acc);
  else gemm_mainloop_big<MT, true>(A, B, row0, nt * 128, 2048, lds, acc);
  int tid_o = threadIdx.x; asm volatile("" : "+v"(tid_o)); const int tid = tid_o, lane = tid & 63, wave = tid >> 6;
  const int wm = wave >> 1, wn = wave & 1, fr = lane & 15, fq = lane >> 4;
#pragma unroll
  for (int m = 0; m < MT; ++m) {
    const int tok = row0 + wm * (MT * 16) + m * 16 + fr;
#pragma unroll
    for (int n = 0; n < 4; ++n) {
      const int col = nt * 128 + wn * 64 + n * 16 + fq * 4;
      f32x4 v = acc[m][n];
      if (MODE == 0) {
        const float* xin = (tok < NPTOK) ? (p.x_prompt + (size_t)tok * 2048) : (p.x_sample + (size_t)(tok - NPTOK) * 2048);
        f32x4 xv = *(const f32x4*)(xin + col);
        const float al = 1.189207115002721f;
        u32x2 o = {pk_bf16(al * xv.x + v.x, al * xv.y + v.y), pk_bf16(al * xv.z + v.z, al * xv.w + v.w)};
        *(u32x2*)((bf16_t*)(p.ws + OFF_X1B) + (size_t)tok * 2048 + col) = o;
      } else {
        u32x2 o = {pk_bf16(v.x, v.y), pk_bf16(v.z, v.w)};
        *(u32x2*)((bf16_t*)(p.ws + OFF_QP) + (size_t)tok * 2048 + col) = o;
      }
    }
  }
}

template <int MODE>
__device__ void gemm23(const Params& p, char* lds) {
  const int xcd = blockIdx.x & 7, lb = blockIdx.x >> 3, nbx = gridDim.x >> 3;
  for (int li = lb; li < 64 * 2; li += nbx) gemm23_tile<MODE, 8>(p, (li >> 1) * 256, (li & 1) * 8 + xcd, lds);
  for (int li = lb; li < 4 * 2; li += nbx) gemm23_tile<MODE, 4>(p, NPTOK + (li >> 1) * 128, (li & 1) * 8 + xcd, lds);
}

__device__ void hgrn_item(const Params& p, int kind, int b, int h, char* lds, int mode, int c0) {
  int tid_o = threadIdx.x; asm volatile("" : "+v"(tid_o)); const int tid = tid_o, lane = tid & 63, w = tid >> 6, fr = lane & 15, fq = lane >> 4;
  const int tokbase = kind == 0 ? b * 4096 : NPTOK + b * 64;
  const int c_begin = mode == 0 ? 0 : c0, nch = mode == 0 ? (kind == 0 ? 64 : 1) : c0 + 1;
  u32x2* LSb = (u32x2*)(p.ws + OFF_LS) + ((size_t)((b * 8 + h) * 64 + c0) * 16) * 256 + tid;
  const bf16_t* IATb = (const bf16_t*)(p.ws + OFF_IAT) +
      (kind == 0 ? (size_t)((b * 8 + h) * 128) * 4096 : (size_t)32 * 128 * 4096 + (size_t)((b * 8 + h) * 128) * 64);
  const int iat_stride = kind == 0 ? 4096 : 64;
  const float* LOGF = (const float*)(p.ws + OFF_LOGF);
  const bf16_t* QA = (const bf16_t*)(p.ws + OFF_QA);
  const bf16_t* GA = (const bf16_t*)(p.ws + OFF_GA);
  bf16_t* MERGED = (bf16_t*)(p.ws + OFF_MERGED);

  f32x4 S[8][2];
  if (mode == 2) {
#pragma unroll
    for (int kt = 0; kt < 8; ++kt)
#pragma unroll
      for (int vv = 0; vv < 2; ++vv) {
        u32x2 t = LSb[(kt * 2 + vv) * 256];
        S[kt][vv] = (f32x4){bflo(t.x), bfhi(t.x), bflo(t.y), bfhi(t.y)};
      }
  } else if (kind == 0) {
#pragma unroll
    for (int kt = 0; kt < 8; ++kt)
#pragma unroll
      for (int vv = 0; vv < 2; ++vv) S[kt][vv] = (f32x4){0.f, 0.f, 0.f, 0.f};
  } else {
    const float* st = p.state + (size_t)((b * 8 + h) * 128) * 128 + (4 * fq) * 128 + 32 * w + fr;
#pragma unroll
    for (int kt = 0; kt < 8; ++kt)
#pragma unroll
      for (int vv = 0; vv < 2; ++vv)
#pragma unroll
        for (int j = 0; j < 4; ++j) S[kt][vv][j] = st[(16 * kt + j) * 128 + 16 * vv];
  }
  f32x4 gn[2];
#pragma unroll
  for (int vv = 0; vv < 2; ++vv) gn[vv] = *(const f32x4*)(p.hgrn_g + 32 * w + 16 * vv + 4 * fq);

  const int ekp = tid & 63, eq = tid >> 6;

  u32x4 gR[8];
  unsigned qn[16];
#pragma unroll
  for (int i = 0; i < 8; ++i) {
    int id = tid + 256 * i, row = id >> 5, cc = id & 31;
    gR[i] = *(const u32x4*)(LOGF + (size_t)(tokbase + c_begin * 64 + row) * 1024 + h * 128 + cc * 4);
  }
#pragma unroll
  for (int i = 0; i < 16; ++i) qn[i] = *(const unsigned*)(QA + (size_t)(tokbase + c_begin * 64 + 16 * eq + i) * 1024 + h * 128 + 2 * ekp);
  for (int c = c_begin; c < nch; ++c) {
    int zz = 0; asm volatile("" : "+v"(zz));
    int tidv = threadIdx.x; asm volatile("" : "+v"(tidv));
    const int tid = tidv, lane = tid & 63, w = tid >> 6, fr = lane & 15, fq = lane >> 4, ekp = tid & 63, eq = tid >> 6;
    char* L = lds + zz;
    float* Dl = (float*)(L + 57344);
    float* part = (float*)(L + 57856);
    const int tok0 = tokbase + c * 64 + zz;
#pragma unroll
    for (int i = 0; i < 8; ++i) {
      int id = tid + 256 * i, row = id >> 5, cc = id & 31;
      *(u32x4*)(L + row * 512 + cc * 16) = gR[i];
    }
    unsigned qv[16];
#pragma unroll
    for (int i = 0; i < 16; ++i) qv[i] = qn[i];
    if (c + 1 < nch) {
#pragma unroll
      for (int i = 0; i < 8; ++i) {
        int id = tid + 256 * i, row = id >> 5, cc = id & 31;
        gR[i] = *(const u32x4*)(LOGF + (size_t)(tok0 + 64 + row) * 1024 + h * 128 + cc * 4);
      }
    }
    bf16x8 vfr[2][2];
#pragma unroll
    for (int ss = 0; ss < 2; ++ss)
#pragma unroll
      for (int vv = 0; vv < 2; ++vv)
        vfr[ss][vv] = *(const bf16x8*)(IATb + (size_t)(32 * w + 16 * vv + fr) * iat_stride + c * 64 + zz + 32 * ss + 8 * fq);
    __syncthreads();
    typedef float f32x2 __attribute__((ext_vector_type(2)));
    f32x2 gv[16];
    const float* Gl = (const float*)L;
    float* qtot = (float*)(L + 58880);
    float tot0 = 1.f, tot1 = 1.f;
#pragma unroll
    for (int i = 0; i < 16; ++i) { gv[i] = *(const f32x2*)(Gl + (16 * eq + i) * 128 + 2 * ekp); tot0 *= gv[i].x; tot1 *= gv[i].y; }
    qtot[eq * 128 + 2 * ekp] = tot0; qtot[eq * 128 + 2 * ekp + 1] = tot1;
    __syncthreads();
    {
      float run0 = 1.f, run1 = 1.f;
      for (int qq = 0; qq < eq; ++qq) { run0 *= qtot[qq * 128 + 2 * ekp]; run1 *= qtot[qq * 128 + 2 * ekp + 1]; }
      const int k0 = 2 * ekp;
#pragma unroll
      for (int i4 = 0; i4 < 4; ++i4) {
        float ka[4], kb[4];
#pragma unroll
        for (int ii = 0; ii < 4; ++ii) {
          const int i = i4 * 4 + ii, t = 16 * eq + i;
          const float f0 = gv[i].x, f1 = gv[i].y;
          run0 *= f0; run1 *= f1;
          const float q0 = bflo(qv[i]) * run0, q1 = bfhi(qv[i]) * run1;
          const float kk0 = (1.f - f0) * __builtin_amdgcn_rcpf(run0), kk1 = (1.f - f1) * __builtin_amdgcn_rcpf(run1);
          ka[ii] = kk0; kb[ii] = kk1;
          const int o = (t * 128 + ((((k0 >> 3) ^ (t & 15)) << 3) | (k0 & 7))) * 2;
          if (mode != 1) {
            *(unsigned*)(L + o) = pk_bf16(q0, q1);
            *(unsigned*)(L + 16384 + o) = pk_bf16(kk0, kk1);
          }
        }
        const int t0 = 16 * eq + i4 * 4;
        u32x2 oa = {pk_bf16(ka[0], ka[1]), pk_bf16(ka[2], ka[3])};
        u32x2 ob = {pk_bf16(kb[0], kb[1]), pk_bf16(kb[2], kb[3])};
        if (mode != 2) {
          *(u32x2*)(L + 32768 + k0 * 128 + ((((t0 >> 3) ^ (k0 & 7)) << 4) | ((t0 & 7) << 1))) = oa;
          *(u32x2*)(L + 32768 + (k0 + 1) * 128 + ((((t0 >> 3) ^ ((k0 + 1) & 7)) << 4) | ((t0 & 7) << 1))) = ob;
        }
      }
      if (eq == 3) { Dl[k0] = run0; Dl[k0 + 1] = run1; }
    }
    if (c + 1 < nch) {
#pragma unroll
      for (int i = 0; i < 16; ++i) qn[i] = *(const unsigned*)(QA + (size_t)(tok0 + 64 + 16 * eq + i) * 1024 + h * 128 + 2 * ekp);
    }
    __syncthreads();
    if (mode != 1) {
      bf16x8 qf[4];
#pragma unroll
      for (int ks = 0; ks < 4; ++ks) {
        const int t = 16 * w + fr;
        qf[ks] = *(const bf16x8*)(L + t * 256 + (((4 * ks + fq) ^ (t & 15)) << 4));
      }
#pragma unroll
      for (int st = 0; st < 4; ++st) {
        f32x4 a = {0.f, 0.f, 0.f, 0.f};
#pragma unroll
        for (int ks = 0; ks < 4; ++ks) {
          const int s = 16 * st + fr;
          bf16x8 kf = *(const bf16x8*)(L + 16384 + s * 256 + (((4 * ks + fq) ^ (s & 15)) << 4));
          a = mfma16(kf, qf[ks], a);
        }
        const int t = 16 * w + fr, s0 = 16 * st + 4 * fq;
        float p0 = (s0 + 0 <= t) ? a.x : 0.f, p1 = (s0 + 1 <= t) ? a.y : 0.f;
        float p2 = (s0 + 2 <= t) ? a.z : 0.f, p3 = (s0 + 3 <= t) ? a.w : 0.f;
        u32x2 o2 = {pk_bf16(p0, p1), pk_bf16(p2, p3)};
        *(u32x2*)(L + 49152 + t * 128 + ((((s0 >> 3) ^ (t & 7)) << 4) | ((s0 & 7) << 1))) = o2;
      }
    }
    f32x4 O[2][4];
#pragma unroll
    for (int vv = 0; vv < 2; ++vv)
#pragma unroll
      for (int tt = 0; tt < 4; ++tt) O[vv][tt] = (f32x4){0.f, 0.f, 0.f, 0.f};
    if (mode != 1) {
#pragma unroll
    for (int ks = 0; ks < 4; ++ks) {
      bf16x8 sf[2];
#pragma unroll
      for (int vv = 0; vv < 2; ++vv)
        sf[vv] = mk8(pk_bf16(S[2 * ks][vv].x, S[2 * ks][vv].y), pk_bf16(S[2 * ks][vv].z, S[2 * ks][vv].w),
                     pk_bf16(S[2 * ks + 1][vv].x, S[2 * ks + 1][vv].y), pk_bf16(S[2 * ks + 1][vv].z, S[2 * ks + 1][vv].w));
#pragma unroll
      for (int tt = 0; tt < 4; ++tt) {
        const int t = 16 * tt + fr;
        const int c0 = 4 * ks + (fq >> 1), c1 = 4 * ks + 2 + (fq >> 1);
        u32x2 q0 = *(const u32x2*)(L + t * 256 + ((c0 ^ (t & 15)) << 4) + ((fq & 1) << 3));
        u32x2 q1 = *(const u32x2*)(L + t * 256 + ((c1 ^ (t & 15)) << 4) + ((fq & 1) << 3));
        bf16x8 qp = mk8(q0, q1);
#pragma unroll
        for (int vv = 0; vv < 2; ++vv) O[vv][tt] = mfma16(sf[vv], qp, O[vv][tt]);
      }
    }
    }
    __syncthreads();
#pragma unroll
    for (int ss = 0; ss < 2; ++ss) {
      bf16x8 vf[2];
#pragma unroll
      for (int vv = 0; vv < 2; ++vv) vf[vv] = vfr[ss][vv];
      if (mode != 1) {
#pragma unroll
      for (int tt = 0; tt < 4; ++tt) {
        const int t = 16 * tt + fr;
        bf16x8 pf = *(const bf16x8*)(L + 49152 + t * 128 + (((4 * ss + fq) ^ (t & 7)) << 4));
#pragma unroll
        for (int vv = 0; vv < 2; ++vv) O[vv][tt] = mfma16(vf[vv], pf, O[vv][tt]);
      }
      }
      if (mode != 2) {
#pragma unroll
      for (int kt = 0; kt < 8; ++kt) {
        const int r = 16 * kt + fr;
        bf16x8 kf = *(const bf16x8*)(L + 32768 + r * 128 + (((4 * ss + fq) ^ (r & 7)) << 4));
#pragma unroll
        for (int vv = 0; vv < 2; ++vv) S[kt][vv] = mfma16(kf, vf[vv], S[kt][vv]);
      }
      }
    }
    if (mode != 2) {
#pragma unroll
    for (int kt = 0; kt < 8; ++kt) {
      f32x4 d = *(const f32x4*)(Dl + 16 * kt + 4 * fq);
#pragma unroll
      for (int vv = 0; vv < 2; ++vv) { S[kt][vv].x *= d.x; S[kt][vv].y *= d.y; S[kt][vv].z *= d.z; S[kt][vv].w *= d.w; }
    }
    }
    if (mode == 1 && tid < 128) ((float*)(p.ws + OFF_DBUF))[(size_t)((b * 8 + h) * 64 + c) * 128 + tid] = Dl[tid];
    if (mode != 1) {
#pragma unroll
    for (int tt = 0; tt < 4; ++tt) {
      float ss = 0.f;
#pragma unroll
      for (int vv = 0; vv < 2; ++vv) ss += O[vv][tt].x * O[vv][tt].x + O[vv][tt].y * O[vv][tt].y + O[vv][tt].z * O[vv][tt].z + O[vv][tt].w * O[vv][tt].w;
      ss += __shfl_xor(ss, 16);
      ss += __shfl_xor(ss, 32);
      if (fq == 0) part[w * 64 + 16 * tt + fr] = ss;
    }
    __syncthreads();
#pragma unroll
    for (int tt = 0; tt < 4; ++tt) {
      const int t = 16 * tt + fr;
      const float tot = part[t] + part[64 + t] + part[128 + t] + part[192 + t];
      const float r = rsqrtf(tot * (1.f / 128.f) + 1e-5f);
      const size_t tok = (size_t)(tok0 + t);
#pragma unroll
      for (int vv = 0; vv < 2; ++vv) {
        const int v0 = h * 128 + 32 * w + 16 * vv + 4 * fq;
        u32x2 gt = *(const u32x2*)(GA + tok * 1024 + v0);
        float o0 = O[vv][tt].x * r * gn[vv].x * bflo(gt.x);
        float o1 = O[vv][tt].y * r * gn[vv].y * bfhi(gt.x);
        float o2 = O[vv][tt].z * r * gn[vv].z * bflo(gt.y);
        float o3 = O[vv][tt].w * r * gn[vv].w * bfhi(gt.y);
        u32x2 ov = {pk_bf16(o0, o1), pk_bf16(o2, o3)};
        *(u32x2*)(MERGED + tok * 2048 + v0) = ov;
      }
    }
    }
    __syncthreads();
  }
  if (mode == 1) {
#pragma unroll
    for (int kt = 0; kt < 8; ++kt)
#pragma unroll
      for (int vv = 0; vv < 2; ++vv) {
        u32x2 t = {pk_bf16(S[kt][vv].x, S[kt][vv].y), pk_bf16(S[kt][vv].z, S[kt][vv].w)};
        LSb[(kt * 2 + vv) * 256] = t;
      }
    return;
  }
  if (mode == 2) return;
  int zq = 0; asm volatile("" : "+v"(zq));
  float* so = p.out + (kind == 0 ? OUT_SP : OUT_SS) + (size_t)((b * 8 + h) * 128) * 128 + (4 * fq) * 128 + 32 * w + fr + zq;
#pragma unroll
  for (int kt = 0; kt < 8; ++kt)
#pragma unroll
    for (int vv = 0; vv < 2; ++vv)
#pragma unroll
      for (int j = 0; j < 4; ++j) so[(16 * kt + j) * 128 + 16 * vv] = S[kt][vv][j];
}


__device__ void hgrn_scan_item(const Params& p, int chain, int kt) {
  int tid_o = threadIdx.x; asm volatile("" : "+v"(tid_o)); const int tid = tid_o, lane = tid & 63, w = tid >> 6, fr = lane & 15, fq = lane >> 4;
  u32x2* LS = (u32x2*)(p.ws + OFF_LS) + ((size_t)(chain * 64) * 16 + kt * 2) * 256 + tid;
  const float* DB = (const float*)(p.ws + OFF_DBUF) + (size_t)(chain * 64) * 128 + 16 * kt + 4 * fq;
  f32x4 S0 = {0.f, 0.f, 0.f, 0.f}, S1 = {0.f, 0.f, 0.f, 0.f};
#pragma unroll 1
  for (int c8 = 0; c8 < 64; c8 += 8) {
    u32x2 l0[8], l1[8];
    f32x4 d[8];
#pragma unroll
    for (int i = 0; i < 8; ++i) {
      l0[i] = LS[(size_t)(c8 + i) * 16 * 256];
      l1[i] = LS[(size_t)(c8 + i) * 16 * 256 + 256];
      d[i] = *(const f32x4*)(DB + (c8 + i) * 128);
    }
#pragma unroll
    for (int i = 0; i < 8; ++i) {
      u32x2 o0 = {pk_bf16(S0.x, S0.y), pk_bf16(S0.z, S0.w)}, o1 = {pk_bf16(S1.x, S1.y), pk_bf16(S1.z, S1.w)};
      LS[(size_t)(c8 + i) * 16 * 256] = o0; LS[(size_t)(c8 + i) * 16 * 256 + 256] = o1;
      S0.x = d[i].x * S0.x + bflo(l0[i].x); S0.y = d[i].y * S0.y + bfhi(l0[i].x); S0.z = d[i].z * S0.z + bflo(l0[i].y); S0.w = d[i].w * S0.w + bfhi(l0[i].y);
      S1.x = d[i].x * S1.x + bflo(l1[i].x); S1.y = d[i].y * S1.y + bfhi(l1[i].x); S1.z = d[i].z * S1.z + bflo(l1[i].y); S1.w = d[i].w * S1.w + bfhi(l1[i].y);
    }
  }
  float* so = p.out + OUT_SP + (size_t)(chain * 128) * 128 + (size_t)(16 * kt + 4 * fq) * 128 + 32 * w + fr;
  so[0] = S0.x; so[128] = S0.y; so[256] = S0.z; so[384] = S0.w;
  so[16] = S1.x; so[128 + 16] = S1.y; so[256 + 16] = S1.z; so[384 + 16] = S1.w;
}

__device__ void attn_item(const Params& p, int kind, int bh, int qt, char* lds) {
  int tid_o = threadIdx.x; asm volatile("" : "+v"(tid_o)); const int tid = tid_o, lane = tid & 63, w = tid >> 6, fr = lane & 15, fq = lane >> 4;
  const int b = bh >> 3, h = bh & 7;
  const int nkt = kind == 0 ? qt + 1 : 17;
  const int tok0 = kind == 0 ? b * 4096 + qt * 64 : NPTOK + b * 64;
  const int qpos0 = kind == 0 ? qt * 64 : 1024;
  const bf16_t* Kb = kind == 0 ? (const bf16_t*)(p.ws + OFF_KP) + (size_t)bh * 4096 * 128
                               : (const bf16_t*)(p.ws + OFF_KS) + (size_t)bh * 1088 * 128;
  const bf16_t* Vb = kind == 0 ? (const bf16_t*)(p.ws + OFF_VTP) + (size_t)bh * 128 * 4096
                               : (const bf16_t*)(p.ws + OFF_VTS) + (size_t)bh * 128 * 1088;
  const int vstride = kind == 0 ? 4096 : 1088;
  const float slope2 = exp2f(-(float)(h + 1)) * 1.4426950408889634f;

  const int tok = tok0 + 16 * w + fr;
  bf16x8 qf[4];
  {
    const bf16_t* qp = (const bf16_t*)(p.ws + OFF_QB) + (size_t)tok * 1024 + h * 128;
#pragma unroll
    for (int ks = 0; ks < 4; ++ks) qf[ks] = *(const bf16x8*)(qp + 32 * ks + 8 * fq);
  }
  const float qposf = (float)(qpos0 + 16 * w + fr);
  float qk[2];
#pragma unroll
  for (int m = 0; m < 2; ++m) {
    float s2 = 0.f;
#pragma unroll
    for (int ks2 = 0; ks2 < 2; ++ks2)
#pragma unroll
      for (int e = 0; e < 8; ++e) { const float qv = bf2f((unsigned short)qf[2 * m + ks2][e]); s2 += qv * qv; }
    s2 += __shfl_xor(s2, 16);
    s2 += __shfl_xor(s2, 32);
    const float kmax2 = kind == 0 ? __uint_as_float(((const unsigned*)(p.ws + 256))[b * 16 + h * 2 + m]) : 3.0e38f;
    qk[m] = sqrtf(s2) * sqrtf(kmax2) * 1.02f;
  }
  f32x4 O0[8], O1[8];
#pragma unroll
  for (int i = 0; i < 8; ++i) { O0[i] = (f32x4){0.f, 0.f, 0.f, 0.f}; O1[i] = (f32x4){0.f, 0.f, 0.f, 0.f}; }
  float mx[2] = {-1e30f, -1e30f}, ls[2] = {0.f, 0.f};

  u32x4 rk[4], rv[4];
  {
    const int kkey = tid >> 4, kc = tid & 15, vrow = tid >> 3, vc = tid & 7;
    const int kt = nkt - 1;
#pragma unroll
    for (int i = 0; i < 4; ++i) {
      rk[i] = *(const u32x4*)(Kb + (size_t)(kt * 64 + kkey + 16 * i) * 128 + kc * 8);
      rv[i] = *(const u32x4*)(Vb + (size_t)(vrow + 32 * i) * vstride + kt * 64 + vc * 8);
    }
#pragma unroll
    for (int i = 0; i < 4; ++i) {
      const int key = kkey + 16 * i;
      *(u32x4*)(lds + key * 256 + ((kc ^ (key & 15)) << 4)) = rk[i];
      const int r = vrow + 32 * i;
      *(u32x4*)(lds + 16384 + r * 128 + ((vc ^ ((r >> 1) & 7)) << 4)) = rv[i];
    }
    if (nkt > 1) {
#pragma unroll
      for (int i = 0; i < 4; ++i) {
        rk[i] = *(const u32x4*)(Kb + (size_t)((kt - 1) * 64 + kkey + 16 * i) * 128 + kc * 8);
        rv[i] = *(const u32x4*)(Vb + (size_t)(vrow + 32 * i) * vstride + (kt - 1) * 64 + vc * 8);
      }
    }
    __syncthreads();
  }
  for (int it = 0; it < nkt; ++it) {
    int zz = 0; asm volatile("" : "+v"(zz));
    int tidv = threadIdx.x; asm volatile("" : "+v"(tidv));
    const int tid = tidv, lane = tid & 63, w = tid >> 6, fr = lane & 15, fq = lane >> 4;
    const int kkey = tid >> 4, kc = tid & 15, vrow = tid >> 3, vc = tid & 7;
    const int kt = nkt - 1 - it;
    char* L = lds + zz + (it & 1) * 32768;
    char* Ln = lds + zz + ((it + 1) & 1) * 32768;
    if (it + 1 < nkt) {
#pragma unroll
      for (int i = 0; i < 4; ++i) {
        const int key = kkey + 16 * i;
        *(u32x4*)(Ln + key * 256 + ((kc ^ (key & 15)) << 4)) = rk[i];
        const int r = vrow + 32 * i;
        *(u32x4*)(Ln + 16384 + r * 128 + ((vc ^ ((r >> 1) & 7)) << 4)) = rv[i];
      }
    }
    if (it + 2 < nkt) {
#pragma unroll
      for (int i = 0; i < 4; ++i) {
        rk[i] = *(const u32x4*)(Kb + (size_t)((kt - 2) * 64 + zz + kkey + 16 * i) * 128 + kc * 8);
        rv[i] = *(const u32x4*)(Vb + (size_t)(vrow + 32 * i) * vstride + (kt - 2) * 64 + zz + vc * 8);
      }
    }
    const float kposf = (float)(kt * 64 + 4 * fq) - qposf;
    bf16x8 pf[2][2];
    bool live[2];
#pragma unroll
    for (int m = 0; m < 2; ++m) {
      f32x4 s[4];
#pragma unroll
      for (int k16 = 0; k16 < 4; ++k16) {
        s[k16] = (f32x4){0.f, 0.f, 0.f, 0.f};
        const int key = 16 * k16 + fr;
#pragma unroll
        for (int ks2 = 0; ks2 < 2; ++ks2) {
          bf16x8 kf = *(const bf16x8*)(L + key * 256 + (((8 * m + 4 * ks2 + fq) ^ (key & 15)) << 4));
          s[k16] = mfma16(kf, qf[2 * m + ks2], s[k16]);
        }
      }
      float tmax = -1e30f;
#pragma unroll
      for (int k16 = 0; k16 < 4; ++k16)
#pragma unroll
        for (int j = 0; j < 4; ++j) {
          const float d = kposf + (float)(16 * k16 + j);
          const float v = s[k16][j] - slope2 * fabsf(d);
          s[k16][j] = v;
          tmax = fmaxf(tmax, v);
        }
      tmax = fmaxf(tmax, __shfl_xor(tmax, 16));
      tmax = fmaxf(tmax, __shfl_xor(tmax, 32));
      live[m] = !__all(tmax - mx[m] < -40.f);
      if (live[m]) {
        const float mnew = fmaxf(mx[m], tmax);
        const float alpha = __builtin_amdgcn_exp2f(mx[m] - mnew);
        mx[m] = mnew;
        float psum = 0.f;
#pragma unroll
        for (int k16 = 0; k16 < 4; ++k16)
#pragma unroll
          for (int j = 0; j < 4; ++j) { const float e = __builtin_amdgcn_exp2f(s[k16][j] - mnew); s[k16][j] = e; psum += e; }
        ls[m] = ls[m] * alpha + psum;
        if (m == 0) {
#pragma unroll
          for (int i = 0; i < 8; ++i) { O0[i].x *= alpha; O0[i].y *= alpha; O0[i].z *= alpha; O0[i].w *= alpha; }
        } else {
#pragma unroll
          for (int i = 0; i < 8; ++i) { O1[i].x *= alpha; O1[i].y *= alpha; O1[i].z *= alpha; O1[i].w *= alpha; }
        }
#pragma unroll
        for (int ks = 0; ks < 2; ++ks)
          pf[m][ks] = mk8(pk_bf16(s[2 * ks].x, s[2 * ks].y), pk_bf16(s[2 * ks].z, s[2 * ks].w),
                          pk_bf16(s[2 * ks + 1].x, s[2 * ks + 1].y), pk_bf16(s[2 * ks + 1].z, s[2 * ks + 1].w));
      } else {
#pragma unroll
        for (int ks = 0; ks < 2; ++ks) pf[m][ks] = mk8(0u, 0u, 0u, 0u);
      }
    }
    if (live[0] || live[1]) {
      __builtin_amdgcn_s_setprio(1);
#pragma unroll
      for (int vt = 0; vt < 8; ++vt) {
        const int r = 16 * vt + fr;
        const int rs = (r >> 1) & 7;
#pragma unroll
        for (int ks = 0; ks < 2; ++ks) {
          const int u0 = 8 * ks + fq, u1 = 8 * ks + 4 + fq;
          u32x2 a0 = *(const u32x2*)(L + 16384 + r * 128 + (((u0 >> 1) ^ rs) << 4) + ((u0 & 1) << 3));
          u32x2 a1 = *(const u32x2*)(L + 16384 + r * 128 + (((u1 >> 1) ^ rs) << 4) + ((u1 & 1) << 3));
          bf16x8 vf = mk8(a0, a1);
          O0[vt] = mfma16(vf, pf[0][ks], O0[vt]);
          O1[vt] = mfma16(vf, pf[1][ks], O1[vt]);
        }
      }
      __builtin_amdgcn_s_setprio(0);
    }
    const float dmin = qposf - (float)((kt - 1) * 64 + 63);
    const bool done = (kind == 0) && (qk[0] - slope2 * dmin - mx[0] < -40.f) && (qk[1] - slope2 * dmin - mx[1] < -40.f);
    if (__syncthreads_and(done ? 1 : 0)) break;
  }
  float l0 = ls[0], l1 = ls[1];
  l0 += __shfl_xor(l0, 16); l0 += __shfl_xor(l0, 32);
  l1 += __shfl_xor(l1, 16); l1 += __shfl_xor(l1, 32);
  const float lam = ((const float*)(p.ws + OFF_CTR))[16];
  const float i0 = 1.f / l0, i1 = lam / l1;
  float ssq = 0.f;
#pragma unroll
  for (int vt = 0; vt < 8; ++vt) {
#pragma unroll
    for (int j = 0; j < 4; ++j) {
      const float o = O0[vt][j] * i0 - O1[vt][j] * i1;
      O0[vt][j] = o;
      ssq += o * o;
    }
  }
  ssq += __shfl_xor(ssq, 16);
  ssq += __shfl_xor(ssq, 32);
  const float r = rsqrtf(ssq * (1.f / 128.f) + 1e-5f) * 0.8f;
  bf16_t* mo = (bf16_t*)(p.ws + OFF_MERGED) + (size_t)tok * 2048 + 1024 + h * 128;
#pragma unroll
  for (int vt = 0; vt < 8; ++vt) {
    f32x4 g = *(const f32x4*)(p.diff_g + 16 * vt + 4 * fq);
    u32x2 ov = {pk_bf16(O0[vt].x * r * g.x, O0[vt].y * r * g.y), pk_bf16(O0[vt].z * r * g.z, O0[vt].w * r * g.w)};
    *(u32x2*)(mo + 16 * vt + 4 * fq) = ov;
  }
}


__device__ void quant_item(const Params& p, int item) {
  int tid_o = threadIdx.x; asm volatile("" : "+v"(tid_o)); const int tid = tid_o, lane = tid & 63, w = tid >> 6;
  unsigned char* U8 = (unsigned char*)(p.ws + OFF_UB);
  float* SCL = (float*)(p.ws + OFF_SCL);
  for (int rr = 0; rr < 16; ++rr) {
    const int row = item * 64 + rr * 4 + w;
    const float* srow = row < 16384 ? p.pu + (size_t)row * 2048 : p.pv + (size_t)(row - 16384) * 2048;
    f32x4 v[8];
    float am = 0.f;
#pragma unroll
    for (int i = 0; i < 8; ++i) {
      v[i] = __builtin_nontemporal_load((const f32x4*)(srow + 256 * i + lane * 4));
      am = fmaxf(fmaxf(am, fmaxf(fabsf(v[i].x), fabsf(v[i].y))), fmaxf(fabsf(v[i].z), fabsf(v[i].w)));
    }
#pragma unroll
    for (int o = 32; o >= 1; o >>= 1) am = fmaxf(am, __shfl_xor(am, o));
    const float sc = am > 0.f ? 224.f / am : 1.f;
    unsigned char* drow = U8 + (size_t)row * 2048;
#pragma unroll
    for (int i = 0; i < 8; ++i) {
      int pk = __builtin_amdgcn_cvt_pk_fp8_f32(v[i].x * sc, v[i].y * sc, 0, false);
      pk = __builtin_amdgcn_cvt_pk_fp8_f32(v[i].z * sc, v[i].w * sc, pk, true);
      *(int*)(drow + 256 * i + lane * 4) = pk;
    }
    if (lane == 0) SCL[row] = am > 0.f ? am * (1.f / 224.f) : 1.f;
  }
}

__device__ void phase2(const Params& p, char* lds, int rep, int par) {
  unsigned* ctr = (unsigned*)(p.ws + OFF_CTR) + rep;
  int* sitem = (int*)lds;
  const int nA = par ? 2048 : 0;
  for (;;) {
    __syncthreads();
    if (threadIdx.x == 0) *sitem = (int)atomicAdd(ctr, 1u);
    __syncthreads();
    int item = *sitem;
    __syncthreads();
    if (item >= nA + 2208) break;
    if (item < nA) { hgrn_item(p, 0, (item & 31) >> 3, item & 7, lds, 1, item >> 5); continue; }
    item -= nA;
    if (item < 96) {
      const int kind = item < 32 ? 0 : 1, ii = item < 32 ? item : item - 32;
      if (kind == 0 && par) continue;
      hgrn_item(p, kind, ii >> 3, ii & 7, lds, 0, 0);
    } else {
      const int kind = item < 160 ? 1 : 0, j = item - 160;
      attn_item(p, kind, kind ? item - 96 : (j & 31), kind ? 0 : 63 - (j >> 5), lds);
    }
  }
}

__device__ void phase2b(const Params& p) {
  for (int item = blockIdx.x; item < 256; item += gridDim.x) hgrn_scan_item(p, item >> 3, item & 7);
}

__device__ void phase2c(const Params& p, char* lds) {
  for (int item = blockIdx.x; item < 2048; item += gridDim.x) {
    __syncthreads();
    hgrn_item(p, 0, (item & 31) >> 3, item & 7, lds, 2, item >> 5);
  }
}

__device__ void phase4(const Params& p) {
  int tid_o = threadIdx.x; asm volatile("" : "+v"(tid_o)); const int tid = tid_o, lane = tid & 63, w = tid >> 6;
  bf16_t* X1B = (bf16_t*)(p.ws + OFF_X1B);
  for (int row = blockIdx.x * 4 + w; row < NTOK; row += gridDim.x * 4) {
    bf16_t* xr = X1B + (size_t)row * 2048;
    float v[4][8];
    float s = 0.f;
#pragma unroll
    for (int i = 0; i < 4; ++i) {
      u32x4 t = *(const u32x4*)(xr + 512 * i + lane * 8);
      v[i][0] = bflo(t.x); v[i][1] = bfhi(t.x); v[i][2] = bflo(t.y); v[i][3] = bfhi(t.y);
      v[i][4] = bflo(t.z); v[i][5] = bfhi(t.z); v[i][6] = bflo(t.w); v[i][7] = bfhi(t.w);
#pragma unroll
      for (int e = 0; e < 8; ++e) s += v[i][e];
    }
    s = wave_sum(s);
    const float mean = s * (1.f / 2048.f);
    float q = 0.f;
#pragma unroll
    for (int i = 0; i < 4; ++i)
#pragma unroll
      for (int e = 0; e < 8; ++e) { const float d = v[i][e] - mean; q += d * d; }
    q = wave_sum(q);
    const float rs = rsqrtf(q * (1.f / 2048.f) + 1e-5f);
#pragma unroll
    for (int i = 0; i < 4; ++i) {
      const int col = 512 * i + lane * 8;
      f32x4 g0 = *(const f32x4*)(p.ln1_g + col), g1 = *(const f32x4*)(p.ln1_g + col + 4);
      f32x4 b0 = *(const f32x4*)(p.ln1_b + col), b1 = *(const f32x4*)(p.ln1_b + col + 4);
      u32x4 o;
      o.x = pk_bf16((v[i][0] - mean) * rs * g0.x + b0.x, (v[i][1] - mean) * rs * g0.y + b0.y);
      o.y = pk_bf16((v[i][2] - mean) * rs * g0.z + b0.z, (v[i][3] - mean) * rs * g0.w + b0.w);
      o.z = pk_bf16((v[i][4] - mean) * rs * g1.x + b1.x, (v[i][5] - mean) * rs * g1.y + b1.y);
      o.w = pk_bf16((v[i][6] - mean) * rs * g1.z + b1.z, (v[i][7] - mean) * rs * g1.w + b1.w);
      *(u32x4*)(xr + col) = o;
    }
  }
}

__device__ __forceinline__ unsigned f2key(float f) {
  unsigned b = __float_as_uint(f);
  return (b & 0x80000000u) ? ~b : (b | 0x80000000u);
}
__device__ __forceinline__ float key2f(unsigned k) {
  unsigned b = (k & 0x80000000u) ? (k & 0x7fffffffu) : ~k;
  return __uint_as_float(b);
}

__device__ __forceinline__ unsigned row_allmax(unsigned x) {
  x = max(x, (unsigned)__builtin_amdgcn_update_dpp(0, (int)x, 0x121, 0xF, 0xF, false));
  x = max(x, (unsigned)__builtin_amdgcn_update_dpp(0, (int)x, 0x122, 0xF, 0xF, false));
  x = max(x, (unsigned)__builtin_amdgcn_update_dpp(0, (int)x, 0x124, 0xF, 0xF, false));
  x = max(x, (unsigned)__builtin_amdgcn_update_dpp(0, (int)x, 0x128, 0xF, 0xF, false));
  return x;
}
__device__ __forceinline__ float row_allsum(float x) {
  x += __int_as_float(__builtin_amdgcn_update_dpp(0, __float_as_int(x), 0x121, 0xF, 0xF, false));
  x += __int_as_float(__builtin_amdgcn_update_dpp(0, __float_as_int(x), 0x122, 0xF, 0xF, false));
  x += __int_as_float(__builtin_amdgcn_update_dpp(0, __float_as_int(x), 0x124, 0xF, 0xF, false));
  x += __int_as_float(__builtin_amdgcn_update_dpp(0, __float_as_int(x), 0x128, 0xF, 0xF, false));
  return x;
}
#define CE_DESC(a, b) { const unsigned _hi = max(a, b), _lo = min(a, b); a = _hi; b = _lo; }

__device__ void phase6(const Params& p, char* lds) {
  int tid_o = threadIdx.x; asm volatile("" : "+v"(tid_o)); const int tid = tid_o, lane = tid & 63, w = tid >> 6, fr = lane & 15, fq = lane >> 4;
  const bf16_t* QP = (const bf16_t*)(p.ws + OFF_QP);
  const bf16_t* SKB = (const bf16_t*)(p.ws + OFF_SKB);
  int* EIDX = (int*)(p.ws + OFF_EIDX);
  float* GATE = (float*)(p.ws + OFF_GATE);
  const bool qfirst = blockIdx.x >= (gridDim.x >> 1);
  if (qfirst) for (int qi = blockIdx.x; qi < 512; qi += gridDim.x) quant_item(p, qi);
  unsigned char* tbl = (unsigned char*)lds;
  __syncthreads();
  if (tid < 64) tbl[tid] = 0xFF;
  __syncthreads();
  {
    const int i = tid >> 4, j = tid & 15;
    if ((i + 1) * (j + 1) <= 16) {
      int rank = j;
      for (int ii = 0; ii < i; ++ii) rank += 16 / (ii + 1);
      tbl[rank] = (unsigned char)((i << 4) | j);
    }
  }
  __syncthreads();
  int pi[4], pj[4]; bool pvalid[4];
#pragma unroll
  for (int s = 0; s < 4; ++s) {
    const int pidx = fr + 16 * s;
    const unsigned code = tbl[pidx];
    pvalid[s] = (pidx < 50);
    pi[s] = pvalid[s] ? (int)(code >> 4) : 0;
    pj[s] = pvalid[s] ? (int)(code & 15) : 0;
  }
  const int rowbase = lane & 48;
  __syncthreads();
  {
    const int hh = blockIdx.x & 7;
#pragma unroll 1
    for (int c = 0; c < 2; ++c)
#pragma unroll 4
      for (int i = 0; i < 8; ++i) {
        const int id = tid + 256 * i, key = id >> 4, ch = id & 15;
        u32x4 v = *(const u32x4*)(SKB + (size_t)((hh * 2 + c) * 128 + key) * 128 + ch * 8);
        *(u32x4*)(lds + c * 32768 + key * 256 + ((ch ^ (key & 15)) << 4)) = v;
      }
  }
  __syncthreads();
  for (int item = blockIdx.x; item < 264 * 8; item += gridDim.x) {
    int zz = 0; asm volatile("" : "+v"(zz));
    const char* L = lds + zz;
    const int tile = item >> 3, h = item & 7;
    const int tok0 = tile * 64;
    unsigned Lst[2][4];
#pragma unroll
    for (int c = 0; c < 2; ++c) {
      unsigned K[8][4];
      {
        bf16x8 af[4];
        const bf16_t* qp = QP + (size_t)(tok0 + 16 * w + fr) * 2048 + h * 256 + c * 128;
#pragma unroll
        for (int ks = 0; ks < 4; ++ks) af[ks] = *(const bf16x8*)(qp + 32 * ks + 8 * fq);
#pragma unroll
        for (int kt = 0; kt < 8; ++kt) {
          f32x4 a = {0.f, 0.f, 0.f, 0.f};
#pragma unroll
          for (int ks = 0; ks < 4; ++ks) {
            const int key = 16 * kt + fr;
            bf16x8 bfr = *(const bf16x8*)(L + c * 32768 + key * 256 + (((4 * ks + fq) ^ (key & 15)) << 4));
            a = mfma16(af[ks], bfr, a);
          }
          const unsigned code = (unsigned)(127 - (16 * kt + fr));
#pragma unroll
          for (int j = 0; j < 4; ++j) K[kt][j] = (f2key(a[j]) & ~127u) | code;
        }
      }
#pragma unroll
      for (int j = 0; j < 4; ++j) {
        CE_DESC(K[0][j], K[1][j]); CE_DESC(K[2][j], K[3][j]); CE_DESC(K[4][j], K[5][j]); CE_DESC(K[6][j], K[7][j]);
        CE_DESC(K[0][j], K[2][j]); CE_DESC(K[1][j], K[3][j]); CE_DESC(K[4][j], K[6][j]); CE_DESC(K[5][j], K[7][j]);
        CE_DESC(K[1][j], K[2][j]); CE_DESC(K[5][j], K[6][j]); CE_DESC(K[0][j], K[4][j]); CE_DESC(K[3][j], K[7][j]);
        CE_DESC(K[1][j], K[5][j]); CE_DESC(K[2][j], K[6][j]);
        CE_DESC(K[1][j], K[4][j]); CE_DESC(K[3][j], K[6][j]);
        CE_DESC(K[2][j], K[4][j]); CE_DESC(K[3][j], K[5][j]);
        CE_DESC(K[3][j], K[4][j]);
      }
      unsigned best[4] = {0u, 0u, 0u, 0u};
#pragma unroll 1
      for (int it = 0; it < 16; ++it) {
#pragma unroll
        for (int j = 0; j < 4; ++j) {
          const unsigned rm = row_allmax(K[0][j]);
          const bool win = (K[0][j] == rm);
#pragma unroll
          for (int k = 0; k < 7; ++k) K[k][j] = win ? K[k + 1][j] : K[k][j];
          K[7][j] = win ? 0u : K[7][j];
          best[j] = (fr == it) ? rm : best[j];
        }
      }
#pragma unroll
      for (int j = 0; j < 4; ++j) Lst[c][j] = best[j];
    }
#pragma unroll
    for (int j = 0; j < 4; ++j) {
      unsigned C[4];
#pragma unroll
      for (int s = 0; s < 4; ++s) {
        const unsigned k0 = (unsigned)__shfl((int)Lst[0][j], rowbase + pi[s]);
        const unsigned k1 = (unsigned)__shfl((int)Lst[1][j], rowbase + pj[s]);
        const float sum = key2f(k0 & ~127u) + key2f(k1 & ~127u);
        C[s] = pvalid[s] ? ((f2key(sum) & ~255u) | (unsigned)(255 - (pi[s] * 16 + pj[s]))) : 0u;
      }
      CE_DESC(C[0], C[1]); CE_DESC(C[2], C[3]); CE_DESC(C[0], C[2]); CE_DESC(C[1], C[3]); CE_DESC(C[1], C[2]);
      unsigned sel = 0u;
#pragma unroll 1
      for (int it = 0; it < 16; ++it) {
        const unsigned rm = row_allmax(C[0]);
        const bool win = (C[0] == rm);
        C[0] = win ? C[1] : C[0]; C[1] = win ? C[2] : C[1]; C[2] = win ? C[3] : C[2]; C[3] = win ? 0u : C[3];
        sel = (fr == it) ? rm : sel;
      }
      const float cv = key2f(sel & ~255u);
      const float cmax = __shfl(cv, rowbase);
      const float e = __expf(cv - cmax);
      const float g = e / row_allsum(e);
      const int flat = 255 - (int)(sel & 255u);
      const unsigned l0 = (unsigned)__shfl((int)Lst[0][j], rowbase + (flat >> 4));
      const unsigned l1 = (unsigned)__shfl((int)Lst[1][j], rowbase + (flat & 15));
      const int eidx = (127 - (int)(l0 & 127u)) * 128 + (127 - (int)(l1 & 127u));
      const size_t ob = ((size_t)(tok0 + 16 * w + 4 * fq + j) * 8 + h) * 16 + fr;
      EIDX[ob] = eidx;
      GATE[ob] = g;
    }
  }
  if (!qfirst) for (int qi = blockIdx.x; qi < 512; qi += gridDim.x) quant_item(p, qi);
}

__device__ __forceinline__ float dot16_fp8(u32x4 r, const float* x) {
  float d = 0.f;
  f32x2_t a;
  a = __builtin_amdgcn_cvt_pk_f32_fp8((int)r.x, false); d += a.x * x[0] + a.y * x[1];
  a = __builtin_amdgcn_cvt_pk_f32_fp8((int)r.x, true);  d += a.x * x[2] + a.y * x[3];
  a = __builtin_amdgcn_cvt_pk_f32_fp8((int)r.y, false); d += a.x * x[4] + a.y * x[5];
  a = __builtin_amdgcn_cvt_pk_f32_fp8((int)r.y, true);  d += a.x * x[6] + a.y * x[7];
  a = __builtin_amdgcn_cvt_pk_f32_fp8((int)r.z, false); d += a.x * x[8] + a.y * x[9];
  a = __builtin_amdgcn_cvt_pk_f32_fp8((int)r.z, true);  d += a.x * x[10] + a.y * x[11];
  a = __builtin_amdgcn_cvt_pk_f32_fp8((int)r.w, false); d += a.x * x[12] + a.y * x[13];
  a = __builtin_amdgcn_cvt_pk_f32_fp8((int)r.w, true);  d += a.x * x[14] + a.y * x[15];
  return d;
}
__device__ __forceinline__ void axpy16_fp8(u32x4 r, float w, float* acc) {
  f32x2_t a;
  a = __builtin_amdgcn_cvt_pk_f32_fp8((int)r.x, false); acc[0] += w * a.x; acc[1] += w * a.y;
  a = __builtin_amdgcn_cvt_pk_f32_fp8((int)r.x, true);  acc[2] += w * a.x; acc[3] += w * a.y;
  a = __builtin_amdgcn_cvt_pk_f32_fp8((int)r.y, false); acc[4] += w * a.x; acc[5] += w * a.y;
  a = __builtin_amdgcn_cvt_pk_f32_fp8((int)r.y, true);  acc[6] += w * a.x; acc[7] += w * a.y;
  a = __builtin_amdgcn_cvt_pk_f32_fp8((int)r.z, false); acc[8] += w * a.x; acc[9] += w * a.y;
  a = __builtin_amdgcn_cvt_pk_f32_fp8((int)r.z, true);  acc[10] += w * a.x; acc[11] += w * a.y;
  a = __builtin_amdgcn_cvt_pk_f32_fp8((int)r.w, false); acc[12] += w * a.x; acc[13] += w * a.y;
  a = __builtin_amdgcn_cvt_pk_f32_fp8((int)r.w, true);  acc[14] += w * a.x; acc[15] += w * a.y;
}

__device__ void phase7(const Params& p, char* lds) {
  int tid_o = threadIdx.x; asm volatile("" : "+v"(tid_o)); const int tid = tid_o, lane = tid & 63, w = tid >> 6;
  const bf16_t* X1B = (const bf16_t*)(p.ws + OFF_X1B);
  const unsigned char* U8 = (const unsigned char*)(p.ws + OFF_UB);
  const unsigned char* V8 = (const unsigned char*)(p.ws + OFF_VB);
  const float* SCL = (const float*)(p.ws + OFF_SCL);
  const int* EIDX = (const int*)(p.ws + OFF_EIDX);
  const float* GATE = (const float*)(p.ws + OFF_GATE);
  float* wgt = (float*)lds;
  float* red = (float*)(lds + 1024);
  float* part = (float*)(lds + 2048);
  for (int tok = blockIdx.x; tok < NTOK; tok += gridDim.x) {
    int tidv = threadIdx.x; asm volatile("" : "+v"(tidv));
    const int tid = tidv, lane = tid & 63, w = tid >> 6;
    const bf16_t* xr = X1B + (size_t)tok * 2048;
    float xa[2][16];
#pragma unroll
    for (int j = 0; j < 2; ++j)
#pragma unroll
      for (int q = 0; q < 2; ++q) {
        u32x4 t = *(const u32x4*)(xr + 1024 * j + 16 * lane + 8 * q);
        xa[j][8 * q] = bflo(t.x); xa[j][8 * q + 1] = bfhi(t.x); xa[j][8 * q + 2] = bflo(t.y); xa[j][8 * q + 3] = bfhi(t.y);
        xa[j][8 * q + 4] = bflo(t.z); xa[j][8 * q + 5] = bfhi(t.z); xa[j][8 * q + 6] = bflo(t.w); xa[j][8 * q + 7] = bfhi(t.w);
      }
    __syncthreads();
#ifndef UR
#define UR 16
#endif
#ifndef VR
#define VR 16
#endif
#pragma unroll 1
    for (int k6 = 0; k6 < 32; k6 += UR) {
      u32x4 r[UR][2];
      int ee[UR];
#pragma unroll
      for (int kk = 0; kk < UR; ++kk) {
        const int kq = (k6 + kk < 32) ? (k6 + kk) : 31;
        ee[kk] = __builtin_amdgcn_readfirstlane(EIDX[(size_t)tok * 128 + w * 32 + kq]);
        const unsigned char* ur = U8 + (size_t)ee[kk] * 2048 + lane * 16;
        r[kk][0] = *(const u32x4*)ur;
        r[kk][1] = *(const u32x4*)(ur + 1024);
      }
      float dot[UR];
#pragma unroll
      for (int kk = 0; kk < UR; ++kk) dot[kk] = dot16_fp8(r[kk][0], xa[0]) + dot16_fp8(r[kk][1], xa[1]);
#pragma unroll
      for (int o = 32; o >= 1; o >>= 1) {
#pragma unroll
        for (int kk = 0; kk < UR; ++kk) dot[kk] += __shfl_xor(dot[kk], o);
      }
      if (lane < UR && k6 + lane < 32) {
        float a = dot[0]; int e = ee[0];
#pragma unroll
        for (int kk = 1; kk < UR; ++kk) { if (lane == kk) { a = dot[kk]; e = ee[kk]; } }
        const int k = w * 32 + k6 + lane;
        a *= SCL[e];
        const float ge = 0.5f * a * (1.f + erff(a * 0.70710678118654752f));
        wgt[k] = GATE[(size_t)tok * 128 + k] * ge * SCL[16384 + e];
      }
    }
    __syncthreads();
#pragma unroll 1
    for (int j = 0; j < 2; ++j) {
      float acc[16];
#pragma unroll
      for (int q = 0; q < 16; ++q) acc[q] = 0.f;
#pragma unroll 1
      for (int k6 = 0; k6 < 32; k6 += VR) {
        u32x4 r[VR];
        float ww[VR];
#pragma unroll
        for (int kk = 0; kk < VR; ++kk) {
          const int kq = (k6 + kk < 32) ? (k6 + kk) : 31;
          const int k = w * 32 + kq;
          const int e = __builtin_amdgcn_readfirstlane(EIDX[(size_t)tok * 128 + k]);
          ww[kk] = (k6 + kk < 32) ? wgt[k] : 0.f;
          r[kk] = *(const u32x4*)(V8 + (size_t)e * 2048 + 1024 * j + lane * 16);
        }
#pragma unroll
        for (int kk = 0; kk < VR; ++kk) axpy16_fp8(r[kk], ww[kk], acc);
      }
#pragma unroll
      for (int q = 0; q < 4; ++q)
        *(f32x4*)(part + w * 2048 + 1024 * j + 16 * lane + 4 * q) = (f32x4){acc[4 * q], acc[4 * q + 1], acc[4 * q + 2], acc[4 * q + 3]};
    }
    __syncthreads();
    const float al = 1.189207115002721f;
    const u32x4 xt = *(const u32x4*)(xr + tid * 8);
    f32x4 x0 = {bflo(xt.x), bfhi(xt.x), bflo(xt.y), bfhi(xt.y)}, x1 = {bflo(xt.z), bfhi(xt.z), bflo(xt.w), bfhi(xt.w)};
    f32x4 s0 = {0.f, 0.f, 0.f, 0.f}, s1 = {0.f, 0.f, 0.f, 0.f};
#pragma unroll
    for (int ww2 = 0; ww2 < 4; ++ww2) {
      f32x4 a0 = *(const f32x4*)(part + ww2 * 2048 + tid * 8), a1 = *(const f32x4*)(part + ww2 * 2048 + tid * 8 + 4);
      s0.x += a0.x; s0.y += a0.y; s0.z += a0.z; s0.w += a0.w; s1.x += a1.x; s1.y += a1.y; s1.z += a1.z; s1.w += a1.w;
    }
    float val[8] = {al * x0.x + s0.x, al * x0.y + s0.y, al * x0.z + s0.z, al * x0.w + s0.w,
                    al * x1.x + s1.x, al * x1.y + s1.y, al * x1.z + s1.z, al * x1.w + s1.w};
    float s = 0.f;
#pragma unroll
    for (int j = 0; j < 8; ++j) s += val[j];
    s = wave_sum(s);
    if (lane == 0) red[w] = s;
    __syncthreads();
    const float mean = (red[0] + red[1] + red[2] + red[3]) * (1.f / 2048.f);
    float q = 0.f;
#pragma unroll
    for (int j = 0; j < 8; ++j) { const float d = val[j] - mean; q += d * d; }
    q = wave_sum(q);
    if (lane == 0) red[4 + w] = q;
    __syncthreads();
    const float rs = rsqrtf((red[4] + red[5] + red[6] + red[7]) * (1.f / 2048.f) + 1e-5f);
    f32x4 g0 = *(const f32x4*)(p.ln2_g + tid * 8), g1 = *(const f32x4*)(p.ln2_g + tid * 8 + 4);
    f32x4 b0 = *(const f32x4*)(p.ln2_b + tid * 8), b1 = *(const f32x4*)(p.ln2_b + tid * 8 + 4);
    f32x4 o0 = {(val[0] - mean) * rs * g0.x + b0.x, (val[1] - mean) * rs * g0.y + b0.y, (val[2] - mean) * rs * g0.z + b0.z, (val[3] - mean) * rs * g0.w + b0.w};
    f32x4 o1 = {(val[4] - mean) * rs * g1.x + b1.x, (val[5] - mean) * rs * g1.y + b1.y, (val[6] - mean) * rs * g1.z + b1.z, (val[7] - mean) * rs * g1.w + b1.w};
    float* yo = p.out + OUT_Y + (size_t)tok * 2048 + tid * 8;
    __builtin_nontemporal_store(o0, (f32x4*)yo);
    __builtin_nontemporal_store(o1, (f32x4*)(yo + 4));
  }
}

__device__ __forceinline__ void grid_bar(unsigned* ctr, unsigned target) {
  asm volatile("s_waitcnt vmcnt(0)" ::: "memory");
  __syncthreads();
  if (threadIdx.x == 0) {
    __builtin_amdgcn_fence(__ATOMIC_RELEASE, "agent");
    asm volatile("s_waitcnt vmcnt(0)" ::: "memory");
    __hip_atomic_fetch_add(ctr, 1u, __ATOMIC_RELAXED, __HIP_MEMORY_SCOPE_AGENT);
    while (__hip_atomic_load(ctr, __ATOMIC_RELAXED, __HIP_MEMORY_SCOPE_AGENT) < target) __builtin_amdgcn_s_sleep(2);
    __builtin_amdgcn_fence(__ATOMIC_ACQUIRE, "agent");
    asm volatile("s_waitcnt vmcnt(0)" ::: "memory");
  }
  __syncthreads();
}

__global__ void __launch_bounds__(256, 2) mega(Params p, int ph_lo, int ph_hi, int use_sync) {
  __shared__ __attribute__((aligned(16))) char lds[LDS_BYTES];
  cg::grid_group grid = cg::this_grid();
  unsigned nbar = 0;
#ifndef DUP_PHASE
#define DUP_PHASE -1
#endif
  const int par = (use_sync == 3);
  const int nph = par ? 10 : 8;
  for (int pi = 0; pi < nph; ++pi) {
    const int ph = par ? (pi < 3 ? pi : (pi < 5 ? pi + 5 : pi - 2)) : pi;
    const int reps = (ph == DUP_PHASE) ? 2 : 1;
    for (int rep = 0; rep < reps; ++rep) {
      switch (ph) {
        case 0: phase0(p, lds); break;
        case 1: phase1(p, lds); break;
        case 2: phase2(p, lds, rep, par); break;
        case 8: phase2b(p); break;
        case 9: phase2c(p, lds); break;
        case 3: gemm23<0>(p, lds); break;
        case 4: phase4(p); break;
        case 5: gemm23<1>(p, lds); break;
        case 6: phase6(p, lds); break;
        case 7: phase7(p, lds); break;
      }
      if (pi + 1 < nph || rep + 1 < reps) {
        if (use_sync == 2) grid.sync();
        else grid_bar((unsigned*)(p.ws + 128), (unsigned)gridDim.x * (++nbar));
      }
    }
  }
}

extern "C" void kernel_launch(void* const* d_in, const int* in_sizes, int n_in, void* d_out, int out_size,
                              void* d_ws, size_t ws_size, hipStream_t stream) {
  static int grid_blocks = 0;
  if (!grid_blocks) {
    int dev = 0, cus = 0, per_cu = 0;
    hipGetDevice(&dev);
    hipDeviceGetAttribute(&cus, hipDeviceAttributeMultiprocessorCount, dev);
    hipOccupancyMaxActiveBlocksPerMultiprocessor(&per_cu, mega, 256, 0);
    if (per_cu > 2) per_cu = 2;
    if (per_cu < 1) per_cu = 1;
    grid_blocks = cus * per_cu;
    grid_blocks &= ~7;
  }
  Params p{};
  p.x_prompt = (const float*)d_in[0]; p.x_sample = (const float*)d_in[1]; p.cache_k = (const float*)d_in[2];
  p.cache_v = (const float*)d_in[3]; p.state = (const float*)d_in[4]; p.w_in = (const float*)d_in[5];
  p.hgrn_lb = (const float*)d_in[6]; p.hgrn_g = (const float*)d_in[7]; p.lq1 = (const float*)d_in[8];
  p.lk1 = (const float*)d_in[9]; p.lq2 = (const float*)d_in[10]; p.lk2 = (const float*)d_in[11];
  p.diff_g = (const float*)d_in[12]; p.w_out = (const float*)d_in[13]; p.ln1_g = (const float*)d_in[14];
  p.ln1_b = (const float*)d_in[15]; p.wq = (const float*)d_in[16]; p.subk = (const float*)d_in[17];
  p.pu = (const float*)d_in[18]; p.pv = (const float*)d_in[19]; p.ln2_g = (const float*)d_in[20];
  p.ln2_b = (const float*)d_in[21];
  p.out = (float*)d_out; p.ws = (char*)d_ws;
  hipMemsetAsync(d_ws, 0, 512, stream);
  int lo = 0, hi = 7, us = 3;
  void* args[] = {&p, &lo, &hi, &us};
  hipError_t e = hipLaunchCooperativeKernel((const void*)mega, dim3(grid_blocks), dim3(256), args, 0, stream);
  if (e != hipSuccess) fprintf(stderr, "cooperative launch failed: %s (grid %d)\n", hipGetErrorString(e), grid_blocks);
}
```

```cpp
#include <hip/hip_runtime.h>
#include <hip/hip_cooperative_groups.h>
#include <stdint.h>
#include <cstdio>
namespace cg = cooperative_groups;

typedef unsigned short bf16_t;
typedef short bf16x8 __attribute__((ext_vector_type(8)));
typedef float f32x4 __attribute__((ext_vector_type(4)));
typedef unsigned u32x4 __attribute__((ext_vector_type(4)));
typedef unsigned u32x2 __attribute__((ext_vector_type(2)));

#define NTOK 16896
#define NPTOK 16384
#define LDS_BYTES 65536

#define OUT_Y   0
#define OUT_KP  34603008
#define OUT_VP  51380224
#define OUT_SP  68157440
#define OUT_KS  68681728
#define OUT_VS  69206016
#define OUT_SS  69730304

constexpr size_t SZ_XB     = (size_t)NTOK * 2048 * 2;
constexpr size_t SZ_T1K2   = (size_t)NTOK * 1024 * 2;
constexpr size_t SZ_W2     = (size_t)2048 * 2048 * 2;
constexpr size_t SZ_KS     = (size_t)64 * 1088 * 128 * 2;
constexpr size_t SZ_KP     = (size_t)32 * 4096 * 128 * 2;
constexpr size_t OFF_CTR   = 0;
constexpr size_t OFF_LB    = 4096;
constexpr size_t OFF_XB    = 8192;
constexpr size_t OFF_WINT  = OFF_XB + SZ_XB;
constexpr size_t OFF_WOUTT = OFF_WINT + (size_t)7168 * 2048 * 2;
constexpr size_t OFF_WQT   = OFF_WOUTT + SZ_W2;
constexpr size_t OFF_SKB   = OFF_WQT + SZ_W2;
constexpr size_t OFF_KS    = OFF_SKB + 524288;
constexpr size_t OFF_VTS   = OFF_KS + SZ_KS;
constexpr size_t OFF_R4    = OFF_VTS + SZ_KS;
constexpr size_t OFF_QA    = OFF_R4;
constexpr size_t OFF_LOGF  = OFF_QA + SZ_T1K2;
constexpr size_t OFF_IAT   = OFF_LOGF + 2 * SZ_T1K2;
constexpr size_t OFF_GA    = OFF_IAT + SZ_T1K2;
constexpr size_t OFF_QB    = OFF_GA + SZ_T1K2;
constexpr size_t OFF_KP    = OFF_QB + SZ_T1K2;
constexpr size_t OFF_VTP   = OFF_KP + SZ_KP;
constexpr size_t OFF_R4END = OFF_VTP + SZ_KP;
constexpr size_t OFF_X1F   = OFF_R4;
constexpr size_t OFF_UB    = OFF_XB;
constexpr size_t OFF_VB    = OFF_UB + (size_t)16384 * 2048;
constexpr size_t OFF_SCL   = OFF_VB + (size_t)16384 * 2048;
constexpr size_t OFF_MERGED= OFF_R4END;
constexpr size_t OFF_QP    = OFF_MERGED;
constexpr size_t OFF_X1B   = OFF_X1F + (size_t)NTOK * 2048 * 4;
constexpr size_t OFF_EIDX  = OFF_WINT;
constexpr size_t OFF_GATE  = OFF_EIDX + (size_t)NTOK * 128 * 4;
constexpr size_t OFF_DBUF  = OFF_WINT + (size_t)20 * 1024 * 1024;
constexpr size_t OFF_LS    = OFF_XB;
constexpr size_t WS_NEED_PAR = OFF_MERGED + SZ_XB;
static_assert((size_t)32 * 64 * 16 * 256 * 8 <= SZ_XB, "LS fits XB");
static_assert(OFF_SCL + 32768 * 4 <= OFF_WINT, "overlay"); static_assert(OFF_X1B + SZ_XB <= OFF_R4END, "overlay");

struct Params {
  const float* x_prompt; const float* x_sample; const float* cache_k; const float* cache_v; const float* state;
  const float* w_in; const float* hgrn_lb; const float* hgrn_g; const float* lq1; const float* lk1;
  const float* lq2; const float* lk2; const float* diff_g; const float* w_out; const float* ln1_g; const float* ln1_b;
  const float* wq; const float* subk; const float* pu; const float* pv; const float* ln2_g; const float* ln2_b;
  float* out; char* ws;
};

typedef __bf16 bf16x2_t __attribute__((ext_vector_type(2)));
typedef float f32x2_t __attribute__((ext_vector_type(2)));
__device__ __forceinline__ unsigned pk_bf16(float lo, float hi) {
  f32x2_t f = {lo, hi};
  bf16x2_t b = __builtin_convertvector(f, bf16x2_t);
  return __builtin_bit_cast(unsigned, b);
}
__device__ __forceinline__ float bf2f(unsigned short x) { return __uint_as_float(((unsigned)x) << 16); }
__device__ __forceinline__ float bflo(unsigned x) { return __uint_as_float(x << 16); }
__device__ __forceinline__ float bfhi(unsigned x) { return __uint_as_float(x & 0xffff0000u); }
__device__ __forceinline__ f32x4 mfma16(bf16x8 a, bf16x8 b, f32x4 c) {
  return __builtin_amdgcn_mfma_f32_16x16x32_bf16(a, b, c, 0, 0, 0);
}
__device__ __forceinline__ bf16x8 mk8(unsigned a, unsigned b, unsigned c, unsigned d) {
  u32x4 v = {a, b, c, d}; return __builtin_bit_cast(bf16x8, v);
}
__device__ __forceinline__ bf16x8 mk8(u32x2 a, u32x2 b) {
  u32x4 v = {a.x, a.y, b.x, b.y}; return __builtin_bit_cast(bf16x8, v);
}
__device__ __forceinline__ float wave_sum(float v) {
#pragma unroll
  for (int o = 32; o >= 1; o >>= 1) v += __shfl_xor(v, o);
  return v;
}

__device__ void transpose_conv(const float* __restrict__ W, bf16_t* __restrict__ WT, int K, int N, char* lds) {
  float* tile = (float*)lds;
  int tid_o = threadIdx.x; asm volatile("" : "+v"(tid_o)); const int tid = tid_o;
  const int nkt = K / 64, nnt = N / 64;
  for (int t = blockIdx.x; t < nkt * nnt; t += gridDim.x) {
    const int kt = t / nnt, nt = t % nnt;
    const int c = tid & 63, r0 = tid >> 6;
#pragma unroll 4
    for (int i = 0; i < 16; ++i) {
      int r = i * 4 + r0;
      tile[r * 65 + c] = W[(size_t)(kt * 64 + r) * N + nt * 64 + c];
    }
    __syncthreads();
#pragma unroll 4
    for (int i = 0; i < 16; ++i) {
      int n = i * 4 + r0;
      float v = tile[c * 65 + n];
      WT[(size_t)(nt * 64 + n) * K + kt * 64 + c] = (bf16_t)(pk_bf16(v, 0.f) & 0xffff);
    }
    __syncthreads();
  }
}

__device__ __forceinline__ void conv8(const float* __restrict__ src, bf16_t* __restrict__ dst) {
  f32x4 a = __builtin_nontemporal_load((const f32x4*)src), b = __builtin_nontemporal_load((const f32x4*)(src + 4));
  u32x4 o = {pk_bf16(a.x, a.y), pk_bf16(a.z, a.w), pk_bf16(b.x, b.y), pk_bf16(b.z, b.w)};
  *(u32x4*)dst = o;
}

__device__ void phase0(const Params& p, char* lds) {
  int tid_o = threadIdx.x; asm volatile("" : "+v"(tid_o)); const int tid = tid_o, bid = blockIdx.x;
  const size_t gtid = (size_t)bid * 256 + tid, gsz = (size_t)gridDim.x * 256;
  if (bid == 0) {
    if (tid < 64) {
      float a = p.lq1[tid] * p.lk1[tid], b = p.lq2[tid] * p.lk2[tid];
      a = wave_sum(a); b = wave_sum(b);
      if (tid == 0) ((float*)(p.ws + OFF_CTR))[16] = expf(a) - expf(b) + 0.2f;
    }
    float* LB = (float*)(p.ws + OFF_LB);
    for (int k = tid; k < 1024; k += 256) {
      float a0 = p.hgrn_lb[k], a1 = p.hgrn_lb[1024 + k];
      LB[k] = 1.0f / (1.0f + expf(a1 - a0));
    }
  }
  {
    bf16_t* XB = (bf16_t*)(p.ws + OFF_XB);
    const size_t nch = (size_t)NTOK * 2048 / 8;
    for (size_t c = gtid; c < nch; c += gsz) {
      size_t e = c * 8;
      const float* src = (e < (size_t)NPTOK * 2048) ? (p.x_prompt + e) : (p.x_sample + (e - (size_t)NPTOK * 2048));
      conv8(src, XB + e);
    }
  }
  {
    bf16_t* KS = (bf16_t*)(p.ws + OFF_KS);
    for (size_t c = gtid; c < (size_t)1048576; c += gsz) {
      int d8 = c & 15, h = (c >> 4) & 7, s = (c >> 7) & 1023, b = (int)(c >> 17);
      conv8(p.cache_k + c * 8, KS + ((size_t)((b * 8 + h) * 1088 + s) * 128 + d8 * 8));
    }
  }
  {
    bf16_t* VTS = (bf16_t*)(p.ws + OFF_VTS);
    for (size_t i = gtid; i < (size_t)2097152; i += gsz) {
      int vc = i & 127, s4 = (i >> 7) & 255, h = (i >> 15) & 7, b = (int)(i >> 18);
      const float* src = p.cache_v + ((size_t)(b * 1024 + s4 * 4) * 8 + h) * 128 + vc;
      float v0 = src[0], v1 = src[1024], v2 = src[2048], v3 = src[3072];
      u32x2 o = {pk_bf16(v0, v1), pk_bf16(v2, v3)};
      *(u32x2*)(VTS + ((size_t)((b * 8 + h) * 128 + vc) * 1088 + s4 * 4)) = o;
    }
  }
  {
    bf16_t* SKB = (bf16_t*)(p.ws + OFF_SKB);
    for (size_t c = gtid; c < (size_t)32768; c += gsz) conv8(p.subk + c * 8, SKB + c * 8);
  }
  transpose_conv(p.w_in, (bf16_t*)(p.ws + OFF_WINT), 2048, 7168, lds);
  transpose_conv(p.w_out, (bf16_t*)(p.ws + OFF_WOUTT), 2048, 2048, lds);
  transpose_conv(p.wq, (bf16_t*)(p.ws + OFF_WQT), 2048, 2048, lds);
}

template <bool SWAP>
__device__ __forceinline__ void gemm_compute_tile(const char* cur, int aoff, int boff, int sw, int fq, f32x4 (&acc)[4][4]) {
#pragma unroll
  for (int ks = 0; ks < 2; ++ks) {
    bf16x8 af[4], bfr[4];
    const int ch = ((ks * 4 + fq) ^ sw) << 4;
#pragma unroll
    for (int m = 0; m < 4; ++m) af[m] = *(const bf16x8*)(cur + aoff + m * 2048 + ch);
#pragma unroll
    for (int n = 0; n < 4; ++n) bfr[n] = *(const bf16x8*)(cur + boff + n * 2048 + ch);
    __builtin_amdgcn_s_setprio(1);
#pragma unroll
    for (int m = 0; m < 4; ++m)
#pragma unroll
      for (int n = 0; n < 4; ++n)
        acc[m][n] = SWAP ? mfma16(bfr[n], af[m], acc[m][n]) : mfma16(af[m], bfr[n], acc[m][n]);
    __builtin_amdgcn_s_setprio(0);
  }
}

template <bool SWAP>
__device__ __forceinline__ void gemm_mainloop(const bf16_t* A, const bf16_t* B,
                                              int row0, int col0, int K, char* lds, f32x4 (&acc)[4][4]) {
  int tid_o = threadIdx.x; asm volatile("" : "+v"(tid_o)); const int tid = tid_o, lane = tid & 63, wave = tid >> 6;
  const int wm = wave >> 1, wn = wave & 1, fr = lane & 15, fq = lane >> 4;
  const int lrow = tid >> 3, lc = tid & 7;
  const int cl = lc ^ (lrow & 7);
  const bf16_t* ga = A + (size_t)(row0 + lrow) * K + cl * 8;
  const bf16_t* gb = B + (size_t)(col0 + lrow) * K + cl * 8;
  const int loff = tid * 16;
#define G_STAGE(BUF, KT) { _Pragma("unroll") for (int i = 0; i < 4; ++i) { \
      __builtin_amdgcn_global_load_lds((const unsigned*)(ga + (size_t)i * 32 * K + (KT) * 64), (unsigned*)((BUF) + loff + i * 4096), 16, 0, 0); \
      __builtin_amdgcn_global_load_lds((const unsigned*)(gb + (size_t)i * 32 * K + (KT) * 64), (unsigned*)((BUF) + 16384 + loff + i * 4096), 16, 0, 0); } }
  const int nkt = K >> 6;
  G_STAGE(lds, 0);
  __syncthreads();
  const int aoff = (wm * 64 + fr) * 128, boff = 16384 + (wn * 64 + fr) * 128;
  const int sw = fr & 7;
  for (int kt = 0; kt < nkt; ++kt) {
    char* cur = lds + (kt & 1) * 32768;
    char* nxt = lds + ((kt + 1) & 1) * 32768;
    if (kt + 1 < nkt) G_STAGE(nxt, kt + 1);
    gemm_compute_tile<SWAP>(cur, aoff, boff, sw, fq, acc);
    __syncthreads();
  }
#undef G_STAGE
}

template <int MT, bool SWAP>
__device__ __forceinline__ void gemm_mainloop_big(const bf16_t* A, const bf16_t* B,
                                                  int row0, int col0, int K, char* lds, f32x4 (&acc)[MT][4]) {
  int tid_o = threadIdx.x; asm volatile("" : "+v"(tid_o)); const int tid = tid_o, lane = tid & 63, wave = tid >> 6;
  const int wm = wave >> 1, wn = wave & 1, fr = lane & 15, fq = lane >> 4;
  const int lrow = tid >> 3, lc = tid & 7;
  const int cl = lc ^ (lrow & 7);
  const bf16_t* ga = A + (size_t)(row0 + lrow) * K + cl * 8;
  const bf16_t* gb = B + (size_t)(col0 + lrow) * K + cl * 8;
  const int loff = tid * 16;
  const int nkt = K >> 6;
  constexpr int BOFF = MT * 32 * 128;
  const int aoff = (wm * (MT * 16) + fr) * 128, boff = BOFF + (wn * 64 + fr) * 128;
  const int sw = fr & 7;
  for (int kt = 0; kt < nkt; ++kt) {
#pragma unroll
    for (int i = 0; i < MT; ++i)
      __builtin_amdgcn_global_load_lds((const unsigned*)(ga + (size_t)i * 32 * K + kt * 64), (unsigned*)(lds + loff + i * 4096), 16, 0, 0);
#pragma unroll
    for (int i = 0; i < 4; ++i)
      __builtin_amdgcn_global_load_lds((const unsigned*)(gb + (size_t)i * 32 * K + kt * 64), (unsigned*)(lds + BOFF + loff + i * 4096), 16, 0, 0);
    __syncthreads();
#pragma unroll
    for (int ks = 0; ks < 2; ++ks) {
      bf16x8 af[MT], bfr[4];
      const int ch = ((ks * 4 + fq) ^ sw) << 4;
#pragma unroll
      for (int m = 0; m < MT; ++m) af[m] = *(const bf16x8*)(lds + aoff + m * 2048 + ch);
#pragma unroll
      for (int n = 0; n < 4; ++n) bfr[n] = *(const bf16x8*)(lds + boff + n * 2048 + ch);
      __builtin_amdgcn_s_setprio(1);
#pragma unroll
      for (int m = 0; m < MT; ++m)
#pragma unroll
        for (int n = 0; n < 4; ++n)
          acc[m][n] = SWAP ? mfma16(bfr[n], af[m], acc[m][n]) : mfma16(af[m], bfr[n], acc[m][n]);
      __builtin_amdgcn_s_setprio(0);
    }
    __syncthreads();
  }
}

template <bool SWAP>
__device__ void gemm1_tile(const Params& p, int mt, int nt, char* lds) {
  f32x4 acc[8][4];
#pragma unroll
  for (int m = 0; m < 8; ++m)
#pragma unroll
    for (int n = 0; n < 4; ++n) acc[m][n] = (f32x4){0.f, 0.f, 0.f, 0.f};
  gemm_mainloop_big<8, SWAP>((const bf16_t*)(p.ws + OFF_XB), (const bf16_t*)(p.ws + OFF_WINT), mt * 256, nt * 128, 2048, lds, acc);
  int tidv = threadIdx.x; asm volatile("" : "+v"(tidv));
  const int tid = tidv, lane = tid & 63, wave = tid >> 6;
  const int wm = wave >> 1, wn = wave & 1, fr = lane & 15, fq = lane >> 4;
  const int seg = nt >> 3, h = nt & 7;
  const bool samp = (mt * 256 >= NPTOK);
  if (SWAP) {
    const float* LB = (const float*)(p.ws + OFF_LB);
    if (seg == 5 && !samp) {
      float nmax = 0.f;
#pragma unroll
      for (int m = 0; m < 8; ++m) {
        float s2 = 0.f;
#pragma unroll
        for (int n = 0; n < 4; ++n) s2 += acc[m][n].x * acc[m][n].x + acc[m][n].y * acc[m][n].y + acc[m][n].z * acc[m][n].z + acc[m][n].w * acc[m][n].w;
        s2 += __shfl_xor(s2, 16);
        s2 += __shfl_xor(s2, 32);
        nmax = fmaxf(nmax, s2);
      }
#pragma unroll
      for (int o = 8; o >= 1; o >>= 1) nmax = fmaxf(nmax, __shfl_xor(nmax, o));
      if (lane == 0) atomicMax((unsigned*)(p.ws + 256) + ((mt * 256) >> 12) * 16 + h * 2 + wn, __float_as_uint(nmax));
    }
#pragma unroll
    for (int m = 0; m < 8; ++m) {
      const int tok = mt * 256 + wm * 128 + m * 16 + fr;
#pragma unroll
      for (int n = 0; n < 4; ++n) {
        const int cl = wn * 64 + n * 16 + fq * 4;
        const int kidx = h * 128 + cl;
        f32x4 v = acc[m][n];
        if (seg == 0) {
          u32x2 o = {pk_bf16(v.x, v.y), pk_bf16(v.z, v.w)};
          *(u32x2*)((bf16_t*)(p.ws + OFF_QA) + (size_t)tok * 1024 + kidx) = o;
        } else if (seg == 1) {
          f32x4 lb = *(const f32x4*)(LB + kidx);
          f32x4 o;
          o.x = lb.x + (1.f - lb.x) / (1.f + __expf(-v.x));
          o.y = lb.y + (1.f - lb.y) / (1.f + __expf(-v.y));
          o.z = lb.z + (1.f - lb.z) / (1.f + __expf(-v.z));
          o.w = lb.w + (1.f - lb.w) / (1.f + __expf(-v.w));
          *(f32x4*)((float*)(p.ws + OFF_LOGF) + (size_t)tok * 1024 + kidx) = o;
        } else if (seg == 3) {
          float s0 = 1.f / (1.f + __expf(-v.x)), s1 = 1.f / (1.f + __expf(-v.y));
          float s2 = 1.f / (1.f + __expf(-v.z)), s3 = 1.f / (1.f + __expf(-v.w));
          u32x2 o = {pk_bf16(s0, s1), pk_bf16(s2, s3)};
          *(u32x2*)((bf16_t*)(p.ws + OFF_GA) + (size_t)tok * 1024 + kidx) = o;
        } else if (seg == 4) {
          const float sc = 0.18033688011112042f;
          u32x2 o = {pk_bf16(v.x * sc, v.y * sc), pk_bf16(v.z * sc, v.w * sc)};
          *(u32x2*)((bf16_t*)(p.ws + OFF_QB) + (size_t)tok * 1024 + kidx) = o;
        } else {
          u32x2 o = {pk_bf16(v.x, v.y), pk_bf16(v.z, v.w)};
          if (!samp) {
            __builtin_nontemporal_store(v, (f32x4*)(p.out + OUT_KP + (size_t)tok * 1024 + kidx));
            const int b = tok >> 12, t = tok & 4095;
            *(u32x2*)((bf16_t*)(p.ws + OFF_KP) + ((size_t)((b * 8 + h) * 4096 + t) * 128 + cl)) = o;
          } else {
            const int ts = tok - NPTOK;
            __builtin_nontemporal_store(v, (f32x4*)(p.out + OUT_KS + (size_t)ts * 1024 + kidx));
            const int b = ts >> 6, t = ts & 63;
            *(u32x2*)((bf16_t*)(p.ws + OFF_KS) + ((size_t)((b * 8 + h) * 1088 + 1024 + t) * 128 + cl)) = o;
          }
        }
      }
    }
  } else {
#pragma unroll
    for (int m = 0; m < 8; ++m) {
      const int tok0 = mt * 256 + wm * 128 + m * 16 + fq * 4;
#pragma unroll
      for (int n = 0; n < 4; ++n) {
        const int cl = wn * 64 + n * 16 + fr;
        f32x4 v = acc[m][n];
        u32x2 o = {pk_bf16(v.x, v.y), pk_bf16(v.z, v.w)};
        if (seg == 2) {
          bf16_t* IAT = (bf16_t*)(p.ws + OFF_IAT);
          if (!samp) {
            const int b = tok0 >> 12, t = tok0 & 4095;
            *(u32x2*)(IAT + ((size_t)((b * 8 + h) * 128 + cl) * 4096 + t)) = o;
          } else {
            const int ts = tok0 - NPTOK, b = ts >> 6, t = ts & 63;
            *(u32x2*)(IAT + (size_t)32 * 128 * 4096 + ((size_t)((b * 8 + h) * 128 + cl) * 64 + t)) = o;
          }
        } else {
          if (!samp) {
            float* ov = p.out + OUT_VP + (size_t)tok0 * 1024 + h * 128 + cl;
            __builtin_nontemporal_store(v.x, ov); __builtin_nontemporal_store(v.y, ov + 1024); __builtin_nontemporal_store(v.z, ov + 2048); __builtin_nontemporal_store(v.w, ov + 3072);
            const int b = tok0 >> 12, t = tok0 & 4095;
            *(u32x2*)((bf16_t*)(p.ws + OFF_VTP) + ((size_t)((b * 8 + h) * 128 + cl) * 4096 + t)) = o;
          } else {
            const int ts = tok0 - NPTOK, b = ts >> 6, t = ts & 63;
            float* ov = p.out + OUT_VS + (size_t)ts * 1024 + h * 128 + cl;
            __builtin_nontemporal_store(v.x, ov); __builtin_nontemporal_store(v.y, ov + 1024); __builtin_nontemporal_store(v.z, ov + 2048); __builtin_nontemporal_store(v.w, ov + 3072);
            *(u32x2*)((bf16_t*)(p.ws + OFF_VTS) + ((size_t)((b * 8 + h) * 128 + cl) * 1088 + 1024 + t)) = o;
          }
        }
      }
    }
  }
}

__device__ void phase1(const Params& p, char* lds) {
  const int xcd = blockIdx.x & 7, lb = blockIdx.x >> 3, nbx = gridDim.x >> 3;
  const int nM = NTOK / 256, nNx = 7;
  for (int li = lb; li < nM * nNx; li += nbx) {
    const int mt = li / nNx, nt = (li % nNx) * 8 + xcd;
    const int seg = nt >> 3;
    if (seg == 2 || seg == 6) gemm1_tile<false>(p, mt, nt, lds);
    else gemm1_tile<true>(p, mt, nt, lds);
  }
}

template <int MODE, int MT>
__device__ void gemm23_tile(const Params& p, int row0, int nt, char* lds) {
  const bf16_t* A = (const bf16_t*)(p.ws + (MODE == 0 ? OFF_MERGED : OFF_X1B));
  const bf16_t* B = (const bf16_t*)(p.ws + (MODE == 0 ? OFF_WOUTT : OFF_WQT));
  f32x4 acc[MT][4];
#pragma unroll
  for (int m = 0; m < MT; ++m)
#pragma unroll
    for (int n = 0; n < 4; ++n) acc[m][n] = (f32x4){0.f, 0.f, 0.f, 0.f};
  if (MT == 4) gemm_mainloop<true>(A, B, row0, nt * 128, 2048, lds, (f32x4(&)[4][4])acc);
  else gemm_mainloop_big<MT, true>(A, B, row0, nt * 128, 2048, lds, acc);
  int tid_o = threadIdx.x; asm volatile("" : "+v"(tid_o)); const int tid = tid_o, lane = tid & 63, wave = tid >> 6;
  const int wm = wave >> 1, wn = wave & 1, fr = lane & 15, fq = lane >> 4;
#pragma unroll
  for (int m = 0; m < MT; ++m) {
    const int tok = row0 + wm * (MT * 16) + m * 16 + fr;
#pragma unroll
    for (int n = 0; n < 4; ++n) {
      const int col = nt * 128 + wn * 64 + n * 16 + fq * 4;
      f32x4 v = acc[m][n];
      if (MODE == 0) {
        const float* xin = (tok < NPTOK) ? (p.x_prompt + (size_t)tok * 2048) : (p.x_sample + (size_t)(tok - NPTOK) * 2048);
        f32x4 xv = __builtin_nontemporal_load((const f32x4*)(xin + col));
        const float al = 1.189207115002721f;
        u32x2 o = {pk_bf16(al * xv.x + v.x, al * xv.y + v.y), pk_bf16(al * xv.z + v.z, al * xv.w + v.w)};
        *(u32x2*)((bf16_t*)(p.ws + OFF_X1B) + (size_t)tok * 2048 + col) = o;
      } else {
        u32x2 o = {pk_bf16(v.x, v.y), pk_bf16(v.z, v.w)};
        *(u32x2*)((bf16_t*)(p.ws + OFF_QP) + (size_t)tok * 2048 + col) = o;
      }
    }
  }
}

template <int MODE>
__device__ void gemm23(const Params& p, char* lds) {
  const int xcd = blockIdx.x & 7, lb = blockIdx.x >> 3, nbx = gridDim.x >> 3;
  for (int li = lb; li < 64 * 2; li += nbx) gemm23_tile<MODE, 8>(p, (li >> 1) * 256, (li & 1) * 8 + xcd, lds);
  for (int li = lb; li < 4 * 2; li += nbx) gemm23_tile<MODE, 4>(p, NPTOK + (li >> 1) * 128, (li & 1) * 8 + xcd, lds);
}

__device__ void hgrn_item(const Params& p, int kind, int b, int h, char* lds, int mode, int c0) {
  int tid_o = threadIdx.x; asm volatile("" : "+v"(tid_o)); const int tid = tid_o, lane = tid & 63, w = tid >> 6, fr = lane & 15, fq = lane >> 4;
  const int tokbase = kind == 0 ? b * 4096 : NPTOK + b * 64;
  const int c_begin = mode == 0 ? 0 : c0, nch = mode == 0 ? (kind == 0 ? 64 : 1) : c0 + 1;
  u32x2* LSb = (u32x2*)(p.ws + OFF_LS) + ((size_t)((b * 8 + h) * 64 + c0) * 16) * 256 + tid;
  const bf16_t* IATb = (const bf16_t*)(p.ws + OFF_IAT) +
      (kind == 0 ? (size_t)((b * 8 + h) * 128) * 4096 : (size_t)32 * 128 * 4096 + (size_t)((b * 8 + h) * 128) * 64);
  const int iat_stride = kind == 0 ? 4096 : 64;
  const float* LOGF = (const float*)(p.ws + OFF_LOGF);
  const bf16_t* QA = (const bf16_t*)(p.ws + OFF_QA);
  const bf16_t* GA = (const bf16_t*)(p.ws + OFF_GA);
  bf16_t* MERGED = (bf16_t*)(p.ws + OFF_MERGED);

  f32x4 S[8][2];
  if (mode == 2) {
#pragma unroll
    for (int kt = 0; kt < 8; ++kt)
#pragma unroll
      for (int vv = 0; vv < 2; ++vv) {
        u32x2 t = LSb[(kt * 2 + vv) * 256];
        S[kt][vv] = (f32x4){bflo(t.x), bfhi(t.x), bflo(t.y), bfhi(t.y)};
      }
  } else if (kind == 0) {
#pragma unroll
    for (int kt = 0; kt < 8; ++kt)
#pragma unroll
      for (int vv = 0; vv < 2; ++vv) S[kt][vv] = (f32x4){0.f, 0.f, 0.f, 0.f};
  } else {
    const float* st = p.state + (size_t)((b * 8 + h) * 128) * 128 + (4 * fq) * 128 + 32 * w + fr;
#pragma unroll
    for (int kt = 0; kt < 8; ++kt)
#pragma unroll
      for (int vv = 0; vv < 2; ++vv)
#pragma unroll
        for (int j = 0; j < 4; ++j) S[kt][vv][j] = st[(16 * kt + j) * 128 + 16 * vv];
  }
  f32x4 gn[2];
#pragma unroll
  for (int vv = 0; vv < 2; ++vv) gn[vv] = *(const f32x4*)(p.hgrn_g + 32 * w + 16 * vv + 4 * fq);

  const int ekp = tid & 63, eq = tid >> 6;

  u32x4 gR[8];
  unsigned qn[16];
#pragma unroll
  for (int i = 0; i < 8; ++i) {
    int id = tid + 256 * i, row = id >> 5, cc = id & 31;
    gR[i] = *(const u32x4*)(LOGF + (size_t)(tokbase + c_begin * 64 + row) * 1024 + h * 128 + cc * 4);
  }
#pragma unroll
  for (int i = 0; i < 16; ++i) qn[i] = *(const unsigned*)(QA + (size_t)(tokbase + c_begin * 64 + 16 * eq + i) * 1024 + h * 128 + 2 * ekp);
  for (int c = c_begin; c < nch; ++c) {
    int zz = 0; asm volatile("" : "+v"(zz));
    int tidv = threadIdx.x; asm volatile("" : "+v"(tidv));
    const int tid = tidv, lane = tid & 63, w = tid >> 6, fr = lane & 15, fq = lane >> 4, ekp = tid & 63, eq = tid >> 6;
    char* L = lds + zz;
    float* Dl = (float*)(L + 57344);
    float* part = (float*)(L + 57856);
    const int tok0 = tokbase + c * 64 + zz;
#pragma unroll
    for (int i = 0; i < 8; ++i) {
      int id = tid + 256 * i, row = id >> 5, cc = id & 31;
      *(u32x4*)(L + row * 512 + cc * 16) = gR[i];
    }
    unsigned qv[16];
#pragma unroll
    for (int i = 0; i < 16; ++i) qv[i] = qn[i];
    if (c + 1 < nch) {
#pragma unroll
      for (int i = 0; i < 8; ++i) {
        int id = tid + 256 * i, row = id >> 5, cc = id & 31;
        gR[i] = *(const u32x4*)(LOGF + (size_t)(tok0 + 64 + row) * 1024 + h * 128 + cc * 4);
      }
    }
    bf16x8 vfr[2][2];
#pragma unroll
    for (int ss = 0; ss < 2; ++ss)
#pragma unroll
      for (int vv = 0; vv < 2; ++vv)
        vfr[ss][vv] = *(const bf16x8*)(IATb + (size_t)(32 * w + 16 * vv + fr) * iat_stride + c * 64 + zz + 32 * ss + 8 * fq);
    __syncthreads();
    typedef float f32x2 __attribute__((ext_vector_type(2)));
    f32x2 gv[16];
    const float* Gl = (const float*)L;
    float* qtot = (float*)(L + 58880);
    float tot0 = 1.f, tot1 = 1.f;
#pragma unroll
    for (int i = 0; i < 16; ++i) { gv[i] = *(const f32x2*)(Gl + (16 * eq + i) * 128 + 2 * ekp); tot0 *= gv[i].x; tot1 *= gv[i].y; }
    qtot[eq * 128 + 2 * ekp] = tot0; qtot[eq * 128 + 2 * ekp + 1] = tot1;
    __syncthreads();
    {
      float run0 = 1.f, run1 = 1.f;
      for (int qq = 0; qq < eq; ++qq) { run0 *= qtot[qq * 128 + 2 * ekp]; run1 *= qtot[qq * 128 + 2 * ekp + 1]; }
      const int k0 = 2 * ekp;
#pragma unroll
      for (int i4 = 0; i4 < 4; ++i4) {
        float ka[4], kb[4];
#pragma unroll
        for (int ii = 0; ii < 4; ++ii) {
          const int i = i4 * 4 + ii, t = 16 * eq + i;
          const float f0 = gv[i].x, f1 = gv[i].y;
          run0 *= f0; run1 *= f1;
          const float q0 = bflo(qv[i]) * run0, q1 = bfhi(qv[i]) * run1;
          const float kk0 = (1.f - f0) * __builtin_amdgcn_rcpf(run0), kk1 = (1.f - f1) * __builtin_amdgcn_rcpf(run1);
          ka[ii] = kk0; kb[ii] = kk1;
          const int o = (t * 128 + ((((k0 >> 3) ^ (t & 15)) << 3) | (k0 & 7))) * 2;
          if (mode != 1) {
            *(unsigned*)(L + o) = pk_bf16(q0, q1);
            *(unsigned*)(L + 16384 + o) = pk_bf16(kk0, kk1);
          }
        }
        const int t0 = 16 * eq + i4 * 4;
        u32x2 oa = {pk_bf16(ka[0], ka[1]), pk_bf16(ka[2], ka[3])};
        u32x2 ob = {pk_bf16(kb[0], kb[1]), pk_bf16(kb[2], kb[3])};
        if (mode != 2) {
          *(u32x2*)(L + 32768 + k0 * 128 + ((((t0 >> 3) ^ (k0 & 7)) << 4) | ((t0 & 7) << 1))) = oa;
          *(u32x2*)(L + 32768 + (k0 + 1) * 128 + ((((t0 >> 3) ^ ((k0 + 1) & 7)) << 4) | ((t0 & 7) << 1))) = ob;
        }
      }
      if (eq == 3) { Dl[k0] = run0; Dl[k0 + 1] = run1; }
    }
    if (c + 1 < nch) {
#pragma unroll
      for (int i = 0; i < 16; ++i) qn[i] = *(const unsigned*)(QA + (size_t)(tok0 + 64 + 16 * eq + i) * 1024 + h * 128 + 2 * ekp);
    }
    __syncthreads();
    if (mode != 1) {
      bf16x8 qf[4];
#pragma unroll
      for (int ks = 0; ks < 4; ++ks) {
        const int t = 16 * w + fr;
        qf[ks] = *(const bf16x8*)(L + t * 256 + (((4 * ks + fq) ^ (t & 15)) << 4));
      }
#pragma unroll
      for (int st = 0; st < 4; ++st) {
        f32x4 a = {0.f, 0.f, 0.f, 0.f};
#pragma unroll
        for (int ks = 0; ks < 4; ++ks) {
          const int s = 16 * st + fr;
          bf16x8 kf = *(const bf16x8*)(L + 16384 + s * 256 + (((4 * ks + fq) ^ (s & 15)) << 4));
          a = mfma16(kf, qf[ks], a);
        }
        const int t = 16 * w + fr, s0 = 16 * st + 4 * fq;
        float p0 = (s0 + 0 <= t) ? a.x : 0.f, p1 = (s0 + 1 <= t) ? a.y : 0.f;
        float p2 = (s0 + 2 <= t) ? a.z : 0.f, p3 = (s0 + 3 <= t) ? a.w : 0.f;
        u32x2 o2 = {pk_bf16(p0, p1), pk_bf16(p2, p3)};
        *(u32x2*)(L + 49152 + t * 128 + ((((s0 >> 3) ^ (t & 7)) << 4) | ((s0 & 7) << 1))) = o2;
      }
    }
    f32x4 O[2][4];
#pragma unroll
    for (int vv = 0; vv < 2; ++vv)
#pragma unroll
      for (int tt = 0; tt < 4; ++tt) O[vv][tt] = (f32x4){0.f, 0.f, 0.f, 0.f};
    if (mode != 1) {
#pragma unroll
    for (int ks = 0; ks < 4; ++ks) {
      bf16x8 sf[2];
#pragma unroll
      for (int vv = 0; vv < 2; ++vv)
        sf[vv] = mk8(pk_bf16(S[2 * ks][vv].x, S[2 * ks][vv].y), pk_bf16(S[2 * ks][vv].z, S[2 * ks][vv].w),
                     pk_bf16(S[2 * ks + 1][vv].x, S[2 * ks + 1][vv].y), pk_bf16(S[2 * ks + 1][vv].z, S[2 * ks + 1][vv].w));
#pragma unroll
      for (int tt = 0; tt < 4; ++tt) {
        const int t = 16 * tt + fr;
        const int c0 = 4 * ks + (fq >> 1), c1 = 4 * ks + 2 + (fq >> 1);
        u32x2 q0 = *(const u32x2*)(L + t * 256 + ((c0 ^ (t & 15)) << 4) + ((fq & 1) << 3));
        u32x2 q1 = *(const u32x2*)(L + t * 256 + ((c1 ^ (t & 15)) << 4) + ((fq & 1) << 3));
        bf16x8 qp = mk8(q0, q1);
#pragma unroll
        for (int vv = 0; vv < 2; ++vv) O[vv][tt] = mfma16(sf[vv], qp, O[vv][tt]);
      }
    }
    }
    __syncthreads();
#pragma unroll
    for (int ss = 0; ss < 2; ++ss) {
      bf16x8 vf[2];
#pragma unroll
      for (int vv = 0; vv < 2; ++vv) vf[vv] = vfr[ss][vv];
      if (mode != 1) {
#pragma unroll
      for (int tt = 0; tt < 4; ++tt) {
        const int t = 16 * tt + fr;
        bf16x8 pf = *(const bf16x8*)(L + 49152 + t * 128 + (((4 * ss + fq) ^ (t & 7)) << 4));
#pragma unroll
        for (int vv = 0; vv < 2; ++vv) O[vv][tt] = mfma16(vf[vv], pf, O[vv][tt]);
      }
      }
      if (mode != 2) {
#pragma unroll
      for (int kt = 0; kt < 8; ++kt) {
        const int r = 16 * kt + fr;
        bf16x8 kf = *(const bf16x8*)(L + 32768 + r * 128 + (((4 * ss + fq) ^ (r & 7)) << 4));
#pragma unroll
        for (int vv = 0; vv < 2; ++vv) S[kt][vv] = mfma16(kf, vf[vv], S[kt][vv]);
      }
      }
    }
    if (mode != 2) {
#pragma unroll
    for (int kt = 0; kt < 8; ++kt) {
      f32x4 d = *(const f32x4*)(Dl + 16 * kt + 4 * fq);
#pragma unroll
      for (int vv = 0; vv < 2; ++vv) { S[kt][vv].x *= d.x; S[kt][vv].y *= d.y; S[kt][vv].z *= d.z; S[kt][vv].w *= d.w; }
    }
    }
    if (mode == 1 && tid < 128) ((float*)(p.ws + OFF_DBUF))[(size_t)((b * 8 + h) * 64 + c) * 128 + tid] = Dl[tid];
    if (mode != 1) {
#pragma unroll
    for (int tt = 0; tt < 4; ++tt) {
      float ss = 0.f;
#pragma unroll
      for (int vv = 0; vv < 2; ++vv) ss += O[vv][tt].x * O[vv][tt].x + O[vv][tt].y * O[vv][tt].y + O[vv][tt].z * O[vv][tt].z + O[vv][tt].w * O[vv][tt].w;
      ss += __shfl_xor(ss, 16);
      ss += __shfl_xor(ss, 32);
      if (fq == 0) part[w * 64 + 16 * tt + fr] = ss;
    }
    __syncthreads();
#pragma unroll
    for (int tt = 0; tt < 4; ++tt) {
      const int t = 16 * tt + fr;
      const float tot = part[t] + part[64 + t] + part[128 + t] + part[192 + t];
      const float r = rsqrtf(tot * (1.f / 128.f) + 1e-5f);
      const size_t tok = (size_t)(tok0 + t);
#pragma unroll
      for (int vv = 0; vv < 2; ++vv) {
        const int v0 = h * 128 + 32 * w + 16 * vv + 4 * fq;
        u32x2 gt = *(const u32x2*)(GA + tok * 1024 + v0);
        float o0 = O[vv][tt].x * r * gn[vv].x * bflo(gt.x);
        float o1 = O[vv][tt].y * r * gn[vv].y * bfhi(gt.x);
        float o2 = O[vv][tt].z * r * gn[vv].z * bflo(gt.y);
        float o3 = O[vv][tt].w * r * gn[vv].w * bfhi(gt.y);
        u32x2 ov = {pk_bf16(o0, o1), pk_bf16(o2, o3)};
        *(u32x2*)(MERGED + tok * 2048 + v0) = ov;
      }
    }
    }
    __syncthreads();
  }
  if (mode == 1) {
#pragma unroll
    for (int kt = 0; kt < 8; ++kt)
#pragma unroll
      for (int vv = 0; vv < 2; ++vv) {
        u32x2 t = {pk_bf16(S[kt][vv].x, S[kt][vv].y), pk_bf16(S[kt][vv].z, S[kt][vv].w)};
        LSb[(kt * 2 + vv) * 256] = t;
      }
    return;
  }
  if (mode == 2) return;
  int zq = 0; asm volatile("" : "+v"(zq));
  float* so = p.out + (kind == 0 ? OUT_SP : OUT_SS) + (size_t)((b * 8 + h) * 128) * 128 + (4 * fq) * 128 + 32 * w + fr + zq;
#pragma unroll
  for (int kt = 0; kt < 8; ++kt)
#pragma unroll
    for (int vv = 0; vv < 2; ++vv)
#pragma unroll
      for (int j = 0; j < 4; ++j) so[(16 * kt + j) * 128 + 16 * vv] = S[kt][vv][j];
}


__device__ void hgrn_scan_item(const Params& p, int chain, int kt) {
  int tid_o = threadIdx.x; asm volatile("" : "+v"(tid_o)); const int tid = tid_o, lane = tid & 63, w = tid >> 6, fr = lane & 15, fq = lane >> 4;
  u32x2* LS = (u32x2*)(p.ws + OFF_LS) + ((size_t)(chain * 64) * 16 + kt * 2) * 256 + tid;
  const float* DB = (const float*)(p.ws + OFF_DBUF) + (size_t)(chain * 64) * 128 + 16 * kt + 4 * fq;
  f32x4 S0 = {0.f, 0.f, 0.f, 0.f}, S1 = {0.f, 0.f, 0.f, 0.f};
#pragma unroll 1
  for (int c8 = 0; c8 < 64; c8 += 8) {
    u32x2 l0[8], l1[8];
    f32x4 d[8];
#pragma unroll
    for (int i = 0; i < 8; ++i) {
      l0[i] = LS[(size_t)(c8 + i) * 16 * 256];
      l1[i] = LS[(size_t)(c8 + i) * 16 * 256 + 256];
      d[i] = *(const f32x4*)(DB + (c8 + i) * 128);
    }
#pragma unroll
    for (int i = 0; i < 8; ++i) {
      u32x2 o0 = {pk_bf16(S0.x, S0.y), pk_bf16(S0.z, S0.w)}, o1 = {pk_bf16(S1.x, S1.y), pk_bf16(S1.z, S1.w)};
      LS[(size_t)(c8 + i) * 16 * 256] = o0; LS[(size_t)(c8 + i) * 16 * 256 + 256] = o1;
      S0.x = d[i].x * S0.x + bflo(l0[i].x); S0.y = d[i].y * S0.y + bfhi(l0[i].x); S0.z = d[i].z * S0.z + bflo(l0[i].y); S0.w = d[i].w * S0.w + bfhi(l0[i].y);
      S1.x = d[i].x * S1.x + bflo(l1[i].x); S1.y = d[i].y * S1.y + bfhi(l1[i].x); S1.z = d[i].z * S1.z + bflo(l1[i].y); S1.w = d[i].w * S1.w + bfhi(l1[i].y);
    }
  }
  float* so = p.out + OUT_SP + (size_t)(chain * 128) * 128 + (size_t)(16 * kt + 4 * fq) * 128 + 32 * w + fr;
  so[0] = S0.x; so[128] = S0.y; so[256] = S0.z; so[384] = S0.w;
  so[16] = S1.x; so[128 + 16] = S1.y; so[256 + 16] = S1.z; so[384 + 16] = S1.w;
}

__device__ void attn_item(const Params& p, int kind, int bh, int qt, char* lds) {
  int tid_o = threadIdx.x; asm volatile("" : "+v"(tid_o)); const int tid = tid_o, lane = tid & 63, w = tid >> 6, fr = lane & 15, fq = lane >> 4;
  const int b = bh >> 3, h = bh & 7;
  const int nkt = kind == 0 ? qt + 1 : 17;
  const int tok0 = kind == 0 ? b * 4096 + qt * 64 : NPTOK + b * 64;
  const int qpos0 = kind == 0 ? qt * 64 : 1024;
  const bf16_t* Kb = kind == 0 ? (const bf16_t*)(p.ws + OFF_KP) + (size_t)bh * 4096 * 128
                               : (const bf16_t*)(p.ws + OFF_KS) + (size_t)bh * 1088 * 128;
  const bf16_t* Vb = kind == 0 ? (const bf16_t*)(p.ws + OFF_VTP) + (size_t)bh * 128 * 4096
                               : (const bf16_t*)(p.ws + OFF_VTS) + (size_t)bh * 128 * 1088;
  const int vstride = kind == 0 ? 4096 : 1088;
  const float slope2 = exp2f(-(float)(h + 1)) * 1.4426950408889634f;

  const int tok = tok0 + 16 * w + fr;
  bf16x8 qf[4];
  {
    const bf16_t* qp = (const bf16_t*)(p.ws + OFF_QB) + (size_t)tok * 1024 + h * 128;
#pragma unroll
    for (int ks = 0; ks < 4; ++ks) qf[ks] = *(const bf16x8*)(qp + 32 * ks + 8 * fq);
  }
  const float qposf = (float)(qpos0 + 16 * w + fr);
  float qk[2];
#pragma unroll
  for (int m = 0; m < 2; ++m) {
    float s2 = 0.f;
#pragma unroll
    for (int ks2 = 0; ks2 < 2; ++ks2)
#pragma unroll
      for (int e = 0; e < 8; ++e) { const float qv = bf2f((unsigned short)qf[2 * m + ks2][e]); s2 += qv * qv; }
    s2 += __shfl_xor(s2, 16);
    s2 += __shfl_xor(s2, 32);
    const float kmax2 = kind == 0 ? __uint_as_float(((const unsigned*)(p.ws + 256))[b * 16 + h * 2 + m]) : 3.0e38f;
    qk[m] = sqrtf(s2) * sqrtf(kmax2) * 1.02f;
  }
  f32x4 O0[8], O1[8];
#pragma unroll
  for (int i = 0; i < 8; ++i) { O0[i] = (f32x4){0.f, 0.f, 0.f, 0.f}; O1[i] = (f32x4){0.f, 0.f, 0.f, 0.f}; }
  float mx[2] = {-1e30f, -1e30f}, ls[2] = {0.f, 0.f};

  u32x4 rk[4], rv[4];
  {
    const int kkey = tid >> 4, kc = tid & 15, vrow = tid >> 3, vc = tid & 7;
    const int kt = nkt - 1;
#pragma unroll
    for (int i = 0; i < 4; ++i) {
      rk[i] = *(const u32x4*)(Kb + (size_t)(kt * 64 + kkey + 16 * i) * 128 + kc * 8);
      rv[i] = *(const u32x4*)(Vb + (size_t)(vrow + 32 * i) * vstride + kt * 64 + vc * 8);
    }
#pragma unroll
    for (int i = 0; i < 4; ++i) {
      const int key = kkey + 16 * i;
      *(u32x4*)(lds + key * 256 + ((kc ^ (key & 15)) << 4)) = rk[i];
      const int r = vrow + 32 * i;
      *(u32x4*)(lds + 16384 + r * 128 + ((vc ^ ((r >> 1) & 7)) << 4)) = rv[i];
    }
    if (nkt > 1) {
#pragma unroll
      for (int i = 0; i < 4; ++i) {
        rk[i] = *(const u32x4*)(Kb + (size_t)((kt - 1) * 64 + kkey + 16 * i) * 128 + kc * 8);
        rv[i] = *(const u32x4*)(Vb + (size_t)(vrow + 32 * i) * vstride + (kt - 1) * 64 + vc * 8);
      }
    }
    __syncthreads();
  }
  for (int it = 0; it < nkt; ++it) {
    int zz = 0; asm volatile("" : "+v"(zz));
    int tidv = threadIdx.x; asm volatile("" : "+v"(tidv));
    const int tid = tidv, lane = tid & 63, w = tid >> 6, fr = lane & 15, fq = lane >> 4;
    const int kkey = tid >> 4, kc = tid & 15, vrow = tid >> 3, vc = tid & 7;
    const int kt = nkt - 1 - it;
    char* L = lds + zz + (it & 1) * 32768;
    char* Ln = lds + zz + ((it + 1) & 1) * 32768;
    if (it + 1 < nkt) {
#pragma unroll
      for (int i = 0; i < 4; ++i) {
        const int key = kkey + 16 * i;
        *(u32x4*)(Ln + key * 256 + ((kc ^ (key & 15)) << 4)) = rk[i];
        const int r = vrow + 32 * i;
        *(u32x4*)(Ln + 16384 + r * 128 + ((vc ^ ((r >> 1) & 7)) << 4)) = rv[i];
      }
    }
    if (it + 2 < nkt) {
#pragma unroll
      for (int i = 0; i < 4; ++i) {
        rk[i] = *(const u32x4*)(Kb + (size_t)((kt - 2) * 64 + zz + kkey + 16 * i) * 128 + kc * 8);
        rv[i] = *(const u32x4*)(Vb + (size_t)(vrow + 32 * i) * vstride + (kt - 2) * 64 + zz + vc * 8);
      }
    }
    const float kposf = (float)(kt * 64 + 4 * fq) - qposf;
    bf16x8 pf[2][2];
    bool live[2];
#pragma unroll
    for (int m = 0; m < 2; ++m) {
      f32x4 s[4];
#pragma unroll
      for (int k16 = 0; k16 < 4; ++k16) {
        s[k16] = (f32x4){0.f, 0.f, 0.f, 0.f};
        const int key = 16 * k16 + fr;
#pragma unroll
        for (int ks2 = 0; ks2 < 2; ++ks2) {
          bf16x8 kf = *(const bf16x8*)(L + key * 256 + (((8 * m + 4 * ks2 + fq) ^ (key & 15)) << 4));
          s[k16] = mfma16(kf, qf[2 * m + ks2], s[k16]);
        }
      }
      float tmax = -1e30f;
#pragma unroll
      for (int k16 = 0; k16 < 4; ++k16)
#pragma unroll
        for (int j = 0; j < 4; ++j) {
          const float d = kposf + (float)(16 * k16 + j);
          const float v = s[k16][j] - slope2 * fabsf(d);
          s[k16][j] = v;
          tmax = fmaxf(tmax, v);
        }
      tmax = fmaxf(tmax, __shfl_xor(tmax, 16));
      tmax = fmaxf(tmax, __shfl_xor(tmax, 32));
      live[m] = !__all(tmax - mx[m] < -40.f);
      if (live[m]) {
        const float mnew = fmaxf(mx[m], tmax);
        const float alpha = __builtin_amdgcn_exp2f(mx[m] - mnew);
        mx[m] = mnew;
        float psum = 0.f;
#pragma unroll
        for (int k16 = 0; k16 < 4; ++k16)
#pragma unroll
          for (int j = 0; j < 4; ++j) { const float e = __builtin_amdgcn_exp2f(s[k16][j] - mnew); s[k16][j] = e; psum += e; }
        ls[m] = ls[m] * alpha + psum;
        if (m == 0) {
#pragma unroll
          for (int i = 0; i < 8; ++i) { O0[i].x *= alpha; O0[i].y *= alpha; O0[i].z *= alpha; O0[i].w *= alpha; }
        } else {
#pragma unroll
          for (int i = 0; i < 8; ++i) { O1[i].x *= alpha; O1[i].y *= alpha; O1[i].z *= alpha; O1[i].w *= alpha; }
        }
#pragma unroll
        for (int ks = 0; ks < 2; ++ks)
          pf[m][ks] = mk8(pk_bf16(s[2 * ks].x, s[2 * ks].y), pk_bf16(s[2 * ks].z, s[2 * ks].w),
                          pk_bf16(s[2 * ks + 1].x, s[2 * ks + 1].y), pk_bf16(s[2 * ks + 1].z, s[2 * ks + 1].w));
      } else {
#pragma unroll
        for (int ks = 0; ks < 2; ++ks) pf[m][ks] = mk8(0u, 0u, 0u, 0u);
      }
    }
    if (live[0] || live[1]) {
      __builtin_amdgcn_s_setprio(1);
#pragma unroll
      for (int vt = 0; vt < 8; ++vt) {
        const int r = 16 * vt + fr;
        const int rs = (r >> 1) & 7;
#pragma unroll
        for (int ks = 0; ks < 2; ++ks) {
          const int u0 = 8 * ks + fq, u1 = 8 * ks + 4 + fq;
          u32x2 a0 = *(const u32x2*)(L + 16384 + r * 128 + (((u0 >> 1) ^ rs) << 4) + ((u0 & 1) << 3));
          u32x2 a1 = *(const u32x2*)(L + 16384 + r * 128 + (((u1 >> 1) ^ rs) << 4) + ((u1 & 1) << 3));
          bf16x8 vf = mk8(a0, a1);
          O0[vt] = mfma16(vf, pf[0][ks], O0[vt]);
          O1[vt] = mfma16(vf, pf[1][ks], O1[vt]);
        }
      }
      __builtin_amdgcn_s_setprio(0);
    }
    const float dmin = qposf - (float)((kt - 1) * 64 + 63);
    const bool done = (kind == 0) && (qk[0] - slope2 * dmin - mx[0] < -40.f) && (qk[1] - slope2 * dmin - mx[1] < -40.f);
    if (__syncthreads_and(done ? 1 : 0)) break;
  }
  float l0 = ls[0], l1 = ls[1];
  l0 += __shfl_xor(l0, 16); l0 += __shfl_xor(l0, 32);
  l1 += __shfl_xor(l1, 16); l1 += __shfl_xor(l1, 32);
  const float lam = ((const float*)(p.ws + OFF_CTR))[16];
  const float i0 = 1.f / l0, i1 = lam / l1;
  float ssq = 0.f;
#pragma unroll
  for (int vt = 0; vt < 8; ++vt) {
#pragma unroll
    for (int j = 0; j < 4; ++j) {
      const float o = O0[vt][j] * i0 - O1[vt][j] * i1;
      O0[vt][j] = o;
      ssq += o * o;
    }
  }
  ssq += __shfl_xor(ssq, 16);
  ssq += __shfl_xor(ssq, 32);
  const float r = rsqrtf(ssq * (1.f / 128.f) + 1e-5f) * 0.8f;
  bf16_t* mo = (bf16_t*)(p.ws + OFF_MERGED) + (size_t)tok * 2048 + 1024 + h * 128;
#pragma unroll
  for (int vt = 0; vt < 8; ++vt) {
    f32x4 g = *(const f32x4*)(p.diff_g + 16 * vt + 4 * fq);
    u32x2 ov = {pk_bf16(O0[vt].x * r * g.x, O0[vt].y * r * g.y), pk_bf16(O0[vt].z * r * g.z, O0[vt].w * r * g.w)};
    *(u32x2*)(mo + 16 * vt + 4 * fq) = ov;
  }
}


__device__ void quant_item(const Params& p, int item) {
  int tid_o = threadIdx.x; asm volatile("" : "+v"(tid_o)); const int tid = tid_o, lane = tid & 63, w = tid >> 6;
  unsigned char* U8 = (unsigned char*)(p.ws + OFF_UB);
  float* SCL = (float*)(p.ws + OFF_SCL);
  for (int rr = 0; rr < 16; ++rr) {
    const int row = item * 64 + rr * 4 + w;
    const float* srow = row < 16384 ? p.pu + (size_t)row * 2048 : p.pv + (size_t)(row - 16384) * 2048;
    f32x4 v[8];
    float am = 0.f;
#pragma unroll
    for (int i = 0; i < 8; ++i) {
      v[i] = __builtin_nontemporal_load((const f32x4*)(srow + 256 * i + lane * 4));
      am = fmaxf(fmaxf(am, fmaxf(fabsf(v[i].x), fabsf(v[i].y))), fmaxf(fabsf(v[i].z), fabsf(v[i].w)));
    }
#pragma unroll
    for (int o = 32; o >= 1; o >>= 1) am = fmaxf(am, __shfl_xor(am, o));
    const float sc = am > 0.f ? 224.f / am : 1.f;
    unsigned char* drow = U8 + (size_t)row * 2048;
#pragma unroll
    for (int i = 0; i < 8; ++i) {
      int pk = __builtin_amdgcn_cvt_pk_fp8_f32(v[i].x * sc, v[i].y * sc, 0, false);
      pk = __builtin_amdgcn_cvt_pk_fp8_f32(v[i].z * sc, v[i].w * sc, pk, true);
      *(int*)(drow + 256 * i + lane * 4) = pk;
    }
    if (lane == 0) SCL[row] = am > 0.f ? am * (1.f / 224.f) : 1.f;
  }
}

__device__ void phase2(const Params& p, char* lds, int rep, int par) {
  unsigned* ctr = (unsigned*)(p.ws + OFF_CTR) + rep;
  int* sitem = (int*)lds;
  const int nA = par ? 2048 : 0;
  for (;;) {
    __syncthreads();
    if (threadIdx.x == 0) *sitem = (int)atomicAdd(ctr, 1u);
    __syncthreads();
    int item = *sitem;
    __syncthreads();
    if (item >= nA + 2208) break;
    if (item < nA) { hgrn_item(p, 0, (item & 31) >> 3, item & 7, lds, 1, item >> 5); continue; }
    item -= nA;
    if (item < 96) {
      const int kind = item < 32 ? 0 : 1, ii = item < 32 ? item : item - 32;
      if (kind == 0 && par) continue;
      hgrn_item(p, kind, ii >> 3, ii & 7, lds, 0, 0);
    } else {
      const int kind = item < 160 ? 1 : 0, j = item - 160;
      attn_item(p, kind, kind ? item - 96 : (j & 31), kind ? 0 : 63 - (j >> 5), lds);
    }
  }
}

__device__ void phase2b(const Params& p) {
  for (int item = blockIdx.x; item < 256; item += gridDim.x) hgrn_scan_item(p, item >> 3, item & 7);
}

__device__ void phase2c(const Params& p, char* lds) {
  for (int item = blockIdx.x; item < 2048; item += gridDim.x) {
    __syncthreads();
    hgrn_item(p, 0, (item & 31) >> 3, item & 7, lds, 2, item >> 5);
  }
}

__device__ void phase4(const Params& p) {
  int tid_o = threadIdx.x; asm volatile("" : "+v"(tid_o)); const int tid = tid_o, lane = tid & 63, w = tid >> 6;
  bf16_t* X1B = (bf16_t*)(p.ws + OFF_X1B);
  for (int row = blockIdx.x * 4 + w; row < NTOK; row += gridDim.x * 4) {
    bf16_t* xr = X1B + (size_t)row * 2048;
    float v[4][8];
    float s = 0.f;
#pragma unroll
    for (int i = 0; i < 4; ++i) {
      u32x4 t = *(const u32x4*)(xr + 512 * i + lane * 8);
      v[i][0] = bflo(t.x); v[i][1] = bfhi(t.x); v[i][2] = bflo(t.y); v[i][3] = bfhi(t.y);
      v[i][4] = bflo(t.z); v[i][5] = bfhi(t.z); v[i][6] = bflo(t.w); v[i][7] = bfhi(t.w);
#pragma unroll
      for (int e = 0; e < 8; ++e) s += v[i][e];
    }
    s = wave_sum(s);
    const float mean = s * (1.f / 2048.f);
    float q = 0.f;
#pragma unroll
    for (int i = 0; i < 4; ++i)
#pragma unroll
      for (int e = 0; e < 8; ++e) { const float d = v[i][e] - mean; q += d * d; }
    q = wave_sum(q);
    const float rs = rsqrtf(q * (1.f / 2048.f) + 1e-5f);
#pragma unroll
    for (int i = 0; i < 4; ++i) {
      const int col = 512 * i + lane * 8;
      f32x4 g0 = *(const f32x4*)(p.ln1_g + col), g1 = *(const f32x4*)(p.ln1_g + col + 4);
      f32x4 b0 = *(const f32x4*)(p.ln1_b + col), b1 = *(const f32x4*)(p.ln1_b + col + 4);
      u32x4 o;
      o.x = pk_bf16((v[i][0] - mean) * rs * g0.x + b0.x, (v[i][1] - mean) * rs * g0.y + b0.y);
      o.y = pk_bf16((v[i][2] - mean) * rs * g0.z + b0.z, (v[i][3] - mean) * rs * g0.w + b0.w);
      o.z = pk_bf16((v[i][4] - mean) * rs * g1.x + b1.x, (v[i][5] - mean) * rs * g1.y + b1.y);
      o.w = pk_bf16((v[i][6] - mean) * rs * g1.z + b1.z, (v[i][7] - mean) * rs * g1.w + b1.w);
      *(u32x4*)(xr + col) = o;
    }
  }
}

__device__ __forceinline__ unsigned f2key(float f) {
  unsigned b = __float_as_uint(f);
  return (b & 0x80000000u) ? ~b : (b | 0x80000000u);
}
__device__ __forceinline__ float key2f(unsigned k) {
  unsigned b = (k & 0x80000000u) ? (k & 0x7fffffffu) : ~k;
  return __uint_as_float(b);
}

__device__ __forceinline__ unsigned row_allmax(unsigned x) {
  x = max(x, (unsigned)__builtin_amdgcn_update_dpp(0, (int)x, 0x121, 0xF, 0xF, false));
  x = max(x, (unsigned)__builtin_amdgcn_update_dpp(0, (int)x, 0x122, 0xF, 0xF, false));
  x = max(x, (unsigned)__builtin_amdgcn_update_dpp(0, (int)x, 0x124, 0xF, 0xF, false));
  x = max(x, (unsigned)__builtin_amdgcn_update_dpp(0, (int)x, 0x128, 0xF, 0xF, false));
  return x;
}
__device__ __forceinline__ float row_allsum(float x) {
  x += __int_as_float(__builtin_amdgcn_update_dpp(0, __float_as_int(x), 0x121, 0xF, 0xF, false));
  x += __int_as_float(__builtin_amdgcn_update_dpp(0, __float_as_int(x), 0x122, 0xF, 0xF, false));
  x += __int_as_float(__builtin_amdgcn_update_dpp(0, __float_as_int(x), 0x124, 0xF, 0xF, false));
  x += __int_as_float(__builtin_amdgcn_update_dpp(0, __float_as_int(x), 0x128, 0xF, 0xF, false));
  return x;
}
#define CE_DESC(a, b) { const unsigned _hi = max(a, b), _lo = min(a, b); a = _hi; b = _lo; }

__device__ void phase6(const Params& p, char* lds) {
  int tid_o = threadIdx.x; asm volatile("" : "+v"(tid_o)); const int tid = tid_o, lane = tid & 63, w = tid >> 6, fr = lane & 15, fq = lane >> 4;
  const bf16_t* QP = (const bf16_t*)(p.ws + OFF_QP);
  const bf16_t* SKB = (const bf16_t*)(p.ws + OFF_SKB);
  int* EIDX = (int*)(p.ws + OFF_EIDX);
  float* GATE = (float*)(p.ws + OFF_GATE);
  const bool qfirst = blockIdx.x >= (gridDim.x >> 1);
  if (qfirst) for (int qi = blockIdx.x; qi < 512; qi += gridDim.x) quant_item(p, qi);
  unsigned char* tbl = (unsigned char*)lds;
  __syncthreads();
  if (tid < 64) tbl[tid] = 0xFF;
  __syncthreads();
  {
    const int i = tid >> 4, j = tid & 15;
    if ((i + 1) * (j + 1) <= 16) {
      int rank = j;
      for (int ii = 0; ii < i; ++ii) rank += 16 / (ii + 1);
      tbl[rank] = (unsigned char)((i << 4) | j);
    }
  }
  __syncthreads();
  int pi[4], pj[4]; bool pvalid[4];
#pragma unroll
  for (int s = 0; s < 4; ++s) {
    const int pidx = fr + 16 * s;
    const unsigned code = tbl[pidx];
    pvalid[s] = (pidx < 50);
    pi[s] = pvalid[s] ? (int)(code >> 4) : 0;
    pj[s] = pvalid[s] ? (int)(code & 15) : 0;
  }
  const int rowbase = lane & 48;
  __syncthreads();
  {
    const int hh = blockIdx.x & 7;
#pragma unroll 1
    for (int c = 0; c < 2; ++c)
#pragma unroll 4
      for (int i = 0; i < 8; ++i) {
        const int id = tid + 256 * i, key = id >> 4, ch = id & 15;
        u32x4 v = *(const u32x4*)(SKB + (size_t)((hh * 2 + c) * 128 + key) * 128 + ch * 8);
        *(u32x4*)(lds + c * 32768 + key * 256 + ((ch ^ (key & 15)) << 4)) = v;
      }
  }
  __syncthreads();
  for (int item = blockIdx.x; item < 264 * 8; item += gridDim.x) {
    int zz = 0; asm volatile("" : "+v"(zz));
    const char* L = lds + zz;
    const int tile = item >> 3, h = item & 7;
    const int tok0 = tile * 64;
    unsigned Lst[2][4];
#pragma unroll
    for (int c = 0; c < 2; ++c) {
      unsigned K[8][4];
      {
        bf16x8 af[4];
        const bf16_t* qp = QP + (size_t)(tok0 + 16 * w + fr) * 2048 + h * 256 + c * 128;
#pragma unroll
        for (int ks = 0; ks < 4; ++ks) af[ks] = *(const bf16x8*)(qp + 32 * ks + 8 * fq);
#pragma unroll
        for (int kt = 0; kt < 8; ++kt) {
          f32x4 a = {0.f, 0.f, 0.f, 0.f};
#pragma unroll
          for (int ks = 0; ks < 4; ++ks) {
            const int key = 16 * kt + fr;
            bf16x8 bfr = *(const bf16x8*)(L + c * 32768 + key * 256 + (((4 * ks + fq) ^ (key & 15)) << 4));
            a = mfma16(af[ks], bfr, a);
          }
          const unsigned code = (unsigned)(127 - (16 * kt + fr));
#pragma unroll
          for (int j = 0; j < 4; ++j) K[kt][j] = (f2key(a[j]) & ~127u) | code;
        }
      }
#pragma unroll
      for (int j = 0; j < 4; ++j) {
        CE_DESC(K[0][j], K[1][j]); CE_DESC(K[2][j], K[3][j]); CE_DESC(K[4][j], K[5][j]); CE_DESC(K[6][j], K[7][j]);
        CE_DESC(K[0][j], K[2][j]); CE_DESC(K[1][j], K[3][j]); CE_DESC(K[4][j], K[6][j]); CE_DESC(K[5][j], K[7][j]);
        CE_DESC(K[1][j], K[2][j]); CE_DESC(K[5][j], K[6][j]); CE_DESC(K[0][j], K[4][j]); CE_DESC(K[3][j], K[7][j]);
        CE_DESC(K[1][j], K[5][j]); CE_DESC(K[2][j], K[6][j]);
        CE_DESC(K[1][j], K[4][j]); CE_DESC(K[3][j], K[6][j]);
        CE_DESC(K[2][j], K[4][j]); CE_DESC(K[3][j], K[5][j]);
        CE_DESC(K[3][j], K[4][j]);
      }
      unsigned best[4] = {0u, 0u, 0u, 0u};
#pragma unroll 1
      for (int it = 0; it < 16; ++it) {
#pragma unroll
        for (int j = 0; j < 4; ++j) {
          const unsigned rm = row_allmax(K[0][j]);
          const bool win = (K[0][j] == rm);
#pragma unroll
          for (int k = 0; k < 7; ++k) K[k][j] = win ? K[k + 1][j] : K[k][j];
          K[7][j] = win ? 0u : K[7][j];
          best[j] = (fr == it) ? rm : best[j];
        }
      }
#pragma unroll
      for (int j = 0; j < 4; ++j) Lst[c][j] = best[j];
    }
#pragma unroll
    for (int j = 0; j < 4; ++j) {
      unsigned C[4];
#pragma unroll
      for (int s = 0; s < 4; ++s) {
        const unsigned k0 = (unsigned)__shfl((int)Lst[0][j], rowbase + pi[s]);
        const unsigned k1 = (unsigned)__shfl((int)Lst[1][j], rowbase + pj[s]);
        const float sum = key2f(k0 & ~127u) + key2f(k1 & ~127u);
        C[s] = pvalid[s] ? ((f2key(sum) & ~255u) | (unsigned)(255 - (pi[s] * 16 + pj[s]))) : 0u;
      }
      CE_DESC(C[0], C[1]); CE_DESC(C[2], C[3]); CE_DESC(C[0], C[2]); CE_DESC(C[1], C[3]); CE_DESC(C[1], C[2]);
      unsigned sel = 0u;
#pragma unroll 1
      for (int it = 0; it < 16; ++it) {
        const unsigned rm = row_allmax(C[0]);
        const bool win = (C[0] == rm);
        C[0] = win ? C[1] : C[0]; C[1] = win ? C[2] : C[1]; C[2] = win ? C[3] : C[2]; C[3] = win ? 0u : C[3];
        sel = (fr == it) ? rm : sel;
      }
      const float cv = key2f(sel & ~255u);
      const float cmax = __shfl(cv, rowbase);
      const float e = __expf(cv - cmax);
      const float g = e / row_allsum(e);
      const int flat = 255 - (int)(sel & 255u);
      const unsigned l0 = (unsigned)__shfl((int)Lst[0][j], rowbase + (flat >> 4));
      const unsigned l1 = (unsigned)__shfl((int)Lst[1][j], rowbase + (flat & 15));
      const int eidx = (127 - (int)(l0 & 127u)) * 128 + (127 - (int)(l1 & 127u));
      const size_t ob = ((size_t)(tok0 + 16 * w + 4 * fq + j) * 8 + h) * 16 + fr;
      EIDX[ob] = eidx;
      GATE[ob] = g;
    }
  }
  if (!qfirst) for (int qi = blockIdx.x; qi < 512; qi += gridDim.x) quant_item(p, qi);
}

__device__ __forceinline__ float dot16_fp8(u32x4 r, const float* x) {
  float d = 0.f;
  f32x2_t a;
  a = __builtin_amdgcn_cvt_pk_f32_fp8((int)r.x, false); d += a.x * x[0] + a.y * x[1];
  a = __builtin_amdgcn_cvt_pk_f32_fp8((int)r.x, true);  d += a.x * x[2] + a.y * x[3];
  a = __builtin_amdgcn_cvt_pk_f32_fp8((int)r.y, false); d += a.x * x[4] + a.y * x[5];
  a = __builtin_amdgcn_cvt_pk_f32_fp8((int)r.y, true);  d += a.x * x[6] + a.y * x[7];
  a = __builtin_amdgcn_cvt_pk_f32_fp8((int)r.z, false); d += a.x * x[8] + a.y * x[9];
  a = __builtin_amdgcn_cvt_pk_f32_fp8((int)r.z, true);  d += a.x * x[10] + a.y * x[11];
  a = __builtin_amdgcn_cvt_pk_f32_fp8((int)r.w, false); d += a.x * x[12] + a.y * x[13];
  a = __builtin_amdgcn_cvt_pk_f32_fp8((int)r.w, true);  d += a.x * x[14] + a.y * x[15];
  return d;
}
__device__ __forceinline__ void axpy16_fp8(u32x4 r, float w, float* acc) {
  f32x2_t a;
  a = __builtin_amdgcn_cvt_pk_f32_fp8((int)r.x, false); acc[0] += w * a.x; acc[1] += w * a.y;
  a = __builtin_amdgcn_cvt_pk_f32_fp8((int)r.x, true);  acc[2] += w * a.x; acc[3] += w * a.y;
  a = __builtin_amdgcn_cvt_pk_f32_fp8((int)r.y, false); acc[4] += w * a.x; acc[5] += w * a.y;
  a = __builtin_amdgcn_cvt_pk_f32_fp8((int)r.y, true);  acc[6] += w * a.x; acc[7] += w * a.y;
  a = __builtin_amdgcn_cvt_pk_f32_fp8((int)r.z, false); acc[8] += w * a.x; acc[9] += w * a.y;
  a = __builtin_amdgcn_cvt_pk_f32_fp8((int)r.z, true);  acc[10] += w * a.x; acc[11] += w * a.y;
  a = __builtin_amdgcn_cvt_pk_f32_fp8((int)r.w, false); acc[12] += w * a.x; acc[13] += w * a.y;
  a = __builtin_amdgcn_cvt_pk_f32_fp8((int)r.w, true);  acc[14] += w * a.x; acc[15] += w * a.y;
}

__device__ void phase7(const Params& p, char* lds) {
  int tid_o = threadIdx.x; asm volatile("" : "+v"(tid_o)); const int tid = tid_o, lane = tid & 63, w = tid >> 6;
  const bf16_t* X1B = (const bf16_t*)(p.ws + OFF_X1B);
  const unsigned char* U8 = (const unsigned char*)(p.ws + OFF_UB);
  const unsigned char* V8 = (const unsigned char*)(p.ws + OFF_VB);
  const float* SCL = (const float*)(p.ws + OFF_SCL);
  const int* EIDX = (const int*)(p.ws + OFF_EIDX);
  const float* GATE = (const float*)(p.ws + OFF_GATE);
  float* wgt = (float*)lds;
  float* red = (float*)(lds + 1024);
  float* part = (float*)(lds + 2048);
  for (int tok = blockIdx.x; tok < NTOK; tok += gridDim.x) {
    int tidv = threadIdx.x; asm volatile("" : "+v"(tidv));
    const int tid = tidv, lane = tid & 63, w = tid >> 6;
    const bf16_t* xr = X1B + (size_t)tok * 2048;
    float xa[2][16];
#pragma unroll
    for (int j = 0; j < 2; ++j)
#pragma unroll
      for (int q = 0; q < 2; ++q) {
        u32x4 t = __builtin_nontemporal_load((const u32x4*)(xr + 1024 * j + 16 * lane + 8 * q));
        xa[j][8 * q] = bflo(t.x); xa[j][8 * q + 1] = bfhi(t.x); xa[j][8 * q + 2] = bflo(t.y); xa[j][8 * q + 3] = bfhi(t.y);
        xa[j][8 * q + 4] = bflo(t.z); xa[j][8 * q + 5] = bfhi(t.z); xa[j][8 * q + 6] = bflo(t.w); xa[j][8 * q + 7] = bfhi(t.w);
      }
    __syncthreads();
#ifndef UR
#define UR 16
#endif
#ifndef VR
#define VR 16
#endif
#pragma unroll 1
    for (int k6 = 0; k6 < 32; k6 += UR) {
      u32x4 r[UR][2];
      int ee[UR];
#pragma unroll
      for (int kk = 0; kk < UR; ++kk) {
        const int kq = (k6 + kk < 32) ? (k6 + kk) : 31;
        ee[kk] = __builtin_amdgcn_readfirstlane(EIDX[(size_t)tok * 128 + w * 32 + kq]);
        const unsigned char* ur = U8 + (size_t)ee[kk] * 2048 + lane * 16;
        r[kk][0] = *(const u32x4*)ur;
        r[kk][1] = *(const u32x4*)(ur + 1024);
      }
      float dot[UR];
#pragma unroll
      for (int kk = 0; kk < UR; ++kk) dot[kk] = dot16_fp8(r[kk][0], xa[0]) + dot16_fp8(r[kk][1], xa[1]);
#pragma unroll
      for (int o = 32; o >= 1; o >>= 1) {
#pragma unroll
        for (int kk = 0; kk < UR; ++kk) dot[kk] += __shfl_xor(dot[kk], o);
      }
      if (lane < UR && k6 + lane < 32) {
        float a = dot[0]; int e = ee[0];
#pragma unroll
        for (int kk = 1; kk < UR; ++kk) { if (lane == kk) { a = dot[kk]; e = ee[kk]; } }
        const int k = w * 32 + k6 + lane;
        a *= SCL[e];
        const float ge = 0.5f * a * (1.f + erff(a * 0.70710678118654752f));
        wgt[k] = GATE[(size_t)tok * 128 + k] * ge * SCL[16384 + e];
      }
    }
    __syncthreads();
#pragma unroll 1
    for (int j = 0; j < 2; ++j) {
      float acc[16];
#pragma unroll
      for (int q = 0; q < 16; ++q) acc[q] = 0.f;
#pragma unroll 1
      for (int k6 = 0; k6 < 32; k6 += VR) {
        u32x4 r[VR];
        float ww[VR];
#pragma unroll
        for (int kk = 0; kk < VR; ++kk) {
          const int kq = (k6 + kk < 32) ? (k6 + kk) : 31;
          const int k = w * 32 + kq;
          const int e = __builtin_amdgcn_readfirstlane(EIDX[(size_t)tok * 128 + k]);
          ww[kk] = (k6 + kk < 32) ? wgt[k] : 0.f;
          r[kk] = *(const u32x4*)(V8 + (size_t)e * 2048 + 1024 * j + lane * 16);
        }
#pragma unroll
        for (int kk = 0; kk < VR; ++kk) axpy16_fp8(r[kk], ww[kk], acc);
      }
#pragma unroll
      for (int q = 0; q < 4; ++q)
        *(f32x4*)(part + w * 2048 + 1024 * j + 16 * lane + 4 * q) = (f32x4){acc[4 * q], acc[4 * q + 1], acc[4 * q + 2], acc[4 * q + 3]};
    }
    __syncthreads();
    const float al = 1.189207115002721f;
    const u32x4 xt = *(const u32x4*)(xr + tid * 8);
    f32x4 x0 = {bflo(xt.x), bfhi(xt.x), bflo(xt.y), bfhi(xt.y)}, x1 = {bflo(xt.z), bfhi(xt.z), bflo(xt.w), bfhi(xt.w)};
    f32x4 s0 = {0.f, 0.f, 0.f, 0.f}, s1 = {0.f, 0.f, 0.f, 0.f};
#pragma unroll
    for (int ww2 = 0; ww2 < 4; ++ww2) {
      f32x4 a0 = *(const f32x4*)(part + ww2 * 2048 + tid * 8), a1 = *(const f32x4*)(part + ww2 * 2048 + tid * 8 + 4);
      s0.x += a0.x; s0.y += a0.y; s0.z += a0.z; s0.w += a0.w; s1.x += a1.x; s1.y += a1.y; s1.z += a1.z; s1.w += a1.w;
    }
    float val[8] = {al * x0.x + s0.x, al * x0.y + s0.y, al * x0.z + s0.z, al * x0.w + s0.w,
                    al * x1.x + s1.x, al * x1.y + s1.y, al * x1.z + s1.z, al * x1.w + s1.w};
    float s = 0.f;
#pragma unroll
    for (int j = 0; j < 8; ++j) s += val[j];
    s = wave_sum(s);
    if (lane == 0) red[w] = s;
    __syncthreads();
    const float mean = (red[0] + red[1] + red[2] + red[3]) * (1.f / 2048.f);
    float q = 0.f;
#pragma unroll
    for (int j = 0; j < 8; ++j) { const float d = val[j] - mean; q += d * d; }
    q = wave_sum(q);
    if (lane == 0) red[4 + w] = q;
    __syncthreads();
    const float rs = rsqrtf((red[4] + red[5] + red[6] + red[7]) * (1.f / 2048.f) + 1e-5f);
    f32x4 g0 = *(const f32x4*)(p.ln2_g + tid * 8), g1 = *(const f32x4*)(p.ln2_g + tid * 8 + 4);
    f32x4 b0 = *(const f32x4*)(p.ln2_b + tid * 8), b1 = *(const f32x4*)(p.ln2_b + tid * 8 + 4);
    f32x4 o0 = {(val[0] - mean) * rs * g0.x + b0.x, (val[1] - mean) * rs * g0.y + b0.y, (val[2] - mean) * rs * g0.z + b0.z, (val[3] - mean) * rs * g0.w + b0.w};
    f32x4 o1 = {(val[4] - mean) * rs * g1.x + b1.x, (val[5] - mean) * rs * g1.y + b1.y, (val[6] - mean) * rs * g1.z + b1.z, (val[7] - mean) * rs * g1.w + b1.w};
    float* yo = p.out + OUT_Y + (size_t)tok * 2048 + tid * 8;
    __builtin_nontemporal_store(o0, (f32x4*)yo);
    __builtin_nontemporal_store(o1, (f32x4*)(yo + 4));
  }
}

__device__ __forceinline__ void grid_bar(unsigned* ctr, unsigned target) {
  asm volatile("s_waitcnt vmcnt(0)" ::: "memory");
  __syncthreads();
  if (threadIdx.x == 0) {
    __builtin_amdgcn_fence(__ATOMIC_RELEASE, "agent");
    asm volatile("s_waitcnt vmcnt(0)" ::: "memory");
    __hip_atomic_fetch_add(ctr, 1u, __ATOMIC_RELAXED, __HIP_MEMORY_SCOPE_AGENT);
    while (__hip_atomic_load(ctr, __ATOMIC_RELAXED, __HIP_MEMORY_SCOPE_AGENT) < target) __builtin_amdgcn_s_sleep(2);
    __builtin_amdgcn_fence(__ATOMIC_ACQUIRE, "agent");
    asm volatile("s_waitcnt vmcnt(0)" ::: "memory");
  }
  __syncthreads();
}

__global__ void __launch_bounds__(256, 2) mega(Params p, int ph_lo, int ph_hi, int use_sync) {
  __shared__ __attribute__((aligned(16))) char lds[LDS_BYTES];
  cg::grid_group grid = cg::this_grid();
  unsigned nbar = 0;
#ifndef DUP_PHASE
#define DUP_PHASE -1
#endif
  const int par = (use_sync == 3);
  const int nph = par ? 10 : 8;
  for (int pi = 0; pi < nph; ++pi) {
    const int ph = par ? (pi < 3 ? pi : (pi < 5 ? pi + 5 : pi - 2)) : pi;
    const int reps = (ph == DUP_PHASE) ? 2 : 1;
    for (int rep = 0; rep < reps; ++rep) {
      switch (ph) {
        case 0: phase0(p, lds); break;
        case 1: phase1(p, lds); break;
        case 2: phase2(p, lds, rep, par); break;
        case 8: phase2b(p); break;
        case 9: phase2c(p, lds); break;
        case 3: gemm23<0>(p, lds); break;
        case 4: phase4(p); break;
        case 5: gemm23<1>(p, lds); break;
        case 6: phase6(p, lds); break;
        case 7: phase7(p, lds); break;
      }
      if (pi + 1 < nph || rep + 1 < reps) {
        if (use_sync == 2) grid.sync();
        else grid_bar((unsigned*)(p.ws + 128), (unsigned)gridDim.x * (++nbar));
      }
    }
  }
}

extern "C" void kernel_launch(void* const* d_in, const int* in_sizes, int n_in, void* d_out, int out_size,
                              void* d_ws, size_t ws_size, hipStream_t stream) {
  static int grid_blocks = 0;
  if (!grid_blocks) {
    int dev = 0, cus = 0, per_cu = 0;
    hipGetDevice(&dev);
    hipDeviceGetAttribute(&cus, hipDeviceAttributeMultiprocessorCount, dev);
    hipOccupancyMaxActiveBlocksPerMultiprocessor(&per_cu, mega, 256, 0);
    if (per_cu > 2) per_cu = 2;
    if (per_cu < 1) per_cu = 1;
    grid_blocks = cus * per_cu;
    grid_blocks &= ~7;
  }
  Params p{};
  p.x_prompt = (const float*)d_in[0]; p.x_sample = (const float*)d_in[1]; p.cache_k = (const float*)d_in[2];
  p.cache_v = (const float*)d_in[3]; p.state = (const float*)d_in[4]; p.w_in = (const float*)d_in[5];
  p.hgrn_lb = (const float*)d_in[6]; p.hgrn_g = (const float*)d_in[7]; p.lq1 = (const float*)d_in[8];
  p.lk1 = (const float*)d_in[9]; p.lq2 = (const float*)d_in[10]; p.lk2 = (const float*)d_in[11];
  p.diff_g = (const float*)d_in[12]; p.w_out = (const float*)d_in[13]; p.ln1_g = (const float*)d_in[14];
  p.ln1_b = (const float*)d_in[15]; p.wq = (const float*)d_in[16]; p.subk = (const float*)d_in[17];
  p.pu = (const float*)d_in[18]; p.pv = (const float*)d_in[19]; p.ln2_g = (const float*)d_in[20];
  p.ln2_b = (const float*)d_in[21];
  p.out = (float*)d_out; p.ws = (char*)d_ws;
  hipMemsetAsync(d_ws, 0, 512, stream);
  int lo = 0, hi = 7, us = 3;
  void* args[] = {&p, &lo, &hi, &us};
  hipError_t e = hipLaunchCooperativeKernel((const void*)mega, dim3(grid_blocks), dim3(256), args, 0, stream);
  if (e != hipSuccess) fprintf(stderr, "cooperative launch failed: %s (grid %d)\n", hipGetErrorString(e), grid_blocks);
}
```

```cpp
#include <hip/hip_runtime.h>
#include <hip/hip_cooperative_groups.h>
#include <stdint.h>
#include <cstdio>
namespace cg = cooperative_groups;

typedef unsigned short bf16_t;
typedef short bf16x8 __attribute__((ext_vector_type(8)));
typedef float f32x4 __attribute__((ext_vector_type(4)));
typedef unsigned u32x4 __attribute__((ext_vector_type(4)));
typedef unsigned u32x2 __attribute__((ext_vector_type(2)));

#define NTOK 16896
#define NPTOK 16384
#define LDS_BYTES 65536

#define OUT_Y   0
#define OUT_KP  34603008
#define OUT_VP  51380224
#define OUT_SP  68157440
#define OUT_KS  68681728
#define OUT_VS  69206016
#define OUT_SS  69730304

constexpr size_t SZ_XB     = (size_t)NTOK * 2048 * 2;
constexpr size_t SZ_T1K2   = (size_t)NTOK * 1024 * 2;
constexpr size_t SZ_W2     = (size_t)2048 * 2048 * 2;
constexpr size_t SZ_KS     = (size_t)64 * 1088 * 128 * 2;
constexpr size_t SZ_KP     = (size_t)32 * 4096 * 128 * 2;
constexpr size_t OFF_CTR   = 0;
constexpr size_t OFF_LB    = 4096;
constexpr size_t OFF_XB    = 8192;
constexpr size_t OFF_WINT  = OFF_XB + SZ_XB;
constexpr size_t OFF_WOUTT = OFF_WINT + (size_t)7168 * 2048 * 2;
constexpr size_t OFF_WQT   = OFF_WOUTT + SZ_W2;
constexpr size_t OFF_SKB   = OFF_WQT + SZ_W2;
constexpr size_t OFF_KS    = OFF_SKB + 524288;
constexpr size_t OFF_VTS   = OFF_KS + SZ_KS;
constexpr size_t OFF_R4    = OFF_VTS + SZ_KS;
constexpr size_t OFF_QA    = OFF_R4;
constexpr size_t OFF_LOGF  = OFF_QA + SZ_T1K2;
constexpr size_t OFF_IAT   = OFF_LOGF + 2 * SZ_T1K2;
constexpr size_t OFF_GA    = OFF_IAT + SZ_T1K2;
constexpr size_t OFF_QB    = OFF_GA + SZ_T1K2;
constexpr size_t OFF_KP    = OFF_QB + SZ_T1K2;
constexpr size_t OFF_VTP   = OFF_KP + SZ_KP;
constexpr size_t OFF_R4END = OFF_VTP + SZ_KP;
constexpr size_t OFF_X1F   = OFF_R4;
constexpr size_t OFF_UB    = OFF_XB;
constexpr size_t OFF_VB    = OFF_UB + (size_t)16384 * 2048;
constexpr size_t OFF_SCL   = OFF_VB + (size_t)16384 * 2048;
constexpr size_t OFF_MERGED= OFF_R4END;
constexpr size_t OFF_QP    = OFF_MERGED;
constexpr size_t OFF_X1B   = OFF_X1F + (size_t)NTOK * 2048 * 4;
constexpr size_t OFF_EIDX  = OFF_WINT;
constexpr size_t OFF_GATE  = OFF_EIDX + (size_t)NTOK * 128 * 4;
constexpr size_t OFF_DBUF  = OFF_WINT + (size_t)20 * 1024 * 1024;
constexpr size_t OFF_LS    = OFF_XB;
constexpr size_t WS_NEED_PAR = OFF_MERGED + SZ_XB;
static_assert((size_t)32 * 64 * 16 * 256 * 8 <= SZ_XB, "LS fits XB");
static_assert(OFF_SCL + 32768 * 4 <= OFF_WINT, "overlay"); static_assert(OFF_X1B + SZ_XB <= OFF_R4END, "overlay");

struct Params {
  const float* x_prompt; const float* x_sample; const float* cache_k; const float* cache_v; const float* state;
  const float* w_in; const float* hgrn_lb; const float* hgrn_g; const float* lq1; const float* lk1;
  const float* lq2; const float* lk2; const float* diff_g; const float* w_out; const float* ln1_g; const float* ln1_b;
  const float* wq; const float* subk; const float* pu; const float* pv; const float* ln2_g; const float* ln2_b;
  float* out; char* ws;
};

typedef __bf16 bf16x2_t __attribute__((ext_vector_type(2)));
typedef float f32x2_t __attribute__((ext_vector_type(2)));
__device__ __forceinline__ unsigned pk_bf16(float lo, float hi) {
  f32x2_t f = {lo, hi};
  bf16x2_t b = __builtin_convertvector(f, bf16x2_t);
  return __builtin_bit_cast(unsigned, b);
}
__device__ __forceinline__ float bf2f(unsigned short x) { return __uint_as_float(((unsigned)x) << 16); }
__device__ __forceinline__ float bflo(unsigned x) { return __uint_as_float(x << 16); }
__device__ __forceinline__ float bfhi(unsigned x) { return __uint_as_float(x & 0xffff0000u); }
__device__ __forceinline__ f32x4 mfma16(bf16x8 a, bf16x8 b, f32x4 c) {
  return __builtin_amdgcn_mfma_f32_16x16x32_bf16(a, b, c, 0, 0, 0);
}
__device__ __forceinline__ bf16x8 mk8(unsigned a, unsigned b, unsigned c, unsigned d) {
  u32x4 v = {a, b, c, d}; return __builtin_bit_cast(bf16x8, v);
}
__device__ __forceinline__ bf16x8 mk8(u32x2 a, u32x2 b) {
  u32x4 v = {a.x, a.y, b.x, b.y}; return __builtin_bit_cast(bf16x8, v);
}
__device__ __forceinline__ float wave_sum(float v) {
#pragma unroll
  for (int o = 32; o >= 1; o >>= 1) v += __shfl_xor(v, o);
  return v;
}

__device__ void transpose_conv(const float* __restrict__ W, bf16_t* __restrict__ WT, int K, int N, char* lds) {
  float* tile = (float*)lds;
  int tid_o = threadIdx.x; asm volatile("" : "+v"(tid_o)); const int tid = tid_o;
  const int nkt = K / 64, nnt = N / 64;
  for (int t = blockIdx.x; t < nkt * nnt; t += gridDim.x) {
    const int kt = t / nnt, nt = t % nnt;
    const int c = tid & 63, r0 = tid >> 6;
#pragma unroll 4
    for (int i = 0; i < 16; ++i) {
      int r = i * 4 + r0;
      tile[r * 65 + c] = W[(size_t)(kt * 64 + r) * N + nt * 64 + c];
    }
    __syncthreads();
#pragma unroll 4
    for (int i = 0; i < 16; ++i) {
      int n = i * 4 + r0;
      float v = tile[c * 65 + n];
      WT[(size_t)(nt * 64 + n) * K + kt * 64 + c] = (bf16_t)(pk_bf16(v, 0.f) & 0xffff);
    }
    __syncthreads();
  }
}

__device__ __forceinline__ void conv8(const float* __restrict__ src, bf16_t* __restrict__ dst) {
  f32x4 a = __builtin_nontemporal_load((const f32x4*)src), b = __builtin_nontemporal_load((const f32x4*)(src + 4));
  u32x4 o = {pk_bf16(a.x, a.y), pk_bf16(a.z, a.w), pk_bf16(b.x, b.y), pk_bf16(b.z, b.w)};
  *(u32x4*)dst = o;
}

__device__ void phase0(const Params& p, char* lds) {
  int tid_o = threadIdx.x; asm volatile("" : "+v"(tid_o)); const int tid = tid_o, bid = blockIdx.x;
  const size_t gtid = (size_t)bid * 256 + tid, gsz = (size_t)gridDim.x * 256;
  if (bid == 0) {
    if (tid < 64) {
      float a = p.lq1[tid] * p.lk1[tid], b = p.lq2[tid] * p.lk2[tid];
      a = wave_sum(a); b = wave_sum(b);
      if (tid == 0) ((float*)(p.ws + OFF_CTR))[16] = expf(a) - expf(b) + 0.2f;
    }
    float* LB = (float*)(p.ws + OFF_LB);
    for (int k = tid; k < 1024; k += 256) {
      float a0 = p.hgrn_lb[k], a1 = p.hgrn_lb[1024 + k];
      LB[k] = 1.0f / (1.0f + expf(a1 - a0));
    }
  }
  {
    bf16_t* XB = (bf16_t*)(p.ws + OFF_XB);
    const size_t nch = (size_t)NTOK * 2048 / 8;
    for (size_t c = gtid; c < nch; c += gsz) {
      size_t e = c * 8;
      const float* src = (e < (size_t)NPTOK * 2048) ? (p.x_prompt + e) : (p.x_sample + (e - (size_t)NPTOK * 2048));
      conv8(src, XB + e);
    }
  }
  {
    bf16_t* KS = (bf16_t*)(p.ws + OFF_KS);
    for (size_t c = gtid; c < (size_t)1048576; c += gsz) {
      int d8 = c & 15, h = (c >> 4) & 7, s = (c >> 7) & 1023, b = (int)(c >> 17);
      conv8(p.cache_k + c * 8, KS + ((size_t)((b * 8 + h) * 1088 + s) * 128 + d8 * 8));
    }
  }
  {
    bf16_t* VTS = (bf16_t*)(p.ws + OFF_VTS);
    for (size_t i = gtid; i < (size_t)2097152; i += gsz) {
      int vc = i & 127, s4 = (i >> 7) & 255, h = (i >> 15) & 7, b = (int)(i >> 18);
      const float* src = p.cache_v + ((size_t)(b * 1024 + s4 * 4) * 8 + h) * 128 + vc;
      float v0 = src[0], v1 = src[1024], v2 = src[2048], v3 = src[3072];
      u32x2 o = {pk_bf16(v0, v1), pk_bf16(v2, v3)};
      *(u32x2*)(VTS + ((size_t)((b * 8 + h) * 128 + vc) * 1088 + s4 * 4)) = o;
    }
  }
  {
    bf16_t* SKB = (bf16_t*)(p.ws + OFF_SKB);
    for (size_t c = gtid; c < (size_t)32768; c += gsz) conv8(p.subk + c * 8, SKB + c * 8);
  }
  transpose_conv(p.w_in, (bf16_t*)(p.ws + OFF_WINT), 2048, 7168, lds);
  transpose_conv(p.w_out, (bf16_t*)(p.ws + OFF_WOUTT), 2048, 2048, lds);
  transpose_conv(p.wq, (bf16_t*)(p.ws + OFF_WQT), 2048, 2048, lds);
}

template <bool SWAP>
__device__ __forceinline__ void gemm_compute_tile(const char* cur, int aoff, int boff, int sw, int fq, f32x4 (&acc)[4][4]) {
  bf16x8 af[2][4], bfr[2][4];
#pragma unroll
  for (int ks = 0; ks < 2; ++ks) {
    const int ch = ((ks * 4 + fq) ^ sw) << 4;
#pragma unroll
    for (int m = 0; m < 4; ++m) af[ks][m] = *(const bf16x8*)(cur + aoff + m * 2048 + ch);
#pragma unroll
    for (int n = 0; n < 4; ++n) bfr[ks][n] = *(const bf16x8*)(cur + boff + n * 2048 + ch);
  }
#pragma unroll
  for (int ks = 0; ks < 2; ++ks) {
    __builtin_amdgcn_s_setprio(1);
#pragma unroll
    for (int m = 0; m < 4; ++m)
#pragma unroll
      for (int n = 0; n < 4; ++n)
        acc[m][n] = SWAP ? mfma16(bfr[ks][n], af[ks][m], acc[m][n]) : mfma16(af[ks][m], bfr[ks][n], acc[m][n]);
    __builtin_amdgcn_s_setprio(0);
  }
}

template <bool SWAP>
__device__ __forceinline__ void gemm_mainloop(const bf16_t* A, const bf16_t* B,
                                              int row0, int col0, int K, char* lds, f32x4 (&acc)[4][4]) {
  int tid_o = threadIdx.x; asm volatile("" : "+v"(tid_o)); const int tid = tid_o, lane = tid & 63, wave = tid >> 6;
  const int wm = wave >> 1, wn = wave & 1, fr = lane & 15, fq = lane >> 4;
  const int lrow = tid >> 3, lc = tid & 7;
  const int cl = lc ^ (lrow & 7);
  const bf16_t* ga = A + (size_t)(row0 + lrow) * K + cl * 8;
  const bf16_t* gb = B + (size_t)(col0 + lrow) * K + cl * 8;
  const int loff = tid * 16;
#define G_STAGE(BUF, KT) { _Pragma("unroll") for (int i = 0; i < 4; ++i) { \
      __builtin_amdgcn_global_load_lds((const unsigned*)(ga + (size_t)i * 32 * K + (KT) * 64), (unsigned*)((BUF) + loff + i * 4096), 16, 0, 0); \
      __builtin_amdgcn_global_load_lds((const unsigned*)(gb + (size_t)i * 32 * K + (KT) * 64), (unsigned*)((BUF) + 16384 + loff + i * 4096), 16, 0, 0); } }
  const int nkt = K >> 6;
  G_STAGE(lds, 0);
  __syncthreads();
  const int aoff = (wm * 64 + fr) * 128, boff = 16384 + (wn * 64 + fr) * 128;
  const int sw = fr & 7;
  for (int kt = 0; kt < nkt; ++kt) {
    char* cur = lds + (kt & 1) * 32768;
    char* nxt = lds + ((kt + 1) & 1) * 32768;
    if (kt + 1 < nkt) G_STAGE(nxt, kt + 1);
    gemm_compute_tile<SWAP>(cur, aoff, boff, sw, fq, acc);
    __syncthreads();
  }
#undef G_STAGE
}

template <int MT, bool SWAP>
__device__ __forceinline__ void gemm_mainloop_big(const bf16_t* A, const bf16_t* B,
                                                  int row0, int col0, int K, char* lds, f32x4 (&acc)[MT][4]) {
  int tid_o = threadIdx.x; asm volatile("" : "+v"(tid_o)); const int tid = tid_o, lane = tid & 63, wave = tid >> 6;
  const int wm = wave >> 1, wn = wave & 1, fr = lane & 15, fq = lane >> 4;
  const int lrow = tid >> 3, lc = tid & 7;
  const int cl = lc ^ (lrow & 7);
  const bf16_t* ga = A + (size_t)(row0 + lrow) * K + cl * 8;
  const bf16_t* gb = B + (size_t)(col0 + lrow) * K + cl * 8;
  const int loff = tid * 16;
  const int nkt = K >> 6;
  constexpr int BOFF = MT * 32 * 128;
  const int aoff = (wm * (MT * 16) + fr) * 128, boff = BOFF + (wn * 64 + fr) * 128;
  const int sw = fr & 7;
  for (int kt = 0; kt < nkt; ++kt) {
#pragma unroll
    for (int i = 0; i < MT; ++i)
      __builtin_amdgcn_global_load_lds((const unsigned*)(ga + (size_t)i * 32 * K + kt * 64), (unsigned*)(lds + loff + i * 4096), 16, 0, 0);
#pragma unroll
    for (int i = 0; i < 4; ++i)
      __builtin_amdgcn_global_load_lds((const unsigned*)(gb + (size_t)i * 32 * K + kt * 64), (unsigned*)(lds + BOFF + loff + i * 4096), 16, 0, 0);
    __syncthreads();
    {
      bf16x8 af[2][MT], bfr[2][4];
#pragma unroll
      for (int ks = 0; ks < 2; ++ks) {
        const int ch = ((ks * 4 + fq) ^ sw) << 4;
#pragma unroll
        for (int m = 0; m < MT; ++m) af[ks][m] = *(const bf16x8*)(lds + aoff + m * 2048 + ch);
#pragma unroll
        for (int n = 0; n < 4; ++n) bfr[ks][n] = *(const bf16x8*)(lds + boff + n * 2048 + ch);
      }
#pragma unroll
      for (int ks = 0; ks < 2; ++ks) {
        __builtin_amdgcn_s_setprio(1);
#pragma unroll
        for (int m = 0; m < MT; ++m)
#pragma unroll
          for (int n = 0; n < 4; ++n)
            acc[m][n] = SWAP ? mfma16(bfr[ks][n], af[ks][m], acc[m][n]) : mfma16(af[ks][m], bfr[ks][n], acc[m][n]);
        __builtin_amdgcn_s_setprio(0);
      }
    }
    __syncthreads();
  }
}

template <bool SWAP>
__device__ void gemm1_tile(const Params& p, int mt, int nt, char* lds) {
  f32x4 acc[8][4];
#pragma unroll
  for (int m = 0; m < 8; ++m)
#pragma unroll
    for (int n = 0; n < 4; ++n) acc[m][n] = (f32x4){0.f, 0.f, 0.f, 0.f};
  gemm_mainloop_big<8, SWAP>((const bf16_t*)(p.ws + OFF_XB), (const bf16_t*)(p.ws + OFF_WINT), mt * 256, nt * 128, 2048, lds, acc);
  int tidv = threadIdx.x; asm volatile("" : "+v"(tidv));
  const int tid = tidv, lane = tid & 63, wave = tid >> 6;
  const int wm = wave >> 1, wn = wave & 1, fr = lane & 15, fq = lane >> 4;
  const int seg = nt >> 3, h = nt & 7;
  const bool samp = (mt * 256 >= NPTOK);
  if (SWAP) {
    const float* LB = (const float*)(p.ws + OFF_LB);
    if (seg == 5 && !samp) {
      float nmax = 0.f;
#pragma unroll
      for (int m = 0; m < 8; ++m) {
        float s2 = 0.f;
#pragma unroll
        for (int n = 0; n < 4; ++n) s2 += acc[m][n].x * acc[m][n].x + acc[m][n].y * acc[m][n].y + acc[m][n].z * acc[m][n].z + acc[m][n].w * acc[m][n].w;
        s2 += __shfl_xor(s2, 16);
        s2 += __shfl_xor(s2, 32);
        nmax = fmaxf(nmax, s2);
      }
#pragma unroll
      for (int o = 8; o >= 1; o >>= 1) nmax = fmaxf(nmax, __shfl_xor(nmax, o));
      if (lane == 0) atomicMax((unsigned*)(p.ws + 256) + ((mt * 256) >> 12) * 16 + h * 2 + wn, __float_as_uint(nmax));
    }
#pragma unroll
    for (int m = 0; m < 8; ++m) {
      const int tok = mt * 256 + wm * 128 + m * 16 + fr;
#pragma unroll
      for (int n = 0; n < 4; ++n) {
        const int cl = wn * 64 + n * 16 + fq * 4;
        const int kidx = h * 128 + cl;
        f32x4 v = acc[m][n];
        if (seg == 0) {
          u32x2 o = {pk_bf16(v.x, v.y), pk_bf16(v.z, v.w)};
          *(u32x2*)((bf16_t*)(p.ws + OFF_QA) + (size_t)tok * 1024 + kidx) = o;
        } else if (seg == 1) {
          f32x4 lb = *(const f32x4*)(LB + kidx);
          f32x4 o;
          o.x = lb.x + (1.f - lb.x) / (1.f + __expf(-v.x));
          o.y = lb.y + (1.f - lb.y) / (1.f + __expf(-v.y));
          o.z = lb.z + (1.f - lb.z) / (1.f + __expf(-v.z));
          o.w = lb.w + (1.f - lb.w) / (1.f + __expf(-v.w));
          *(f32x4*)((float*)(p.ws + OFF_LOGF) + (size_t)tok * 1024 + kidx) = o;
        } else if (seg == 3) {
          float s0 = 1.f / (1.f + __expf(-v.x)), s1 = 1.f / (1.f + __expf(-v.y));
          float s2 = 1.f / (1.f + __expf(-v.z)), s3 = 1.f / (1.f + __expf(-v.w));
          u32x2 o = {pk_bf16(s0, s1), pk_bf16(s2, s3)};
          *(u32x2*)((bf16_t*)(p.ws + OFF_GA) + (size_t)tok * 1024 + kidx) = o;
        } else if (seg == 4) {
          const float sc = 0.18033688011112042f;
          u32x2 o = {pk_bf16(v.x * sc, v.y * sc), pk_bf16(v.z * sc, v.w * sc)};
          *(u32x2*)((bf16_t*)(p.ws + OFF_QB) + (size_t)tok * 1024 + kidx) = o;
        } else {
          u32x2 o = {pk_bf16(v.x, v.y), pk_bf16(v.z, v.w)};
          if (!samp) {
            __builtin_nontemporal_store(v, (f32x4*)(p.out + OUT_KP + (size_t)tok * 1024 + kidx));
            const int b = tok >> 12, t = tok & 4095;
            *(u32x2*)((bf16_t*)(p.ws + OFF_KP) + ((size_t)((b * 8 + h) * 4096 + t) * 128 + cl)) = o;
          } else {
            const int ts = tok - NPTOK;
            __builtin_nontemporal_store(v, (f32x4*)(p.out + OUT_KS + (size_t)ts * 1024 + kidx));
            const int b = ts >> 6, t = ts & 63;
            *(u32x2*)((bf16_t*)(p.ws + OFF_KS) + ((size_t)((b * 8 + h) * 1088 + 1024 + t) * 128 + cl)) = o;
          }
        }
      }
    }
  } else {
#pragma unroll
    for (int m = 0; m < 8; ++m) {
      const int tok0 = mt * 256 + wm * 128 + m * 16 + fq * 4;
#pragma unroll
      for (int n = 0; n < 4; ++n) {
        const int cl = wn * 64 + n * 16 + fr;
        f32x4 v = acc[m][n];
        u32x2 o = {pk_bf16(v.x, v.y), pk_bf16(v.z, v.w)};
        if (seg == 2) {
          bf16_t* IAT = (bf16_t*)(p.ws + OFF_IAT);
          if (!samp) {
            const int b = tok0 >> 12, t = tok0 & 4095;
            *(u32x2*)(IAT + ((size_t)((b * 8 + h) * 128 + cl) * 4096 + t)) = o;
          } else {
            const int ts = tok0 - NPTOK, b = ts >> 6, t = ts & 63;
            *(u32x2*)(IAT + (size_t)32 * 128 * 4096 + ((size_t)((b * 8 + h) * 128 + cl) * 64 + t)) = o;
          }
        } else {
          if (!samp) {
            float* ov = p.out + OUT_VP + (size_t)tok0 * 1024 + h * 128 + cl;
            __builtin_nontemporal_store(v.x, ov); __builtin_nontemporal_store(v.y, ov + 1024); __builtin_nontemporal_store(v.z, ov + 2048); __builtin_nontemporal_store(v.w, ov + 3072);
            const int b = tok0 >> 12, t = tok0 & 4095;
            *(u32x2*)((bf16_t*)(p.ws + OFF_VTP) + ((size_t)((b * 8 + h) * 128 + cl) * 4096 + t)) = o;
          } else {
            const int ts = tok0 - NPTOK, b = ts >> 6, t = ts & 63;
            float* ov = p.out + OUT_VS + (size_t)ts * 1024 + h * 128 + cl;
            __builtin_nontemporal_store(v.x, ov); __builtin_nontemporal_store(v.y, ov + 1024); __builtin_nontemporal_store(v.z, ov + 2048); __builtin_nontemporal_store(v.w, ov + 3072);
            *(u32x2*)((bf16_t*)(p.ws + OFF_VTS) + ((size_t)((b * 8 + h) * 128 + cl) * 1088 + 1024 + t)) = o;
          }
        }
      }
    }
  }
}

__device__ void phase1(const Params& p, char* lds) {
  const int xcd = blockIdx.x & 7, lb = blockIdx.x >> 3, nbx = gridDim.x >> 3;
  const int nM = NTOK / 256, nNx = 7;
  for (int li = lb; li < nM * nNx; li += nbx) {
    const int mt = li / nNx, nt = (li % nNx) * 8 + xcd;
    const int seg = nt >> 3;
    if (seg == 2 || seg == 6) gemm1_tile<false>(p, mt, nt, lds);
    else gemm1_tile<true>(p, mt, nt, lds);
  }
}

template <int MODE, int MT>
__device__ void gemm23_tile(const Params& p, int row0, int nt, char* lds) {
  const bf16_t* A = (const bf16_t*)(p.ws + (MODE == 0 ? OFF_MERGED : OFF_X1B));
  const bf16_t* B = (const bf16_t*)(p.ws + (MODE == 0 ? OFF_WOUTT : OFF_WQT));
  f32x4 acc[MT][4];
#pragma unroll
  for (int m = 0; m < MT; ++m)
#pragma unroll
    for (int n = 0; n < 4; ++n) acc[m][n] = (f32x4){0.f, 0.f, 0.f, 0.f};
  if (MT == 4) gemm_mainloop<true>(A, B, row0, nt * 128, 2048, lds, (f32x4(&)[4][4])acc);
  else gemm_mainloop_big<MT, true>(A, B, row0, nt * 128, 2048, lds, acc);
  int tid_o = threadIdx.x; asm volatile("" : "+v"(tid_o)); const int tid = tid_o, lane = tid & 63, wave = tid >> 6;
  const int wm = wave >> 1, wn = wave & 1, fr = lane & 15, fq = lane >> 4;
#pragma unroll
  for (int m = 0; m < MT; ++m) {
    const int tok = row0 + wm * (MT * 16) + m * 16 + fr;
#pragma unroll
    for (int n = 0; n < 4; ++n) {
      const int col = nt * 128 + wn * 64 + n * 16 + fq * 4;
      f32x4 v = acc[m][n];
      if (MODE == 0) {
        const float* xin = (tok < NPTOK) ? (p.x_prompt + (size_t)tok * 2048) : (p.x_sample + (size_t)(tok - NPTOK) * 2048);
        f32x4 xv = __builtin_nontemporal_load((const f32x4*)(xin + col));
        const float al = 1.189207115002721f;
        u32x2 o = {pk_bf16(al * xv.x + v.x, al * xv.y + v.y), pk_bf16(al * xv.z + v.z, al * xv.w + v.w)};
        *(u32x2*)((bf16_t*)(p.ws + OFF_X1B) + (size_t)tok * 2048 + col) = o;
      } else {
        u32x2 o = {pk_bf16(v.x, v.y), pk_bf16(v.z, v.w)};
        *(u32x2*)((bf16_t*)(p.ws + OFF_QP) + (size_t)tok * 2048 + col) = o;
      }
    }
  }
}

template <int MODE>
__device__ void gemm23(const Params& p, char* lds) {
  const int xcd = blockIdx.x & 7, lb = blockIdx.x >> 3, nbx = gridDim.x >> 3;
  for (int li = lb; li < 64 * 2; li += nbx) gemm23_tile<MODE, 8>(p, (li >> 1) * 256, (li & 1) * 8 + xcd, lds);
  for (int li = lb; li < 4 * 2; li += nbx) gemm23_tile<MODE, 4>(p, NPTOK + (li >> 1) * 128, (li & 1) * 8 + xcd, lds);
}

__device__ void hgrn_item(const Params& p, int kind, int b, int h, char* lds, int mode, int c0) {
  int tid_o = threadIdx.x; asm volatile("" : "+v"(tid_o)); const int tid = tid_o, lane = tid & 63, w = tid >> 6, fr = lane & 15, fq = lane >> 4;
  const int tokbase = kind == 0 ? b * 4096 : NPTOK + b * 64;
  const int c_begin = mode == 0 ? 0 : c0, nch = mode == 0 ? (kind == 0 ? 64 : 1) : c0 + 1;
  u32x2* LSb = (u32x2*)(p.ws + OFF_LS) + ((size_t)((b * 8 + h) * 64 + c0) * 16) * 256 + tid;
  const bf16_t* IATb = (const bf16_t*)(p.ws + OFF_IAT) +
      (kind == 0 ? (size_t)((b * 8 + h) * 128) * 4096 : (size_t)32 * 128 * 4096 + (size_t)((b * 8 + h) * 128) * 64);
  const int iat_stride = kind == 0 ? 4096 : 64;
  const float* LOGF = (const float*)(p.ws + OFF_LOGF);
  const bf16_t* QA = (const bf16_t*)(p.ws + OFF_QA);
  const bf16_t* GA = (const bf16_t*)(p.ws + OFF_GA);
  bf16_t* MERGED = (bf16_t*)(p.ws + OFF_MERGED);

  f32x4 S[8][2];
  if (mode == 2) {
#pragma unroll
    for (int kt = 0; kt < 8; ++kt)
#pragma unroll
      for (int vv = 0; vv < 2; ++vv) {
        u32x2 t = LSb[(kt * 2 + vv) * 256];
        S[kt][vv] = (f32x4){bflo(t.x), bfhi(t.x), bflo(t.y), bfhi(t.y)};
      }
  } else if (kind == 0) {
#pragma unroll
    for (int kt = 0; kt < 8; ++kt)
#pragma unroll
      for (int vv = 0; vv < 2; ++vv) S[kt][vv] = (f32x4){0.f, 0.f, 0.f, 0.f};
  } else {
    const float* st = p.state + (size_t)((b * 8 + h) * 128) * 128 + (4 * fq) * 128 + 32 * w + fr;
#pragma unroll
    for (int kt = 0; kt < 8; ++kt)
#pragma unroll
      for (int vv = 0; vv < 2; ++vv)
#pragma unroll
        for (int j = 0; j < 4; ++j) S[kt][vv][j] = st[(16 * kt + j) * 128 + 16 * vv];
  }
  f32x4 gn[2];
#pragma unroll
  for (int vv = 0; vv < 2; ++vv) gn[vv] = *(const f32x4*)(p.hgrn_g + 32 * w + 16 * vv + 4 * fq);

  const int ekp = tid & 63, eq = tid >> 6;

  u32x4 gR[8];
  unsigned qn[16];
#pragma unroll
  for (int i = 0; i < 8; ++i) {
    int id = tid + 256 * i, row = id >> 5, cc = id & 31;
    gR[i] = *(const u32x4*)(LOGF + (size_t)(tokbase + c_begin * 64 + row) * 1024 + h * 128 + cc * 4);
  }
#pragma unroll
  for (int i = 0; i < 16; ++i) qn[i] = *(const unsigned*)(QA + (size_t)(tokbase + c_begin * 64 + 16 * eq + i) * 1024 + h * 128 + 2 * ekp);
  for (int c = c_begin; c < nch; ++c) {
    int zz = 0; asm volatile("" : "+v"(zz));
    int tidv = threadIdx.x; asm volatile("" : "+v"(tidv));
    const int tid = tidv, lane = tid & 63, w = tid >> 6, fr = lane & 15, fq = lane >> 4, ekp = tid & 63, eq = tid >> 6;
    char* L = lds + zz;
    float* Dl = (float*)(L + 57344);
    float* part = (float*)(L + 57856);
    const int tok0 = tokbase + c * 64 + zz;
#pragma unroll
    for (int i = 0; i < 8; ++i) {
      int id = tid + 256 * i, row = id >> 5, cc = id & 31;
      *(u32x4*)(L + row * 512 + cc * 16) = gR[i];
    }
    unsigned qv[16];
#pragma unroll
    for (int i = 0; i < 16; ++i) qv[i] = qn[i];
    if (c + 1 < nch) {
#pragma unroll
      for (int i = 0; i < 8; ++i) {
        int id = tid + 256 * i, row = id >> 5, cc = id & 31;
        gR[i] = *(const u32x4*)(LOGF + (size_t)(tok0 + 64 + row) * 1024 + h * 128 + cc * 4);
      }
    }
    bf16x8 vfr[2][2];
#pragma unroll
    for (int ss = 0; ss < 2; ++ss)
#pragma unroll
      for (int vv = 0; vv < 2; ++vv)
        vfr[ss][vv] = *(const bf16x8*)(IATb + (size_t)(32 * w + 16 * vv + fr) * iat_stride + c * 64 + zz + 32 * ss + 8 * fq);
    __syncthreads();
    typedef float f32x2 __attribute__((ext_vector_type(2)));
    f32x2 gv[16];
    const float* Gl = (const float*)L;
    float* qtot = (float*)(L + 58880);
    float tot0 = 1.f, tot1 = 1.f;
#pragma unroll
    for (int i = 0; i < 16; ++i) { gv[i] = *(const f32x2*)(Gl + (16 * eq + i) * 128 + 2 * ekp); tot0 *= gv[i].x; tot1 *= gv[i].y; }
    qtot[eq * 128 + 2 * ekp] = tot0; qtot[eq * 128 + 2 * ekp + 1] = tot1;
    __syncthreads();
    {
      float run0 = 1.f, run1 = 1.f;
      for (int qq = 0; qq < eq; ++qq) { run0 *= qtot[qq * 128 + 2 * ekp]; run1 *= qtot[qq * 128 + 2 * ekp + 1]; }
      const int k0 = 2 * ekp;
#pragma unroll
      for (int i4 = 0; i4 < 4; ++i4) {
        float ka[4], kb[4];
#pragma unroll
        for (int ii = 0; ii < 4; ++ii) {
          const int i = i4 * 4 + ii, t = 16 * eq + i;
          const float f0 = gv[i].x, f1 = gv[i].y;
          run0 *= f0; run1 *= f1;
          const float q0 = bflo(qv[i]) * run0, q1 = bfhi(qv[i]) * run1;
          const float kk0 = (1.f - f0) * __builtin_amdgcn_rcpf(run0), kk1 = (1.f - f1) * __builtin_amdgcn_rcpf(run1);
          ka[ii] = kk0; kb[ii] = kk1;
          const int o = (t * 128 + ((((k0 >> 3) ^ (t & 15)) << 3) | (k0 & 7))) * 2;
          if (mode != 1) {
            *(unsigned*)(L + o) = pk_bf16(q0, q1);
            *(unsigned*)(L + 16384 + o) = pk_bf16(kk0, kk1);
          }
        }
        const int t0 = 16 * eq + i4 * 4;
        u32x2 oa = {pk_bf16(ka[0], ka[1]), pk_bf16(ka[2], ka[3])};
        u32x2 ob = {pk_bf16(kb[0], kb[1]), pk_bf16(kb[2], kb[3])};
        if (mode != 2) {
          *(u32x2*)(L + 32768 + k0 * 128 + ((((t0 >> 3) ^ (k0 & 7)) << 4) | ((t0 & 7) << 1))) = oa;
          *(u32x2*)(L + 32768 + (k0 + 1) * 128 + ((((t0 >> 3) ^ ((k0 + 1) & 7)) << 4) | ((t0 & 7) << 1))) = ob;
        }
      }
      if (eq == 3) { Dl[k0] = run0; Dl[k0 + 1] = run1; }
    }
    if (c + 1 < nch) {
#pragma unroll
      for (int i = 0; i < 16; ++i) qn[i] = *(const unsigned*)(QA + (size_t)(tok0 + 64 + 16 * eq + i) * 1024 + h * 128 + 2 * ekp);
    }
    __syncthreads();
    if (mode != 1) {
      bf16x8 qf[4];
#pragma unroll
      for (int ks = 0; ks < 4; ++ks) {
        const int t = 16 * w + fr;
        qf[ks] = *(const bf16x8*)(L + t * 256 + (((4 * ks + fq) ^ (t & 15)) << 4));
      }
#pragma unroll
      for (int st = 0; st < 4; ++st) {
        f32x4 a = {0.f, 0.f, 0.f, 0.f};
#pragma unroll
        for (int ks = 0; ks < 4; ++ks) {
          const int s = 16 * st + fr;
          bf16x8 kf = *(const bf16x8*)(L + 16384 + s * 256 + (((4 * ks + fq) ^ (s & 15)) << 4));
          a = mfma16(kf, qf[ks], a);
        }
        const int t = 16 * w + fr, s0 = 16 * st + 4 * fq;
        float p0 = (s0 + 0 <= t) ? a.x : 0.f, p1 = (s0 + 1 <= t) ? a.y : 0.f;
        float p2 = (s0 + 2 <= t) ? a.z : 0.f, p3 = (s0 + 3 <= t) ? a.w : 0.f;
        u32x2 o2 = {pk_bf16(p0, p1), pk_bf16(p2, p3)};
        *(u32x2*)(L + 49152 + t * 128 + ((((s0 >> 3) ^ (t & 7)) << 4) | ((s0 & 7) << 1))) = o2;
      }
    }
    f32x4 O[2][4];
#pragma unroll
    for (int vv = 0; vv < 2; ++vv)
#pragma unroll
      for (int tt = 0; tt < 4; ++tt) O[vv][tt] = (f32x4){0.f, 0.f, 0.f, 0.f};
    if (mode != 1) {
#pragma unroll
    for (int ks = 0; ks < 4; ++ks) {
      bf16x8 sf[2];
#pragma unroll
      for (int vv = 0; vv < 2; ++vv)
        sf[vv] = mk8(pk_bf16(S[2 * ks][vv].x, S[2 * ks][vv].y), pk_bf16(S[2 * ks][vv].z, S[2 * ks][vv].w),
                     pk_bf16(S[2 * ks + 1][vv].x, S[2 * ks + 1][vv].y), pk_bf16(S[2 * ks + 1][vv].z, S[2 * ks + 1][vv].w));
#pragma unroll
      for (int tt = 0; tt < 4; ++tt) {
        const int t = 16 * tt + fr;
        const int c0 = 4 * ks + (fq >> 1), c1 = 4 * ks + 2 + (fq >> 1);
        u32x2 q0 = *(const u32x2*)(L + t * 256 + ((c0 ^ (t & 15)) << 4) + ((fq & 1) << 3));
        u32x2 q1 = *(const u32x2*)(L + t * 256 + ((c1 ^ (t & 15)) << 4) + ((fq & 1) << 3));
        bf16x8 qp = mk8(q0, q1);
#pragma unroll
        for (int vv = 0; vv < 2; ++vv) O[vv][tt] = mfma16(sf[vv], qp, O[vv][tt]);
      }
    }
    }
    __syncthreads();
#pragma unroll
    for (int ss = 0; ss < 2; ++ss) {
      bf16x8 vf[2];
#pragma unroll
      for (int vv = 0; vv < 2; ++vv) vf[vv] = vfr[ss][vv];
      if (mode != 1) {
#pragma unroll
      for (int tt = 0; tt < 4; ++tt) {
        const int t = 16 * tt + fr;
        bf16x8 pf = *(const bf16x8*)(L + 49152 + t * 128 + (((4 * ss + fq) ^ (t & 7)) << 4));
#pragma unroll
        for (int vv = 0; vv < 2; ++vv) O[vv][tt] = mfma16(vf[vv], pf, O[vv][tt]);
      }
      }
      if (mode != 2) {
#pragma unroll
      for (int kt = 0; kt < 8; ++kt) {
        const int r = 16 * kt + fr;
        bf16x8 kf = *(const bf16x8*)(L + 32768 + r * 128 + (((4 * ss + fq) ^ (r & 7)) << 4));
#pragma unroll
        for (int vv = 0; vv < 2; ++vv) S[kt][vv] = mfma16(kf, vf[vv], S[kt][vv]);
      }
      }
    }
    if (mode != 2) {
#pragma unroll
    for (int kt = 0; kt < 8; ++kt) {
      f32x4 d = *(const f32x4*)(Dl + 16 * kt + 4 * fq);
#pragma unroll
      for (int vv = 0; vv < 2; ++vv) { S[kt][vv].x *= d.x; S[kt][vv].y *= d.y; S[kt][vv].z *= d.z; S[kt][vv].w *= d.w; }
    }
    }
    if (mode == 1 && tid < 128) ((float*)(p.ws + OFF_DBUF))[(size_t)((b * 8 + h) * 64 + c) * 128 + tid] = Dl[tid];
    if (mode != 1) {
#pragma unroll
    for (int tt = 0; tt < 4; ++tt) {
      float ss = 0.f;
#pragma unroll
      for (int vv = 0; vv < 2; ++vv) ss += O[vv][tt].x * O[vv][tt].x + O[vv][tt].y * O[vv][tt].y + O[vv][tt].z * O[vv][tt].z + O[vv][tt].w * O[vv][tt].w;
      ss += __shfl_xor(ss, 16);
      ss += __shfl_xor(ss, 32);
      if (fq == 0) part[w * 64 + 16 * tt + fr] = ss;
    }
    __syncthreads();
#pragma unroll
    for (int tt = 0; tt < 4; ++tt) {
      const int t = 16 * tt + fr;
      const float tot = part[t] + part[64 + t] + part[128 + t] + part[192 + t];
      const float r = rsqrtf(tot * (1.f / 128.f) + 1e-5f);
      const size_t tok = (size_t)(tok0 + t);
#pragma unroll
      for (int vv = 0; vv < 2; ++vv) {
        const int v0 = h * 128 + 32 * w + 16 * vv + 4 * fq;
        u32x2 gt = *(const u32x2*)(GA + tok * 1024 + v0);
        float o0 = O[vv][tt].x * r * gn[vv].x * bflo(gt.x);
        float o1 = O[vv][tt].y * r * gn[vv].y * bfhi(gt.x);
        float o2 = O[vv][tt].z * r * gn[vv].z * bflo(gt.y);
        float o3 = O[vv][tt].w * r * gn[vv].w * bfhi(gt.y);
        u32x2 ov = {pk_bf16(o0, o1), pk_bf16(o2, o3)};
        *(u32x2*)(MERGED + tok * 2048 + v0) = ov;
      }
    }
    }
    __syncthreads();
  }
  if (mode == 1) {
#pragma unroll
    for (int kt = 0; kt < 8; ++kt)
#pragma unroll
      for (int vv = 0; vv < 2; ++vv) {
        u32x2 t = {pk_bf16(S[kt][vv].x, S[kt][vv].y), pk_bf16(S[kt][vv].z, S[kt][vv].w)};
        LSb[(kt * 2 + vv) * 256] = t;
      }
    return;
  }
  if (mode == 2) return;
  int zq = 0; asm volatile("" : "+v"(zq));
  float* so = p.out + (kind == 0 ? OUT_SP : OUT_SS) + (size_t)((b * 8 + h) * 128) * 128 + (4 * fq) * 128 + 32 * w + fr + zq;
#pragma unroll
  for (int kt = 0; kt < 8; ++kt)
#pragma unroll
    for (int vv = 0; vv < 2; ++vv)
#pragma unroll
      for (int j = 0; j < 4; ++j) so[(16 * kt + j) * 128 + 16 * vv] = S[kt][vv][j];
}


__device__ void hgrn_scan_item(const Params& p, int chain, int kt) {
  int tid_o = threadIdx.x; asm volatile("" : "+v"(tid_o)); const int tid = tid_o, lane = tid & 63, w = tid >> 6, fr = lane & 15, fq = lane >> 4;
  u32x2* LS = (u32x2*)(p.ws + OFF_LS) + ((size_t)(chain * 64) * 16 + kt * 2) * 256 + tid;
  const float* DB = (const float*)(p.ws + OFF_DBUF) + (size_t)(chain * 64) * 128 + 16 * kt + 4 * fq;
  f32x4 S0 = {0.f, 0.f, 0.f, 0.f}, S1 = {0.f, 0.f, 0.f, 0.f};
#pragma unroll 1
  for (int c8 = 0; c8 < 64; c8 += 8) {
    u32x2 l0[8], l1[8];
    f32x4 d[8];
#pragma unroll
    for (int i = 0; i < 8; ++i) {
      l0[i] = LS[(size_t)(c8 + i) * 16 * 256];
      l1[i] = LS[(size_t)(c8 + i) * 16 * 256 + 256];
      d[i] = *(const f32x4*)(DB + (c8 + i) * 128);
    }
#pragma unroll
    for (int i = 0; i < 8; ++i) {
      u32x2 o0 = {pk_bf16(S0.x, S0.y), pk_bf16(S0.z, S0.w)}, o1 = {pk_bf16(S1.x, S1.y), pk_bf16(S1.z, S1.w)};
      LS[(size_t)(c8 + i) * 16 * 256] = o0; LS[(size_t)(c8 + i) * 16 * 256 + 256] = o1;
      S0.x = d[i].x * S0.x + bflo(l0[i].x); S0.y = d[i].y * S0.y + bfhi(l0[i].x); S0.z = d[i].z * S0.z + bflo(l0[i].y); S0.w = d[i].w * S0.w + bfhi(l0[i].y);
      S1.x = d[i].x * S1.x + bflo(l1[i].x); S1.y = d[i].y * S1.y + bfhi(l1[i].x); S1.z = d[i].z * S1.z + bflo(l1[i].y); S1.w = d[i].w * S1.w + bfhi(l1[i].y);
    }
  }
  float* so = p.out + OUT_SP + (size_t)(chain * 128) * 128 + (size_t)(16 * kt + 4 * fq) * 128 + 32 * w + fr;
  so[0] = S0.x; so[128] = S0.y; so[256] = S0.z; so[384] = S0.w;
  so[16] = S1.x; so[128 + 16] = S1.y; so[256 + 16] = S1.z; so[384 + 16] = S1.w;
}

__device__ void attn_item(const Params& p, int kind, int bh, int qt, char* lds) {
  int tid_o = threadIdx.x; asm volatile("" : "+v"(tid_o)); const int tid = tid_o, lane = tid & 63, w = tid >> 6, fr = lane & 15, fq = lane >> 4;
  const int b = bh >> 3, h = bh & 7;
  const int nkt = kind == 0 ? qt + 1 : 17;
  const int tok0 = kind == 0 ? b * 4096 + qt * 64 : NPTOK + b * 64;
  const int qpos0 = kind == 0 ? qt * 64 : 1024;
  const bf16_t* Kb = kind == 0 ? (const bf16_t*)(p.ws + OFF_KP) + (size_t)bh * 4096 * 128
                               : (const bf16_t*)(p.ws + OFF_KS) + (size_t)bh * 1088 * 128;
  const bf16_t* Vb = kind == 0 ? (const bf16_t*)(p.ws + OFF_VTP) + (size_t)bh * 128 * 4096
                               : (const bf16_t*)(p.ws + OFF_VTS) + (size_t)bh * 128 * 1088;
  const int vstride = kind == 0 ? 4096 : 1088;
  const float slope2 = exp2f(-(float)(h + 1)) * 1.4426950408889634f;

  const int tok = tok0 + 16 * w + fr;
  bf16x8 qf[4];
  {
    const bf16_t* qp = (const bf16_t*)(p.ws + OFF_QB) + (size_t)tok * 1024 + h * 128;
#pragma unroll
    for (int ks = 0; ks < 4; ++ks) qf[ks] = *(const bf16x8*)(qp + 32 * ks + 8 * fq);
  }
  const float qposf = (float)(qpos0 + 16 * w + fr);
  float qk[2];
#pragma unroll
  for (int m = 0; m < 2; ++m) {
    float s2 = 0.f;
#pragma unroll
    for (int ks2 = 0; ks2 < 2; ++ks2)
#pragma unroll
      for (int e = 0; e < 8; ++e) { const float qv = bf2f((unsigned short)qf[2 * m + ks2][e]); s2 += qv * qv; }
    s2 += __shfl_xor(s2, 16);
    s2 += __shfl_xor(s2, 32);
    const float kmax2 = kind == 0 ? __uint_as_float(((const unsigned*)(p.ws + 256))[b * 16 + h * 2 + m]) : 3.0e38f;
    qk[m] = sqrtf(s2) * sqrtf(kmax2) * 1.02f;
  }
  f32x4 O0[8], O1[8];
#pragma unroll
  for (int i = 0; i < 8; ++i) { O0[i] = (f32x4){0.f, 0.f, 0.f, 0.f}; O1[i] = (f32x4){0.f, 0.f, 0.f, 0.f}; }
  float mx[2] = {-1e30f, -1e30f}, ls[2] = {0.f, 0.f};

  u32x4 rk[4], rv[4];
  {
    const int kkey = tid >> 4, kc = tid & 15, vrow = tid >> 3, vc = tid & 7;
    const int kt = nkt - 1;
#pragma unroll
    for (int i = 0; i < 4; ++i) {
      rk[i] = *(const u32x4*)(Kb + (size_t)(kt * 64 + kkey + 16 * i) * 128 + kc * 8);
      rv[i] = *(const u32x4*)(Vb + (size_t)(vrow + 32 * i) * vstride + kt * 64 + vc * 8);
    }
#pragma unroll
    for (int i = 0; i < 4; ++i) {
      const int key = kkey + 16 * i;
      *(u32x4*)(lds + key * 256 + ((kc ^ (key & 15)) << 4)) = rk[i];
      const int r = vrow + 32 * i;
      *(u32x4*)(lds + 16384 + r * 128 + ((vc ^ ((r >> 1) & 7)) << 4)) = rv[i];
    }
    if (nkt > 1) {
#pragma unroll
      for (int i = 0; i < 4; ++i) {
        rk[i] = *(const u32x4*)(Kb + (size_t)((kt - 1) * 64 + kkey + 16 * i) * 128 + kc * 8);
        rv[i] = *(const u32x4*)(Vb + (size_t)(vrow + 32 * i) * vstride + (kt - 1) * 64 + vc * 8);
      }
    }
    __syncthreads();
  }
  for (int it = 0; it < nkt; ++it) {
    int zz = 0; asm volatile("" : "+v"(zz));
    int tidv = threadIdx.x; asm volatile("" : "+v"(tidv));
    const int tid = tidv, lane = tid & 63, w = tid >> 6, fr = lane & 15, fq = lane >> 4;
    const int kkey = tid >> 4, kc = tid & 15, vrow = tid >> 3, vc = tid & 7;
    const int kt = nkt - 1 - it;
    char* L = lds + zz + (it & 1) * 32768;
    char* Ln = lds + zz + ((it + 1) & 1) * 32768;
    if (it + 1 < nkt) {
#pragma unroll
      for (int i = 0; i < 4; ++i) {
        const int key = kkey + 16 * i;
        *(u32x4*)(Ln + key * 256 + ((kc ^ (key & 15)) << 4)) = rk[i];
        const int r = vrow + 32 * i;
        *(u32x4*)(Ln + 16384 + r * 128 + ((vc ^ ((r >> 1) & 7)) << 4)) = rv[i];
      }
    }
    if (it + 2 < nkt) {
#pragma unroll
      for (int i = 0; i < 4; ++i) {
        rk[i] = *(const u32x4*)(Kb + (size_t)((kt - 2) * 64 + zz + kkey + 16 * i) * 128 + kc * 8);
        rv[i] = *(const u32x4*)(Vb + (size_t)(vrow + 32 * i) * vstride + (kt - 2) * 64 + zz + vc * 8);
      }
    }
    const float kposf = (float)(kt * 64 + 4 * fq) - qposf;
    bf16x8 pf[2][2];
    bool live[2];
#pragma unroll
    for (int m = 0; m < 2; ++m) {
      f32x4 s[4];
#pragma unroll
      for (int k16 = 0; k16 < 4; ++k16) {
        s[k16] = (f32x4){0.f, 0.f, 0.f, 0.f};
        const int key = 16 * k16 + fr;
#pragma unroll
        for (int ks2 = 0; ks2 < 2; ++ks2) {
          bf16x8 kf = *(const bf16x8*)(L + key * 256 + (((8 * m + 4 * ks2 + fq) ^ (key & 15)) << 4));
          s[k16] = mfma16(kf, qf[2 * m + ks2], s[k16]);
        }
      }
      float tmax = -1e30f;
#pragma unroll
      for (int k16 = 0; k16 < 4; ++k16)
#pragma unroll
        for (int j = 0; j < 4; ++j) {
          const float d = kposf + (float)(16 * k16 + j);
          const float v = s[k16][j] - slope2 * fabsf(d);
          s[k16][j] = v;
          tmax = fmaxf(tmax, v);
        }
      tmax = fmaxf(tmax, __shfl_xor(tmax, 16));
      tmax = fmaxf(tmax, __shfl_xor(tmax, 32));
      live[m] = !__all(tmax - mx[m] < -40.f);
      if (live[m]) {
        const float mnew = fmaxf(mx[m], tmax);
        const float alpha = __builtin_amdgcn_exp2f(mx[m] - mnew);
        mx[m] = mnew;
        float psum = 0.f;
#pragma unroll
        for (int k16 = 0; k16 < 4; ++k16)
#pragma unroll
          for (int j = 0; j < 4; ++j) { const float e = __builtin_amdgcn_exp2f(s[k16][j] - mnew); s[k16][j] = e; psum += e; }
        ls[m] = ls[m] * alpha + psum;
        if (m == 0) {
#pragma unroll
          for (int i = 0; i < 8; ++i) { O0[i].x *= alpha; O0[i].y *= alpha; O0[i].z *= alpha; O0[i].w *= alpha; }
        } else {
#pragma unroll
          for (int i = 0; i < 8; ++i) { O1[i].x *= alpha; O1[i].y *= alpha; O1[i].z *= alpha; O1[i].w *= alpha; }
        }
#pragma unroll
        for (int ks = 0; ks < 2; ++ks)
          pf[m][ks] = mk8(pk_bf16(s[2 * ks].x, s[2 * ks].y), pk_bf16(s[2 * ks].z, s[2 * ks].w),
                          pk_bf16(s[2 * ks + 1].x, s[2 * ks + 1].y), pk_bf16(s[2 * ks + 1].z, s[2 * ks + 1].w));
      } else {
#pragma unroll
        for (int ks = 0; ks < 2; ++ks) pf[m][ks] = mk8(0u, 0u, 0u, 0u);
      }
    }
    if (live[0] || live[1]) {
      __builtin_amdgcn_s_setprio(1);
#pragma unroll
      for (int vt = 0; vt < 8; ++vt) {
        const int r = 16 * vt + fr;
        const int rs = (r >> 1) & 7;
#pragma unroll
        for (int ks = 0; ks < 2; ++ks) {
          const int u0 = 8 * ks + fq, u1 = 8 * ks + 4 + fq;
          u32x2 a0 = *(const u32x2*)(L + 16384 + r * 128 + (((u0 >> 1) ^ rs) << 4) + ((u0 & 1) << 3));
          u32x2 a1 = *(const u32x2*)(L + 16384 + r * 128 + (((u1 >> 1) ^ rs) << 4) + ((u1 & 1) << 3));
          bf16x8 vf = mk8(a0, a1);
          O0[vt] = mfma16(vf, pf[0][ks], O0[vt]);
          O1[vt] = mfma16(vf, pf[1][ks], O1[vt]);
        }
      }
      __builtin_amdgcn_s_setprio(0);
    }
    const float dmin = qposf - (float)((kt - 1) * 64 + 63);
    const bool done = (kind == 0) && (qk[0] - slope2 * dmin - mx[0] < -40.f) && (qk[1] - slope2 * dmin - mx[1] < -40.f);
    if (__syncthreads_and(done ? 1 : 0)) break;
  }
  float l0 = ls[0], l1 = ls[1];
  l0 += __shfl_xor(l0, 16); l0 += __shfl_xor(l0, 32);
  l1 += __shfl_xor(l1, 16); l1 += __shfl_xor(l1, 32);
  const float lam = ((const float*)(p.ws + OFF_CTR))[16];
  const float i0 = 1.f / l0, i1 = lam / l1;
  float ssq = 0.f;
#pragma unroll
  for (int vt = 0; vt < 8; ++vt) {
#pragma unroll
    for (int j = 0; j < 4; ++j) {
      const float o = O0[vt][j] * i0 - O1[vt][j] * i1;
      O0[vt][j] = o;
      ssq += o * o;
    }
  }
  ssq += __shfl_xor(ssq, 16);
  ssq += __shfl_xor(ssq, 32);
  const float r = rsqrtf(ssq * (1.f / 128.f) + 1e-5f) * 0.8f;
  bf16_t* mo = (bf16_t*)(p.ws + OFF_MERGED) + (size_t)tok * 2048 + 1024 + h * 128;
#pragma unroll
  for (int vt = 0; vt < 8; ++vt) {
    f32x4 g = *(const f32x4*)(p.diff_g + 16 * vt + 4 * fq);
    u32x2 ov = {pk_bf16(O0[vt].x * r * g.x, O0[vt].y * r * g.y), pk_bf16(O0[vt].z * r * g.z, O0[vt].w * r * g.w)};
    *(u32x2*)(mo + 16 * vt + 4 * fq) = ov;
  }
}


__device__ void quant_item(const Params& p, int item) {
  int tid_o = threadIdx.x; asm volatile("" : "+v"(tid_o)); const int tid = tid_o, lane = tid & 63, w = tid >> 6;
  unsigned char* U8 = (unsigned char*)(p.ws + OFF_UB);
  float* SCL = (float*)(p.ws + OFF_SCL);
  for (int rr = 0; rr < 16; ++rr) {
    const int row = item * 64 + rr * 4 + w;
    const float* srow = row < 16384 ? p.pu + (size_t)row * 2048 : p.pv + (size_t)(row - 16384) * 2048;
    f32x4 v[8];
    float am = 0.f;
#pragma unroll
    for (int i = 0; i < 8; ++i) {
      v[i] = __builtin_nontemporal_load((const f32x4*)(srow + 256 * i + lane * 4));
      am = fmaxf(fmaxf(am, fmaxf(fabsf(v[i].x), fabsf(v[i].y))), fmaxf(fabsf(v[i].z), fabsf(v[i].w)));
    }
#pragma unroll
    for (int o = 32; o >= 1; o >>= 1) am = fmaxf(am, __shfl_xor(am, o));
    const float sc = am > 0.f ? 224.f / am : 1.f;
    unsigned char* drow = U8 + (size_t)row * 2048;
#pragma unroll
    for (int i = 0; i < 8; ++i) {
      int pk = __builtin_amdgcn_cvt_pk_fp8_f32(v[i].x * sc, v[i].y * sc, 0, false);
      pk = __builtin_amdgcn_cvt_pk_fp8_f32(v[i].z * sc, v[i].w * sc, pk, true);
      *(int*)(drow + 256 * i + lane * 4) = pk;
    }
    if (lane == 0) SCL[row] = am > 0.f ? am * (1.f / 224.f) : 1.f;
  }
}

__device__ void phase2(const Params& p, char* lds, int rep, int par) {
  unsigned* ctr = (unsigned*)(p.ws + OFF_CTR) + rep;
  int* sitem = (int*)lds;
  const int nA = par ? 2048 : 0;
  for (;;) {
    __syncthreads();
    if (threadIdx.x == 0) *sitem = (int)atomicAdd(ctr, 1u);
    __syncthreads();
    int item = *sitem;
    __syncthreads();
    if (item >= nA + 2208) break;
    if (item < nA) { hgrn_item(p, 0, (item & 31) >> 3, item & 7, lds, 1, item >> 5); continue; }
    item -= nA;
    if (item < 96) {
      const int kind = item < 32 ? 0 : 1, ii = item < 32 ? item : item - 32;
      if (kind == 0 && par) continue;
      hgrn_item(p, kind, ii >> 3, ii & 7, lds, 0, 0);
    } else {
      const int kind = item < 160 ? 1 : 0, j = item - 160;
      attn_item(p, kind, kind ? item - 96 : (j & 31), kind ? 0 : 63 - (j >> 5), lds);
    }
  }
}

__device__ void phase2b(const Params& p) {
  for (int item = blockIdx.x; item < 256; item += gridDim.x) hgrn_scan_item(p, item >> 3, item & 7);
}

__device__ void phase2c(const Params& p, char* lds) {
  for (int item = blockIdx.x; item < 2048; item += gridDim.x) {
    __syncthreads();
    hgrn_item(p, 0, (item & 31) >> 3, item & 7, lds, 2, item >> 5);
  }
}

__device__ void phase4(const Params& p) {
  int tid_o = threadIdx.x; asm volatile("" : "+v"(tid_o)); const int tid = tid_o, lane = tid & 63, w = tid >> 6;
  bf16_t* X1B = (bf16_t*)(p.ws + OFF_X1B);
  for (int row = blockIdx.x * 4 + w; row < NTOK; row += gridDim.x * 4) {
    bf16_t* xr = X1B + (size_t)row * 2048;
    float v[4][8];
    float s = 0.f;
#pragma unroll
    for (int i = 0; i < 4; ++i) {
      u32x4 t = *(const u32x4*)(xr + 512 * i + lane * 8);
      v[i][0] = bflo(t.x); v[i][1] = bfhi(t.x); v[i][2] = bflo(t.y); v[i][3] = bfhi(t.y);
      v[i][4] = bflo(t.z); v[i][5] = bfhi(t.z); v[i][6] = bflo(t.w); v[i][7] = bfhi(t.w);
#pragma unroll
      for (int e = 0; e < 8; ++e) s += v[i][e];
    }
    s = wave_sum(s);
    const float mean = s * (1.f / 2048.f);
    float q = 0.f;
#pragma unroll
    for (int i = 0; i < 4; ++i)
#pragma unroll
      for (int e = 0; e < 8; ++e) { const float d = v[i][e] - mean; q += d * d; }
    q = wave_sum(q);
    const float rs = rsqrtf(q * (1.f / 2048.f) + 1e-5f);
#pragma unroll
    for (int i = 0; i < 4; ++i) {
      const int col = 512 * i + lane * 8;
      f32x4 g0 = *(const f32x4*)(p.ln1_g + col), g1 = *(const f32x4*)(p.ln1_g + col + 4);
      f32x4 b0 = *(const f32x4*)(p.ln1_b + col), b1 = *(const f32x4*)(p.ln1_b + col + 4);
      u32x4 o;
      o.x = pk_bf16((v[i][0] - mean) * rs * g0.x + b0.x, (v[i][1] - mean) * rs * g0.y + b0.y);
      o.y = pk_bf16((v[i][2] - mean) * rs * g0.z + b0.z, (v[i][3] - mean) * rs * g0.w + b0.w);
      o.z = pk_bf16((v[i][4] - mean) * rs * g1.x + b1.x, (v[i][5] - mean) * rs * g1.y + b1.y);
      o.w = pk_bf16((v[i][6] - mean) * rs * g1.z + b1.z, (v[i][7] - mean) * rs * g1.w + b1.w);
      *(u32x4*)(xr + col) = o;
    }
  }
}

__device__ __forceinline__ unsigned f2key(float f) {
  unsigned b = __float_as_uint(f);
  return (b & 0x80000000u) ? ~b : (b | 0x80000000u);
}
__device__ __forceinline__ float key2f(unsigned k) {
  unsigned b = (k & 0x80000000u) ? (k & 0x7fffffffu) : ~k;
  return __uint_as_float(b);
}

__device__ __forceinline__ unsigned row_allmax(unsigned x) {
  x = max(x, (unsigned)__builtin_amdgcn_update_dpp(0, (int)x, 0x121, 0xF, 0xF, false));
  x = max(x, (unsigned)__builtin_amdgcn_update_dpp(0, (int)x, 0x122, 0xF, 0xF, false));
  x = max(x, (unsigned)__builtin_amdgcn_update_dpp(0, (int)x, 0x124, 0xF, 0xF, false));
  x = max(x, (unsigned)__builtin_amdgcn_update_dpp(0, (int)x, 0x128, 0xF, 0xF, false));
  return x;
}
__device__ __forceinline__ float row_allsum(float x) {
  x += __int_as_float(__builtin_amdgcn_update_dpp(0, __float_as_int(x), 0x121, 0xF, 0xF, false));
  x += __int_as_float(__builtin_amdgcn_update_dpp(0, __float_as_int(x), 0x122, 0xF, 0xF, false));
  x += __int_as_float(__builtin_amdgcn_update_dpp(0, __float_as_int(x), 0x124, 0xF, 0xF, false));
  x += __int_as_float(__builtin_amdgcn_update_dpp(0, __float_as_int(x), 0x128, 0xF, 0xF, false));
  return x;
}
#define CE_DESC(a, b) { const unsigned _hi = max(a, b), _lo = min(a, b); a = _hi; b = _lo; }

__device__ void phase6(const Params& p, char* lds) {
  int tid_o = threadIdx.x; asm volatile("" : "+v"(tid_o)); const int tid = tid_o, lane = tid & 63, w = tid >> 6, fr = lane & 15, fq = lane >> 4;
  const bf16_t* QP = (const bf16_t*)(p.ws + OFF_QP);
  const bf16_t* SKB = (const bf16_t*)(p.ws + OFF_SKB);
  int* EIDX = (int*)(p.ws + OFF_EIDX);
  float* GATE = (float*)(p.ws + OFF_GATE);
  const bool qfirst = blockIdx.x >= (gridDim.x >> 1);
  if (qfirst) for (int qi = blockIdx.x; qi < 512; qi += gridDim.x) quant_item(p, qi);
  unsigned char* tbl = (unsigned char*)lds;
  __syncthreads();
  if (tid < 64) tbl[tid] = 0xFF;
  __syncthreads();
  {
    const int i = tid >> 4, j = tid & 15;
    if ((i + 1) * (j + 1) <= 16) {
      int rank = j;
      for (int ii = 0; ii < i; ++ii) rank += 16 / (ii + 1);
      tbl[rank] = (unsigned char)((i << 4) | j);
    }
  }
  __syncthreads();
  int pi[4], pj[4]; bool pvalid[4];
#pragma unroll
  for (int s = 0; s < 4; ++s) {
    const int pidx = fr + 16 * s;
    const unsigned code = tbl[pidx];
    pvalid[s] = (pidx < 50);
    pi[s] = pvalid[s] ? (int)(code >> 4) : 0;
    pj[s] = pvalid[s] ? (int)(code & 15) : 0;
  }
  const int rowbase = lane & 48;
  __syncthreads();
  {
    const int hh = blockIdx.x & 7;
#pragma unroll 1
    for (int c = 0; c < 2; ++c)
#pragma unroll 4
      for (int i = 0; i < 8; ++i) {
        const int id = tid + 256 * i, key = id >> 4, ch = id & 15;
        u32x4 v = *(const u32x4*)(SKB + (size_t)((hh * 2 + c) * 128 + key) * 128 + ch * 8);
        *(u32x4*)(lds + c * 32768 + key * 256 + ((ch ^ (key & 15)) << 4)) = v;
      }
  }
  __syncthreads();
  for (int item = blockIdx.x; item < 264 * 8; item += gridDim.x) {
    int zz = 0; asm volatile("" : "+v"(zz));
    const char* L = lds + zz;
    const int tile = item >> 3, h = item & 7;
    const int tok0 = tile * 64;
    unsigned Lst[2][4];
#pragma unroll
    for (int c = 0; c < 2; ++c) {
      unsigned K[8][4];
      {
        bf16x8 af[4];
        const bf16_t* qp = QP + (size_t)(tok0 + 16 * w + fr) * 2048 + h * 256 + c * 128;
#pragma unroll
        for (int ks = 0; ks < 4; ++ks) af[ks] = *(const bf16x8*)(qp + 32 * ks + 8 * fq);
#pragma unroll
        for (int kt = 0; kt < 8; ++kt) {
          f32x4 a = {0.f, 0.f, 0.f, 0.f};
#pragma unroll
          for (int ks = 0; ks < 4; ++ks) {
            const int key = 16 * kt + fr;
            bf16x8 bfr = *(const bf16x8*)(L + c * 32768 + key * 256 + (((4 * ks + fq) ^ (key & 15)) << 4));
            a = mfma16(af[ks], bfr, a);
          }
          const unsigned code = (unsigned)(127 - (16 * kt + fr));
#pragma unroll
          for (int j = 0; j < 4; ++j) K[kt][j] = (f2key(a[j]) & ~127u) | code;
        }
      }
#pragma unroll
      for (int j = 0; j < 4; ++j) {
        CE_DESC(K[0][j], K[1][j]); CE_DESC(K[2][j], K[3][j]); CE_DESC(K[4][j], K[5][j]); CE_DESC(K[6][j], K[7][j]);
        CE_DESC(K[0][j], K[2][j]); CE_DESC(K[1][j], K[3][j]); CE_DESC(K[4][j], K[6][j]); CE_DESC(K[5][j], K[7][j]);
        CE_DESC(K[1][j], K[2][j]); CE_DESC(K[5][j], K[6][j]); CE_DESC(K[0][j], K[4][j]); CE_DESC(K[3][j], K[7][j]);
        CE_DESC(K[1][j], K[5][j]); CE_DESC(K[2][j], K[6][j]);
        CE_DESC(K[1][j], K[4][j]); CE_DESC(K[3][j], K[6][j]);
        CE_DESC(K[2][j], K[4][j]); CE_DESC(K[3][j], K[5][j]);
        CE_DESC(K[3][j], K[4][j]);
      }
      unsigned best[4] = {0u, 0u, 0u, 0u};
#pragma unroll 1
      for (int it = 0; it < 16; ++it) {
#pragma unroll
        for (int j = 0; j < 4; ++j) {
          const unsigned rm = row_allmax(K[0][j]);
          const bool win = (K[0][j] == rm);
#pragma unroll
          for (int k = 0; k < 7; ++k) K[k][j] = win ? K[k + 1][j] : K[k][j];
          K[7][j] = win ? 0u : K[7][j];
          best[j] = (fr == it) ? rm : best[j];
        }
      }
#pragma unroll
      for (int j = 0; j < 4; ++j) Lst[c][j] = best[j];
    }
#pragma unroll
    for (int j = 0; j < 4; ++j) {
      unsigned C[4];
#pragma unroll
      for (int s = 0; s < 4; ++s) {
        const unsigned k0 = (unsigned)__shfl((int)Lst[0][j], rowbase + pi[s]);
        const unsigned k1 = (unsigned)__shfl((int)Lst[1][j], rowbase + pj[s]);
        const float sum = key2f(k0 & ~127u) + key2f(k1 & ~127u);
        C[s] = pvalid[s] ? ((f2key(sum) & ~255u) | (unsigned)(255 - (pi[s] * 16 + pj[s]))) : 0u;
      }
      CE_DESC(C[0], C[1]); CE_DESC(C[2], C[3]); CE_DESC(C[0], C[2]); CE_DESC(C[1], C[3]); CE_DESC(C[1], C[2]);
      unsigned sel = 0u;
#pragma unroll 1
      for (int it = 0; it < 16; ++it) {
        const unsigned rm = row_allmax(C[0]);
        const bool win = (C[0] == rm);
        C[0] = win ? C[1] : C[0]; C[1] = win ? C[2] : C[1]; C[2] = win ? C[3] : C[2]; C[3] = win ? 0u : C[3];
        sel = (fr == it) ? rm : sel;
      }
      const float cv = key2f(sel & ~255u);
      const float cmax = __shfl(cv, rowbase);
      const float e = __expf(cv - cmax);
      const float g = e / row_allsum(e);
      const int flat = 255 - (int)(sel & 255u);
      const unsigned l0 = (unsigned)__shfl((int)Lst[0][j], rowbase + (flat >> 4));
      const unsigned l1 = (unsigned)__shfl((int)Lst[1][j], rowbase + (flat & 15));
      const int eidx = (127 - (int)(l0 & 127u)) * 128 + (127 - (int)(l1 & 127u));
      const size_t ob = ((size_t)(tok0 + 16 * w + 4 * fq + j) * 8 + h) * 16 + fr;
      EIDX[ob] = eidx;
      GATE[ob] = g;
    }
  }
  if (!qfirst) for (int qi = blockIdx.x; qi < 512; qi += gridDim.x) quant_item(p, qi);
}

__device__ __forceinline__ float dot16_fp8(u32x4 r, const float* x) {
  float d = 0.f;
  f32x2_t a;
  a = __builtin_amdgcn_cvt_pk_f32_fp8((int)r.x, false); d += a.x * x[0] + a.y * x[1];
  a = __builtin_amdgcn_cvt_pk_f32_fp8((int)r.x, true);  d += a.x * x[2] + a.y * x[3];
  a = __builtin_amdgcn_cvt_pk_f32_fp8((int)r.y, false); d += a.x * x[4] + a.y * x[5];
  a = __builtin_amdgcn_cvt_pk_f32_fp8((int)r.y, true);  d += a.x * x[6] + a.y * x[7];
  a = __builtin_amdgcn_cvt_pk_f32_fp8((int)r.z, false); d += a.x * x[8] + a.y * x[9];
  a = __builtin_amdgcn_cvt_pk_f32_fp8((int)r.z, true);  d += a.x * x[10] + a.y * x[11];
  a = __builtin_amdgcn_cvt_pk_f32_fp8((int)r.w, false); d += a.x * x[12] + a.y * x[13];
  a = __builtin_amdgcn_cvt_pk_f32_fp8((int)r.w, true);  d += a.x * x[14] + a.y * x[15];
  return d;
}
__device__ __forceinline__ void axpy16_fp8(u32x4 r, float w, float* acc) {
  f32x2_t a;
  a = __builtin_amdgcn_cvt_pk_f32_fp8((int)r.x, false); acc[0] += w * a.x; acc[1] += w * a.y;
  a = __builtin_amdgcn_cvt_pk_f32_fp8((int)r.x, true);  acc[2] += w * a.x; acc[3] += w * a.y;
  a = __builtin_amdgcn_cvt_pk_f32_fp8((int)r.y, false); acc[4] += w * a.x; acc[5] += w * a.y;
  a = __builtin_amdgcn_cvt_pk_f32_fp8((int)r.y, true);  acc[6] += w * a.x; acc[7] += w * a.y;
  a = __builtin_amdgcn_cvt_pk_f32_fp8((int)r.z, false); acc[8] += w * a.x; acc[9] += w * a.y;
  a = __builtin_amdgcn_cvt_pk_f32_fp8((int)r.z, true);  acc[10] += w * a.x; acc[11] += w * a.y;
  a = __builtin_amdgcn_cvt_pk_f32_fp8((int)r.w, false); acc[12] += w * a.x; acc[13] += w * a.y;
  a = __builtin_amdgcn_cvt_pk_f32_fp8((int)r.w, true);  acc[14] += w * a.x; acc[15] += w * a.y;
}

__device__ void phase7(const Params& p, char* lds) {
  int tid_o = threadIdx.x; asm volatile("" : "+v"(tid_o)); const int tid = tid_o, lane = tid & 63, w = tid >> 6;
  const bf16_t* X1B = (const bf16_t*)(p.ws + OFF_X1B);
  const unsigned char* U8 = (const unsigned char*)(p.ws + OFF_UB);
  const unsigned char* V8 = (const unsigned char*)(p.ws + OFF_VB);
  const float* SCL = (const float*)(p.ws + OFF_SCL);
  const int* EIDX = (const int*)(p.ws + OFF_EIDX);
  const float* GATE = (const float*)(p.ws + OFF_GATE);
  float* wgt = (float*)lds;
  float* red = (float*)(lds + 1024);
  float* part = (float*)(lds + 2048);
  for (int tok = blockIdx.x; tok < NTOK; tok += gridDim.x) {
    int tidv = threadIdx.x; asm volatile("" : "+v"(tidv));
    const int tid = tidv, lane = tid & 63, w = tid >> 6;
    const bf16_t* xr = X1B + (size_t)tok * 2048;
    float xa[2][16];
#pragma unroll
    for (int j = 0; j < 2; ++j)
#pragma unroll
      for (int q = 0; q < 2; ++q) {
        u32x4 t = __builtin_nontemporal_load((const u32x4*)(xr + 1024 * j + 16 * lane + 8 * q));
        xa[j][8 * q] = bflo(t.x); xa[j][8 * q + 1] = bfhi(t.x); xa[j][8 * q + 2] = bflo(t.y); xa[j][8 * q + 3] = bfhi(t.y);
        xa[j][8 * q + 4] = bflo(t.z); xa[j][8 * q + 5] = bfhi(t.z); xa[j][8 * q + 6] = bflo(t.w); xa[j][8 * q + 7] = bfhi(t.w);
      }
    __syncthreads();
#ifndef UR
#define UR 16
#endif
#ifndef VR
#define VR 16
#endif
#pragma unroll 1
    for (int k6 = 0; k6 < 32; k6 += UR) {
      u32x4 r[UR][2];
      int ee[UR];
#pragma unroll
      for (int kk = 0; kk < UR; ++kk) {
        const int kq = (k6 + kk < 32) ? (k6 + kk) : 31;
        ee[kk] = __builtin_amdgcn_readfirstlane(EIDX[(size_t)tok * 128 + w * 32 + kq]);
        const unsigned char* ur = U8 + (size_t)ee[kk] * 2048 + lane * 16;
        r[kk][0] = *(const u32x4*)ur;
        r[kk][1] = *(const u32x4*)(ur + 1024);
      }
      float dot[UR];
#pragma unroll
      for (int kk = 0; kk < UR; ++kk) dot[kk] = dot16_fp8(r[kk][0], xa[0]) + dot16_fp8(r[kk][1], xa[1]);
#pragma unroll
      for (int o = 32; o >= 1; o >>= 1) {
#pragma unroll
        for (int kk = 0; kk < UR; ++kk) dot[kk] += __shfl_xor(dot[kk], o);
      }
      if (lane < UR && k6 + lane < 32) {
        float a = dot[0]; int e = ee[0];
#pragma unroll
        for (int kk = 1; kk < UR; ++kk) { if (lane == kk) { a = dot[kk]; e = ee[kk]; } }
        const int k = w * 32 + k6 + lane;
        a *= SCL[e];
        const float ge = 0.5f * a * (1.f + erff(a * 0.70710678118654752f));
        wgt[k] = GATE[(size_t)tok * 128 + k] * ge * SCL[16384 + e];
      }
    }
    __syncthreads();
#pragma unroll 1
    for (int j = 0; j < 2; ++j) {
      float acc[16];
#pragma unroll
      for (int q = 0; q < 16; ++q) acc[q] = 0.f;
#pragma unroll 1
      for (int k6 = 0; k6 < 32; k6 += VR) {
        u32x4 r[VR];
        float ww[VR];
#pragma unroll
        for (int kk = 0; kk < VR; ++kk) {
          const int kq = (k6 + kk < 32) ? (k6 + kk) : 31;
          const int k = w * 32 + kq;
          const int e = __builtin_amdgcn_readfirstlane(EIDX[(size_t)tok * 128 + k]);
          ww[kk] = (k6 + kk < 32) ? wgt[k] : 0.f;
          r[kk] = *(const u32x4*)(V8 + (size_t)e * 2048 + 1024 * j + lane * 16);
        }
#pragma unroll
        for (int kk = 0; kk < VR; ++kk) axpy16_fp8(r[kk], ww[kk], acc);
      }
#pragma unroll
      for (int q = 0; q < 4; ++q)
        *(f32x4*)(part + w * 2048 + 1024 * j + 16 * lane + 4 * q) = (f32x4){acc[4 * q], acc[4 * q + 1], acc[4 * q + 2], acc[4 * q + 3]};
    }
    __syncthreads();
    const float al = 1.189207115002721f;
    const u32x4 xt = *(const u32x4*)(xr + tid * 8);
    f32x4 x0 = {bflo(xt.x), bfhi(xt.x), bflo(xt.y), bfhi(xt.y)}, x1 = {bflo(xt.z), bfhi(xt.z), bflo(xt.w), bfhi(xt.w)};
    f32x4 s0 = {0.f, 0.f, 0.f, 0.f}, s1 = {0.f, 0.f, 0.f, 0.f};
#pragma unroll
    for (int ww2 = 0; ww2 < 4; ++ww2) {
      f32x4 a0 = *(const f32x4*)(part + ww2 * 2048 + tid * 8), a1 = *(const f32x4*)(part + ww2 * 2048 + tid * 8 + 4);
      s0.x += a0.x; s0.y += a0.y; s0.z += a0.z; s0.w += a0.w; s1.x += a1.x; s1.y += a1.y; s1.z += a1.z; s1.w += a1.w;
    }
    float val[8] = {al * x0.x + s0.x, al * x0.y + s0.y, al * x0.z + s0.z, al * x0.w + s0.w,
                    al * x1.x + s1.x, al * x1.y + s1.y, al * x1.z + s1.z, al * x1.w + s1.w};
    float s = 0.f;
#pragma unroll
    for (int j = 0; j < 8; ++j) s += val[j];
    s = wave_sum(s);
    if (lane == 0) red[w] = s;
    __syncthreads();
    const float mean = (red[0] + red[1] + red[2] + red[3]) * (1.f / 2048.f);
    float q = 0.f;
#pragma unroll
    for (int j = 0; j < 8; ++j) { const float d = val[j] - mean; q += d * d; }
    q = wave_sum(q);
    if (lane == 0) red[4 + w] = q;
    __syncthreads();
    const float rs = rsqrtf((red[4] + red[5] + red[6] + red[7]) * (1.f / 2048.f) + 1e-5f);
    f32x4 g0 = *(const f32x4*)(p.ln2_g + tid * 8), g1 = *(const f32x4*)(p.ln2_g + tid * 8 + 4);
    f32x4 b0 = *(const f32x4*)(p.ln2_b + tid * 8), b1 = *(const f32x4*)(p.ln2_b + tid * 8 + 4);
    f32x4 o0 = {(val[0] - mean) * rs * g0.x + b0.x, (val[1] - mean) * rs * g0.y + b0.y, (val[2] - mean) * rs * g0.z + b0.z, (val[3] - mean) * rs * g0.w + b0.w};
    f32x4 o1 = {(val[4] - mean) * rs * g1.x + b1.x, (val[5] - mean) * rs * g1.y + b1.y, (val[6] - mean) * rs * g1.z + b1.z, (val[7] - mean) * rs * g1.w + b1.w};
    float* yo = p.out + OUT_Y + (size_t)tok * 2048 + tid * 8;
    __builtin_nontemporal_store(o0, (f32x4*)yo);
    __builtin_nontemporal_store(o1, (f32x4*)(yo + 4));
  }
}

__device__ __forceinline__ void grid_bar(unsigned* ctr, unsigned target) {
  asm volatile("s_waitcnt vmcnt(0)" ::: "memory");
  __syncthreads();
  if (threadIdx.x == 0) {
    __builtin_amdgcn_fence(__ATOMIC_RELEASE, "agent");
    asm volatile("s_waitcnt vmcnt(0)" ::: "memory");
    __hip_atomic_fetch_add(ctr, 1u, __ATOMIC_RELAXED, __HIP_MEMORY_SCOPE_AGENT);
    while (__hip_atomic_load(ctr, __ATOMIC_RELAXED, __HIP_MEMORY_SCOPE_AGENT) < target) __builtin_amdgcn_s_sleep(2);
    __builtin_amdgcn_fence(__ATOMIC_ACQUIRE, "agent");
    asm volatile("s_waitcnt vmcnt(0)" ::: "memory");
  }
  __syncthreads();
}

__global__ void __launch_bounds__(256, 2) mega(Params p, int ph_lo, int ph_hi, int use_sync) {
  __shared__ __attribute__((aligned(16))) char lds[LDS_BYTES];
  cg::grid_group grid = cg::this_grid();
  unsigned nbar = 0;
#ifndef DUP_PHASE
#define DUP_PHASE -1
#endif
  const int par = (use_sync == 3);
  const int nph = par ? 10 : 8;
  for (int pi = 0; pi < nph; ++pi) {
    const int ph = par ? (pi < 3 ? pi : (pi < 5 ? pi + 5 : pi - 2)) : pi;
    const int reps = (ph == DUP_PHASE) ? 2 : 1;
    for (int rep = 0; rep < reps; ++rep) {
      switch (ph) {
        case 0: phase0(p, lds); break;
        case 1: phase1(p, lds); break;
        case 2: phase2(p, lds, rep, par); break;
        case 8: phase2b(p); break;
        case 9: phase2c(p, lds); break;
        case 3: gemm23<0>(p, lds); break;
        case 4: phase4(p); break;
        case 5: gemm23<1>(p, lds); break;
        case 6: phase6(p, lds); break;
        case 7: phase7(p, lds); break;
      }
      if (pi + 1 < nph || rep + 1 < reps) {
        if (use_sync == 2) grid.sync();
        else grid_bar((unsigned*)(p.ws + 128), (unsigned)gridDim.x * (++nbar));
      }
    }
  }
}

extern "C" void kernel_launch(void* const* d_in, const int* in_sizes, int n_in, void* d_out, int out_size,
                              void* d_ws, size_t ws_size, hipStream_t stream) {
  static int grid_blocks = 0;
  if (!grid_blocks) {
    int dev = 0, cus = 0, per_cu = 0;
    hipGetDevice(&dev);
    hipDeviceGetAttribute(&cus, hipDeviceAttributeMultiprocessorCount, dev);
    hipOccupancyMaxActiveBlocksPerMultiprocessor(&per_cu, mega, 256, 0);
    if (per_cu > 2) per_cu = 2;
    if (per_cu < 1) per_cu = 1;
    grid_blocks = cus * per_cu;
    grid_blocks &= ~7;
  }
  Params p{};
  p.x_prompt = (const float*)d_in[0]; p.x_sample = (const float*)d_in[1]; p.cache_k = (const float*)d_in[2];
  p.cache_v = (const float*)d_in[3]; p.state = (const float*)d_in[4]; p.w_in = (const float*)d_in[5];
  p.hgrn_lb = (const float*)d_in[6]; p.hgrn_g = (const float*)d_in[7]; p.lq1 = (const float*)d_in[8];
  p.lk1 = (const float*)d_in[9]; p.lq2 = (const float*)d_in[10]; p.lk2 = (const float*)d_in[11];
  p.diff_g = (const float*)d_in[12]; p.w_out = (const float*)d_in[13]; p.ln1_g = (const float*)d_in[14];
  p.ln1_b = (const float*)d_in[15]; p.wq = (const float*)d_in[16]; p.subk = (const float*)d_in[17];
  p.pu = (const float*)d_in[18]; p.pv = (const float*)d_in[19]; p.ln2_g = (const float*)d_in[20];
  p.ln2_b = (const float*)d_in[21];
  p.out = (float*)d_out; p.ws = (char*)d_ws;
  hipMemsetAsync(d_ws, 0, 512, stream);
  int lo = 0, hi = 7, us = 3;
  void* args[] = {&p, &lo, &hi, &us};
  hipError_t e = hipLaunchCooperativeKernel((const void*)mega, dim3(grid_blocks), dim3(256), args, 0, stream);
  if (e != hipSuccess) fprintf(stderr, "cooperative launch failed: %s (grid %d)\n", hipGetErrorString(e), grid_blocks);
}
```
